# Optimizing an MI355X kernel written in HIP

```python
import jax, jax.numpy as jnp
from jax import lax
import numpy as np

D_MODEL = 1024
BATCH = 4
SEQ = 8192
DEPTH = 1
DEC_BATCH = 128
DEC_SEQ = 1
PAST_LEN = 16384
PAGE_SIZE = 128

N_HEADS = 8
Q_LORA = 256
KV_LORA = 128
QK_NOPE = 64
QK_ROPE = 32
V_HEAD = 64
MLA_WIDTH = N_HEADS * V_HEAD
ROPE_THETA = 10000.0
MLA_SCALE = (QK_NOPE + QK_ROPE) ** -0.5
CONV_WIDTH = 256
CONV_K = 3
N_MEM = 256
MEM_HEADS = 4
MEM_HEAD_DIM = 64
MEM_WIDTH = MEM_HEADS * MEM_HEAD_DIM
MEM_SCALE = MEM_HEAD_DIM ** -0.5
D_MIX = MLA_WIDTH + CONV_WIDTH + MEM_WIDTH
D_FF = 2816
EPS = 1e-6
Q_BLOCK = 128
IN_SPLIT_SIZES = (Q_LORA, KV_LORA, QK_ROPE, CONV_WIDTH, CONV_WIDTH, CONV_WIDTH, MEM_WIDTH)
IN_WIDTH = Q_LORA + KV_LORA + QK_ROPE + 3 * CONV_WIDTH + MEM_WIDTH

kernel_name = "hymba_mla_shortconv_memory_macaron_step"


def rmsnorm(x, g):
    xf = x.astype(jnp.float32)
    inv = lax.rsqrt(jnp.mean(xf * xf, axis=-1, keepdims=True) + EPS)
    return (xf * inv * g.astype(jnp.float32)).astype(x.dtype)


def swiglu(x, w_gate, w_up, w_down):
    return (jax.nn.silu(x @ w_gate) * (x @ w_up)) @ w_down


def rope_cos_sin(pos):
    inv_freq = ROPE_THETA ** (-jnp.arange(0, QK_ROPE, 2, dtype=jnp.float32) / QK_ROPE)
    ang = pos.astype(jnp.float32)[:, None] * inv_freq[None, :]
    return jnp.cos(ang), jnp.sin(ang)


def apply_rope(x, cos, sin):
    xf = x.astype(jnp.float32)
    x1, x2 = jnp.split(xf, 2, axis=-1)
    return jnp.concatenate([x1 * cos - x2 * sin, x1 * sin + x2 * cos], axis=-1).astype(x.dtype)


def pre_mix(x, cos, sin, g_ffn1, w1_gate, w1_up, w1_down, g_mix, w_in, g_q_lora, w_uq, g_qn, g_qr,
            g_kv_lora, g_kr, g_mq):
    x = x + 0.5 * swiglu(rmsnorm(x, g_ffn1), w1_gate, w1_up, w1_down)
    h = rmsnorm(x, g_mix)
    z = h @ w_in
    split_at = np.cumsum(IN_SPLIT_SIZES)[:-1].tolist()
    c_q, c_kv, k_r, u_in, gate_b, gate_c, m_q = jnp.split(z, split_at, axis=-1)
    B, T = x.shape[0], x.shape[1]
    q = (rmsnorm(c_q, g_q_lora) @ w_uq).reshape(B, T, N_HEADS, QK_NOPE + QK_ROPE)
    q_nope = rmsnorm(q[..., :QK_NOPE], g_qn)
    q_rope = apply_rope(rmsnorm(q[..., QK_NOPE:], g_qr), cos[:, None, :], sin[:, None, :])
    c_kv = rmsnorm(c_kv, g_kv_lora)
    k_rope = apply_rope(rmsnorm(k_r, g_kr), cos, sin)
    u = gate_c * u_in
    m_q = rmsnorm(m_q.reshape(B, T, MEM_HEADS, MEM_HEAD_DIM), g_mq)
    return x, q_nope, q_rope, c_kv, k_rope, u, gate_b, m_q


def latent_to_kv(c_kv, w_uk, w_uv, g_kn):
    k_nope = rmsnorm(jnp.einsum("bkl,lhd->bkhd", c_kv, w_uk), g_kn)
    v = jnp.einsum("bkl,lhd->bkhd", c_kv, w_uv)
    return k_nope, v


def mla_scores(q_nope, q_rope, k_nope, k_rope):
    s = jnp.einsum("bthd,bkhd->bhtk", q_nope, k_nope, preferred_element_type=jnp.float32)
    s = s + jnp.einsum("bthr,bkr->bhtk", q_rope, k_rope, preferred_element_type=jnp.float32)
    return s * MLA_SCALE


def mla_prompt(q_nope, q_rope, c_kv, k_rope, w_uk, w_uv, g_kn):
    B, S = q_nope.shape[0], q_nope.shape[1]
    k_nope, v = latent_to_kv(c_kv, w_uk, w_uv, g_kn)
    n_blk = S // Q_BLOCK
    qn_b = q_nope.reshape(B, n_blk, Q_BLOCK, N_HEADS, QK_NOPE).transpose(1, 0, 2, 3, 4)
    qr_b = q_rope.reshape(B, n_blk, Q_BLOCK, N_HEADS, QK_ROPE).transpose(1, 0, 2, 3, 4)
    key_pos = jnp.arange(S)

    def block(args):
        i, qn, qr = args
        s = mla_scores(qn, qr, k_nope, k_rope)
        q_pos = i * Q_BLOCK + jnp.arange(Q_BLOCK)
        mask = key_pos[None, :] <= q_pos[:, None]
        p = jax.nn.softmax(jnp.where(mask, s, -jnp.inf), axis=-1).astype(v.dtype)
        return jnp.einsum("bhqk,bkhd->bqhd", p, v)

    o = lax.map(block, (jnp.arange(n_blk), qn_b, qr_b))
    return o.transpose(1, 0, 2, 3, 4).reshape(B, S, MLA_WIDTH)


def mla_sample(q_nope, q_rope, c_kv_new, k_rope_new, cache_ckv, cache_krope, page_table, w_uk, w_uv, g_kn):
    B, T = q_nope.shape[0], q_nope.shape[1]

    def merge(carry, s, v):
        m, l, acc = carry
        m_new = jnp.maximum(m, jnp.max(s, axis=-1))
        corr = jnp.exp(m - m_new)
        p = jnp.exp(s - m_new[..., None])
        l_new = l * corr + jnp.sum(p, axis=-1)
        acc_new = acc * corr[..., None] + jnp.einsum("bhtk,bkhd->bhtd", p, v.astype(jnp.float32))
        return (m_new, l_new, acc_new)

    def page_step(carry, page_ids):
        ckv = cache_ckv[page_ids]
        kr = cache_krope[page_ids]
        k_nope, v = latent_to_kv(ckv, w_uk, w_uv, g_kn)
        s = mla_scores(q_nope, q_rope, k_nope, kr)
        return merge(carry, s, v), None

    init = (jnp.full((B, N_HEADS, T), -jnp.inf, jnp.float32),
            jnp.zeros((B, N_HEADS, T), jnp.float32),
            jnp.zeros((B, N_HEADS, T, V_HEAD), jnp.float32))
    carry, _ = lax.scan(page_step, init, page_table.T)
    k_nope, v = latent_to_kv(c_kv_new, w_uk, w_uv, g_kn)
    s = mla_scores(q_nope, q_rope, k_nope, k_rope_new)
    causal = jnp.arange(T)[None, :] <= jnp.arange(T)[:, None]
    m, l, acc = merge(carry, jnp.where(causal, s, -jnp.inf), v)
    o = (acc / l[..., None]).astype(q_nope.dtype)
    return o.transpose(0, 2, 1, 3).reshape(B, T, MLA_WIDTH)


def short_conv(u_ext, conv_w):
    T = u_ext.shape[1] - (CONV_K - 1)
    y = conv_w[0] * u_ext[:, 0:T]
    for k in range(1, CONV_K):
        y = y + conv_w[k] * u_ext[:, k:k + T]
    return y


def mem_kv(mem, g_mem, w_mem_k, w_mem_v, g_mk):
    B, N = mem.shape[0], mem.shape[1]
    hm = rmsnorm(mem, g_mem)
    k = rmsnorm((hm @ w_mem_k).reshape(B, N, MEM_HEADS, MEM_HEAD_DIM), g_mk)
    v = (hm @ w_mem_v).reshape(B, N, MEM_HEADS, MEM_HEAD_DIM)
    return k, v


def mem_attend(m_q, mem_k, mem_v):
    B, T = m_q.shape[0], m_q.shape[1]
    s = jnp.einsum("bthd,bnhd->bhtn", m_q, mem_k, preferred_element_type=jnp.float32) * MEM_SCALE
    p = jax.nn.softmax(s, axis=-1).astype(mem_v.dtype)
    return jnp.einsum("bhtn,bnhd->bthd", p, mem_v).reshape(B, T, MEM_WIDTH)


def post_mix(x, o_mla, y_conv, o_mem, g_out_mla, g_out_conv, g_out_mem, w_o, g_ffn2, w2_gate, w2_up, w2_down):
    o = jnp.concatenate([rmsnorm(o_mla, g_out_mla), rmsnorm(y_conv, g_out_conv), rmsnorm(o_mem, g_out_mem)], axis=-1)
    x = x + o @ w_o
    return x + 0.5 * swiglu(rmsnorm(x, g_ffn2), w2_gate, w2_up, w2_down)


def setup_inputs(seed: int = 0) -> dict:
    key = jax.random.key(seed)
    ks = iter(jax.random.split(key, 48))

    def nrm(shape, scale=1.0):
        return jax.random.normal(next(ks), shape, jnp.float32) * scale

    def gain(width):
        return 1.0 + nrm((DEPTH, width), 0.05)

    n_pages = PAST_LEN // PAGE_SIZE
    n_used = DEC_BATCH * n_pages
    n_phys = n_used + n_used // 4
    page_table = jax.random.permutation(next(ks), n_phys)[:n_used].reshape(DEC_BATCH, n_pages).astype(jnp.int32)
    return {
        "x_prompt": nrm((BATCH, SEQ, D_MODEL)),
        "mem_prompt": nrm((BATCH, N_MEM, D_MODEL)),
        "x_sample": nrm((DEC_BATCH, DEC_SEQ, D_MODEL)),
        "cache_ckv": nrm((DEPTH, n_phys, PAGE_SIZE, KV_LORA)),
        "cache_krope": nrm((DEPTH, n_phys, PAGE_SIZE, QK_ROPE)),
        "page_table": page_table,
        "state_conv": nrm((DEPTH, DEC_BATCH, CONV_K - 1, CONV_WIDTH)),
        "cache_mem_k": nrm((DEPTH, DEC_BATCH, N_MEM, MEM_HEADS, MEM_HEAD_DIM)),
        "cache_mem_v": nrm((DEPTH, DEC_BATCH, N_MEM, MEM_HEADS, MEM_HEAD_DIM)),
        "g_ffn1": gain(D_MODEL),
        "w1_gate": nrm((DEPTH, D_MODEL, D_FF), D_MODEL ** -0.5),
        "w1_up": nrm((DEPTH, D_MODEL, D_FF), D_MODEL ** -0.5),
        "w1_down": nrm((DEPTH, D_FF, D_MODEL), D_FF ** -0.5),
        "g_mix": gain(D_MODEL),
        "w_in": nrm((DEPTH, D_MODEL, IN_WIDTH), D_MODEL ** -0.5),
        "g_q_lora": gain(Q_LORA),
        "w_uq": nrm((DEPTH, Q_LORA, N_HEADS * (QK_NOPE + QK_ROPE)), Q_LORA ** -0.5),
        "g_qn": gain(QK_NOPE),
        "g_qr": gain(QK_ROPE),
        "g_kv_lora": gain(KV_LORA),
        "w_uk": nrm((DEPTH, KV_LORA, N_HEADS, QK_NOPE), KV_LORA ** -0.5),
        "w_uv": nrm((DEPTH, KV_LORA, N_HEADS, V_HEAD), KV_LORA ** -0.5),
        "g_kn": gain(QK_NOPE),
        "g_kr": gain(QK_ROPE),
        "conv_w": nrm((DEPTH, CONV_K, CONV_WIDTH), CONV_K ** -0.5),
        "g_mem": gain(D_MODEL),
        "w_mem_k": nrm((DEPTH, D_MODEL, MEM_WIDTH), D_MODEL ** -0.5),
        "w_mem_v": nrm((DEPTH, D_MODEL, MEM_WIDTH), D_MODEL ** -0.5),
        "g_mq": gain(MEM_HEAD_DIM),
        "g_mk": gain(MEM_HEAD_DIM),
        "g_out_mla": gain(MLA_WIDTH),
        "g_out_conv": gain(CONV_WIDTH),
        "g_out_mem": gain(MEM_WIDTH),
        "w_o": nrm((DEPTH, D_MIX, D_MODEL), D_MIX ** -0.5),
        "g_ffn2": gain(D_MODEL),
        "w2_gate": nrm((DEPTH, D_MODEL, D_FF), D_MODEL ** -0.5),
        "w2_up": nrm((DEPTH, D_MODEL, D_FF), D_MODEL ** -0.5),
        "w2_down": nrm((DEPTH, D_FF, D_MODEL), D_FF ** -0.5),
    }


def reference(x_prompt, mem_prompt, x_sample, cache_ckv, cache_krope, page_table, state_conv, cache_mem_k,
              cache_mem_v, g_ffn1, w1_gate, w1_up, w1_down, g_mix, w_in, g_q_lora, w_uq, g_qn, g_qr, g_kv_lora,
              w_uk, w_uv, g_kn, g_kr, conv_w, g_mem, w_mem_k, w_mem_v, g_mq, g_mk, g_out_mla, g_out_conv,
              g_out_mem, w_o, g_ffn2, w2_gate, w2_up, w2_down):
    cos_p, sin_p = rope_cos_sin(jnp.arange(SEQ))
    cos_s, sin_s = rope_cos_sin(PAST_LEN + jnp.arange(DEC_SEQ))
    xp, xs = x_prompt, x_sample
    ckv_p_l, kr_p_l, conv_p_l, mk_p_l, mv_p_l = [], [], [], [], []
    ckv_s_l, kr_s_l, conv_s_l = [], [], []
    for l in range(DEPTH):
        pre_w = (g_ffn1[l], w1_gate[l], w1_up[l], w1_down[l], g_mix[l], w_in[l], g_q_lora[l], w_uq[l],
                 g_qn[l], g_qr[l], g_kv_lora[l], g_kr[l], g_mq[l])
        post_w = (g_out_mla[l], g_out_conv[l], g_out_mem[l], w_o[l], g_ffn2[l], w2_gate[l], w2_up[l], w2_down[l])

        xp, qn, qr, ckv, kr, u, gb, mq = pre_mix(xp, cos_p, sin_p, *pre_w)
        o_mla = mla_prompt(qn, qr, ckv, kr, w_uk[l], w_uv[l], g_kn[l])
        u_ext = jnp.pad(u, ((0, 0), (CONV_K - 1, 0), (0, 0)))
        y_conv = gb * short_conv(u_ext, conv_w[l])
        mk, mv = mem_kv(mem_prompt, g_mem[l], w_mem_k[l], w_mem_v[l], g_mk[l])
        o_mem = mem_attend(mq, mk, mv)
        xp = post_mix(xp, o_mla, y_conv, o_mem, *post_w)
        ckv_p_l.append(ckv)
        kr_p_l.append(kr)
        conv_p_l.append(u[:, -(CONV_K - 1):])
        mk_p_l.append(mk)
        mv_p_l.append(mv)

        xs, qn, qr, ckv, kr, u, gb, mq = pre_mix(xs, cos_s, sin_s, *pre_w)
        o_mla = mla_sample(qn, qr, ckv, kr, cache_ckv[l], cache_krope[l], page_table, w_uk[l], w_uv[l], g_kn[l])
        u_ext = jnp.concatenate([state_conv[l].astype(u.dtype), u], axis=1)
        y_conv = gb * short_conv(u_ext, conv_w[l])
        o_mem = mem_attend(mq, cache_mem_k[l], cache_mem_v[l])
        xs = post_mix(xs, o_mla, y_conv, o_mem, *post_w)
        ckv_s_l.append(ckv)
        kr_s_l.append(kr)
        conv_s_l.append(u_ext[:, -(CONV_K - 1):])

    return (xp, xs, jnp.stack(ckv_p_l), jnp.stack(kr_p_l), jnp.stack(conv_p_l), jnp.stack(mk_p_l),
            jnp.stack(mv_p_l), jnp.stack(ckv_s_l), jnp.stack(kr_s_l), jnp.stack(conv_s_l))
```

```cpp
#include <hip/hip_runtime.h>
#include <cstdint>
#include <cstdio>
#include <cmath>
#define DBG_ORACLE 0
#define DBG_TOL 0.03f
namespace pg8 {
#define PG8_LAS __attribute__((address_space(3)))
typedef unsigned short bf16_t;
typedef short bf16x8 __attribute__((ext_vector_type(8)));
typedef float f32x4 __attribute__((ext_vector_type(4)));
typedef unsigned u32x4 __attribute__((ext_vector_type(4)));
constexpr int BM = 256, BK = 64, HALF = 128, HTB = HALF * BK * 2  , STAGE_BYTES = 8 * HTB, NXCD = 8, WGM = 8;

__host__ __device__ __forceinline__ int lds_byte(int r, int c) { const int st = (r >> 4) * 2 + (c >> 5), rr = r & 15, cc = c & 31, ob = rr * 64 + cc * 2; return st * 1024 + (ob ^ (((ob >> 9) & 1) << 5)); }
__host__ __device__ __forceinline__ void stage_rc(int b, int& R, int& C) { const int st = b / 1024, sb = b % 1024, swz = sb ^ (((sb >> 9) & 1) << 5); R = (st >> 1) * 16 + swz / 64; C = (st & 1) * 32 + (swz % 64) / 2; }
__host__ __device__ __forceinline__ int perm32(int rho) { const int n = rho >> 4, i = rho & 15; return 8 * (i >> 2) + 4 * n + (i & 3); }

struct Unit { int pm, pn; };
struct Gemm { const bf16_t* A; const bf16_t* Bt; int M, N, K; };

struct StaticOrder {
    int nM, nN, nwg, G, c;
    __host__ __device__ void init(int M, int N, int G_, int c_) { nM = M / BM; nN = N / BM; nwg = nM * nN; G = G_; c = c_; }
    __host__ __device__ bool next(int i, Unit& u) const {
        const long L = (long)i * G + c; if (L >= nwg) return false;
        int wgid = (int)L; { const int q = nwg / NXCD, r = nwg % NXCD, xcd = wgid % NXCD, off = wgid / NXCD; wgid = (xcd < r ? xcd * (q + 1) : r * (q + 1) + (xcd - r) * q) + off; }
        const int nig = WGM * nN, gid = wgid / nig, fm = gid * WGM, gsz = (nM - fm) < WGM ? (nM - fm) : WGM;
        u.pm = fm + ((wgid % nig) % gsz); u.pn = (wgid % nig) / gsz; return true;
    }
    __device__ __forceinline__ void a_ready(const Unit&) const {}
    __device__ __forceinline__ void done(const Unit&) const {}
};

__device__ __forceinline__ unsigned cvt_pk_bf16(float lo, float hi) { typedef float f2_ __attribute__((ext_vector_type(2))); typedef __bf16 b2_ __attribute__((ext_vector_type(2))); const f2_ v = {lo, hi}; const b2_ b = __builtin_convertvector(v, b2_); return __builtin_bit_cast(unsigned, b); }
typedef float f32x2 __attribute__((ext_vector_type(2)));
constexpr int kNTOK = 32768, kMR = 32896, kSEQ = 8192;
constexpr float kEPS = 1e-6f;
constexpr float kLOG2E = 1.4426950408889634f;
constexpr float kC2Q = 0.10206207261596577f * 1.4426950408889634f;
constexpr float kC2M = 0.125f * 1.4426950408889634f;
typedef unsigned u32x2 __attribute__((ext_vector_type(2)));
__device__ __forceinline__ int fresh_lane() { int l; asm volatile("v_mbcnt_lo_u32_b32 %0, -1, 0\n\tv_mbcnt_hi_u32_b32 %0, -1, %0" : "=v"(l)); return l; }

__device__ __forceinline__ float row_inv_from_parts(const float* parts, int row) {
    const f32x4* p = (const f32x4*)(parts + (size_t)row * 16);
    const f32x4 a = p[0], b = p[1], c = p[2], d = p[3];
    const float s = ((a[0] + a[1]) + (a[2] + a[3])) + ((b[0] + b[1]) + (b[2] + b[3])) + ((c[0] + c[1]) + (c[2] + c[3])) + ((d[0] + d[1]) + (d[2] + d[3]));
    return __builtin_amdgcn_rsqf(s * (1.0f / 1024.0f) + kEPS);
}
__device__ __forceinline__ float silu_mul(float g, float u) {
    const float e = __builtin_amdgcn_exp2f(-g * kLOG2E);
    return g * __builtin_amdgcn_rcpf(1.0f + e) * u;
}

struct EpiSwiGLU {
    static constexpr bool PERM = true, AFTER_DRAIN = false;
    const float* ssq; bf16_t* act; int ldact;
    __device__ __forceinline__ void operator()(const f32x4 (&acc)[2][2][4][2], const Unit& u, int wr, int wc, int fr_, int fq_) const {
        const int ln_ = fresh_lane(), fr = ln_ & 15, fq = ln_ >> 4; (void)fr_; (void)fq_;
#pragma unroll
        for (int ai = 0; ai < 2; ++ai)
#pragma unroll
            for (int m = 0; m < 4; ++m) {
                const int row = u.pm * BM + ai * HALF + wr * 64 + m * 16 + fr;
                const float inv = row_inv_from_parts(ssq, row);
                const f32x4 g0 = acc[ai][0][m][0] * inv, g1 = acc[ai][0][m][1] * inv, u0 = acc[ai][1][m][0] * inv, u1 = acc[ai][1][m][1] * inv;
                u32x4 w;
                w.x = cvt_pk_bf16(silu_mul(g0[0], u0[0]), silu_mul(g0[1], u0[1])); w.y = cvt_pk_bf16(silu_mul(g0[2], u0[2]), silu_mul(g0[3], u0[3]));
                w.z = cvt_pk_bf16(silu_mul(g1[0], u1[0]), silu_mul(g1[1], u1[1])); w.w = cvt_pk_bf16(silu_mul(g1[2], u1[2]), silu_mul(g1[3], u1[3]));
                *(u32x4*)(act + (size_t)row * ldact + u.pn * 128 + wc * 32 + 8 * fq) = w;
                if (m & 1) asm volatile("" ::: "memory");
            }
    }
};

struct EpiResid {
    static constexpr bool PERM = true, AFTER_DRAIN = false;
    const float* base0; const float* base1; float* out0; float* out1; bf16_t* ob; float* ssq_out; float scale;
    __device__ __forceinline__ void operator()(const f32x4 (&acc)[2][2][4][2], const Unit& u, int wr, int wc, int fr_, int fq_) const {
        const int ln_ = fresh_lane(), fr = ln_ & 15, fq = ln_ >> 4; (void)fr_; (void)fq_;
#pragma unroll
        for (int ai = 0; ai < 2; ++ai)
#pragma unroll
            for (int m = 0; m < 4; ++m) {
                const int row = u.pm * BM + ai * HALF + wr * 64 + m * 16 + fr;
                const bool live = row < kMR;
                const int rr = row < kNTOK ? row : row - kNTOK;
                const float* bp = (row < kNTOK ? base0 : base1) + (size_t)rr * 1024;
                float* op = (row < kNTOK ? out0 : out1) + (size_t)rr * 1024;
                float s = 0.f;
#pragma unroll
                for (int bj = 0; bj < 2; ++bj) {
                    const int col = u.pn * BM + bj * HALF + wc * 32 + 8 * fq;
                    f32x4 v0 = (f32x4){0.f, 0.f, 0.f, 0.f}, v1 = v0;
                    if (live) { v0 = *(const f32x4*)(bp + col); v1 = *(const f32x4*)(bp + col + 4); }
                    v0 = v0 + acc[ai][bj][m][0] * scale; v1 = v1 + acc[ai][bj][m][1] * scale;
                    s += (v0[0] * v0[0] + v0[1] * v0[1]) + (v0[2] * v0[2] + v0[3] * v0[3]) + (v1[0] * v1[0] + v1[1] * v1[1]) + (v1[2] * v1[2] + v1[3] * v1[3]);
                    if (live) {
                        *(f32x4*)(op + col) = v0; *(f32x4*)(op + col + 4) = v1;
                        if (ob) { u32x4 w; w.x = cvt_pk_bf16(v0[0], v0[1]); w.y = cvt_pk_bf16(v0[2], v0[3]); w.z = cvt_pk_bf16(v1[0], v1[1]); w.w = cvt_pk_bf16(v1[2], v1[3]);
                            *(u32x4*)(ob + (size_t)row * 1024 + col) = w; }
                    }
                }
                s += __shfl_xor(s, 16); s += __shfl_xor(s, 32);
                if (ssq_out && fq == 0) ssq_out[(size_t)row * 16 + u.pn * 4 + wc] = s;
                asm volatile("" ::: "memory");
            }
    }
};

struct EpiZ {
    static constexpr bool PERM = false, AFTER_DRAIN = false;
    const float* ssq1;
    PG8_LAS float* xch;
    float* msq;
    bf16_t* cqb;
    const float* g_kv; const float* g_kr; const float* g_mq;
    const float* rope;
    float* ckv_p; float* ckv_s; float* kr_p; float* kr_s; float* conv_p; float* conv_s;
    bf16_t* ckvb; bf16_t* krb; bf16_t* Kb; bf16_t* ub; bf16_t* gbb; bf16_t* mqb;
    __device__ __forceinline__ void operator()(const f32x4 (&acc)[2][2][4][2], const Unit& u, int wr, int wc, int fr_, int fq_) const {
        const int ln_ = fresh_lane(), fr = ln_ & 15, fq = ln_ >> 4; (void)fr_; (void)fq_;
        const int pn = u.pn;
        float inv1[2][4]; int rows[2][4];
#pragma unroll
        for (int ai = 0; ai < 2; ++ai)
#pragma unroll
            for (int m = 0; m < 4; ++m) { rows[ai][m] = u.pm * BM + ai * HALF + wr * 64 + m * 16 + fr; inv1[ai][m] = row_inv_from_parts(ssq1, rows[ai][m]); }
        if (pn == 0 || pn == 1) {
#pragma unroll
            for (int ai = 0; ai < 2; ++ai)
#pragma unroll
                for (int m = 0; m < 4; ++m) {
                    float s = 0.f; const float iv = inv1[ai][m];
#pragma unroll
                    for (int bj = 0; bj < 2; ++bj) { if (pn == 1 && bj == 1) continue;
#pragma unroll
                        for (int n = 0; n < 2; ++n) { const f32x4 v = acc[ai][bj][m][n] * iv; s += (v[0] * v[0] + v[1] * v[1]) + (v[2] * v[2] + v[3] * v[3]); } }
                    s += __shfl_xor(s, 16); s += __shfl_xor(s, 32);
                    if (fq == 0) xch[(ai * HALF + wr * 64 + m * 16 + fr) * 4 + wc] = s;
                }
            asm volatile("s_waitcnt lgkmcnt(0)" ::: "memory"); __builtin_amdgcn_s_barrier(); asm volatile("" ::: "memory");
        }
        if (pn == 0) {
#pragma unroll
            for (int ai = 0; ai < 2; ++ai)
#pragma unroll
                for (int m = 0; m < 4; ++m) {
                    const int row = rows[ai][m]; const float iv = inv1[ai][m];
                    const f32x4 t = *(const PG8_LAS f32x4*)(xch + (ai * HALF + wr * 64 + m * 16 + fr) * 4);
                    if (wc == 0 && fq == 0 && row < kMR) msq[row] = ((t[0] + t[1]) + (t[2] + t[3])) * (1.0f / 256.0f);
                    if (row < kMR) {
#pragma unroll
                        for (int bj = 0; bj < 2; ++bj)
#pragma unroll
                            for (int n = 0; n < 2; ++n) { const f32x4 v = acc[ai][bj][m][n] * iv; u32x2 w; w.x = cvt_pk_bf16(v[0], v[1]); w.y = cvt_pk_bf16(v[2], v[3]);
                                *(u32x2*)(cqb + (size_t)row * 256 + bj * HALF + wc * 32 + n * 16 + 4 * fq) = w; }
                    }
                }
        } else if (pn == 1) {
#pragma unroll
            for (int ai = 0; ai < 2; ++ai)
#pragma unroll
                for (int m = 0; m < 4; ++m) {
                    const int row = rows[ai][m]; const float iv = inv1[ai][m];
                    if (row >= kMR) continue;
                    const bool smp = row >= kNTOK; const int rr = smp ? row - kNTOK : row;
                    const f32x4 t = *(const PG8_LAS f32x4*)(xch + (ai * HALF + wr * 64 + m * 16 + fr) * 4);
                    const float ic = __builtin_amdgcn_rsqf(((t[0] + t[1]) + (t[2] + t[3])) * (1.0f / 128.0f) + kEPS);
#pragma unroll
                    for (int n = 0; n < 2; ++n) {
                        const int c = wc * 32 + n * 16 + 4 * fq;
                        const f32x4 g = *(const f32x4*)(g_kv + c);
                        const f32x4 v = acc[ai][0][m][n] * (iv * ic) * g;
                        *(f32x4*)((smp ? ckv_s : ckv_p) + (size_t)rr * 128 + c) = v;
                        u32x2 w; w.x = cvt_pk_bf16(v[0], v[1]); w.y = cvt_pk_bf16(v[2], v[3]);
                        *(u32x2*)(ckvb + (size_t)row * 128 + c) = w;
                    }
                    if (wc == 0) {
                        const f32x4 a = acc[ai][1][m][0] * iv, b = acc[ai][1][m][1] * iv;
                        float s = (a[0] * a[0] + a[1] * a[1]) + (a[2] * a[2] + a[3] * a[3]) + (b[0] * b[0] + b[1] * b[1]) + (b[2] * b[2] + b[3] * b[3]);
                        s += __shfl_xor(s, 16); s += __shfl_xor(s, 32);
                        const float ik = __builtin_amdgcn_rsqf(s * (1.0f / 32.0f) + kEPS);
                        const f32x4 ga = *(const f32x4*)(g_kr + 4 * fq), gb = *(const f32x4*)(g_kr + 16 + 4 * fq);
                        const f32x4 x1 = a * ik * ga, x2 = b * ik * gb;
                        const int pos = smp ? kSEQ : (row & (kSEQ - 1));
                        const f32x4 cs = *(const f32x4*)(rope + (size_t)pos * 32 + 4 * fq), sn = *(const f32x4*)(rope + (size_t)pos * 32 + 16 + 4 * fq);
                        const f32x4 o1 = x1 * cs - x2 * sn, o2 = x1 * sn + x2 * cs;
                        float* kro = (smp ? kr_s : kr_p) + (size_t)rr * 32;
                        *(f32x4*)(kro + 4 * fq) = o1; *(f32x4*)(kro + 16 + 4 * fq) = o2;
                        u32x2 w1, w2; w1.x = cvt_pk_bf16(o1[0], o1[1]); w1.y = cvt_pk_bf16(o1[2], o1[3]); w2.x = cvt_pk_bf16(o2[0], o2[1]); w2.y = cvt_pk_bf16(o2[2], o2[3]);
                        *(u32x2*)(krb + (size_t)row * 32 + 4 * fq) = w1; *(u32x2*)(krb + (size_t)row * 32 + 16 + 4 * fq) = w2;
                        if (!smp) { const int b_ = row >> 13, t_ = row & (kSEQ - 1);
#pragma unroll
                            for (int h = 0; h < 8; ++h) { bf16_t* kp = Kb + ((size_t)(b_ * 8 + h) * kSEQ + t_) * 96 + 64; *(u32x2*)(kp + 4 * fq) = w1; *(u32x2*)(kp + 16 + 4 * fq) = w2; } }
                    }
                    asm volatile("" ::: "memory");
                }
        } else if (pn == 2 || pn == 3) {
#pragma unroll
            for (int ai = 0; ai < 2; ++ai)
#pragma unroll
                for (int m = 0; m < 4; ++m) {
                    const int row = rows[ai][m]; const float iv = inv1[ai][m];
                    if (row >= kMR) continue;
                    const bool smp = row >= kNTOK; const int t_ = row & (kSEQ - 1), b_ = row >> 13;
#pragma unroll
                    for (int n = 0; n < 2; ++n) {
                        const int c = (pn - 2) * 128 + wc * 32 + n * 16 + 4 * fq;
                        const f32x4 v = (acc[ai][0][m][n] * iv) * (acc[ai][1][m][n] * iv);
                        u32x2 w; w.x = cvt_pk_bf16(v[0], v[1]); w.y = cvt_pk_bf16(v[2], v[3]);
                        *(u32x2*)(ub + (size_t)row * 256 + c) = w;
                        if (smp) *(f32x4*)(conv_s + (size_t)(row - kNTOK) * 512 + 256 + c) = v;
                        else if (t_ >= kSEQ - 2) *(f32x4*)(conv_p + (size_t)(b_ * 2 + (t_ - (kSEQ - 2))) * 256 + c) = v;
                    }
                }
        } else if (pn == 4) {
#pragma unroll
            for (int ai = 0; ai < 2; ++ai)
#pragma unroll
                for (int m = 0; m < 4; ++m) {
                    const int row = rows[ai][m]; const float iv = inv1[ai][m];
                    if (row >= kMR) continue;
#pragma unroll
                    for (int bj = 0; bj < 2; ++bj)
#pragma unroll
                        for (int n = 0; n < 2; ++n) { const f32x4 v = acc[ai][bj][m][n] * iv; u32x2 w; w.x = cvt_pk_bf16(v[0], v[1]); w.y = cvt_pk_bf16(v[2], v[3]);
                            *(u32x2*)(gbb + (size_t)row * 256 + bj * HALF + wc * 32 + n * 16 + 4 * fq) = w; }
                }
        } else {
#pragma unroll
            for (int ai = 0; ai < 2; ++ai)
#pragma unroll
                for (int m = 0; m < 4; ++m) {
                    const int row = rows[ai][m]; const float iv = inv1[ai][m];
                    float s = 0.f;
#pragma unroll
                    for (int bj = 0; bj < 2; ++bj)
#pragma unroll
                        for (int n = 0; n < 2; ++n) { const f32x4 v = acc[ai][bj][m][n] * iv; s += (v[0] * v[0] + v[1] * v[1]) + (v[2] * v[2] + v[3] * v[3]); }
                    s += __shfl_xor(s, 16); s += __shfl_xor(s, 32);
                    const float im = __builtin_amdgcn_rsqf(s * (1.0f / 64.0f) + kEPS) * kC2M;
                    if (row >= kMR) continue;
#pragma unroll
                    for (int bj = 0; bj < 2; ++bj)
#pragma unroll
                        for (int n = 0; n < 2; ++n) { const int d = bj * 32 + n * 16 + 4 * fq; const f32x4 g = *(const f32x4*)(g_mq + d);
                            const f32x4 v = acc[ai][bj][m][n] * (iv * im) * g; u32x2 w; w.x = cvt_pk_bf16(v[0], v[1]); w.y = cvt_pk_bf16(v[2], v[3]);
                            *(u32x2*)(mqb + (size_t)row * 256 + wc * 64 + d) = w; }
                }
        }
    }
};

struct EpiQ {
    static constexpr bool PERM = false, AFTER_DRAIN = false;
    const float* msq; const float* g_qn; const float* g_qr; const float* rope; bf16_t* qb;
    __device__ __forceinline__ void operator()(const f32x4 (&acc)[2][2][4][2], const Unit& u, int wr, int wc, int fr_, int fq_) const {
        const int ln_ = fresh_lane(), fr = ln_ & 15, fq = ln_ >> 4; (void)fr_; (void)fq_;
        const int pn = u.pn;
#pragma unroll
        for (int ai = 0; ai < 2; ++ai)
#pragma unroll
            for (int m = 0; m < 4; ++m) {
                const int row = u.pm * BM + ai * HALF + wr * 64 + m * 16 + fr;
                const bool live = row < kMR;
                const float epsq = kEPS * ((live ? msq[row] : 1.0f) + kEPS);
                if (pn < 2) {
                    const int head = 4 * pn + wc; float s = 0.f;
#pragma unroll
                    for (int bj = 0; bj < 2; ++bj)
#pragma unroll
                        for (int n = 0; n < 2; ++n) { const f32x4 v = acc[ai][bj][m][n]; s += (v[0] * v[0] + v[1] * v[1]) + (v[2] * v[2] + v[3] * v[3]); }
                    s += __shfl_xor(s, 16); s += __shfl_xor(s, 32);
                    const float rs = __builtin_amdgcn_rsqf(s * (1.0f / 64.0f) + epsq) * kC2Q;
                    if (live) {
#pragma unroll
                        for (int bj = 0; bj < 2; ++bj)
#pragma unroll
                            for (int n = 0; n < 2; ++n) { const int d = bj * 32 + n * 16 + 4 * fq; const f32x4 g = *(const f32x4*)(g_qn + d);
                                const f32x4 v = acc[ai][bj][m][n] * rs * g; u32x2 w; w.x = cvt_pk_bf16(v[0], v[1]); w.y = cvt_pk_bf16(v[2], v[3]);
                                *(u32x2*)(qb + (size_t)row * 768 + head * 96 + d) = w; }
                    }
                } else {
                    const int pos = row >= kNTOK ? kSEQ : (row & (kSEQ - 1));
                    const f32x4 cs = *(const f32x4*)(rope + (size_t)pos * 32 + 4 * fq), sn = *(const f32x4*)(rope + (size_t)pos * 32 + 16 + 4 * fq);
                    const f32x4 ga = *(const f32x4*)(g_qr + 4 * fq), gb = *(const f32x4*)(g_qr + 16 + 4 * fq);
#pragma unroll
                    for (int bj = 0; bj < 2; ++bj) {
                        const int head = 4 * bj + wc;
                        const f32x4 a = acc[ai][bj][m][0], b = acc[ai][bj][m][1];
                        float s = (a[0] * a[0] + a[1] * a[1]) + (a[2] * a[2] + a[3] * a[3]) + (b[0] * b[0] + b[1] * b[1]) + (b[2] * b[2] + b[3] * b[3]);
                        s += __shfl_xor(s, 16); s += __shfl_xor(s, 32);
                        const float rs = __builtin_amdgcn_rsqf(s * (1.0f / 32.0f) + epsq);
                        const f32x4 x1 = a * rs * ga, x2 = b * rs * gb;
                        const f32x4 o1 = (x1 * cs - x2 * sn) * kC2Q, o2 = (x1 * sn + x2 * cs) * kC2Q;
                        if (live) { u32x2 w1, w2; w1.x = cvt_pk_bf16(o1[0], o1[1]); w1.y = cvt_pk_bf16(o1[2], o1[3]); w2.x = cvt_pk_bf16(o2[0], o2[1]); w2.y = cvt_pk_bf16(o2[2], o2[3]);
                            *(u32x2*)(qb + (size_t)row * 768 + head * 96 + 64 + 4 * fq) = w1; *(u32x2*)(qb + (size_t)row * 768 + head * 96 + 80 + 4 * fq) = w2; }
                    }
                }
                asm volatile("" ::: "memory");
            }
    }
};

struct EpiKV {
    static constexpr bool PERM = false, AFTER_DRAIN = false;
    const float* g_kn; bf16_t* Kb; bf16_t* Vb;
    __device__ __forceinline__ void operator()(const f32x4 (&acc)[2][2][4][2], const Unit& u, int wr, int wc, int fr_, int fq_) const {
        const int ln_ = fresh_lane(), fr = ln_ & 15, fq = ln_ >> 4; (void)fr_; (void)fq_;
        const int pn = u.pn;
#pragma unroll
        for (int ai = 0; ai < 2; ++ai)
#pragma unroll
            for (int m = 0; m < 4; ++m) {
                const int row = u.pm * BM + ai * HALF + wr * 64 + m * 16 + fr;
                const int b_ = row >> 13, t_ = row & (kSEQ - 1);
                if (pn < 2) {
                    const int head = 4 * pn + wc; float s = 0.f;
#pragma unroll
                    for (int bj = 0; bj < 2; ++bj)
#pragma unroll
                        for (int n = 0; n < 2; ++n) { const f32x4 v = acc[ai][bj][m][n]; s += (v[0] * v[0] + v[1] * v[1]) + (v[2] * v[2] + v[3] * v[3]); }
                    s += __shfl_xor(s, 16); s += __shfl_xor(s, 32);
                    const float rs = __builtin_amdgcn_rsqf(s * (1.0f / 64.0f) + kEPS);
                    bf16_t* kp = Kb + ((size_t)(b_ * 8 + head) * kSEQ + t_) * 96;
#pragma unroll
                    for (int bj = 0; bj < 2; ++bj)
#pragma unroll
                        for (int n = 0; n < 2; ++n) { const int d = bj * 32 + n * 16 + 4 * fq; const f32x4 g = *(const f32x4*)(g_kn + d);
                            const f32x4 v = acc[ai][bj][m][n] * rs * g; u32x2 w; w.x = cvt_pk_bf16(v[0], v[1]); w.y = cvt_pk_bf16(v[2], v[3]);
                            *(u32x2*)(kp + d) = w; }
                } else {
#pragma unroll
                    for (int bj = 0; bj < 2; ++bj)
#pragma unroll
                        for (int n = 0; n < 2; ++n) { const int c = (pn - 2) * 256 + bj * HALF + wc * 32 + n * 16 + 4 * fq; const int head = c >> 6, d = c & 63;
                            const f32x4 v = acc[ai][bj][m][n]; u32x2 w; w.x = cvt_pk_bf16(v[0], v[1]); w.y = cvt_pk_bf16(v[2], v[3]);
                            *(u32x2*)(Vb + ((size_t)(b_ * 8 + head) * kSEQ + t_) * 64 + d) = w; }
                }
                asm volatile("" ::: "memory");
            }
    }
};

struct EpiMem {
    static constexpr bool PERM = false, AFTER_DRAIN = false;
    const float* ssqm; const float* g_mk; float* mk_out; float* mv_out; bf16_t* mKb; bf16_t* mVb;
    __device__ __forceinline__ void operator()(const f32x4 (&acc)[2][2][4][2], const Unit& u, int wr, int wc, int fr_, int fq_) const {
        const int ln_ = fresh_lane(), fr = ln_ & 15, fq = ln_ >> 4; (void)fr_; (void)fq_;
        const int pn = u.pn;
#pragma unroll
        for (int ai = 0; ai < 2; ++ai)
#pragma unroll
            for (int m = 0; m < 4; ++m) {
                const int row = u.pm * BM + ai * HALF + wr * 64 + m * 16 + fr;
                const float iv = row_inv_from_parts(ssqm, row);
                const int b_ = row >> 8, n_ = row & 255;
                if (pn == 0) {
                    const int head = wc; float s = 0.f;
#pragma unroll
                    for (int bj = 0; bj < 2; ++bj)
#pragma unroll
                        for (int n = 0; n < 2; ++n) { const f32x4 v = acc[ai][bj][m][n] * iv; s += (v[0] * v[0] + v[1] * v[1]) + (v[2] * v[2] + v[3] * v[3]); }
                    s += __shfl_xor(s, 16); s += __shfl_xor(s, 32);
                    const float rs = __builtin_amdgcn_rsqf(s * (1.0f / 64.0f) + kEPS);
#pragma unroll
                    for (int bj = 0; bj < 2; ++bj)
#pragma unroll
                        for (int n = 0; n < 2; ++n) { const int d = bj * 32 + n * 16 + 4 * fq; const f32x4 g = *(const f32x4*)(g_mk + d);
                            const f32x4 v = acc[ai][bj][m][n] * (iv * rs) * g;
                            *(f32x4*)(mk_out + (size_t)row * 256 + head * 64 + d) = v;
                            u32x2 w; w.x = cvt_pk_bf16(v[0], v[1]); w.y = cvt_pk_bf16(v[2], v[3]);
                            *(u32x2*)(mKb + ((size_t)(b_ * 4 + head) * 256 + n_) * 64 + d) = w; }
                } else {
#pragma unroll
                    for (int bj = 0; bj < 2; ++bj)
#pragma unroll
                        for (int n = 0; n < 2; ++n) { const int c = bj * HALF + wc * 32 + n * 16 + 4 * fq; const int head = c >> 6, d = c & 63;
                            const f32x4 v = acc[ai][bj][m][n] * iv;
                            *(f32x4*)(mv_out + (size_t)row * 256 + c) = v;
                            u32x2 w; w.x = cvt_pk_bf16(v[0], v[1]); w.y = cvt_pk_bf16(v[2], v[3]);
                            *(u32x2*)(mVb + ((size_t)(b_ * 4 + head) * 256 + n_) * 64 + d) = w; }
                }
                asm volatile("" ::: "memory");
            }
    }
};
template <class Epi, class Sched, bool ALIGN_EPI = false, bool SP2 = false>
__device__ __forceinline__ void gemm_phase(PG8_LAS unsigned char* lds, const Gemm g, const Sched& S, const Epi& E) {
    int tid_ = threadIdx.x; asm volatile("" : "+v"(tid_));
    const int tid = tid_, wid = __builtin_amdgcn_readfirstlane(tid >> 6), lane = tid & 63, wr = wid >> 2, wc = wid & 3, fr = lane & 15, fq = lane >> 4;
    const int K = g.K, nt = K / BK;
    unsigned voffA[2], voffB[2];
#pragma unroll
    for (int i = 0; i < 2; ++i) { int R, C; stage_rc(tid * 16 + i * 8192, R, C); const int Rb = Epi::PERM ? ((R & ~31) + perm32(R & 31)) : R;
        voffA[i] = (unsigned)(R * K + C) * 2u; voffB[i] = (unsigned)(Rb * K + C) * 2u; }
    const size_t kstep = (size_t)(BK * 2);
    const size_t hstep = (size_t)HALF * K * 2;
    const size_t tstep = 2 * hstep;
    const unsigned ldsw = (unsigned)wid * 1024u;
    const int aoff = lds_byte(wr * 64 + fr, fq * 8), boff = lds_byte(wc * 32 + fr, fq * 8);
#define PG8_SA(b, h) (((b) * 2 + (h)) * HTB)
#define PG8_SB(b, h) ((4 + (b) * 2 + (h)) * HTB)
#define PG8_STAGE(bufoff, gbase, voff) do { _Pragma("unroll") for (int _i = 0; _i < 2; ++_i) \
        __builtin_amdgcn_global_load_lds((const unsigned*)((const char*)(gbase) + (voff)[_i]), (PG8_LAS unsigned*)(lds + (bufoff) + ldsw + _i * 8192), 16, 0, 0); } while (0)
#define PG8_LDA(dst, b, h) do { _Pragma("unroll") for (int m = 0; m < 4; ++m) _Pragma("unroll") for (int k = 0; k < 2; ++k) dst[m][k] = *(const PG8_LAS bf16x8*)(lds + PG8_SA(b, h) + aoff + m * 2048 + k * 1024); } while (0)
#define PG8_LDB(dst, b, h) do { _Pragma("unroll") for (int n = 0; n < 2; ++n) _Pragma("unroll") for (int k = 0; k < 2; ++k) dst[n][k] = *(const PG8_LAS bf16x8*)(lds + PG8_SB(b, h) + boff + n * 2048 + k * 1024); } while (0)
#define PG8_MMA(ai, bj, At, Bt) do { __builtin_amdgcn_s_setprio(1); _Pragma("unroll") for (int m = 0; m < 4; ++m) _Pragma("unroll") for (int n = 0; n < 2; ++n) _Pragma("unroll") for (int k = 0; k < 2; ++k) \
        acc[ai][bj][m][n] = __builtin_amdgcn_mfma_f32_16x16x32_bf16(Bt[n][k], At[m][k], acc[ai][bj][m][n], 0, 0, 0); __builtin_amdgcn_s_setprio(0); } while (0)
#define PG8_WAIT_V(n) asm volatile("s_waitcnt vmcnt(" #n ")" ::: "memory")
#define PG8_WAIT_L(n) asm volatile("s_waitcnt lgkmcnt(" #n ")" ::: "memory")
#define PG8_BAR __builtin_amdgcn_s_barrier()
#define PG8_SCHED __builtin_amdgcn_sched_barrier(0)
    Unit cur, nxt; int ui = 0;
    if (!S.next(0, cur)) return;
    f32x4 acc[2][2][4][2];
#pragma unroll
    for (int a = 0; a < 2; ++a)
#pragma unroll
        for (int b = 0; b < 2; ++b)
#pragma unroll
            for (int m = 0; m < 4; ++m)
#pragma unroll
                for (int n = 0; n < 2; ++n) acc[a][b][m][n] = (f32x4){0.f, 0.f, 0.f, 0.f};
    bf16x8 At[4][2], B0[2][2], B1[2][2];
    const char* cA = (const char*)g.A + (size_t)cur.pm * tstep; const char* cB = (const char*)g.Bt + (size_t)cur.pn * tstep;
    S.a_ready(cur);
    if constexpr (SP2) {
        PG8_STAGE(PG8_SB(0, 0), cB, voffB); PG8_STAGE(PG8_SB(0, 1), cB + hstep, voffB); PG8_STAGE(PG8_SA(0, 0), cA, voffA); PG8_STAGE(PG8_SA(0, 1), cA + hstep, voffA);
        if (wr == 1) PG8_BAR;
        PG8_WAIT_V(2); PG8_BAR;
        PG8_STAGE(PG8_SB(1, 0), cB + kstep, voffB); PG8_STAGE(PG8_SA(1, 0), cA + kstep, voffA); PG8_STAGE(PG8_SB(1, 1), cB + hstep + kstep, voffB);
        PG8_WAIT_V(6); PG8_BAR;
    } else {
        PG8_STAGE(PG8_SB(0, 0), cB, voffB); PG8_STAGE(PG8_SA(0, 0), cA, voffA); PG8_STAGE(PG8_SB(0, 1), cB + hstep, voffB); PG8_STAGE(PG8_SA(0, 1), cA + hstep, voffA);
        if (wr == 1) PG8_BAR;
        PG8_WAIT_V(4); PG8_BAR;
        PG8_STAGE(PG8_SB(1, 0), cB + kstep, voffB); PG8_STAGE(PG8_SA(1, 0), cA + kstep, voffA); PG8_STAGE(PG8_SB(1, 1), cB + hstep + kstep, voffB);
        PG8_WAIT_V(6); PG8_BAR;
    }
    for (;;) {
        const bool has_next = S.next(ui + 1, nxt);
        const char* nA = has_next ? (const char*)g.A + (size_t)nxt.pm * tstep : cA; const char* nB = has_next ? (const char*)g.Bt + (size_t)nxt.pn * tstep : cB;
        for (int t = 0; t < nt; t += 2) {
            const bool last = (t == nt - 2);
            const char* a1 = cA + (size_t)(t + 1) * kstep;
            const char* a2 = last ? nA : cA + (size_t)(t + 2) * kstep; const char* b2 = last ? nB : cB + (size_t)(t + 2) * kstep;
            const char* a3 = a2 + kstep; const char* b3 = b2 + kstep;
            if (last && has_next) S.a_ready(nxt);
            if constexpr (SP2) {
            PG8_LDB(B0, 0, 0); PG8_LDB(B1, 0, 1); PG8_SCHED; PG8_LDA(At, 0, 0); PG8_STAGE(PG8_SA(1, 1), a1 + hstep, voffA);
            PG8_WAIT_V(8); PG8_WAIT_L(0); PG8_BAR; PG8_MMA(0, 0, At, B0); PG8_MMA(0, 1, At, B1); PG8_BAR; PG8_SCHED;
            PG8_LDA(At, 0, 1); PG8_STAGE(PG8_SB(0, 0), b2, voffB); PG8_STAGE(PG8_SB(0, 1), b2 + hstep, voffB); PG8_STAGE(PG8_SA(0, 0), a2, voffA);
            PG8_WAIT_V(8); PG8_WAIT_L(0); PG8_BAR; PG8_MMA(1, 0, At, B0); PG8_MMA(1, 1, At, B1); PG8_BAR; PG8_SCHED;
            PG8_LDB(B0, 1, 0); PG8_LDB(B1, 1, 1); PG8_SCHED; PG8_LDA(At, 1, 0); PG8_STAGE(PG8_SA(0, 1), a2 + hstep, voffA);
            PG8_WAIT_V(8); PG8_WAIT_L(0); PG8_BAR; PG8_MMA(0, 0, At, B0); PG8_MMA(0, 1, At, B1); PG8_BAR; PG8_SCHED;
            PG8_LDA(At, 1, 1); PG8_STAGE(PG8_SB(1, 0), b3, voffB); PG8_STAGE(PG8_SB(1, 1), b3 + hstep, voffB); PG8_STAGE(PG8_SA(1, 0), a3, voffA);
            PG8_WAIT_V(8); PG8_WAIT_L(0); PG8_BAR; PG8_MMA(1, 0, At, B0); PG8_MMA(1, 1, At, B1); PG8_BAR; PG8_SCHED;
            } else {
            PG8_LDB(B0, 0, 0); PG8_SCHED; PG8_LDA(At, 0, 0); PG8_STAGE(PG8_SA(1, 1), a1 + hstep, voffA);
            PG8_WAIT_L(8); PG8_BAR; PG8_WAIT_L(0); PG8_MMA(0, 0, At, B0); PG8_BAR; PG8_SCHED;
            PG8_LDB(B1, 0, 1); PG8_STAGE(PG8_SB(0, 0), b2, voffB);
            PG8_BAR; PG8_WAIT_L(0); PG8_MMA(0, 1, At, B1); PG8_BAR;
            PG8_LDA(At, 0, 1); PG8_STAGE(PG8_SA(0, 0), a2, voffA);
            PG8_BAR; PG8_WAIT_L(0); PG8_MMA(1, 0, At, B0); PG8_BAR; PG8_SCHED;
            PG8_STAGE(PG8_SB(0, 1), b2 + hstep, voffB);
            PG8_WAIT_V(6); PG8_BAR; PG8_MMA(1, 1, At, B1); PG8_BAR;
            PG8_LDB(B0, 1, 0); PG8_SCHED; PG8_LDA(At, 1, 0); PG8_STAGE(PG8_SA(0, 1), a2 + hstep, voffA);
            PG8_WAIT_L(8); PG8_BAR; PG8_WAIT_L(0); PG8_MMA(0, 0, At, B0); PG8_BAR; PG8_SCHED;
            PG8_LDB(B1, 1, 1); PG8_STAGE(PG8_SB(1, 0), b3, voffB);
            PG8_BAR; PG8_WAIT_L(0); PG8_MMA(0, 1, At, B1); PG8_BAR;
            PG8_LDA(At, 1, 1); PG8_STAGE(PG8_SA(1, 0), a3, voffA);
            PG8_BAR; PG8_WAIT_L(0); PG8_MMA(1, 0, At, B0); PG8_BAR; PG8_SCHED;
            PG8_STAGE(PG8_SB(1, 1), b3 + hstep, voffB);
            PG8_WAIT_V(6); PG8_BAR; PG8_MMA(1, 1, At, B1); PG8_BAR;
            }
        }
        if constexpr (ALIGN_EPI) { if (wr == 0) PG8_BAR; }
        if constexpr (!Epi::AFTER_DRAIN) { E(acc, cur, wr, wc, fr, fq); S.done(cur); }
        if (!has_next) break;
#pragma unroll
        for (int a = 0; a < 2; ++a)
#pragma unroll
            for (int b = 0; b < 2; ++b)
#pragma unroll
                for (int m = 0; m < 4; ++m)
#pragma unroll
                    for (int n = 0; n < 2; ++n) acc[a][b][m][n] = (f32x4){0.f, 0.f, 0.f, 0.f};
        cur = nxt; cA = nA; cB = nB; ++ui;
        if constexpr (ALIGN_EPI) { if (wr == 1) PG8_BAR; }
    }
    PG8_WAIT_V(0);
    if constexpr (!ALIGN_EPI) { if (wr == 0) PG8_BAR; }
    PG8_BAR;
    if constexpr (Epi::AFTER_DRAIN) { E.fused(acc, cur, wr, wc, fr, fq, lds, wid, lane); S.done(cur); }
#undef PG8_SA
#undef PG8_SB
#undef PG8_STAGE
#undef PG8_LDA
#undef PG8_LDB
#undef PG8_MMA
#undef PG8_WAIT_V
#undef PG8_WAIT_L
#undef PG8_BAR
#undef PG8_SCHED
}
}
#define LAS __attribute__((address_space(3)))
#define XB_TMO      128
#define XB_XCNT(j)  (256  + 64 * (j))
#define XB_XSUB(j)  (1280 + 64 * (j))
#define XB_XGEN(j)  (2304 + 64 * (j))
#define XB_TOP      3328
#define XB_TOPGEN   3392
#define XCD_BAR_WORDS 3456
#define XB_SPIN_CAP (1u << 25)

__device__ __forceinline__ unsigned xb_ld(unsigned* p)              { return __hip_atomic_load(p, __ATOMIC_RELAXED, __HIP_MEMORY_SCOPE_AGENT); }
__device__ __forceinline__ unsigned xb_add(unsigned* p, unsigned v) { return __hip_atomic_fetch_add(p, v, __ATOMIC_RELAXED, __HIP_MEMORY_SCOPE_AGENT); }
__device__ __forceinline__ unsigned xb_xcc_id() { return (unsigned)__builtin_amdgcn_s_getreg((3 << 11) | 20) & 0xFu; }
#define XB_SPIN(cond, bar) do { unsigned _sp = 0; while (cond) { __builtin_amdgcn_s_sleep(1); \
    if ((++_sp & 255u) == 0u) { if (xb_ld(&(bar)[XB_TMO])) break; if (_sp > XB_SPIN_CAP) { atomicAdd(&(bar)[XB_TMO], 1u); break; } } } } while (0)

struct XcdBarrier {
    unsigned* bar; unsigned x;
    volatile LAS unsigned* st;
};

__device__ __forceinline__ XcdBarrier xcd_barrier_post(unsigned* bar, volatile LAS unsigned* st) {
    XcdBarrier b; b.bar = bar; b.x = xb_xcc_id(); b.st = st;
    if (threadIdx.x == 0) (void)xb_add(&bar[XB_XCNT(b.x)], 1u);
    return b;
}
__device__ __forceinline__ void xcd_barrier_complete(unsigned* bar, unsigned x, unsigned& nloc, unsigned& nx) {
    const unsigned G = gridDim.x * gridDim.y * gridDim.z;
    unsigned sum, cnt, mine, sp = 0u;
    for (;;) {
        sum = 0u; cnt = 0u; mine = 0u;
#pragma unroll
        for (unsigned j = 0; j < 16; ++j) { const unsigned c = xb_ld(&bar[XB_XCNT(j)]); sum += c; cnt += (c > 0u) ? 1u : 0u; mine = (j == x) ? c : mine; }
        if (sum == G) break;
        __builtin_amdgcn_s_sleep(1);
        if ((++sp & 255u) == 0u) { if (xb_ld(&bar[XB_TMO])) break; if (sp > XB_SPIN_CAP) { atomicAdd(&bar[XB_TMO], 1u); break; } }
    }
    nloc = mine > 0u ? mine : 1u; nx = cnt > 0u ? cnt : 1u;
}

__device__ __forceinline__ void xcd_barrier(const XcdBarrier& b) {
    asm volatile("s_waitcnt vmcnt(0)" ::: "memory");
    __syncthreads();
    if (threadIdx.x == 0) {
        unsigned* bar = b.bar;
        __builtin_amdgcn_s_waitcnt(0);
        unsigned nloc = b.st[0], nx = b.st[1];
        if (nloc == 0u) { xcd_barrier_complete(bar, b.x, nloc, nx); b.st[0] = nloc; b.st[1] = nx; }
        const unsigned old = xb_add(&bar[XB_XSUB(b.x)], 1u);
        const unsigned gen = old / nloc;
        if (old + 1u == (gen + 1u) * nloc) {
            __builtin_amdgcn_fence(__ATOMIC_RELEASE, "agent");
            asm volatile("s_waitcnt vmcnt(0)" ::: "memory");
            const unsigned og = xb_add(&bar[XB_TOP], 1u);
            const unsigned tg = og / nx;
            if (og + 1u == (tg + 1u) * nx) xb_add(&bar[XB_TOPGEN], 1u);
            else XB_SPIN(xb_ld(&bar[XB_TOPGEN]) == tg, bar);
            __builtin_amdgcn_fence(__ATOMIC_ACQUIRE, "agent");
            xb_add(&bar[XB_XGEN(b.x)], 1u);
            asm volatile("s_waitcnt vmcnt(0)" ::: "memory");
        } else {
            XB_SPIN(xb_ld(&bar[XB_XGEN(b.x)]) == gen, bar);
            __builtin_amdgcn_fence(__ATOMIC_ACQUIRE, "agent");
            asm volatile("s_waitcnt vmcnt(0)" ::: "memory");
        }
    }
    __syncthreads();
}
#define GAS __attribute__((address_space(1)))
typedef unsigned short bf16;
typedef unsigned v4u __attribute__((ext_vector_type(4)));
typedef unsigned v2u __attribute__((ext_vector_type(2)));
typedef float f32x4 __attribute__((ext_vector_type(4)));
typedef float f32x16 __attribute__((ext_vector_type(16)));
typedef short bf16x8 __attribute__((ext_vector_type(8)));
typedef short s16x4 __attribute__((ext_vector_type(4)));
#define LDS_WAIT() asm volatile("s_waitcnt lgkmcnt(0)" ::: "memory")
#define VM_WAIT() asm volatile("s_waitcnt vmcnt(0)" ::: "memory")
using pg8::cvt_pk_bf16;
__device__ __forceinline__ float bf2f(unsigned short h) { return __uint_as_float((unsigned)h << 16); }
__device__ __forceinline__ float bflo(unsigned w) { return __uint_as_float(w << 16); }
__device__ __forceinline__ float bfhi(unsigned w) { return __uint_as_float(w & 0xffff0000u); }

constexpr int D = 1024, SEQ = 8192, NB = 4, NTOK = 32768, NS = 128, MR = 32896, MP = 33024;
constexpr int FF = 2816, FF2 = 5632, INW = 1440, INWP = 1536;
constexpr int NPAGES = 128, PAGE = 128, NPHYS = 20480;
constexpr float EPS = 1e-6f;
static_assert(pg8::kNTOK == NTOK && pg8::kMR == MR && pg8::kSEQ == SEQ, "constants");

constexpr size_t O_Y = 0, O_YS = 33554432, O_CKVP = 33685504, O_KRP = 37879808, O_CONVP = 38928384, O_MKP = 38930432, O_MVP = 39192576,
                 O_CKVS = 39454720, O_KRS = 39471104, O_CONVS = 39475200, O_TOTAL = 39540736;

constexpr size_t MiB = 1u << 20;
constexpr size_t WS_CTL = 0, CTL_ZERO_BYTES = 1 * MiB;
constexpr size_t WS_W1GU = 1 * MiB, WS_W1D = WS_W1GU + 12 * MiB, WS_WIN = WS_W1D + 6 * MiB, WS_WUQ = WS_WIN + 3 * MiB, WS_WKV = WS_WUQ + 1 * MiB, WS_WO = WS_WKV + 1 * MiB,
                 WS_W2GU = WS_WO + 2 * MiB, WS_W2D = WS_W2GU + 12 * MiB, WS_WMEM = WS_W2D + 6 * MiB, WS_ROPE = WS_WMEM + 1 * MiB,
                 WS_SSQ0 = WS_ROPE + 2 * MiB, WS_SSQ1 = WS_SSQ0 + 3 * MiB, WS_SSQ2 = WS_SSQ1 + 3 * MiB, WS_MSQ = WS_SSQ2 + 3 * MiB, WS_SSQM = WS_MSQ + 1 * MiB,
                 WS_XB = WS_SSQM + 1 * MiB, WS_ACT1 = WS_XB + 65 * MiB, WS_ACT2 = WS_ACT1 + 178 * MiB, WS_X1F = WS_ACT2 + 178 * MiB, WS_X1B = WS_X1F + 129 * MiB,
                 WS_X2F = WS_X1B + 65 * MiB, WS_X2B = WS_X2F + 129 * MiB, WS_CQB = WS_X2B + 65 * MiB, WS_CKVB = WS_CQB + 17 * MiB, WS_KRB = WS_CKVB + 9 * MiB,
                 WS_UB = WS_KRB + 3 * MiB, WS_GBB = WS_UB + 17 * MiB, WS_MQB = WS_GBB + 17 * MiB, WS_QB = WS_MQB + 17 * MiB, WS_KB = WS_QB + 49 * MiB, WS_VB = WS_KB + 48 * MiB,
                 WS_MEMB = WS_VB + 32 * MiB, WS_MEMK = WS_MEMB + 2 * MiB, WS_MEMV = WS_MEMK + 1 * MiB, WS_OAB = WS_MEMV + 1 * MiB, WS_OMB = WS_OAB + 33 * MiB,
                 WS_OMIX = WS_OMB + 17 * MiB, WS_DPART = WS_OMIX + 65 * MiB, WS_DBG = WS_DPART + 2 * MiB, WS_END = WS_DBG + 1 * MiB;
constexpr int CW_BAR = 4096;

constexpr int RING_BYTES = 131072, LDSCTL_OFF = RING_BYTES, MISC_OFF = LDSCTL_OFF + 320, XCH_OFF = RING_BYTES + 512, LDS_BYTES = 147456;
constexpr int NWAVES = 8;

struct Args {
    const float* in[38];
    float* out; unsigned char* ws;
    int ph_lo, ph_hi;
};

#define CAS __attribute__((address_space(4)))
typedef const float* const CAS* InTab;
struct Frame {
    LAS unsigned char* lds;
    int tid, lane, wave, vcu, G;
    InTab in;
    float* out; unsigned char* ws;
};
__device__ __forceinline__ float wave_sum(float v) {
#pragma unroll
    for (int o = 1; o < 64; o <<= 1) v += __shfl_xor(v, o);
    return v;
}
__device__ __forceinline__ float wave_max(float v) {
#pragma unroll
    for (int o = 1; o < 64; o <<= 1) v = fmaxf(v, __shfl_xor(v, o));
    return v;
}

struct TSrc { const float* p; int ld; int col0; };
__device__ __forceinline__ void tr_item(TSrc s, const float* kscale, int K, bf16* WT, int n0, int k0, LAS float* scr, int lane) {
#pragma unroll 8
    for (int i = 0; i < 32; ++i) { const int kk = 2 * i + (lane >> 5);
        float v = 0.f; if (s.p) { v = s.p[(size_t)(k0 + kk) * s.ld + s.col0 + (lane & 31)]; if (kscale) v *= kscale[k0 + kk]; }
        scr[kk * 33 + (lane & 31)] = v; }
    LDS_WAIT(); asm volatile("" ::: "memory");
    const int c = lane & 7;
#pragma unroll
    for (int j = 0; j < 4; ++j) { const int n = (lane >> 3) + 8 * j; const LAS float* q = scr + (8 * c) * 33 + n;
        v4u o; o.x = cvt_pk_bf16(q[0 * 33], q[1 * 33]); o.y = cvt_pk_bf16(q[2 * 33], q[3 * 33]); o.z = cvt_pk_bf16(q[4 * 33], q[5 * 33]); o.w = cvt_pk_bf16(q[6 * 33], q[7 * 33]);
        *(v4u*)(WT + (size_t)(n0 + n) * K + k0 + 8 * c) = o; }
    LDS_WAIT(); asm volatile("" ::: "memory");
}
enum { MAT_W1GU = 0, MAT_W1D, MAT_WIN, MAT_WUQ, MAT_WKV, MAT_WO, MAT_W2GU, MAT_W2D, MAT_WMEM, MAT_N };
__device__ __forceinline__ void mat_dims(int mat, int& N, int& K) {
    switch (mat) {
        case MAT_W1GU: case MAT_W2GU: N = FF2; K = D; break;
        case MAT_W1D: case MAT_W2D: N = D; K = FF; break;
        case MAT_WIN: N = INWP; K = D; break;
        case MAT_WUQ: N = 768; K = 256; break;
        case MAT_WKV: N = 1024; K = 128; break;
        case MAT_WO: N = D; K = D; break;
        default: N = 512; K = D; break;
    }
}
__device__ __forceinline__ void p0_weight_item(const Frame& F, int mat, int item, LAS float* scr) {
    int N, K; mat_dims(mat, N, K);
    const int nkb = K / 64, kb = item % nkb, slot = item / nkb, k0 = kb * 64;
    const int pn = slot >> 3, w = slot & 7, bj = w >> 2, wc = w & 3;
    InTab in = F.in;
    TSrc s{nullptr, 0, 0}; const float* ks = nullptr; bf16* dst = nullptr;
    switch (mat) {
        case MAT_W1GU: s = TSrc{bj == 0 ? in[10] : in[11], FF, 128 * pn + 32 * wc}; ks = in[9]; dst = (bf16*)(F.ws + WS_W1GU); break;
        case MAT_W2GU: s = TSrc{bj == 0 ? in[35] : in[36], FF, 128 * pn + 32 * wc}; ks = in[34]; dst = (bf16*)(F.ws + WS_W2GU); break;
        case MAT_W1D: s = TSrc{in[12], D, 32 * slot}; dst = (bf16*)(F.ws + WS_W1D); break;
        case MAT_W2D: s = TSrc{in[37], D, 32 * slot}; dst = (bf16*)(F.ws + WS_W2D); break;
        case MAT_WIN: {
            int c0 = -1;
            if (pn == 0) c0 = 32 * w;
            else if (pn == 1) c0 = (bj == 0) ? 256 + 32 * wc : (wc == 0 ? 384 : -1);
            else if (pn == 2) c0 = (bj == 0) ? 416 + 32 * wc : 928 + 32 * wc;
            else if (pn == 3) c0 = (bj == 0) ? 416 + 128 + 32 * wc : 928 + 128 + 32 * wc;
            else if (pn == 4) c0 = 672 + 32 * w;
            else c0 = 1184 + 64 * wc + 32 * bj;
            if (c0 >= 0) s = TSrc{in[14], INW, c0};
            ks = in[13]; dst = (bf16*)(F.ws + WS_WIN); break; }
        case MAT_WUQ: s = TSrc{in[16], 768, pn < 2 ? (4 * pn + wc) * 96 + 32 * bj : (4 * bj + wc) * 96 + 64}; ks = in[15]; dst = (bf16*)(F.ws + WS_WUQ); break;
        case MAT_WKV: if (pn < 2) s = TSrc{in[20], 512, (4 * pn + wc) * 64 + 32 * bj}; else s = TSrc{in[21], 512, 256 * (pn - 2) + 32 * w}; dst = (bf16*)(F.ws + WS_WKV); break;
        case MAT_WO: s = TSrc{in[33], D, 32 * slot}; ks = (k0 < 512) ? in[30] : (k0 < 768) ? in[31] - 512 : in[32] - 768; dst = (bf16*)(F.ws + WS_WO); break;
        default: if (pn == 0) s = TSrc{in[26], 256, 64 * wc + 32 * bj}; else s = TSrc{in[27], 256, 32 * w}; ks = in[25]; dst = (bf16*)(F.ws + WS_WMEM); break;
    }
    tr_item(s, ks, K, dst, 32 * slot, k0, scr, F.lane);
}
__device__ __forceinline__ void row_to_bf16_ssq(const float* src, bf16* dst, float* parts, int lane) {
    f32x4 v[4]; float s = 0.f;
#pragma unroll
    for (int j = 0; j < 4; ++j) { v[j] = src ? ((const f32x4*)src)[lane + 64 * j] : (f32x4){0.f, 0.f, 0.f, 0.f}; s += (v[j][0] * v[j][0] + v[j][1] * v[j][1]) + (v[j][2] * v[j][2] + v[j][3] * v[j][3]); }
    s = wave_sum(s);
#pragma unroll
    for (int j = 0; j < 4; ++j) { v2u w; w.x = cvt_pk_bf16(v[j][0], v[j][1]); w.y = cvt_pk_bf16(v[j][2], v[j][3]); ((v2u*)dst)[lane + 64 * j] = w; }
    if (lane < 16) parts[lane] = lane == 0 ? s : 0.f;
}
__device__ __forceinline__ float rope_inv_freq(int i) {
    switch (i) { case 0: return 1.000000000e+00f; case 1: return 5.623413324e-01f; case 2: return 3.162277639e-01f; case 3: return 1.778279394e-01f;
        case 4: return 1.000000015e-01f; case 5: return 5.623413250e-02f; case 6: return 3.162277490e-02f; case 7: return 1.778279431e-02f;
        case 8: return 9.999999776e-03f; case 9: return 5.623413250e-03f; case 10: return 3.162277630e-03f; case 11: return 1.778279431e-03f;
        case 12: return 1.000000047e-03f; case 13: return 5.623413017e-04f; case 14: return 3.162277571e-04f; default: return 1.778279402e-04f; }
}
__device__ __forceinline__ void p0_prologue(const Frame& F) {
    LAS float* scr = (LAS float*)(F.lds + F.wave * 16384);
    const int gw = F.vcu * NWAVES + F.wave, NGW = F.G * NWAVES;
    int base = 0;
#pragma unroll 1
    for (int mat = 0; mat < MAT_N; ++mat) {
        int N, K; mat_dims(mat, N, K);
        const int nit = (N / 32) * (K / 64);
        int first = (gw - base % NGW + NGW) % NGW;
        for (int it = first; it < nit; it += NGW) p0_weight_item(F, mat, it, scr);
        base += nit;
    }
    bf16* xb = (bf16*)(F.ws + WS_XB); float* ssq0 = (float*)(F.ws + WS_SSQ0);
    for (int r = gw; r < MP; r += NGW) {
        const float* src = r < NTOK ? F.in[0] + (size_t)r * D : (r < MR ? F.in[2] + (size_t)(r - NTOK) * D : nullptr);
        row_to_bf16_ssq(src, xb + (size_t)r * D, ssq0 + (size_t)r * 16, F.lane);
    }
    bf16* memb = (bf16*)(F.ws + WS_MEMB); float* ssqm = (float*)(F.ws + WS_SSQM);
    for (int r = gw; r < 1024; r += NGW) row_to_bf16_ssq(F.in[1] + (size_t)r * D, memb + (size_t)r * D, ssqm + (size_t)r * 16, F.lane);
    float* rope = (float*)(F.ws + WS_ROPE);
    const int gt = F.vcu * (NWAVES * 64) + F.tid, NGT = F.G * NWAVES * 64;
    for (int e = gt; e < 8193 * 16; e += NGT) { const int pi = e >> 4, i = e & 15; const float pos = pi == 8192 ? 16384.0f : (float)pi;
        const float ang = pos * rope_inv_freq(i);
        const double rev = (double)ang * 0.15915494309189535;
        const float fr = (float)(rev - floor(rev));
        rope[(size_t)pi * 32 + i] = __builtin_amdgcn_cosf(fr); rope[(size_t)pi * 32 + 16 + i] = __builtin_amdgcn_sinf(fr); }
    for (int e = gt; e < NS * 256; e += NGT) { const int b = e >> 8, c = e & 255; F.out[O_CONVS + (size_t)b * 512 + c] = F.in[6][(size_t)b * 512 + 256 + c]; }
}
__device__ __forceinline__ int crow(int r, int hi) { return (r & 3) + 8 * (r >> 2) + 4 * hi; }
constexpr int AT_K = 0, AT_V = 16384, AT_WS = 24576, AT_OST = 28672;
template <int DQK, bool CAUSAL>
__device__ __forceinline__ void attn_unit_simple(const bf16* Q0, int qpitch, const bf16* Kh, const bf16* Vh, bf16* O0, int opitch, int NT, LAS unsigned char* lds) {
    constexpr int NC = DQK / 8, ND = DQK / 16;
    int tid_ = threadIdx.x; asm volatile("" : "+v"(tid_));
    const int tid = tid_, lane = tid & 63, r32 = lane & 31, hi = lane >> 5; const int wid = __builtin_amdgcn_readfirstlane(tid >> 6);
    bf16x8 qr[ND];
#pragma unroll
    for (int d0 = 0; d0 < ND; ++d0) qr[d0] = *(const bf16x8*)(Q0 + (size_t)(wid * 32 + r32) * qpitch + d0 * 16 + hi * 8);
    float mrun = -INFINITY, lrun = 0.f;
    f32x16 o0, o1;
#pragma unroll
    for (int r = 0; r < 16; ++r) { o0[r] = 0.f; o1[r] = 0.f; }
    LAS float* wsf = (LAS float*)(lds + AT_WS) + wid * 64;
    const int qrel = wid * 32 + r32;
    for (int t = 0; t < NT; ++t) {
        __syncthreads();
        for (int idx = tid; idx < NC * 64; idx += 512) { const int key = idx / NC, c = idx - key * NC;
            const v4u v = *(const v4u*)(Kh + (size_t)(t * 64 + key) * DQK + c * 8);
            *(LAS v4u*)(lds + AT_K + c * 1024 + key * 16) = v; }
        { const int key = tid >> 3, c = tid & 7;
            const v4u v = *(const v4u*)(Vh + (size_t)(t * 64 + key) * 64 + c * 8);
            *(LAS v4u*)(lds + AT_V + (c >> 2) * 4096 + key * 64 + (c & 3) * 16) = v; }
        __syncthreads();
        const int jb = t - (NT - 4);
        if (CAUSAL && jb >= 0 && 64 * jb > 32 * wid + 31) continue;
        f32x16 p0, p1;
#pragma unroll
        for (int r = 0; r < 16; ++r) { p0[r] = 0.f; p1[r] = 0.f; }
#pragma unroll
        for (int d0 = 0; d0 < ND; ++d0) {
            const bf16x8 k0 = *(const LAS bf16x8*)(lds + AT_K + (2 * d0 + hi) * 1024 + r32 * 16);
            const bf16x8 k1 = *(const LAS bf16x8*)(lds + AT_K + (2 * d0 + hi) * 1024 + 512 + r32 * 16);
            p0 = __builtin_amdgcn_mfma_f32_32x32x16_bf16(k0, qr[d0], p0, 0, 0, 0);
            p1 = __builtin_amdgcn_mfma_f32_32x32x16_bf16(k1, qr[d0], p1, 0, 0, 0);
        }
        if (CAUSAL && jb >= 0) {
            const int kb = 64 * jb + 4 * hi;
#pragma unroll
            for (int r = 0; r < 16; ++r) { const int kv = kb + (r & 3) + 8 * (r >> 2); if (kv > qrel) p0[r] = -INFINITY; if (kv + 32 > qrel) p1[r] = -INFINITY; }
        }
        float rm = p0[0];
#pragma unroll
        for (int r = 1; r < 16; ++r) rm = fmaxf(rm, p0[r]);
#pragma unroll
        for (int r = 0; r < 16; ++r) rm = fmaxf(rm, p1[r]);
        rm = fmaxf(rm, __shfl_xor(rm, 32));
        const float mn = fmaxf(mrun, rm);
        const float alpha = __builtin_amdgcn_exp2f(mrun - mn);
        mrun = mn;
        float ls = 0.f;
#pragma unroll
        for (int r = 0; r < 16; ++r) { p0[r] = __builtin_amdgcn_exp2f(p0[r] - mn); p1[r] = __builtin_amdgcn_exp2f(p1[r] - mn); ls += p0[r] + p1[r]; }
        lrun = lrun * alpha + ls;
        if (hi == 0) wsf[r32] = alpha;
        LDS_WAIT();
#pragma unroll
        for (int r = 0; r < 16; ++r) { const float a = wsf[crow(r, hi)]; o0[r] *= a; o1[r] *= a; }
        bf16x8 pa[4];
        { v4u w;
          w.x = cvt_pk_bf16(p0[0], p0[1]); w.y = cvt_pk_bf16(p0[2], p0[3]); w.z = cvt_pk_bf16(p0[4], p0[5]); w.w = cvt_pk_bf16(p0[6], p0[7]); pa[0] = __builtin_bit_cast(bf16x8, w);
          w.x = cvt_pk_bf16(p0[8], p0[9]); w.y = cvt_pk_bf16(p0[10], p0[11]); w.z = cvt_pk_bf16(p0[12], p0[13]); w.w = cvt_pk_bf16(p0[14], p0[15]); pa[1] = __builtin_bit_cast(bf16x8, w);
          w.x = cvt_pk_bf16(p1[0], p1[1]); w.y = cvt_pk_bf16(p1[2], p1[3]); w.z = cvt_pk_bf16(p1[4], p1[5]); w.w = cvt_pk_bf16(p1[6], p1[7]); pa[2] = __builtin_bit_cast(bf16x8, w);
          w.x = cvt_pk_bf16(p1[8], p1[9]); w.y = cvt_pk_bf16(p1[10], p1[11]); w.z = cvt_pk_bf16(p1[12], p1[13]); w.w = cvt_pk_bf16(p1[14], p1[15]); pa[3] = __builtin_bit_cast(bf16x8, w); }
        const unsigned vb = (unsigned)(uintptr_t)(lds + AT_V) + ((lane >> 4) & 1) * 32 + (lane & 3) * 8 + (4 * hi + ((lane & 15) >> 2)) * 64;
#pragma unroll
        for (int d0 = 0; d0 < 2; ++d0) {
            s16x4 lo[4], hh[4];
#pragma unroll
            for (int ks = 0; ks < 4; ++ks) {
                asm volatile("ds_read_b64_tr_b16 %0, %1 offset:%2" : "=&v"(lo[ks]) : "v"(vb), "i"(d0 * 4096 + ks * 1024) : "memory");
                asm volatile("ds_read_b64_tr_b16 %0, %1 offset:%2" : "=&v"(hh[ks]) : "v"(vb), "i"(d0 * 4096 + ks * 1024 + 512) : "memory");
            }
            asm volatile("s_waitcnt lgkmcnt(0)" : "+v"(lo[0]), "+v"(lo[1]), "+v"(lo[2]), "+v"(lo[3]), "+v"(hh[0]), "+v"(hh[1]), "+v"(hh[2]), "+v"(hh[3]) :: "memory");
#pragma unroll
            for (int ks = 0; ks < 4; ++ks) {
                const bf16x8 vf = (bf16x8){lo[ks][0], lo[ks][1], lo[ks][2], lo[ks][3], hh[ks][0], hh[ks][1], hh[ks][2], hh[ks][3]};
                if (d0 == 0) o0 = __builtin_amdgcn_mfma_f32_32x32x16_bf16(pa[ks], vf, o0, 0, 0, 0);
                else o1 = __builtin_amdgcn_mfma_f32_32x32x16_bf16(pa[ks], vf, o1, 0, 0, 0);
            }
        }
    }
    lrun += __shfl_xor(lrun, 32);
    if (hi == 0) wsf[32 + r32] = lrun;
    LDS_WAIT();
    LAS bf16* stg = (LAS bf16*)(lds + AT_OST) + wid * 2048;
#pragma unroll
    for (int r = 0; r < 16; ++r) { const int orow = crow(r, hi); const float rl = __builtin_amdgcn_rcpf(wsf[32 + orow]);
        stg[orow * 64 + r32] = (bf16)(cvt_pk_bf16(o0[r] * rl, 0.f) & 0xffffu); stg[orow * 64 + 32 + r32] = (bf16)(cvt_pk_bf16(o1[r] * rl, 0.f) & 0xffffu); }
    LDS_WAIT();
#pragma unroll
    for (int i = 0; i < 4; ++i) { const int row = i * 8 + (lane >> 3), ch = lane & 7; const v4u v = *(const LAS v4u*)(stg + row * 64 + ch * 8);
        *(v4u*)(O0 + (size_t)(wid * 32 + row) * opitch + ch * 8) = v; }
    LDS_WAIT();
}

constexpr int DC_T = 0, DC_KR = 32768, DC_P = 49664, DC_AL = 53760;
constexpr int DPART_STRIDE = 8 * 132;
__device__ __forceinline__ void decode_item(const Frame& F, int b, int half) {
    LAS unsigned char* lds = F.lds;
    const int tid = F.tid, lane = F.lane, wid = F.wave, r32 = lane & 31, hi = lane >> 5, fr = lane & 15, fq = lane >> 4;
    const bf16* wkv = (const bf16*)(F.ws + WS_WKV);
    const bf16* qb = (const bf16*)(F.ws + WS_QB) + (size_t)(NTOK + b) * 768 + wid * 96;
    const float* g_kn = F.in[22];
    bf16x8 wA[8][2];
    { const int pn = wid >> 2, wc = wid & 3;
#pragma unroll
      for (int dt = 0; dt < 2; ++dt) { const bf16* rowp = wkv + (size_t)(256 * pn + 128 * dt + 32 * wc + r32) * 128;
#pragma unroll
        for (int s = 0; s < 8; ++s) wA[s][dt] = *(const bf16x8*)(rowp + 16 * s + 8 * hi); } }
    float qg[2][16], qrp[16];
#pragma unroll
    for (int dt = 0; dt < 2; ++dt)
#pragma unroll
        for (int r = 0; r < 16; ++r) { const int d = 32 * dt + crow(r, hi); qg[dt][r] = g_kn[d] * bf2f(qb[d]); }
#pragma unroll
    for (int i = 0; i < 16; ++i) qrp[i] = bf2f(qb[64 + 16 * hi + i]);
    for (int i = tid; i < 8 * 64; i += 512) ((LAS unsigned*)(lds + DC_P + 8 * 256))[i] = 0u;
    float mrun = -INFINITY, lrun = 0.f;
    f32x4 accL = (f32x4){0.f, 0.f, 0.f, 0.f};
    const int* ptab = (const int*)F.in[5] + b * NPAGES + half * 64;
    const int npg = 64 + (half == 1 ? 1 : 0);
    for (int pg = 0; pg < npg; ++pg) {
        const bool newtok = pg == 64;
        __syncthreads();
        if (!newtok) {
            const int page = ptab[pg];
            const float* ck = F.in[3] + (size_t)page * (PAGE * 128);
            const float* kr = F.in[4] + (size_t)page * (PAGE * 32);
#pragma unroll
            for (int it = 0; it < 4; ++it) {
                const int idx = tid + it * 512, key = idx >> 4, c = idx & 15;
                const f32x4 a = *(const f32x4*)(ck + (size_t)key * 128 + c * 8), bq = *(const f32x4*)(ck + (size_t)key * 128 + c * 8 + 4);
                v4u w; w.x = cvt_pk_bf16(a[0], a[1]); w.y = cvt_pk_bf16(a[2], a[3]); w.z = cvt_pk_bf16(bq[0], bq[1]); w.w = cvt_pk_bf16(bq[2], bq[3]);
                *(LAS v4u*)(lds + DC_T + c * 2048 + key * 16) = w;
            }
#pragma unroll
            for (int it = 0; it < 2; ++it) {
                const int idx = tid + it * 512, key = idx >> 3, c4 = idx & 7;
                const f32x4 a = *(const f32x4*)(kr + (size_t)key * 32 + c4 * 4);
                LAS float* dst = (LAS float*)(lds + DC_KR) + key * 33 + c4 * 4;
                dst[0] = a[0]; dst[1] = a[1]; dst[2] = a[2]; dst[3] = a[3];
            }
        } else {
            const bf16* ckn = (const bf16*)(F.ws + WS_CKVB) + (size_t)(NTOK + b) * 128;
            const bf16* krn = (const bf16*)(F.ws + WS_KRB) + (size_t)(NTOK + b) * 32;
#pragma unroll
            for (int it = 0; it < 4; ++it) { const int idx = tid + it * 512, key = idx >> 4, c = idx & 15;
                v4u w = (v4u){0u, 0u, 0u, 0u}; if (key == 0) w = *(const v4u*)(ckn + c * 8);
                *(LAS v4u*)(lds + DC_T + c * 2048 + key * 16) = w; }
            for (int i = tid; i < 128 * 33; i += 512) { const int key = i / 33, c = i - key * 33; ((LAS float*)(lds + DC_KR))[i] = (key == 0 && c < 32) ? bf2f(krn[c]) : 0.f; }
        }
        __syncthreads();
        float sc[4];
#pragma unroll
        for (int g = 0; g < 4; ++g) {
            f32x16 a0, a1;
#pragma unroll
            for (int r = 0; r < 16; ++r) { a0[r] = 0.f; a1[r] = 0.f; }
#pragma unroll
            for (int s = 0; s < 8; ++s) {
                const bf16x8 bfrag = *(const LAS bf16x8*)(lds + DC_T + (2 * s + hi) * 2048 + (32 * g + r32) * 16);
                a0 = __builtin_amdgcn_mfma_f32_32x32x16_bf16(wA[s][0], bfrag, a0, 0, 0, 0);
                a1 = __builtin_amdgcn_mfma_f32_32x32x16_bf16(wA[s][1], bfrag, a1, 0, 0, 0);
            }
            float ssq = 0.f, dot = 0.f;
#pragma unroll
            for (int r = 0; r < 16; ++r) { ssq += a0[r] * a0[r] + a1[r] * a1[r]; dot += a0[r] * qg[0][r] + a1[r] * qg[1][r]; }
            const LAS float* krow = (const LAS float*)(lds + DC_KR) + (32 * g + r32) * 33 + 16 * hi;
            float sr = 0.f;
#pragma unroll
            for (int i = 0; i < 16; ++i) sr += krow[i] * qrp[i];
            ssq += __shfl_xor(ssq, 32); dot += __shfl_xor(dot, 32); sr += __shfl_xor(sr, 32);
            float sv = dot * __builtin_amdgcn_rsqf(ssq * (1.0f / 64.0f) + EPS) + sr;
            if (newtok && (32 * g + r32) != 0) sv = -INFINITY;
            sc[g] = sv;
        }
        float pm = fmaxf(fmaxf(sc[0], sc[1]), fmaxf(sc[2], sc[3]));
        pm = wave_max(pm);
        const float mn = fmaxf(mrun, pm);
        const float alpha = __builtin_amdgcn_exp2f(mrun - mn);
        mrun = mn;
        float ls = 0.f;
#pragma unroll
        for (int g = 0; g < 4; ++g) { sc[g] = __builtin_amdgcn_exp2f(sc[g] - mn); ls += sc[g]; }
        ls = wave_sum(ls) * 0.5f;
        lrun = lrun * alpha + ls;
        if (hi == 0) {
#pragma unroll
            for (int g = 0; g < 4; ++g) ((LAS bf16*)(lds + DC_P))[wid * 128 + 32 * g + r32] = (bf16)(cvt_pk_bf16(sc[g], 0.f) & 0xffffu);
        }
        if (lane == 0) ((LAS float*)(lds + DC_AL))[wid] = alpha;
        __syncthreads();
        if (fq < 2) {
#pragma unroll
            for (int i = 0; i < 4; ++i) accL[i] *= ((LAS float*)(lds + DC_AL))[4 * fq + i];
        }
        {
            const int q = fr >> 2, p = fr & 3;
#pragma unroll
            for (int ks = 0; ks < 4; ++ks) {
                const bf16x8 pa = *(const LAS bf16x8*)(lds + DC_P + fr * 256 + (32 * ks + 8 * fq) * 2);
                const unsigned a0 = (unsigned)(uintptr_t)(lds + DC_T) + (2 * wid + (p >> 1)) * 2048 + (32 * ks + 8 * fq + q) * 16 + (p & 1) * 8;
                s16x4 lo, hh;
                asm volatile("ds_read_b64_tr_b16 %0, %2\n\tds_read_b64_tr_b16 %1, %2 offset:64\n\ts_waitcnt lgkmcnt(0)" : "=&v"(lo), "=&v"(hh) : "v"(a0) : "memory");
                const bf16x8 vf = (bf16x8){lo[0], lo[1], lo[2], lo[3], hh[0], hh[1], hh[2], hh[3]};
                accL = __builtin_amdgcn_mfma_f32_16x16x32_bf16(pa, vf, accL, 0, 0, 0);
            }
        }
    }
    float* part = (float*)(F.ws + WS_DPART) + (size_t)(b * 2 + half) * DPART_STRIDE;
    if (lane == 0) { part[wid * 132 + 0] = mrun; part[wid * 132 + 1] = lrun; }
    if (fq < 2) {
#pragma unroll
        for (int i = 0; i < 4; ++i) part[(4 * fq + i) * 132 + 4 + 16 * wid + fr] = accL[i];
    }
    __syncthreads();
}
__device__ __forceinline__ v4u norm8_pack(const float (&v)[8], float inv) {
    v4u w; w.x = cvt_pk_bf16(v[0] * inv, v[1] * inv); w.y = cvt_pk_bf16(v[2] * inv, v[3] * inv); w.z = cvt_pk_bf16(v[4] * inv, v[5] * inv); w.w = cvt_pk_bf16(v[6] * inv, v[7] * inv); return w;
}
__device__ __forceinline__ v2u norm4_pack(const float (&v)[4], float inv) { v2u w; w.x = cvt_pk_bf16(v[0] * inv, v[1] * inv); w.y = cvt_pk_bf16(v[2] * inv, v[3] * inv); return w; }
__device__ __forceinline__ void tp_finish_row(bf16* omix_row, const float (&a)[8], const float (&y)[4], const float (&mo)[4], int lane) {
    float sa = 0.f, sy = 0.f, sm = 0.f;
#pragma unroll
    for (int i = 0; i < 8; ++i) sa += a[i] * a[i];
#pragma unroll
    for (int i = 0; i < 4; ++i) { sy += y[i] * y[i]; sm += mo[i] * mo[i]; }
    sa = wave_sum(sa); sy = wave_sum(sy); sm = wave_sum(sm);
    const float ia = __builtin_amdgcn_rsqf(sa * (1.0f / 512.0f) + EPS), iy = __builtin_amdgcn_rsqf(sy * (1.0f / 256.0f) + EPS), im = __builtin_amdgcn_rsqf(sm * (1.0f / 256.0f) + EPS);
    *(v4u*)(omix_row + 8 * lane) = norm8_pack(a, ia);
    *(v2u*)(omix_row + 512 + 4 * lane) = norm4_pack(y, iy);
    *(v2u*)(omix_row + 768 + 4 * lane) = norm4_pack(mo, im);
}
__device__ __forceinline__ void tp_prompt_row(const Frame& F, int r) {
    const int lane = F.lane, t = r & (SEQ - 1);
    const bf16* oab = (const bf16*)(F.ws + WS_OAB); const bf16* omb = (const bf16*)(F.ws + WS_OMB); const bf16* ub = (const bf16*)(F.ws + WS_UB); const bf16* gbb = (const bf16*)(F.ws + WS_GBB);
    const float* cw = F.in[24];
    float a[8], y[4], mo[4];
    { const v4u w = *(const v4u*)(oab + (size_t)r * 512 + 8 * lane); a[0] = bflo(w.x); a[1] = bfhi(w.x); a[2] = bflo(w.y); a[3] = bfhi(w.y); a[4] = bflo(w.z); a[5] = bfhi(w.z); a[6] = bflo(w.w); a[7] = bfhi(w.w); }
    { const v2u w = *(const v2u*)(omb + (size_t)r * 256 + 4 * lane); mo[0] = bflo(w.x); mo[1] = bfhi(w.x); mo[2] = bflo(w.y); mo[3] = bfhi(w.y); }
    { const v2u u0 = *(const v2u*)(ub + (size_t)r * 256 + 4 * lane);
      v2u u1 = (v2u){0u, 0u}, u2 = (v2u){0u, 0u};
      if (t >= 1) u1 = *(const v2u*)(ub + (size_t)(r - 1) * 256 + 4 * lane);
      if (t >= 2) u2 = *(const v2u*)(ub + (size_t)(r - 2) * 256 + 4 * lane);
      const v2u g = *(const v2u*)(gbb + (size_t)r * 256 + 4 * lane);
      const f32x4 w0 = *(const f32x4*)(cw + 4 * lane), w1 = *(const f32x4*)(cw + 256 + 4 * lane), w2 = *(const f32x4*)(cw + 512 + 4 * lane);
      y[0] = bflo(g.x) * (w0[0] * bflo(u2.x) + w1[0] * bflo(u1.x) + w2[0] * bflo(u0.x));
      y[1] = bfhi(g.x) * (w0[1] * bfhi(u2.x) + w1[1] * bfhi(u1.x) + w2[1] * bfhi(u0.x));
      y[2] = bflo(g.y) * (w0[2] * bflo(u2.y) + w1[2] * bflo(u1.y) + w2[2] * bflo(u0.y));
      y[3] = bfhi(g.y) * (w0[3] * bfhi(u2.y) + w1[3] * bfhi(u1.y) + w2[3] * bfhi(u0.y)); }
    tp_finish_row((bf16*)(F.ws + WS_OMIX) + (size_t)r * D, a, y, mo, lane);
}
__device__ __forceinline__ void tp_sample_row(const Frame& F, int b, LAS float* scr) {
    const int lane = F.lane, r = NTOK + b;
    LAS float* lat = scr;
    LAS float* qf = scr + 1024;
    LAS float* pb = scr + 1088;
    LAS float* omo = scr + 1344;
    const float* part = (const float*)(F.ws + WS_DPART) + (size_t)(b * 2) * DPART_STRIDE;
#pragma unroll
    for (int h = 0; h < 8; ++h) {
        const float m0 = part[h * 132], l0 = part[h * 132 + 1], m1 = part[DPART_STRIDE + h * 132], l1 = part[DPART_STRIDE + h * 132 + 1];
        const float M = fmaxf(m0, m1), e0 = __builtin_amdgcn_exp2f(m0 - M), e1 = __builtin_amdgcn_exp2f(m1 - M);
        const float rl = 1.0f / (l0 * e0 + l1 * e1);
#pragma unroll
        for (int j = 0; j < 2; ++j) { const int c = lane + 64 * j; lat[h * 128 + c] = (part[h * 132 + 4 + c] * e0 + part[DPART_STRIDE + h * 132 + 4 + c] * e1) * rl; }
    }
    LDS_WAIT();
    float a[8], y[4], mo[4];
    { const float* wuv = F.in[21]; const int h = lane >> 3;
#pragma unroll
      for (int i = 0; i < 8; ++i) a[i] = 0.f;
      for (int l = 0; l < 128; ++l) { const float x = lat[h * 128 + l]; const f32x4 w0 = *(const f32x4*)(wuv + (size_t)l * 512 + 8 * lane), w1 = *(const f32x4*)(wuv + (size_t)l * 512 + 8 * lane + 4);
          a[0] += x * w0[0]; a[1] += x * w0[1]; a[2] += x * w0[2]; a[3] += x * w0[3]; a[4] += x * w1[0]; a[5] += x * w1[1]; a[6] += x * w1[2]; a[7] += x * w1[3]; } }
    { const bf16* ub = (const bf16*)(F.ws + WS_UB); const bf16* gbb = (const bf16*)(F.ws + WS_GBB); const float* cw = F.in[24]; const float* st = F.in[6] + (size_t)b * 512;
      const v2u u0 = *(const v2u*)(ub + (size_t)r * 256 + 4 * lane); const v2u g = *(const v2u*)(gbb + (size_t)r * 256 + 4 * lane);
      const f32x4 s0 = *(const f32x4*)(st + 4 * lane), s1 = *(const f32x4*)(st + 256 + 4 * lane);
      const f32x4 w0 = *(const f32x4*)(cw + 4 * lane), w1 = *(const f32x4*)(cw + 256 + 4 * lane), w2 = *(const f32x4*)(cw + 512 + 4 * lane);
      y[0] = bflo(g.x) * (w0[0] * s0[0] + w1[0] * s1[0] + w2[0] * bflo(u0.x));
      y[1] = bfhi(g.x) * (w0[1] * s0[1] + w1[1] * s1[1] + w2[1] * bfhi(u0.x));
      y[2] = bflo(g.y) * (w0[2] * s0[2] + w1[2] * s1[2] + w2[2] * bflo(u0.y));
      y[3] = bfhi(g.y) * (w0[3] * s0[3] + w1[3] * s1[3] + w2[3] * bfhi(u0.y)); }
    { const bf16* mqb = (const bf16*)(F.ws + WS_MQB) + (size_t)r * 256; const float* ck = F.in[7] + (size_t)b * (256 * 256); const float* cv = F.in[8] + (size_t)b * (256 * 256);
#pragma unroll 1
      for (int h = 0; h < 4; ++h) {
          qf[lane] = bf2f(mqb[h * 64 + lane]);
          LDS_WAIT();
          float s[4];
#pragma unroll
          for (int j = 0; j < 4; ++j) { const int n = lane + 64 * j; const float* kp = ck + (size_t)n * 256 + h * 64; float acc = 0.f;
#pragma unroll
              for (int d4 = 0; d4 < 16; ++d4) { const f32x4 kv = *(const f32x4*)(kp + 4 * d4); const f32x4 qv = *(const LAS f32x4*)(qf + 4 * d4); acc += kv[0] * qv[0] + kv[1] * qv[1] + kv[2] * qv[2] + kv[3] * qv[3]; }
              s[j] = acc; }
          const float mx = wave_max(fmaxf(fmaxf(s[0], s[1]), fmaxf(s[2], s[3])));
          float ls = 0.f;
#pragma unroll
          for (int j = 0; j < 4; ++j) { s[j] = __builtin_amdgcn_exp2f(s[j] - mx); ls += s[j]; pb[lane + 64 * j] = s[j]; }
          ls = wave_sum(ls);
          LDS_WAIT();
          float o = 0.f;
          for (int n = 0; n < 256; ++n) o += pb[n] * cv[(size_t)n * 256 + h * 64 + lane];
          omo[h * 64 + lane] = o / ls;
          LDS_WAIT();
      }
#pragma unroll
      for (int i = 0; i < 4; ++i) mo[i] = omo[4 * lane + i]; }
    *(v4u*)((bf16*)(F.ws + WS_OAB) + (size_t)r * 512 + 8 * lane) = norm8_pack(a, 1.0f);
    *(v2u*)((bf16*)(F.ws + WS_OMB) + (size_t)r * 256 + 4 * lane) = norm4_pack(mo, 1.0f);
    tp_finish_row((bf16*)(F.ws + WS_OMIX) + (size_t)r * D, a, y, mo, lane);
    LDS_WAIT();
}
__device__ __forceinline__ void tp_phase(const Frame& F) {
    LAS float* scr = (LAS float*)(F.lds + F.wave * 16384);
    if (F.wave == 0) for (int b = F.vcu; b < NS; b += F.G) tp_sample_row(F, b, scr);
    const int gw = F.vcu * NWAVES + F.wave, NGW = F.G * NWAVES;
    for (int r = gw; r < NTOK; r += NGW) tp_prompt_row(F, r);
}
#if DBG_ORACLE
__device__ __forceinline__ void dbg_phase(const Frame& F);
__device__ __forceinline__ void dbg_report(const Frame& F, unsigned* barw);
#endif
#define P_BF(off) ((bf16*)(F.ws + (off)))
#define P_F32(off) ((float*)(F.ws + (off)))
#define W1GU P_BF(WS_W1GU)
#define W1D P_BF(WS_W1D)
#define WIN P_BF(WS_WIN)
#define WUQ P_BF(WS_WUQ)
#define WKV P_BF(WS_WKV)
#define WO P_BF(WS_WO)
#define W2GU P_BF(WS_W2GU)
#define W2D P_BF(WS_W2D)
#define WMEM P_BF(WS_WMEM)
#define rope P_F32(WS_ROPE)
#define ssq0 P_F32(WS_SSQ0)
#define ssq1 P_F32(WS_SSQ1)
#define ssq2 P_F32(WS_SSQ2)
#define msq P_F32(WS_MSQ)
#define ssqm P_F32(WS_SSQM)
#define xb P_BF(WS_XB)
#define act1 P_BF(WS_ACT1)
#define act2 P_BF(WS_ACT2)
#define x1f P_F32(WS_X1F)
#define x1b P_BF(WS_X1B)
#define x2f P_F32(WS_X2F)
#define x2b P_BF(WS_X2B)
#define cqb P_BF(WS_CQB)
#define ckvb P_BF(WS_CKVB)
#define krb P_BF(WS_KRB)
#define ub P_BF(WS_UB)
#define gbb P_BF(WS_GBB)
#define mqb P_BF(WS_MQB)
#define qb P_BF(WS_QB)
#define Kb P_BF(WS_KB)
#define Vb P_BF(WS_VB)
#define memb P_BF(WS_MEMB)
#define memK P_BF(WS_MEMK)
#define memV P_BF(WS_MEMV)
#define oab P_BF(WS_OAB)
#define omb P_BF(WS_OMB)
#define omix P_BF(WS_OMIX)
__global__ void __launch_bounds__(NWAVES * 64, 2) mk_fwd(Args args) {
    extern __shared__ __attribute__((aligned(16))) unsigned char lds_raw[];
    Frame F;
    F.lds = (LAS unsigned char*)lds_raw;
    F.wave = __builtin_amdgcn_readfirstlane((int)threadIdx.x >> 6);
    F.G = gridDim.x; { const int bx = blockIdx.x; F.vcu = (F.G % 8 == 0) ? (bx % 8) * (F.G / 8) + bx / 8 : bx; }
#define PHASE_BEGIN() do { const CAS Args* ka_ = (const CAS Args*)__builtin_amdgcn_kernarg_segment_ptr(); asm volatile("" : "+s"(ka_)); F.in = (InTab)ka_->in; F.out = ka_->out; F.ws = ka_->ws; \
        int t_ = threadIdx.x; asm volatile("" : "+v"(t_)); F.tid = t_; F.lane = t_ & 63; } while (0)
    PHASE_BEGIN();
    for (int u = F.tid; u < (LDS_BYTES - LDSCTL_OFF) / 4; u += NWAVES * 64) ((LAS unsigned*)(F.lds + LDSCTL_OFF))[u] = 0u;
    __syncthreads();
    XcdBarrier bar = xcd_barrier_post((unsigned*)(F.ws + WS_CTL) + CW_BAR, (volatile LAS unsigned*)(F.lds + MISC_OFF) + 8);
    const int lo = args.ph_lo, hi = args.ph_hi;
#ifndef PH_MASK
#define PH_MASK 0xFFFF
#endif
#define IN(k) (((PH_MASK >> (k)) & 1) && lo <= (k) && (k) < hi)
#define SEAM(k) do { if (IN(k) && IN((k) + 1)) xcd_barrier(bar); } while (0)
    const int bx = (int)blockIdx.x;

    if (IN(0)) { PHASE_BEGIN(); p0_prologue(F); }
    SEAM(0);
    if (IN(1)) { PHASE_BEGIN();
        pg8::Gemm g{xb, W1GU, MP, FF2, D}; pg8::StaticOrder S; S.init(MP, FF2, F.G, bx);
        pg8::EpiSwiGLU E{ssq0, act1, FF};
        pg8::gemm_phase<pg8::EpiSwiGLU, pg8::StaticOrder, true, true>(F.lds, g, S, E);
    }
    SEAM(1);
    if (IN(2)) { PHASE_BEGIN();
        pg8::Gemm g{act1, W1D, MP, D, FF}; pg8::StaticOrder S; S.init(MP, D, F.G, bx);
        pg8::EpiResid E{F.in[0], F.in[2], x1f, x1f + (size_t)NTOK * D, x1b, ssq1, 0.5f};
        pg8::gemm_phase<pg8::EpiResid, pg8::StaticOrder, true, true>(F.lds, g, S, E);
    }
    SEAM(2);
    if (IN(3)) { PHASE_BEGIN();
        { pg8::Gemm g{x1b, WIN, MP, INWP, D}; pg8::StaticOrder S; S.init(MP, INWP, F.G, bx);
          pg8::EpiZ E{ssq1, (LAS float*)(F.lds + XCH_OFF), msq, cqb, F.in[19], F.in[23], F.in[28], rope,
                      F.out + O_CKVP, F.out + O_CKVS, F.out + O_KRP, F.out + O_KRS, F.out + O_CONVP, F.out + O_CONVS, ckvb, krb, Kb, ub, gbb, mqb};
          pg8::gemm_phase<pg8::EpiZ, pg8::StaticOrder, true, true>(F.lds, g, S, E); }
        { pg8::Gemm g{memb, WMEM, 1024, 512, D}; pg8::StaticOrder S; S.init(1024, 512, F.G, bx);
          pg8::EpiMem E{ssqm, F.in[29], F.out + O_MKP, F.out + O_MVP, memK, memV};
          pg8::gemm_phase<pg8::EpiMem, pg8::StaticOrder, true, true>(F.lds, g, S, E); }
    }
    SEAM(3);
    if (IN(4)) { PHASE_BEGIN();
        { pg8::Gemm g{cqb, WUQ, MP, 768, 256}; pg8::StaticOrder S; S.init(MP, 768, F.G, bx);
          pg8::EpiQ E{msq, F.in[17], F.in[18], rope, qb};
          pg8::gemm_phase<pg8::EpiQ, pg8::StaticOrder, true, true>(F.lds, g, S, E); }
        { pg8::Gemm g{ckvb, WKV, NTOK, 1024, 128}; pg8::StaticOrder S; S.init(NTOK, 1024, F.G, bx);
          pg8::EpiKV E{F.in[22], Kb, Vb};
          pg8::gemm_phase<pg8::EpiKV, pg8::StaticOrder, true, true>(F.lds, g, S, E); }
    }
    SEAM(4);
    if (IN(5)) { PHASE_BEGIN();
        for (int i = 0;; ++i) {
            int bh, qblk;
            if (F.G == 256) { if (i >= 4) break; const int s = F.vcu & 7; bh = F.vcu >> 3; qblk = (i == 0) ? s : (i == 1) ? 15 - s : (i == 2) ? 16 + s : 31 - s; }
            else { const int u = F.vcu + i * F.G; if (u >= 1024) break; bh = u >> 5; qblk = u & 31; }
            const int b = bh >> 3, h = bh & 7; const size_t row0 = (size_t)b * SEQ + (size_t)qblk * 256;
            attn_unit_simple<96, true>(qb + row0 * 768 + h * 96, 768, Kb + (size_t)bh * SEQ * 96, Vb + (size_t)bh * SEQ * 64, oab + row0 * 512 + h * 64, 512, 4 * (qblk + 1), F.lds);
        }
        for (int u = F.vcu; u < 512; u += F.G) {
            const int b = u >> 7, h = (u >> 5) & 3, qblk = u & 31; const size_t row0 = (size_t)b * SEQ + (size_t)qblk * 256;
            attn_unit_simple<64, false>(mqb + row0 * 256 + h * 64, 256, memK + (size_t)(b * 4 + h) * 256 * 64, memV + (size_t)(b * 4 + h) * 256 * 64, omb + row0 * 256 + h * 64, 256, 4, F.lds);
        }
        __syncthreads();
        for (int it = F.vcu; it < 2 * NS; it += F.G) decode_item(F, it >> 1, it & 1);
    }
    SEAM(5);
    if (IN(6)) { PHASE_BEGIN(); tp_phase(F); }
    SEAM(6);
    if (IN(7)) { PHASE_BEGIN();
        pg8::Gemm g{omix, WO, MP, D, D}; pg8::StaticOrder S; S.init(MP, D, F.G, bx);
        pg8::EpiResid E{x1f, x1f + (size_t)NTOK * D, x2f, x2f + (size_t)NTOK * D, x2b, ssq2, 1.0f};
        pg8::gemm_phase<pg8::EpiResid, pg8::StaticOrder, true, true>(F.lds, g, S, E);
    }
    SEAM(7);
    if (IN(8)) { PHASE_BEGIN();
        pg8::Gemm g{x2b, W2GU, MP, FF2, D}; pg8::StaticOrder S; S.init(MP, FF2, F.G, bx);
        pg8::EpiSwiGLU E{ssq2, act2, FF};
        pg8::gemm_phase<pg8::EpiSwiGLU, pg8::StaticOrder, true, true>(F.lds, g, S, E);
    }
    SEAM(8);
    if (IN(9)) { PHASE_BEGIN();
        pg8::Gemm g{act2, W2D, MP, D, FF}; pg8::StaticOrder S; S.init(MP, D, F.G, bx);
        pg8::EpiResid E{x2f, x2f + (size_t)NTOK * D, F.out + O_Y, F.out + O_YS, nullptr, nullptr, 0.5f};
        pg8::gemm_phase<pg8::EpiResid, pg8::StaticOrder, true, true>(F.lds, g, S, E);
    }
#if DBG_ORACLE
    if (IN(9)) { xcd_barrier(bar); PHASE_BEGIN(); dbg_phase(F); xcd_barrier(bar); PHASE_BEGIN(); dbg_report(F, (unsigned*)(F.ws + WS_CTL) + CW_BAR); }
#endif
#undef IN
#undef SEAM
#undef PHASE_BEGIN
}
#undef W1GU
#undef W1D
#undef WIN
#undef WUQ
#undef WKV
#undef WO
#undef W2GU
#undef W2D
#undef WMEM
#undef rope
#undef ssq0
#undef ssq1
#undef ssq2
#undef msq
#undef ssqm
#undef xb
#undef act1
#undef act2
#undef x1f
#undef x1b
#undef x2f
#undef x2b
#undef cqb
#undef ckvb
#undef krb
#undef ub
#undef gbb
#undef mqb
#undef qb
#undef Kb
#undef Vb
#undef memb
#undef memK
#undef memV
#undef oab
#undef omb
#undef omix
#undef P_BF
#undef P_F32

extern "C" void kernel_launch(void* const* d_in, const int* in_sizes, int n_in, void* d_out, int out_size, void* d_ws, size_t ws_size, hipStream_t stream) {
    static int grid = 0;
    if (grid == 0) {
        if (n_in != 38 || (size_t)out_size != O_TOTAL || ws_size < WS_END) { fprintf(stderr, "kernel_launch: unexpected shapes (n_in %d, out %d, ws %zu)\n", n_in, out_size, ws_size); grid = -1; return; }
        int dev = 0, cus = 0, per_cu = 0;
        if (hipGetDevice(&dev) != hipSuccess || hipDeviceGetAttribute(&cus, hipDeviceAttributeMultiprocessorCount, dev) != hipSuccess) { grid = -1; return; }
        if (hipFuncSetAttribute((const void*)mk_fwd, hipFuncAttributeMaxDynamicSharedMemorySize, LDS_BYTES) != hipSuccess) { fprintf(stderr, "kernel_launch: hipFuncSetAttribute failed\n"); grid = -1; return; }
        if (hipOccupancyMaxActiveBlocksPerMultiprocessor(&per_cu, (const void*)mk_fwd, NWAVES * 64, LDS_BYTES) != hipSuccess || per_cu < 1) { fprintf(stderr, "kernel_launch: occupancy query says %d\n", per_cu); }
        (void)hipGetLastError();
        grid = cus;
    }
    if (grid < 0) return;
    (void)hipMemsetAsync((char*)d_ws + WS_CTL, 0, CTL_ZERO_BYTES, stream);
#if DBG_ORACLE
    (void)hipMemsetAsync((char*)d_ws + WS_DBG, 0, 1 * MiB, stream);
#endif
    Args a{};
    for (int i = 0; i < 38; ++i) a.in[i] = (const float*)d_in[i];
    a.out = (float*)d_out; a.ws = (unsigned char*)d_ws;
    a.ph_lo = 0; a.ph_hi = 10;
    hipLaunchKernelGGL(mk_fwd, dim3(grid), dim3(NWAVES * 64), LDS_BYTES, stream, a);
}
```

```cpp
#include <hip/hip_runtime.h>
#include <cstdint>
#include <cstdio>
#include <cmath>
#define DBG_ORACLE 0
#define DBG_TOL 0.03f

namespace pg8 {
#define PG8_LAS __attribute__((address_space(3)))
typedef unsigned short bf16_t;
typedef short bf16x8 __attribute__((ext_vector_type(8)));
typedef float f32x4 __attribute__((ext_vector_type(4)));
typedef unsigned u32x4 __attribute__((ext_vector_type(4)));
constexpr int BM = 256, BK = 64, HALF = 128, HTB = HALF * BK * 2  , STAGE_BYTES = 8 * HTB, NXCD = 8, WGM = 8;

__host__ __device__ __forceinline__ int lds_byte(int r, int c) { const int st = (r >> 4) * 2 + (c >> 5), rr = r & 15, cc = c & 31, ob = rr * 64 + cc * 2; return st * 1024 + (ob ^ (((ob >> 9) & 1) << 5)); }
__host__ __device__ __forceinline__ void stage_rc(int b, int& R, int& C) { const int st = b / 1024, sb = b % 1024, swz = sb ^ (((sb >> 9) & 1) << 5); R = (st >> 1) * 16 + swz / 64; C = (st & 1) * 32 + (swz % 64) / 2; }
__host__ __device__ __forceinline__ int perm32(int rho) { const int n = rho >> 4, i = rho & 15; return 8 * (i >> 2) + 4 * n + (i & 3); }

struct Unit { int pm, pn; };
struct Gemm { const bf16_t* A; const bf16_t* Bt; int M, N, K; };

struct StaticOrder {
    int nM, nN, nwg, G, c;
    __host__ __device__ void init(int M, int N, int G_, int c_) { nM = M / BM; nN = N / BM; nwg = nM * nN; G = G_; c = c_; }
    __host__ __device__ bool next(int i, Unit& u) const {
        const long L = (long)i * G + c; if (L >= nwg) return false;
        int wgid = (int)L; { const int q = nwg / NXCD, r = nwg % NXCD, xcd = wgid % NXCD, off = wgid / NXCD; wgid = (xcd < r ? xcd * (q + 1) : r * (q + 1) + (xcd - r) * q) + off; }
        const int nig = WGM * nN, gid = wgid / nig, fm = gid * WGM, gsz = (nM - fm) < WGM ? (nM - fm) : WGM;
        u.pm = fm + ((wgid % nig) % gsz); u.pn = (wgid % nig) / gsz; return true;
    }
    __device__ __forceinline__ void a_ready(const Unit&) const {}
    __device__ __forceinline__ void done(const Unit&) const {}
};

__device__ __forceinline__ unsigned cvt_pk_bf16(float lo, float hi) { typedef float f2_ __attribute__((ext_vector_type(2))); typedef __bf16 b2_ __attribute__((ext_vector_type(2))); const f2_ v = {lo, hi}; const b2_ b = __builtin_convertvector(v, b2_); return __builtin_bit_cast(unsigned, b); }
typedef float f32x2 __attribute__((ext_vector_type(2)));
constexpr int kNTOK = 32768, kMR = 32896, kSEQ = 8192;
constexpr float kEPS = 1e-6f;
constexpr float kLOG2E = 1.4426950408889634f;
constexpr float kC2Q = 0.10206207261596577f * 1.4426950408889634f;
constexpr float kC2M = 0.125f * 1.4426950408889634f;
typedef unsigned u32x2 __attribute__((ext_vector_type(2)));
__device__ __forceinline__ int fresh_lane() { int l; asm volatile("v_mbcnt_lo_u32_b32 %0, -1, 0\n\tv_mbcnt_hi_u32_b32 %0, -1, %0" : "=v"(l)); return l; }

__device__ __forceinline__ float row_inv_from_parts(const float* parts, int row) {
    const f32x4* p = (const f32x4*)(parts + (size_t)row * 16);
    const f32x4 a = p[0], b = p[1], c = p[2], d = p[3];
    const float s = ((a[0] + a[1]) + (a[2] + a[3])) + ((b[0] + b[1]) + (b[2] + b[3])) + ((c[0] + c[1]) + (c[2] + c[3])) + ((d[0] + d[1]) + (d[2] + d[3]));
    return __builtin_amdgcn_rsqf(s * (1.0f / 1024.0f) + kEPS);
}
__device__ __forceinline__ float silu_mul(float g, float u) {
    const float e = __builtin_amdgcn_exp2f(-g * kLOG2E);
    return g * __builtin_amdgcn_rcpf(1.0f + e) * u;
}

struct EpiSwiGLU {
    static constexpr bool PERM = true, AFTER_DRAIN = false;
    const float* ssq; bf16_t* act; int ldact;
    __device__ __forceinline__ void operator()(const f32x4 (&acc)[2][2][4][2], const Unit& u, int wr, int wc, int fr_, int fq_) const {
        const int ln_ = fresh_lane(), fr = ln_ & 15, fq = ln_ >> 4; (void)fr_; (void)fq_;
#pragma unroll
        for (int ai = 0; ai < 2; ++ai)
#pragma unroll
            for (int m = 0; m < 4; ++m) {
                const int row = u.pm * BM + ai * HALF + wr * 64 + m * 16 + fr;
                const float inv = row_inv_from_parts(ssq, row);
                const f32x4 g0 = acc[ai][0][m][0] * inv, g1 = acc[ai][0][m][1] * inv, u0 = acc[ai][1][m][0] * inv, u1 = acc[ai][1][m][1] * inv;
                u32x4 w;
                w.x = cvt_pk_bf16(silu_mul(g0[0], u0[0]), silu_mul(g0[1], u0[1])); w.y = cvt_pk_bf16(silu_mul(g0[2], u0[2]), silu_mul(g0[3], u0[3]));
                w.z = cvt_pk_bf16(silu_mul(g1[0], u1[0]), silu_mul(g1[1], u1[1])); w.w = cvt_pk_bf16(silu_mul(g1[2], u1[2]), silu_mul(g1[3], u1[3]));
                *(u32x4*)(act + (size_t)row * ldact + u.pn * 128 + wc * 32 + 8 * fq) = w;
                if (m & 1) asm volatile("" ::: "memory");
            }
    }
};

struct EpiResid {
    static constexpr bool PERM = true, AFTER_DRAIN = false;
    const float* base0; const float* base1; float* out0; float* out1; bf16_t* ob; float* ssq_out; float scale;
    __device__ __forceinline__ void operator()(const f32x4 (&acc)[2][2][4][2], const Unit& u, int wr, int wc, int fr_, int fq_) const {
        const int ln_ = fresh_lane(), fr = ln_ & 15, fq = ln_ >> 4; (void)fr_; (void)fq_;
#pragma unroll
        for (int ai = 0; ai < 2; ++ai)
#pragma unroll
            for (int m = 0; m < 4; ++m) {
                const int row = u.pm * BM + ai * HALF + wr * 64 + m * 16 + fr;
                const bool live = row < kMR;
                const int rr = row < kNTOK ? row : row - kNTOK;
                const float* bp = (row < kNTOK ? base0 : base1) + (size_t)rr * 1024;
                float* op = (row < kNTOK ? out0 : out1) + (size_t)rr * 1024;
                float s = 0.f;
#pragma unroll
                for (int bj = 0; bj < 2; ++bj) {
                    const int col = u.pn * BM + bj * HALF + wc * 32 + 8 * fq;
                    f32x4 v0 = (f32x4){0.f, 0.f, 0.f, 0.f}, v1 = v0;
                    if (live) { v0 = *(const f32x4*)(bp + col); v1 = *(const f32x4*)(bp + col + 4); }
                    v0 = v0 + acc[ai][bj][m][0] * scale; v1 = v1 + acc[ai][bj][m][1] * scale;
                    s += (v0[0] * v0[0] + v0[1] * v0[1]) + (v0[2] * v0[2] + v0[3] * v0[3]) + (v1[0] * v1[0] + v1[1] * v1[1]) + (v1[2] * v1[2] + v1[3] * v1[3]);
                    if (live) {
                        *(f32x4*)(op + col) = v0; *(f32x4*)(op + col + 4) = v1;
                        if (ob) { u32x4 w; w.x = cvt_pk_bf16(v0[0], v0[1]); w.y = cvt_pk_bf16(v0[2], v0[3]); w.z = cvt_pk_bf16(v1[0], v1[1]); w.w = cvt_pk_bf16(v1[2], v1[3]);
                            *(u32x4*)(ob + (size_t)row * 1024 + col) = w; }
                    }
                }
                s += __shfl_xor(s, 16); s += __shfl_xor(s, 32);
                if (ssq_out && fq == 0) ssq_out[(size_t)row * 16 + u.pn * 4 + wc] = s;
                asm volatile("" ::: "memory");
            }
    }
};

struct EpiZ {
    static constexpr bool PERM = false, AFTER_DRAIN = false;
    const float* ssq1;
    PG8_LAS float* xch;
    float* msq;
    bf16_t* cqb;
    const float* g_kv; const float* g_kr; const float* g_mq;
    const float* rope;
    float* ckv_p; float* ckv_s; float* kr_p; float* kr_s; float* conv_p; float* conv_s;
    bf16_t* ckvb; bf16_t* krb; bf16_t* Kb; bf16_t* ub; bf16_t* gbb; bf16_t* mqb;
    __device__ __forceinline__ void operator()(const f32x4 (&acc)[2][2][4][2], const Unit& u, int wr, int wc, int fr_, int fq_) const {
        const int ln_ = fresh_lane(), fr = ln_ & 15, fq = ln_ >> 4; (void)fr_; (void)fq_;
        const int pn = u.pn;
        float inv1[2][4]; int rows[2][4];
#pragma unroll
        for (int ai = 0; ai < 2; ++ai)
#pragma unroll
            for (int m = 0; m < 4; ++m) { rows[ai][m] = u.pm * BM + ai * HALF + wr * 64 + m * 16 + fr; inv1[ai][m] = row_inv_from_parts(ssq1, rows[ai][m]); }
        if (pn == 0 || pn == 1) {
#pragma unroll
            for (int ai = 0; ai < 2; ++ai)
#pragma unroll
                for (int m = 0; m < 4; ++m) {
                    float s = 0.f; const float iv = inv1[ai][m];
#pragma unroll
                    for (int bj = 0; bj < 2; ++bj) { if (pn == 1 && bj == 1) continue;
#pragma unroll
                        for (int n = 0; n < 2; ++n) { const f32x4 v = acc[ai][bj][m][n] * iv; s += (v[0] * v[0] + v[1] * v[1]) + (v[2] * v[2] + v[3] * v[3]); } }
                    s += __shfl_xor(s, 16); s += __shfl_xor(s, 32);
                    if (fq == 0) xch[(ai * HALF + wr * 64 + m * 16 + fr) * 4 + wc] = s;
                }
            asm volatile("s_waitcnt lgkmcnt(0)" ::: "memory"); __builtin_amdgcn_s_barrier(); asm volatile("" ::: "memory");
        }
        if (pn == 0) {
#pragma unroll
            for (int ai = 0; ai < 2; ++ai)
#pragma unroll
                for (int m = 0; m < 4; ++m) {
                    const int row = rows[ai][m]; const float iv = inv1[ai][m];
                    const f32x4 t = *(const PG8_LAS f32x4*)(xch + (ai * HALF + wr * 64 + m * 16 + fr) * 4);
                    if (wc == 0 && fq == 0 && row < kMR) msq[row] = ((t[0] + t[1]) + (t[2] + t[3])) * (1.0f / 256.0f);
                    if (row < kMR) {
#pragma unroll
                        for (int bj = 0; bj < 2; ++bj)
#pragma unroll
                            for (int n = 0; n < 2; ++n) { const f32x4 v = acc[ai][bj][m][n] * iv; u32x2 w; w.x = cvt_pk_bf16(v[0], v[1]); w.y = cvt_pk_bf16(v[2], v[3]);
                                *(u32x2*)(cqb + (size_t)row * 256 + bj * HALF + wc * 32 + n * 16 + 4 * fq) = w; }
                    }
                }
        } else if (pn == 1) {
#pragma unroll
            for (int ai = 0; ai < 2; ++ai)
#pragma unroll
                for (int m = 0; m < 4; ++m) {
                    const int row = rows[ai][m]; const float iv = inv1[ai][m];
                    if (row >= kMR) continue;
                    const bool smp = row >= kNTOK; const int rr = smp ? row - kNTOK : row;
                    const f32x4 t = *(const PG8_LAS f32x4*)(xch + (ai * HALF + wr * 64 + m * 16 + fr) * 4);
                    const float ic = __builtin_amdgcn_rsqf(((t[0] + t[1]) + (t[2] + t[3])) * (1.0f / 128.0f) + kEPS);
#pragma unroll
                    for (int n = 0; n < 2; ++n) {
                        const int c = wc * 32 + n * 16 + 4 * fq;
                        const f32x4 g = *(const f32x4*)(g_kv + c);
                        const f32x4 v = acc[ai][0][m][n] * (iv * ic) * g;
                        *(f32x4*)((smp ? ckv_s : ckv_p) + (size_t)rr * 128 + c) = v;
                        u32x2 w; w.x = cvt_pk_bf16(v[0], v[1]); w.y = cvt_pk_bf16(v[2], v[3]);
                        *(u32x2*)(ckvb + (size_t)row * 128 + c) = w;
                    }
                    if (wc == 0) {
                        const f32x4 a = acc[ai][1][m][0] * iv, b = acc[ai][1][m][1] * iv;
                        float s = (a[0] * a[0] + a[1] * a[1]) + (a[2] * a[2] + a[3] * a[3]) + (b[0] * b[0] + b[1] * b[1]) + (b[2] * b[2] + b[3] * b[3]);
                        s += __shfl_xor(s, 16); s += __shfl_xor(s, 32);
                        const float ik = __builtin_amdgcn_rsqf(s * (1.0f / 32.0f) + kEPS);
                        const f32x4 ga = *(const f32x4*)(g_kr + 4 * fq), gb = *(const f32x4*)(g_kr + 16 + 4 * fq);
                        const f32x4 x1 = a * ik * ga, x2 = b * ik * gb;
                        const int pos = smp ? kSEQ : (row & (kSEQ - 1));
                        const f32x4 cs = *(const f32x4*)(rope + (size_t)pos * 32 + 4 * fq), sn = *(const f32x4*)(rope + (size_t)pos * 32 + 16 + 4 * fq);
                        const f32x4 o1 = x1 * cs - x2 * sn, o2 = x1 * sn + x2 * cs;
                        float* kro = (smp ? kr_s : kr_p) + (size_t)rr * 32;
                        *(f32x4*)(kro + 4 * fq) = o1; *(f32x4*)(kro + 16 + 4 * fq) = o2;
                        u32x2 w1, w2; w1.x = cvt_pk_bf16(o1[0], o1[1]); w1.y = cvt_pk_bf16(o1[2], o1[3]); w2.x = cvt_pk_bf16(o2[0], o2[1]); w2.y = cvt_pk_bf16(o2[2], o2[3]);
                        *(u32x2*)(krb + (size_t)row * 32 + 4 * fq) = w1; *(u32x2*)(krb + (size_t)row * 32 + 16 + 4 * fq) = w2;
                        if (!smp) { const int b_ = row >> 13, t_ = row & (kSEQ - 1);
#pragma unroll
                            for (int h = 0; h < 8; ++h) { bf16_t* kp = Kb + ((size_t)(b_ * 8 + h) * kSEQ + t_) * 96 + 64; *(u32x2*)(kp + 4 * fq) = w1; *(u32x2*)(kp + 16 + 4 * fq) = w2; } }
                    }
                    asm volatile("" ::: "memory");
                }
        } else if (pn == 2 || pn == 3) {
#pragma unroll
            for (int ai = 0; ai < 2; ++ai)
#pragma unroll
                for (int m = 0; m < 4; ++m) {
                    const int row = rows[ai][m]; const float iv = inv1[ai][m];
                    if (row >= kMR) continue;
                    const bool smp = row >= kNTOK; const int t_ = row & (kSEQ - 1), b_ = row >> 13;
#pragma unroll
                    for (int n = 0; n < 2; ++n) {
                        const int c = (pn - 2) * 128 + wc * 32 + n * 16 + 4 * fq;
                        const f32x4 v = (acc[ai][0][m][n] * iv) * (acc[ai][1][m][n] * iv);
                        u32x2 w; w.x = cvt_pk_bf16(v[0], v[1]); w.y = cvt_pk_bf16(v[2], v[3]);
                        *(u32x2*)(ub + (size_t)row * 256 + c) = w;
                        if (smp) *(f32x4*)(conv_s + (size_t)(row - kNTOK) * 512 + 256 + c) = v;
                        else if (t_ >= kSEQ - 2) *(f32x4*)(conv_p + (size_t)(b_ * 2 + (t_ - (kSEQ - 2))) * 256 + c) = v;
                    }
                }
        } else if (pn == 4) {
#pragma unroll
            for (int ai = 0; ai < 2; ++ai)
#pragma unroll
                for (int m = 0; m < 4; ++m) {
                    const int row = rows[ai][m]; const float iv = inv1[ai][m];
                    if (row >= kMR) continue;
#pragma unroll
                    for (int bj = 0; bj < 2; ++bj)
#pragma unroll
                        for (int n = 0; n < 2; ++n) { const f32x4 v = acc[ai][bj][m][n] * iv; u32x2 w; w.x = cvt_pk_bf16(v[0], v[1]); w.y = cvt_pk_bf16(v[2], v[3]);
                            *(u32x2*)(gbb + (size_t)row * 256 + bj * HALF + wc * 32 + n * 16 + 4 * fq) = w; }
                }
        } else {
#pragma unroll
            for (int ai = 0; ai < 2; ++ai)
#pragma unroll
                for (int m = 0; m < 4; ++m) {
                    const int row = rows[ai][m]; const float iv = inv1[ai][m];
                    float s = 0.f;
#pragma unroll
                    for (int bj = 0; bj < 2; ++bj)
#pragma unroll
                        for (int n = 0; n < 2; ++n) { const f32x4 v = acc[ai][bj][m][n] * iv; s += (v[0] * v[0] + v[1] * v[1]) + (v[2] * v[2] + v[3] * v[3]); }
                    s += __shfl_xor(s, 16); s += __shfl_xor(s, 32);
                    const float im = __builtin_amdgcn_rsqf(s * (1.0f / 64.0f) + kEPS) * kC2M;
                    if (row >= kMR) continue;
#pragma unroll
                    for (int bj = 0; bj < 2; ++bj)
#pragma unroll
                        for (int n = 0; n < 2; ++n) { const int d = bj * 32 + n * 16 + 4 * fq; const f32x4 g = *(const f32x4*)(g_mq + d);
                            const f32x4 v = acc[ai][bj][m][n] * (iv * im) * g; u32x2 w; w.x = cvt_pk_bf16(v[0], v[1]); w.y = cvt_pk_bf16(v[2], v[3]);
                            *(u32x2*)(mqb + (size_t)row * 256 + wc * 64 + d) = w; }
                }
        }
    }
};

struct EpiQ {
    static constexpr bool PERM = false, AFTER_DRAIN = false;
    const float* msq; const float* g_qn; const float* g_qr; const float* rope; bf16_t* qb;
    __device__ __forceinline__ void operator()(const f32x4 (&acc)[2][2][4][2], const Unit& u, int wr, int wc, int fr_, int fq_) const {
        const int ln_ = fresh_lane(), fr = ln_ & 15, fq = ln_ >> 4; (void)fr_; (void)fq_;
        const int pn = u.pn;
#pragma unroll
        for (int ai = 0; ai < 2; ++ai)
#pragma unroll
            for (int m = 0; m < 4; ++m) {
                const int row = u.pm * BM + ai * HALF + wr * 64 + m * 16 + fr;
                const bool live = row < kMR;
                const float epsq = kEPS * ((live ? msq[row] : 1.0f) + kEPS);
                if (pn < 2) {
                    const int head = 4 * pn + wc; float s = 0.f;
#pragma unroll
                    for (int bj = 0; bj < 2; ++bj)
#pragma unroll
                        for (int n = 0; n < 2; ++n) { const f32x4 v = acc[ai][bj][m][n]; s += (v[0] * v[0] + v[1] * v[1]) + (v[2] * v[2] + v[3] * v[3]); }
                    s += __shfl_xor(s, 16); s += __shfl_xor(s, 32);
                    const float rs = __builtin_amdgcn_rsqf(s * (1.0f / 64.0f) + epsq) * kC2Q;
                    if (live) {
#pragma unroll
                        for (int bj = 0; bj < 2; ++bj)
#pragma unroll
                            for (int n = 0; n < 2; ++n) { const int d = bj * 32 + n * 16 + 4 * fq; const f32x4 g = *(const f32x4*)(g_qn + d);
                                const f32x4 v = acc[ai][bj][m][n] * rs * g; u32x2 w; w.x = cvt_pk_bf16(v[0], v[1]); w.y = cvt_pk_bf16(v[2], v[3]);
                                *(u32x2*)(qb + (size_t)row * 768 + head * 96 + d) = w; }
                    }
                } else {
                    const int pos = row >= kNTOK ? kSEQ : (row & (kSEQ - 1));
                    const f32x4 cs = *(const f32x4*)(rope + (size_t)pos * 32 + 4 * fq), sn = *(const f32x4*)(rope + (size_t)pos * 32 + 16 + 4 * fq);
                    const f32x4 ga = *(const f32x4*)(g_qr + 4 * fq), gb = *(const f32x4*)(g_qr + 16 + 4 * fq);
#pragma unroll
                    for (int bj = 0; bj < 2; ++bj) {
                        const int head = 4 * bj + wc;
                        const f32x4 a = acc[ai][bj][m][0], b = acc[ai][bj][m][1];
                        float s = (a[0] * a[0] + a[1] * a[1]) + (a[2] * a[2] + a[3] * a[3]) + (b[0] * b[0] + b[1] * b[1]) + (b[2] * b[2] + b[3] * b[3]);
                        s += __shfl_xor(s, 16); s += __shfl_xor(s, 32);
                        const float rs = __builtin_amdgcn_rsqf(s * (1.0f / 32.0f) + epsq);
                        const f32x4 x1 = a * rs * ga, x2 = b * rs * gb;
                        const f32x4 o1 = (x1 * cs - x2 * sn) * kC2Q, o2 = (x1 * sn + x2 * cs) * kC2Q;
                        if (live) { u32x2 w1, w2; w1.x = cvt_pk_bf16(o1[0], o1[1]); w1.y = cvt_pk_bf16(o1[2], o1[3]); w2.x = cvt_pk_bf16(o2[0], o2[1]); w2.y = cvt_pk_bf16(o2[2], o2[3]);
                            *(u32x2*)(qb + (size_t)row * 768 + head * 96 + 64 + 4 * fq) = w1; *(u32x2*)(qb + (size_t)row * 768 + head * 96 + 80 + 4 * fq) = w2; }
                    }
                }
                asm volatile("" ::: "memory");
            }
    }
};

struct EpiKV {
    static constexpr bool PERM = false, AFTER_DRAIN = false;
    const float* g_kn; bf16_t* Kb; bf16_t* Vb;
    __device__ __forceinline__ void operator()(const f32x4 (&acc)[2][2][4][2], const Unit& u, int wr, int wc, int fr_, int fq_) const {
        const int ln_ = fresh_lane(), fr = ln_ & 15, fq = ln_ >> 4; (void)fr_; (void)fq_;
        const int pn = u.pn;
#pragma unroll
        for (int ai = 0; ai < 2; ++ai)
#pragma unroll
            for (int m = 0; m < 4; ++m) {
                const int row = u.pm * BM + ai * HALF + wr * 64 + m * 16 + fr;
                const int b_ = row >> 13, t_ = row & (kSEQ - 1);
                if (pn < 2) {
                    const int head = 4 * pn + wc; float s = 0.f;
#pragma unroll
                    for (int bj = 0; bj < 2; ++bj)
#pragma unroll
                        for (int n = 0; n < 2; ++n) { const f32x4 v = acc[ai][bj][m][n]; s += (v[0] * v[0] + v[1] * v[1]) + (v[2] * v[2] + v[3] * v[3]); }
                    s += __shfl_xor(s, 16); s += __shfl_xor(s, 32);
                    const float rs = __builtin_amdgcn_rsqf(s * (1.0f / 64.0f) + kEPS);
                    bf16_t* kp = Kb + ((size_t)(b_ * 8 + head) * kSEQ + t_) * 96;
#pragma unroll
                    for (int bj = 0; bj < 2; ++bj)
#pragma unroll
                        for (int n = 0; n < 2; ++n) { const int d = bj * 32 + n * 16 + 4 * fq; const f32x4 g = *(const f32x4*)(g_kn + d);
                            const f32x4 v = acc[ai][bj][m][n] * rs * g; u32x2 w; w.x = cvt_pk_bf16(v[0], v[1]); w.y = cvt_pk_bf16(v[2], v[3]);
                            *(u32x2*)(kp + d) = w; }
                } else {
#pragma unroll
                    for (int bj = 0; bj < 2; ++bj)
#pragma unroll
                        for (int n = 0; n < 2; ++n) { const int c = (pn - 2) * 256 + bj * HALF + wc * 32 + n * 16 + 4 * fq; const int head = c >> 6, d = c & 63;
                            const f32x4 v = acc[ai][bj][m][n]; u32x2 w; w.x = cvt_pk_bf16(v[0], v[1]); w.y = cvt_pk_bf16(v[2], v[3]);
                            *(u32x2*)(Vb + ((size_t)(b_ * 8 + head) * kSEQ + t_) * 64 + d) = w; }
                }
                asm volatile("" ::: "memory");
            }
    }
};

struct EpiMem {
    static constexpr bool PERM = false, AFTER_DRAIN = false;
    const float* ssqm; const float* g_mk; float* mk_out; float* mv_out; bf16_t* mKb; bf16_t* mVb;
    __device__ __forceinline__ void operator()(const f32x4 (&acc)[2][2][4][2], const Unit& u, int wr, int wc, int fr_, int fq_) const {
        const int ln_ = fresh_lane(), fr = ln_ & 15, fq = ln_ >> 4; (void)fr_; (void)fq_;
        const int pn = u.pn;
#pragma unroll
        for (int ai = 0; ai < 2; ++ai)
#pragma unroll
            for (int m = 0; m < 4; ++m) {
                const int row = u.pm * BM + ai * HALF + wr * 64 + m * 16 + fr;
                const float iv = row_inv_from_parts(ssqm, row);
                const int b_ = row >> 8, n_ = row & 255;
                if (pn == 0) {
                    const int head = wc; float s = 0.f;
#pragma unroll
                    for (int bj = 0; bj < 2; ++bj)
#pragma unroll
                        for (int n = 0; n < 2; ++n) { const f32x4 v = acc[ai][bj][m][n] * iv; s += (v[0] * v[0] + v[1] * v[1]) + (v[2] * v[2] + v[3] * v[3]); }
                    s += __shfl_xor(s, 16); s += __shfl_xor(s, 32);
                    const float rs = __builtin_amdgcn_rsqf(s * (1.0f / 64.0f) + kEPS);
#pragma unroll
                    for (int bj = 0; bj < 2; ++bj)
#pragma unroll
                        for (int n = 0; n < 2; ++n) { const int d = bj * 32 + n * 16 + 4 * fq; const f32x4 g = *(const f32x4*)(g_mk + d);
                            const f32x4 v = acc[ai][bj][m][n] * (iv * rs) * g;
                            *(f32x4*)(mk_out + (size_t)row * 256 + head * 64 + d) = v;
                            u32x2 w; w.x = cvt_pk_bf16(v[0], v[1]); w.y = cvt_pk_bf16(v[2], v[3]);
                            *(u32x2*)(mKb + ((size_t)(b_ * 4 + head) * 256 + n_) * 64 + d) = w; }
                } else {
#pragma unroll
                    for (int bj = 0; bj < 2; ++bj)
#pragma unroll
                        for (int n = 0; n < 2; ++n) { const int c = bj * HALF + wc * 32 + n * 16 + 4 * fq; const int head = c >> 6, d = c & 63;
                            const f32x4 v = acc[ai][bj][m][n] * iv;
                            *(f32x4*)(mv_out + (size_t)row * 256 + c) = v;
                            u32x2 w; w.x = cvt_pk_bf16(v[0], v[1]); w.y = cvt_pk_bf16(v[2], v[3]);
                            *(u32x2*)(mVb + ((size_t)(b_ * 4 + head) * 256 + n_) * 64 + d) = w; }
                }
                asm volatile("" ::: "memory");
            }
    }
};
template <class Epi, class Sched, bool ALIGN_EPI = false, bool SP2 = false>
__device__ __forceinline__ void gemm_phase(PG8_LAS unsigned char* lds, const Gemm g, const Sched& S, const Epi& E) {
    int tid_ = threadIdx.x; asm volatile("" : "+v"(tid_));
    const int tid = tid_, wid = __builtin_amdgcn_readfirstlane(tid >> 6), lane = tid & 63, wr = wid >> 2, wc = wid & 3, fr = lane & 15, fq = lane >> 4;
    const int K = g.K, nt = K / BK;
    unsigned voffA[2], voffB[2];
#pragma unroll
    for (int i = 0; i < 2; ++i) { int R, C; stage_rc(tid * 16 + i * 8192, R, C); const int Rb = Epi::PERM ? ((R & ~31) + perm32(R & 31)) : R;
        voffA[i] = (unsigned)(R * K + C) * 2u; voffB[i] = (unsigned)(Rb * K + C) * 2u; }
    const size_t kstep = (size_t)(BK * 2);
    const size_t hstep = (size_t)HALF * K * 2;
    const size_t tstep = 2 * hstep;
    const unsigned ldsw = (unsigned)wid * 1024u;
    const int aoff = lds_byte(wr * 64 + fr, fq * 8), boff = lds_byte(wc * 32 + fr, fq * 8);
#define PG8_SA(b, h) (((b) * 2 + (h)) * HTB)
#define PG8_SB(b, h) ((4 + (b) * 2 + (h)) * HTB)
#define PG8_STAGE(bufoff, gbase, voff) do { _Pragma("unroll") for (int _i = 0; _i < 2; ++_i) \
        __builtin_amdgcn_global_load_lds((const unsigned*)((const char*)(gbase) + (voff)[_i]), (PG8_LAS unsigned*)(lds + (bufoff) + ldsw + _i * 8192), 16, 0, 0); } while (0)
#define PG8_LDA(dst, b, h) do { _Pragma("unroll") for (int m = 0; m < 4; ++m) _Pragma("unroll") for (int k = 0; k < 2; ++k) dst[m][k] = *(const PG8_LAS bf16x8*)(lds + PG8_SA(b, h) + aoff + m * 2048 + k * 1024); } while (0)
#define PG8_LDB(dst, b, h) do { _Pragma("unroll") for (int n = 0; n < 2; ++n) _Pragma("unroll") for (int k = 0; k < 2; ++k) dst[n][k] = *(const PG8_LAS bf16x8*)(lds + PG8_SB(b, h) + boff + n * 2048 + k * 1024); } while (0)
#define PG8_MMA(ai, bj, At, Bt) do { __builtin_amdgcn_s_setprio(1); _Pragma("unroll") for (int m = 0; m < 4; ++m) _Pragma("unroll") for (int n = 0; n < 2; ++n) _Pragma("unroll") for (int k = 0; k < 2; ++k) \
        acc[ai][bj][m][n] = __builtin_amdgcn_mfma_f32_16x16x32_bf16(Bt[n][k], At[m][k], acc[ai][bj][m][n], 0, 0, 0); __builtin_amdgcn_s_setprio(0); } while (0)
#define PG8_WAIT_V(n) asm volatile("s_waitcnt vmcnt(" #n ")" ::: "memory")
#define PG8_WAIT_L(n) asm volatile("s_waitcnt lgkmcnt(" #n ")" ::: "memory")
#define PG8_BAR __builtin_amdgcn_s_barrier()
#define PG8_SCHED __builtin_amdgcn_sched_barrier(0)
    Unit cur, nxt; int ui = 0;
    if (!S.next(0, cur)) return;
    f32x4 acc[2][2][4][2];
#pragma unroll
    for (int a = 0; a < 2; ++a)
#pragma unroll
        for (int b = 0; b < 2; ++b)
#pragma unroll
            for (int m = 0; m < 4; ++m)
#pragma unroll
                for (int n = 0; n < 2; ++n) acc[a][b][m][n] = (f32x4){0.f, 0.f, 0.f, 0.f};
    bf16x8 At[4][2], B0[2][2], B1[2][2];
    const char* cA = (const char*)g.A + (size_t)cur.pm * tstep; const char* cB = (const char*)g.Bt + (size_t)cur.pn * tstep;
    S.a_ready(cur);
    if constexpr (SP2) {
        PG8_STAGE(PG8_SB(0, 0), cB, voffB); PG8_STAGE(PG8_SB(0, 1), cB + hstep, voffB); PG8_STAGE(PG8_SA(0, 0), cA, voffA); PG8_STAGE(PG8_SA(0, 1), cA + hstep, voffA);
        if (wr == 1) PG8_BAR;
        PG8_WAIT_V(2); PG8_BAR;
        PG8_STAGE(PG8_SB(1, 0), cB + kstep, voffB); PG8_STAGE(PG8_SA(1, 0), cA + kstep, voffA); PG8_STAGE(PG8_SB(1, 1), cB + hstep + kstep, voffB);
        PG8_WAIT_V(6); PG8_BAR;
    } else {
        PG8_STAGE(PG8_SB(0, 0), cB, voffB); PG8_STAGE(PG8_SA(0, 0), cA, voffA); PG8_STAGE(PG8_SB(0, 1), cB + hstep, voffB); PG8_STAGE(PG8_SA(0, 1), cA + hstep, voffA);
        if (wr == 1) PG8_BAR;
        PG8_WAIT_V(4); PG8_BAR;
        PG8_STAGE(PG8_SB(1, 0), cB + kstep, voffB); PG8_STAGE(PG8_SA(1, 0), cA + kstep, voffA); PG8_STAGE(PG8_SB(1, 1), cB + hstep + kstep, voffB);
        PG8_WAIT_V(6); PG8_BAR;
    }
    for (;;) {
        const bool has_next = S.next(ui + 1, nxt);
        const char* nA = has_next ? (const char*)g.A + (size_t)nxt.pm * tstep : cA; const char* nB = has_next ? (const char*)g.Bt + (size_t)nxt.pn * tstep : cB;
        for (int t = 0; t < nt; t += 2) {
            const bool last = (t == nt - 2);
            const char* a1 = cA + (size_t)(t + 1) * kstep;
            const char* a2 = last ? nA : cA + (size_t)(t + 2) * kstep; const char* b2 = last ? nB : cB + (size_t)(t + 2) * kstep;
            const char* a3 = a2 + kstep; const char* b3 = b2 + kstep;
            if (last && has_next) S.a_ready(nxt);
            if constexpr (SP2) {
            PG8_LDB(B0, 0, 0); PG8_LDB(B1, 0, 1); PG8_SCHED; PG8_LDA(At, 0, 0); PG8_STAGE(PG8_SA(1, 1), a1 + hstep, voffA);
            PG8_WAIT_V(8); PG8_WAIT_L(0); PG8_BAR; PG8_MMA(0, 0, At, B0); PG8_MMA(0, 1, At, B1); PG8_BAR; PG8_SCHED;
            PG8_LDA(At, 0, 1); PG8_STAGE(PG8_SB(0, 0), b2, voffB); PG8_STAGE(PG8_SB(0, 1), b2 + hstep, voffB); PG8_STAGE(PG8_SA(0, 0), a2, voffA);
            PG8_WAIT_V(8); PG8_WAIT_L(0); PG8_BAR; PG8_MMA(1, 0, At, B0); PG8_MMA(1, 1, At, B1); PG8_BAR; PG8_SCHED;
            PG8_LDB(B0, 1, 0); PG8_LDB(B1, 1, 1); PG8_SCHED; PG8_LDA(At, 1, 0); PG8_STAGE(PG8_SA(0, 1), a2 + hstep, voffA);
            PG8_WAIT_V(8); PG8_WAIT_L(0); PG8_BAR; PG8_MMA(0, 0, At, B0); PG8_MMA(0, 1, At, B1); PG8_BAR; PG8_SCHED;
            PG8_LDA(At, 1, 1); PG8_STAGE(PG8_SB(1, 0), b3, voffB); PG8_STAGE(PG8_SB(1, 1), b3 + hstep, voffB); PG8_STAGE(PG8_SA(1, 0), a3, voffA);
            PG8_WAIT_V(8); PG8_WAIT_L(0); PG8_BAR; PG8_MMA(1, 0, At, B0); PG8_MMA(1, 1, At, B1); PG8_BAR; PG8_SCHED;
            } else {
            PG8_LDB(B0, 0, 0); PG8_SCHED; PG8_LDA(At, 0, 0); PG8_STAGE(PG8_SA(1, 1), a1 + hstep, voffA);
            PG8_WAIT_L(8); PG8_BAR; PG8_WAIT_L(0); PG8_MMA(0, 0, At, B0); PG8_BAR; PG8_SCHED;
            PG8_LDB(B1, 0, 1); PG8_STAGE(PG8_SB(0, 0), b2, voffB);
            PG8_BAR; PG8_WAIT_L(0); PG8_MMA(0, 1, At, B1); PG8_BAR;
            PG8_LDA(At, 0, 1); PG8_STAGE(PG8_SA(0, 0), a2, voffA);
            PG8_BAR; PG8_WAIT_L(0); PG8_MMA(1, 0, At, B0); PG8_BAR; PG8_SCHED;
            PG8_STAGE(PG8_SB(0, 1), b2 + hstep, voffB);
            PG8_WAIT_V(6); PG8_BAR; PG8_MMA(1, 1, At, B1); PG8_BAR;
            PG8_LDB(B0, 1, 0); PG8_SCHED; PG8_LDA(At, 1, 0); PG8_STAGE(PG8_SA(0, 1), a2 + hstep, voffA);
            PG8_WAIT_L(8); PG8_BAR; PG8_WAIT_L(0); PG8_MMA(0, 0, At, B0); PG8_BAR; PG8_SCHED;
            PG8_LDB(B1, 1, 1); PG8_STAGE(PG8_SB(1, 0), b3, voffB);
            PG8_BAR; PG8_WAIT_L(0); PG8_MMA(0, 1, At, B1); PG8_BAR;
            PG8_LDA(At, 1, 1); PG8_STAGE(PG8_SA(1, 0), a3, voffA);
            PG8_BAR; PG8_WAIT_L(0); PG8_MMA(1, 0, At, B0); PG8_BAR; PG8_SCHED;
            PG8_STAGE(PG8_SB(1, 1), b3 + hstep, voffB);
            PG8_WAIT_V(6); PG8_BAR; PG8_MMA(1, 1, At, B1); PG8_BAR;
            }
        }
        if constexpr (ALIGN_EPI) { if (wr == 0) PG8_BAR; }
        if constexpr (!Epi::AFTER_DRAIN) { E(acc, cur, wr, wc, fr, fq); S.done(cur); }
        if (!has_next) break;
#pragma unroll
        for (int a = 0; a < 2; ++a)
#pragma unroll
            for (int b = 0; b < 2; ++b)
#pragma unroll
                for (int m = 0; m < 4; ++m)
#pragma unroll
                    for (int n = 0; n < 2; ++n) acc[a][b][m][n] = (f32x4){0.f, 0.f, 0.f, 0.f};
        cur = nxt; cA = nA; cB = nB; ++ui;
        if constexpr (ALIGN_EPI) { if (wr == 1) PG8_BAR; }
    }
    PG8_WAIT_V(0);
    if constexpr (!ALIGN_EPI) { if (wr == 0) PG8_BAR; }
    PG8_BAR;
    if constexpr (Epi::AFTER_DRAIN) { E.fused(acc, cur, wr, wc, fr, fq, lds, wid, lane); S.done(cur); }
#undef PG8_SA
#undef PG8_SB
#undef PG8_STAGE
#undef PG8_LDA
#undef PG8_LDB
#undef PG8_MMA
#undef PG8_WAIT_V
#undef PG8_WAIT_L
#undef PG8_BAR
#undef PG8_SCHED
}
}
#define LAS __attribute__((address_space(3)))
#define XB_TMO      128
#define XB_XCNT(j)  (256  + 64 * (j))
#define XB_XSUB(j)  (1280 + 64 * (j))
#define XB_XGEN(j)  (2304 + 64 * (j))
#define XB_TOP      3328
#define XB_TOPGEN   3392
#define XCD_BAR_WORDS 3456
#define XB_SPIN_CAP (1u << 25)

__device__ __forceinline__ unsigned xb_ld(unsigned* p)              { return __hip_atomic_load(p, __ATOMIC_RELAXED, __HIP_MEMORY_SCOPE_AGENT); }
__device__ __forceinline__ unsigned xb_add(unsigned* p, unsigned v) { return __hip_atomic_fetch_add(p, v, __ATOMIC_RELAXED, __HIP_MEMORY_SCOPE_AGENT); }
__device__ __forceinline__ unsigned xb_xcc_id() { return (unsigned)__builtin_amdgcn_s_getreg((3 << 11) | 20) & 0xFu; }
#define XB_SPIN(cond, bar) do { unsigned _sp = 0; while (cond) { __builtin_amdgcn_s_sleep(1); \
    if ((++_sp & 255u) == 0u) { if (xb_ld(&(bar)[XB_TMO])) break; if (_sp > XB_SPIN_CAP) { atomicAdd(&(bar)[XB_TMO], 1u); break; } } } } while (0)

struct XcdBarrier {
    unsigned* bar; unsigned x;
    volatile LAS unsigned* st;
};

__device__ __forceinline__ XcdBarrier xcd_barrier_post(unsigned* bar, volatile LAS unsigned* st) {
    XcdBarrier b; b.bar = bar; b.x = xb_xcc_id(); b.st = st;
    if (threadIdx.x == 0) (void)xb_add(&bar[XB_XCNT(b.x)], 1u);
    return b;
}
__device__ __forceinline__ void xcd_barrier_complete(unsigned* bar, unsigned x, unsigned& nloc, unsigned& nx) {
    const unsigned G = gridDim.x * gridDim.y * gridDim.z;
    unsigned sum, cnt, mine, sp = 0u;
    for (;;) {
        sum = 0u; cnt = 0u; mine = 0u;
#pragma unroll
        for (unsigned j = 0; j < 16; ++j) { const unsigned c = xb_ld(&bar[XB_XCNT(j)]); sum += c; cnt += (c > 0u) ? 1u : 0u; mine = (j == x) ? c : mine; }
        if (sum == G) break;
        __builtin_amdgcn_s_sleep(1);
        if ((++sp & 255u) == 0u) { if (xb_ld(&bar[XB_TMO])) break; if (sp > XB_SPIN_CAP) { atomicAdd(&bar[XB_TMO], 1u); break; } }
    }
    nloc = mine > 0u ? mine : 1u; nx = cnt > 0u ? cnt : 1u;
}

__device__ __forceinline__ void xcd_barrier(const XcdBarrier& b) {
    asm volatile("s_waitcnt vmcnt(0)" ::: "memory");
    __syncthreads();
    if (threadIdx.x == 0) {
        unsigned* bar = b.bar;
        __builtin_amdgcn_s_waitcnt(0);
        unsigned nloc = b.st[0], nx = b.st[1];
        if (nloc == 0u) { xcd_barrier_complete(bar, b.x, nloc, nx); b.st[0] = nloc; b.st[1] = nx; }
        const unsigned old = xb_add(&bar[XB_XSUB(b.x)], 1u);
        const unsigned gen = old / nloc;
        if (old + 1u == (gen + 1u) * nloc) {
            __builtin_amdgcn_fence(__ATOMIC_RELEASE, "agent");
            asm volatile("s_waitcnt vmcnt(0)" ::: "memory");
            const unsigned og = xb_add(&bar[XB_TOP], 1u);
            const unsigned tg = og / nx;
            if (og + 1u == (tg + 1u) * nx) xb_add(&bar[XB_TOPGEN], 1u);
            else XB_SPIN(xb_ld(&bar[XB_TOPGEN]) == tg, bar);
            __builtin_amdgcn_fence(__ATOMIC_ACQUIRE, "agent");
            xb_add(&bar[XB_XGEN(b.x)], 1u);
            asm volatile("s_waitcnt vmcnt(0)" ::: "memory");
        } else {
            XB_SPIN(xb_ld(&bar[XB_XGEN(b.x)]) == gen, bar);
            __builtin_amdgcn_fence(__ATOMIC_ACQUIRE, "agent");
            asm volatile("s_waitcnt vmcnt(0)" ::: "memory");
        }
    }
    __syncthreads();
}
#define GAS __attribute__((address_space(1)))
typedef unsigned short bf16;
typedef unsigned v4u __attribute__((ext_vector_type(4)));
typedef unsigned v2u __attribute__((ext_vector_type(2)));
typedef float f32x4 __attribute__((ext_vector_type(4)));
typedef float f32x16 __attribute__((ext_vector_type(16)));
typedef short bf16x8 __attribute__((ext_vector_type(8)));
typedef short s16x4 __attribute__((ext_vector_type(4)));
#define LDS_WAIT() asm volatile("s_waitcnt lgkmcnt(0)" ::: "memory")
#define VM_WAIT() asm volatile("s_waitcnt vmcnt(0)" ::: "memory")
using pg8::cvt_pk_bf16;
__device__ __forceinline__ float bf2f(unsigned short h) { return __uint_as_float((unsigned)h << 16); }
__device__ __forceinline__ float bflo(unsigned w) { return __uint_as_float(w << 16); }
__device__ __forceinline__ float bfhi(unsigned w) { return __uint_as_float(w & 0xffff0000u); }

constexpr int D = 1024, SEQ = 8192, NB = 4, NTOK = 32768, NS = 128, MR = 32896, MP = 33024;
constexpr int FF = 2816, FF2 = 5632, INW = 1440, INWP = 1536;
constexpr int NPAGES = 128, PAGE = 128, NPHYS = 20480;
constexpr float EPS = 1e-6f;
static_assert(pg8::kNTOK == NTOK && pg8::kMR == MR && pg8::kSEQ == SEQ, "constants");

constexpr size_t O_Y = 0, O_YS = 33554432, O_CKVP = 33685504, O_KRP = 37879808, O_CONVP = 38928384, O_MKP = 38930432, O_MVP = 39192576,
                 O_CKVS = 39454720, O_KRS = 39471104, O_CONVS = 39475200, O_TOTAL = 39540736;

constexpr size_t MiB = 1u << 20;
constexpr size_t WS_CTL = 0, CTL_ZERO_BYTES = 1 * MiB;
constexpr size_t WS_W1GU = 1 * MiB, WS_W1D = WS_W1GU + 12 * MiB, WS_WIN = WS_W1D + 6 * MiB, WS_WUQ = WS_WIN + 3 * MiB, WS_WKV = WS_WUQ + 1 * MiB, WS_WO = WS_WKV + 1 * MiB,
                 WS_W2GU = WS_WO + 2 * MiB, WS_W2D = WS_W2GU + 12 * MiB, WS_WMEM = WS_W2D + 6 * MiB, WS_ROPE = WS_WMEM + 1 * MiB,
                 WS_SSQ0 = WS_ROPE + 2 * MiB, WS_SSQ1 = WS_SSQ0 + 3 * MiB, WS_SSQ2 = WS_SSQ1 + 3 * MiB, WS_MSQ = WS_SSQ2 + 3 * MiB, WS_SSQM = WS_MSQ + 1 * MiB,
                 WS_XB = WS_SSQM + 1 * MiB, WS_ACT1 = WS_XB + 65 * MiB, WS_ACT2 = WS_ACT1 + 178 * MiB, WS_X1F = WS_ACT2 + 178 * MiB, WS_X1B = WS_X1F + 129 * MiB,
                 WS_X2F = WS_X1B + 65 * MiB, WS_X2B = WS_X2F + 129 * MiB, WS_CQB = WS_X2B + 65 * MiB, WS_CKVB = WS_CQB + 17 * MiB, WS_KRB = WS_CKVB + 9 * MiB,
                 WS_UB = WS_KRB + 3 * MiB, WS_GBB = WS_UB + 17 * MiB, WS_MQB = WS_GBB + 17 * MiB, WS_QB = WS_MQB + 17 * MiB, WS_KB = WS_QB + 49 * MiB, WS_VB = WS_KB + 48 * MiB,
                 WS_MEMB = WS_VB + 32 * MiB, WS_MEMK = WS_MEMB + 2 * MiB, WS_MEMV = WS_MEMK + 1 * MiB, WS_OAB = WS_MEMV + 1 * MiB, WS_OMB = WS_OAB + 33 * MiB,
                 WS_OMIX = WS_OMB + 17 * MiB, WS_DPART = WS_OMIX + 65 * MiB, WS_DBG = WS_DPART + 2 * MiB, WS_END = WS_DBG + 1 * MiB;
constexpr int CW_BAR = 4096;

constexpr int RING_BYTES = 131072, LDSCTL_OFF = RING_BYTES, MISC_OFF = LDSCTL_OFF + 320, XCH_OFF = RING_BYTES + 512, LDS_BYTES = 147456;
constexpr int NWAVES = 8;

struct Args {
    const float* in[38];
    float* out; unsigned char* ws;
    int ph_lo, ph_hi;
};

#define CAS __attribute__((address_space(4)))
typedef const float* const CAS* InTab;
struct Frame {
    LAS unsigned char* lds;
    int tid, lane, wave, vcu, G;
    InTab in;
    float* out; unsigned char* ws;
};
__device__ __forceinline__ float wave_sum(float v) {
#pragma unroll
    for (int o = 1; o < 64; o <<= 1) v += __shfl_xor(v, o);
    return v;
}
__device__ __forceinline__ float wave_max(float v) {
#pragma unroll
    for (int o = 1; o < 64; o <<= 1) v = fmaxf(v, __shfl_xor(v, o));
    return v;
}

struct TSrc { const float* p; int ld; int col0; };
__device__ __forceinline__ void tr_item(TSrc s, const float* kscale, int K, bf16* WT, int n0, int k0, LAS float* scr, int lane) {
#pragma unroll 8
    for (int i = 0; i < 32; ++i) { const int kk = 2 * i + (lane >> 5);
        float v = 0.f; if (s.p) { v = s.p[(size_t)(k0 + kk) * s.ld + s.col0 + (lane & 31)]; if (kscale) v *= kscale[k0 + kk]; }
        scr[kk * 33 + (lane & 31)] = v; }
    LDS_WAIT(); asm volatile("" ::: "memory");
    const int c = lane & 7;
#pragma unroll
    for (int j = 0; j < 4; ++j) { const int n = (lane >> 3) + 8 * j; const LAS float* q = scr + (8 * c) * 33 + n;
        v4u o; o.x = cvt_pk_bf16(q[0 * 33], q[1 * 33]); o.y = cvt_pk_bf16(q[2 * 33], q[3 * 33]); o.z = cvt_pk_bf16(q[4 * 33], q[5 * 33]); o.w = cvt_pk_bf16(q[6 * 33], q[7 * 33]);
        *(v4u*)(WT + (size_t)(n0 + n) * K + k0 + 8 * c) = o; }
    LDS_WAIT(); asm volatile("" ::: "memory");
}
enum { MAT_W1GU = 0, MAT_W1D, MAT_WIN, MAT_WUQ, MAT_WKV, MAT_WO, MAT_W2GU, MAT_W2D, MAT_WMEM, MAT_N };
__device__ __forceinline__ void mat_dims(int mat, int& N, int& K) {
    switch (mat) {
        case MAT_W1GU: case MAT_W2GU: N = FF2; K = D; break;
        case MAT_W1D: case MAT_W2D: N = D; K = FF; break;
        case MAT_WIN: N = INWP; K = D; break;
        case MAT_WUQ: N = 768; K = 256; break;
        case MAT_WKV: N = 1024; K = 128; break;
        case MAT_WO: N = D; K = D; break;
        default: N = 512; K = D; break;
    }
}
__device__ __forceinline__ void p0_weight_item(const Frame& F, int mat, int item, LAS float* scr) {
    int N, K; mat_dims(mat, N, K);
    const int nkb = K / 64, kb = item % nkb, slot = item / nkb, k0 = kb * 64;
    const int pn = slot >> 3, w = slot & 7, bj = w >> 2, wc = w & 3;
    InTab in = F.in;
    TSrc s{nullptr, 0, 0}; const float* ks = nullptr; bf16* dst = nullptr;
    switch (mat) {
        case MAT_W1GU: s = TSrc{bj == 0 ? in[10] : in[11], FF, 128 * pn + 32 * wc}; ks = in[9]; dst = (bf16*)(F.ws + WS_W1GU); break;
        case MAT_W2GU: s = TSrc{bj == 0 ? in[35] : in[36], FF, 128 * pn + 32 * wc}; ks = in[34]; dst = (bf16*)(F.ws + WS_W2GU); break;
        case MAT_W1D: s = TSrc{in[12], D, 32 * slot}; dst = (bf16*)(F.ws + WS_W1D); break;
        case MAT_W2D: s = TSrc{in[37], D, 32 * slot}; dst = (bf16*)(F.ws + WS_W2D); break;
        case MAT_WIN: {
            int c0 = -1;
            if (pn == 0) c0 = 32 * w;
            else if (pn == 1) c0 = (bj == 0) ? 256 + 32 * wc : (wc == 0 ? 384 : -1);
            else if (pn == 2) c0 = (bj == 0) ? 416 + 32 * wc : 928 + 32 * wc;
            else if (pn == 3) c0 = (bj == 0) ? 416 + 128 + 32 * wc : 928 + 128 + 32 * wc;
            else if (pn == 4) c0 = 672 + 32 * w;
            else c0 = 1184 + 64 * wc + 32 * bj;
            if (c0 >= 0) s = TSrc{in[14], INW, c0};
            ks = in[13]; dst = (bf16*)(F.ws + WS_WIN); break; }
        case MAT_WUQ: s = TSrc{in[16], 768, pn < 2 ? (4 * pn + wc) * 96 + 32 * bj : (4 * bj + wc) * 96 + 64}; ks = in[15]; dst = (bf16*)(F.ws + WS_WUQ); break;
        case MAT_WKV: if (pn < 2) s = TSrc{in[20], 512, (4 * pn + wc) * 64 + 32 * bj}; else s = TSrc{in[21], 512, 256 * (pn - 2) + 32 * w}; dst = (bf16*)(F.ws + WS_WKV); break;
        case MAT_WO: s = TSrc{in[33], D, 32 * slot}; ks = (k0 < 512) ? in[30] : (k0 < 768) ? in[31] - 512 : in[32] - 768; dst = (bf16*)(F.ws + WS_WO); break;
        default: if (pn == 0) s = TSrc{in[26], 256, 64 * wc + 32 * bj}; else s = TSrc{in[27], 256, 32 * w}; ks = in[25]; dst = (bf16*)(F.ws + WS_WMEM); break;
    }
    tr_item(s, ks, K, dst, 32 * slot, k0, scr, F.lane);
}
__device__ __forceinline__ void row_to_bf16_ssq(const float* src, bf16* dst, float* parts, int lane) {
    f32x4 v[4]; float s = 0.f;
#pragma unroll
    for (int j = 0; j < 4; ++j) { v[j] = src ? ((const f32x4*)src)[lane + 64 * j] : (f32x4){0.f, 0.f, 0.f, 0.f}; s += (v[j][0] * v[j][0] + v[j][1] * v[j][1]) + (v[j][2] * v[j][2] + v[j][3] * v[j][3]); }
    s = wave_sum(s);
#pragma unroll
    for (int j = 0; j < 4; ++j) { v2u w; w.x = cvt_pk_bf16(v[j][0], v[j][1]); w.y = cvt_pk_bf16(v[j][2], v[j][3]); ((v2u*)dst)[lane + 64 * j] = w; }
    if (lane < 16) parts[lane] = lane == 0 ? s : 0.f;
}
__device__ __forceinline__ float rope_inv_freq(int i) {
    switch (i) { case 0: return 1.000000000e+00f; case 1: return 5.623413324e-01f; case 2: return 3.162277639e-01f; case 3: return 1.778279394e-01f;
        case 4: return 1.000000015e-01f; case 5: return 5.623413250e-02f; case 6: return 3.162277490e-02f; case 7: return 1.778279431e-02f;
        case 8: return 9.999999776e-03f; case 9: return 5.623413250e-03f; case 10: return 3.162277630e-03f; case 11: return 1.778279431e-03f;
        case 12: return 1.000000047e-03f; case 13: return 5.623413017e-04f; case 14: return 3.162277571e-04f; default: return 1.778279402e-04f; }
}
__device__ __forceinline__ void p0_prologue(const Frame& F) {
    LAS float* scr = (LAS float*)(F.lds + F.wave * 16384);
    const int gw = F.vcu * NWAVES + F.wave, NGW = F.G * NWAVES;
    int base = 0;
#pragma unroll 1
    for (int mat = 0; mat < MAT_N; ++mat) {
        int N, K; mat_dims(mat, N, K);
        const int nit = (N / 32) * (K / 64);
        int first = (gw - base % NGW + NGW) % NGW;
        for (int it = first; it < nit; it += NGW) p0_weight_item(F, mat, it, scr);
        base += nit;
    }
    bf16* xb = (bf16*)(F.ws + WS_XB); float* ssq0 = (float*)(F.ws + WS_SSQ0);
    for (int r = gw; r < MP; r += NGW) {
        const float* src = r < NTOK ? F.in[0] + (size_t)r * D : (r < MR ? F.in[2] + (size_t)(r - NTOK) * D : nullptr);
        row_to_bf16_ssq(src, xb + (size_t)r * D, ssq0 + (size_t)r * 16, F.lane);
    }
    bf16* memb = (bf16*)(F.ws + WS_MEMB); float* ssqm = (float*)(F.ws + WS_SSQM);
    for (int r = gw; r < 1024; r += NGW) row_to_bf16_ssq(F.in[1] + (size_t)r * D, memb + (size_t)r * D, ssqm + (size_t)r * 16, F.lane);
    float* rope = (float*)(F.ws + WS_ROPE);
    const int gt = F.vcu * (NWAVES * 64) + F.tid, NGT = F.G * NWAVES * 64;
    for (int e = gt; e < 8193 * 16; e += NGT) { const int pi = e >> 4, i = e & 15; const float pos = pi == 8192 ? 16384.0f : (float)pi;
        const float ang = pos * rope_inv_freq(i);
        const double rev = (double)ang * 0.15915494309189535;
        const float fr = (float)(rev - floor(rev));
        rope[(size_t)pi * 32 + i] = __builtin_amdgcn_cosf(fr); rope[(size_t)pi * 32 + 16 + i] = __builtin_amdgcn_sinf(fr); }
    for (int e = gt; e < NS * 256; e += NGT) { const int b = e >> 8, c = e & 255; F.out[O_CONVS + (size_t)b * 512 + c] = F.in[6][(size_t)b * 512 + 256 + c]; }
}
__device__ __forceinline__ int crow(int r, int hi) { return (r & 3) + 8 * (r >> 2) + 4 * hi; }
constexpr int AT_BUF = 20480, AT_V = 12288, AT_WS = 2 * AT_BUF, AT_OST = AT_WS + 2048;
template <int DQK>
__device__ __forceinline__ void attn_dma_tile(const bf16* Kt, const bf16* Vt, LAS unsigned char* buf, int wid, int lane) {
    constexpr int NC = DQK / 8;
    __builtin_amdgcn_global_load_lds((const unsigned*)(Kt + (size_t)lane * DQK + wid * 8), (LAS unsigned*)(buf + wid * 1024), 16, 0, 0);
    if (NC > 8 && wid < NC - 8) __builtin_amdgcn_global_load_lds((const unsigned*)(Kt + (size_t)lane * DQK + (8 + wid) * 8), (LAS unsigned*)(buf + (8 + wid) * 1024), 16, 0, 0);
    __builtin_amdgcn_global_load_lds((const unsigned*)(Vt + (size_t)(16 * (wid & 3) + (lane >> 2)) * 64 + (wid >> 2) * 32 + (lane & 3) * 8), (LAS unsigned*)(buf + AT_V + wid * 1024), 16, 0, 0);
}
template <int DQK, bool CAUSAL>
__device__ __forceinline__ void attn_unit_simple(const bf16* Q0, int qpitch, const bf16* Kh, const bf16* Vh, bf16* O0, int opitch, int NT, LAS unsigned char* lds) {
    constexpr int ND = DQK / 16;
    int tid_ = threadIdx.x; asm volatile("" : "+v"(tid_));
    const int tid = tid_, lane = tid & 63, r32 = lane & 31, hi = lane >> 5; const int wid = __builtin_amdgcn_readfirstlane(tid >> 6);
    __syncthreads();
    attn_dma_tile<DQK>(Kh, Vh, lds, wid, lane);
    bf16x8 qr[ND];
#pragma unroll
    for (int d0 = 0; d0 < ND; ++d0) qr[d0] = *(const bf16x8*)(Q0 + (size_t)(wid * 32 + r32) * qpitch + d0 * 16 + hi * 8);
    float mrun = -INFINITY, lrun = 0.f;
    f32x16 o0, o1;
#pragma unroll
    for (int r = 0; r < 16; ++r) { o0[r] = 0.f; o1[r] = 0.f; }
    LAS float* wsf = (LAS float*)(lds + AT_WS) + wid * 64;
    const int qrel = wid * 32 + r32;
    __syncthreads();
    for (int t = 0; t < NT; ++t) {
        LAS unsigned char* kb = lds + (t & 1) * AT_BUF; LAS unsigned char* vbuf = kb + AT_V;
        if (t + 1 < NT) attn_dma_tile<DQK>(Kh + (size_t)(t + 1) * 64 * DQK, Vh + (size_t)(t + 1) * 64 * 64, lds + ((t + 1) & 1) * AT_BUF, wid, lane);
        const int jb = t - (NT - 4);
        if (!(CAUSAL && jb >= 0 && 64 * jb > 32 * wid + 31)) {
        f32x16 p0, p1;
#pragma unroll
        for (int r = 0; r < 16; ++r) { p0[r] = 0.f; p1[r] = 0.f; }
#pragma unroll
        for (int d0 = 0; d0 < ND; ++d0) {
            const bf16x8 k0 = *(const LAS bf16x8*)(kb + (2 * d0 + hi) * 1024 + r32 * 16);
            const bf16x8 k1 = *(const LAS bf16x8*)(kb + (2 * d0 + hi) * 1024 + 512 + r32 * 16);
            p0 = __builtin_amdgcn_mfma_f32_32x32x16_bf16(k0, qr[d0], p0, 0, 0, 0);
            p1 = __builtin_amdgcn_mfma_f32_32x32x16_bf16(k1, qr[d0], p1, 0, 0, 0);
        }
        if (CAUSAL && jb >= 0) {
            const int kb_ = 64 * jb + 4 * hi;
#pragma unroll
            for (int r = 0; r < 16; ++r) { const int kv = kb_ + (r & 3) + 8 * (r >> 2); if (kv > qrel) p0[r] = -INFINITY; if (kv + 32 > qrel) p1[r] = -INFINITY; }
        }
        float rm = p0[0];
#pragma unroll
        for (int r = 1; r < 16; ++r) rm = fmaxf(rm, p0[r]);
#pragma unroll
        for (int r = 0; r < 16; ++r) rm = fmaxf(rm, p1[r]);
        { auto tt = __builtin_amdgcn_permlane32_swap(__float_as_uint(rm), __float_as_uint(rm), false, false); rm = fmaxf(__uint_as_float(tt[0]), __uint_as_float(tt[1])); }
        const float mn = fmaxf(mrun, rm);
        const float alpha = __builtin_amdgcn_exp2f(mrun - mn);
        mrun = mn;
        float ls = 0.f;
#pragma unroll
        for (int r = 0; r < 16; ++r) { p0[r] = __builtin_amdgcn_exp2f(p0[r] - mn); p1[r] = __builtin_amdgcn_exp2f(p1[r] - mn); ls += p0[r] + p1[r]; }
        lrun = lrun * alpha + ls;
        if (hi == 0) wsf[r32] = alpha;
        LDS_WAIT();
#pragma unroll
        for (int r = 0; r < 16; ++r) { const float a = wsf[crow(r, hi)]; o0[r] *= a; o1[r] *= a; }
        bf16x8 pa[4];
        { v4u w;
          w.x = cvt_pk_bf16(p0[0], p0[1]); w.y = cvt_pk_bf16(p0[2], p0[3]); w.z = cvt_pk_bf16(p0[4], p0[5]); w.w = cvt_pk_bf16(p0[6], p0[7]); pa[0] = __builtin_bit_cast(bf16x8, w);
          w.x = cvt_pk_bf16(p0[8], p0[9]); w.y = cvt_pk_bf16(p0[10], p0[11]); w.z = cvt_pk_bf16(p0[12], p0[13]); w.w = cvt_pk_bf16(p0[14], p0[15]); pa[1] = __builtin_bit_cast(bf16x8, w);
          w.x = cvt_pk_bf16(p1[0], p1[1]); w.y = cvt_pk_bf16(p1[2], p1[3]); w.z = cvt_pk_bf16(p1[4], p1[5]); w.w = cvt_pk_bf16(p1[6], p1[7]); pa[2] = __builtin_bit_cast(bf16x8, w);
          w.x = cvt_pk_bf16(p1[8], p1[9]); w.y = cvt_pk_bf16(p1[10], p1[11]); w.z = cvt_pk_bf16(p1[12], p1[13]); w.w = cvt_pk_bf16(p1[14], p1[15]); pa[3] = __builtin_bit_cast(bf16x8, w); }
        const unsigned vb = (unsigned)(uintptr_t)vbuf + ((lane >> 4) & 1) * 32 + (lane & 3) * 8 + (4 * hi + ((lane & 15) >> 2)) * 64;
#pragma unroll
        for (int d0 = 0; d0 < 2; ++d0) {
            s16x4 lo[4], hh[4];
#pragma unroll
            for (int ks = 0; ks < 4; ++ks) {
                asm volatile("ds_read_b64_tr_b16 %0, %1 offset:%2" : "=&v"(lo[ks]) : "v"(vb), "i"(d0 * 4096 + ks * 1024) : "memory");
                asm volatile("ds_read_b64_tr_b16 %0, %1 offset:%2" : "=&v"(hh[ks]) : "v"(vb), "i"(d0 * 4096 + ks * 1024 + 512) : "memory");
            }
            asm volatile("s_waitcnt lgkmcnt(0)" : "+v"(lo[0]), "+v"(lo[1]), "+v"(lo[2]), "+v"(lo[3]), "+v"(hh[0]), "+v"(hh[1]), "+v"(hh[2]), "+v"(hh[3]) :: "memory");
#pragma unroll
            for (int ks = 0; ks < 4; ++ks) {
                const bf16x8 vf = (bf16x8){lo[ks][0], lo[ks][1], lo[ks][2], lo[ks][3], hh[ks][0], hh[ks][1], hh[ks][2], hh[ks][3]};
                if (d0 == 0) o0 = __builtin_amdgcn_mfma_f32_32x32x16_bf16(pa[ks], vf, o0, 0, 0, 0);
                else o1 = __builtin_amdgcn_mfma_f32_32x32x16_bf16(pa[ks], vf, o1, 0, 0, 0);
            }
        }
        }
        __syncthreads();
    }
    lrun += __shfl_xor(lrun, 32);
    if (hi == 0) wsf[32 + r32] = lrun;
    LDS_WAIT();
    LAS bf16* stg = (LAS bf16*)(lds + AT_OST) + wid * 2048;
#pragma unroll
    for (int r = 0; r < 16; ++r) { const int orow = crow(r, hi); const float rl = __builtin_amdgcn_rcpf(wsf[32 + orow]);
        stg[orow * 64 + r32] = (bf16)(cvt_pk_bf16(o0[r] * rl, 0.f) & 0xffffu); stg[orow * 64 + 32 + r32] = (bf16)(cvt_pk_bf16(o1[r] * rl, 0.f) & 0xffffu); }
    LDS_WAIT();
#pragma unroll
    for (int i = 0; i < 4; ++i) { const int row = i * 8 + (lane >> 3), ch = lane & 7; const v4u v = *(const LAS v4u*)(stg + row * 64 + ch * 8);
        *(v4u*)(O0 + (size_t)(wid * 32 + row) * opitch + ch * 8) = v; }
    LDS_WAIT();
}

constexpr int DC_TSTR = 2080, DC_TB = 16 * DC_TSTR, DC_T0 = 0, DC_KR0 = 2 * DC_TB, DC_KRB = 4 * DC_TSTR, DC_P = DC_KR0 + 2 * DC_KRB, DC_AL = DC_P + 4096;
static_assert(DC_AL + 64 <= RING_BYTES, "decode LDS");
constexpr int DPART_STRIDE = 8 * 132;
struct DecPre { f32x4 c[4]; f32x4 k; };
__device__ __forceinline__ void dec_load_half(DecPre& P, const float* ck, const float* kr, int hf, int tid) {
#pragma unroll
    for (int it = 0; it < 4; ++it) P.c[it] = *(const f32x4*)((const char*)(ck + 2048 * (4 * hf + it)) + (unsigned)tid * 16u);
    P.k = *(const f32x4*)((const char*)(kr + 2048 * hf) + (unsigned)tid * 16u);
}
__device__ __forceinline__ void dec_load_newtok_half(DecPre& P, const bf16* ckn, const bf16* krn, int hf, int tid) {
#pragma unroll
    for (int it = 0; it < 4; ++it) { const int i4 = tid + 512 * (4 * hf + it); f32x4 v = (f32x4){0.f, 0.f, 0.f, 0.f};
        if ((i4 >> 5) == 0) { const v2u w = *(const v2u*)(ckn + 4 * (i4 & 31)); v = (f32x4){bflo(w.x), bfhi(w.x), bflo(w.y), bfhi(w.y)}; } P.c[it] = v; }
    { const int j4 = tid + 512 * hf; f32x4 v = (f32x4){0.f, 0.f, 0.f, 0.f};
        if ((j4 >> 3) == 0) { const v2u w = *(const v2u*)(krn + 4 * (j4 & 7)); v = (f32x4){bflo(w.x), bfhi(w.x), bflo(w.y), bfhi(w.y)}; } P.k = v; }
}
__device__ __forceinline__ void dec_store_half(const DecPre& P, LAS unsigned char* T, LAS unsigned char* KR, int hf, int tid) {
#pragma unroll
    for (int it = 0; it < 4; ++it) { const int i4 = tid + 512 * (4 * hf + it), key = i4 >> 5, l4 = i4 & 31;
        v2u w; w.x = cvt_pk_bf16(P.c[it][0], P.c[it][1]); w.y = cvt_pk_bf16(P.c[it][2], P.c[it][3]);
        *(LAS v2u*)(T + (l4 >> 1) * DC_TSTR + key * 16 + (l4 & 1) * 8) = w; }
    { const int j4 = tid + 512 * hf, key = j4 >> 3, c4 = j4 & 7;
        v2u w; w.x = cvt_pk_bf16(P.k[0], P.k[1]); w.y = cvt_pk_bf16(P.k[2], P.k[3]);
        *(LAS v2u*)(KR + (c4 >> 1) * DC_TSTR + key * 16 + (c4 & 1) * 8) = w; }
}
__device__ __forceinline__ void decode_item(const Frame& F, int b, int half) {
    LAS unsigned char* lds = F.lds;
    int tid_ = F.tid; asm volatile("" : "+v"(tid_));
    const int tid = tid_, lane = tid & 63, wid = F.wave, r32 = lane & 31, hi = lane >> 5, fr = lane & 15, fq = lane >> 4;
    const bf16* wkv = (const bf16*)(F.ws + WS_WKV);
    const bf16* qb = (const bf16*)(F.ws + WS_QB) + (size_t)(NTOK + b) * 768 + wid * 96;
    const float* g_kn = F.in[22];
    bf16x8 wA[8][2];
    { const int pn = wid >> 2, wc = wid & 3; const unsigned loff = (unsigned)(r32 * 128 + 8 * hi) * 2u;
#pragma unroll
      for (int dt = 0; dt < 2; ++dt) { const char* rowp = (const char*)(wkv + (size_t)(256 * pn + 128 * dt + 32 * wc) * 128);
#pragma unroll
        for (int s = 0; s < 8; ++s) wA[s][dt] = *(const bf16x8*)(rowp + 32 * s + loff); } }
    float qg[2][16];
    { const unsigned hoff = (unsigned)hi * 4u;
#pragma unroll
      for (int dt = 0; dt < 2; ++dt)
#pragma unroll
        for (int r = 0; r < 16; ++r) { const int d0 = 32 * dt + (r & 3) + 8 * (r >> 2);
            qg[dt][r] = *(const float*)((const char*)(g_kn + d0) + hoff * 4u) * bf2f(*(const bf16*)((const char*)(qb + d0) + hoff * 2u)); } }
    bf16x8 qrA;
    { v4u w = (v4u){0u, 0u, 0u, 0u}; if ((fr & 3) == 0) w = *(const v4u*)(qb + 64 + 8 * fq); qrA = __builtin_bit_cast(bf16x8, w); }
    __syncthreads();
    for (int i = tid; i < 8 * 64; i += 512) ((LAS unsigned*)(lds + DC_P + 8 * 256))[i] = 0u;
    float mrun = -INFINITY, lrun = 0.f;
    f32x4 accL = (f32x4){0.f, 0.f, 0.f, 0.f};
    const int* ptab = (const int*)F.in[5] + b * NPAGES + half * 64;
    const int npg = 64 + (half == 1 ? 1 : 0);
    const bf16* ckn = (const bf16*)(F.ws + WS_CKVB) + (size_t)(NTOK + b) * 128;
    const bf16* krn = (const bf16*)(F.ws + WS_KRB) + (size_t)(NTOK + b) * 32;
    DecPre pre;
    { const int page = __builtin_amdgcn_readfirstlane(ptab[0]); const float* ck0 = F.in[3] + (size_t)page * (PAGE * 128); const float* kr0 = F.in[4] + (size_t)page * (PAGE * 32);
      dec_load_half(pre, ck0, kr0, 0, tid); dec_store_half(pre, lds + DC_T0, lds + DC_KR0, 0, tid);
      dec_load_half(pre, ck0, kr0, 1, tid); dec_store_half(pre, lds + DC_T0, lds + DC_KR0, 1, tid); }
    __syncthreads();
    for (int pg = 0; pg < npg; ++pg) {
        const bool newtok = pg == 64;
        LAS unsigned char* T = lds + DC_T0 + (pg & 1) * DC_TB; LAS unsigned char* KR = lds + DC_KR0 + (pg & 1) * DC_KRB;
        LAS unsigned char* Tn = lds + DC_T0 + ((pg + 1) & 1) * DC_TB; LAS unsigned char* KRn = lds + DC_KR0 + ((pg + 1) & 1) * DC_KRB;
        const bool more = pg + 1 < npg, nextnew = pg + 1 >= 64;
        const float* ckN = nullptr; const float* krN = nullptr;
        if (more && !nextnew) { const int page = __builtin_amdgcn_readfirstlane(ptab[pg + 1]); ckN = F.in[3] + (size_t)page * (PAGE * 128); krN = F.in[4] + (size_t)page * (PAGE * 32); }
        if (more) { if (!nextnew) dec_load_half(pre, ckN, krN, 0, tid); else dec_load_newtok_half(pre, ckn, krn, 0, tid); }
        float sc[4];
#pragma unroll
        for (int g = 0; g < 4; ++g) {
            f32x16 a0, a1;
#pragma unroll
            for (int r = 0; r < 16; ++r) { a0[r] = 0.f; a1[r] = 0.f; }
#pragma unroll
            for (int s = 0; s < 8; ++s) {
                const bf16x8 bfrag = *(const LAS bf16x8*)(T + (2 * s + hi) * DC_TSTR + (32 * g + r32) * 16);
                a0 = __builtin_amdgcn_mfma_f32_32x32x16_bf16(wA[s][0], bfrag, a0, 0, 0, 0);
                a1 = __builtin_amdgcn_mfma_f32_32x32x16_bf16(wA[s][1], bfrag, a1, 0, 0, 0);
            }
            const bf16x8 kf0 = *(const LAS bf16x8*)(KR + fq * DC_TSTR + (32 * g + fr) * 16), kf1 = *(const LAS bf16x8*)(KR + fq * DC_TSTR + (32 * g + 16 + fr) * 16);
            const f32x4 z4 = (f32x4){0.f, 0.f, 0.f, 0.f};
            const f32x4 rr0 = __builtin_amdgcn_mfma_f32_16x16x32_bf16(qrA, kf0, z4, 0, 0, 0), rr1 = __builtin_amdgcn_mfma_f32_16x16x32_bf16(qrA, kf1, z4, 0, 0, 0);
            typedef float f32x2 __attribute__((ext_vector_type(2)));
            f32x2 ssq2 = (f32x2){0.f, 0.f}, dot2 = (f32x2){0.f, 0.f};
#pragma unroll
            for (int r = 0; r < 16; r += 2) {
                const f32x2 x0 = (f32x2){a0[r], a0[r + 1]}, x1 = (f32x2){a1[r], a1[r + 1]};
                ssq2 = x0 * x0 + ssq2; ssq2 = x1 * x1 + ssq2;
                dot2 = x0 * (f32x2){qg[0][r], qg[0][r + 1]} + dot2; dot2 = x1 * (f32x2){qg[1][r], qg[1][r + 1]} + dot2; }
            float ssq = ssq2[0] + ssq2[1], dot = dot2[0] + dot2[1];
            { auto t = __builtin_amdgcn_permlane32_swap(__float_as_uint(ssq), __float_as_uint(ssq), false, false); ssq = __uint_as_float(t[0]) + __uint_as_float(t[1]); }
            { auto t = __builtin_amdgcn_permlane32_swap(__float_as_uint(dot), __float_as_uint(dot), false, false); dot = __uint_as_float(t[0]) + __uint_as_float(t[1]); }
            const float sr = (r32 < 16) ? rr0[0] : rr1[0];
            float sv = dot * __builtin_amdgcn_rsqf(ssq * (1.0f / 64.0f) + EPS) + sr;
            if (newtok && (32 * g + r32) != 0) sv = -INFINITY;
            sc[g] = sv;
            __builtin_amdgcn_sched_barrier(0);
            if (g == 1 && more) {
                dec_store_half(pre, Tn, KRn, 0, tid);
                __builtin_amdgcn_sched_barrier(0);
                if (!nextnew) dec_load_half(pre, ckN, krN, 1, tid); else dec_load_newtok_half(pre, ckn, krn, 1, tid);
                __builtin_amdgcn_sched_barrier(0);
            }
        }
        const float pm = fmaxf(fmaxf(sc[0], sc[1]), fmaxf(sc[2], sc[3]));
        float alpha = 1.0f;
        if (__any(pm > mrun + 8.0f)) {
            const float mn = fmaxf(mrun, wave_max(pm));
            alpha = __builtin_amdgcn_exp2f(mrun - mn);
            mrun = mn; lrun *= alpha;
        }
#pragma unroll
        for (int g = 0; g < 4; ++g) { sc[g] = __builtin_amdgcn_exp2f(sc[g] - mrun); lrun += sc[g]; }
        if (hi == 0) {
#pragma unroll
            for (int g = 0; g < 4; ++g) ((LAS bf16*)(lds + DC_P))[wid * 128 + 32 * g + r32] = (bf16)(cvt_pk_bf16(sc[g], 0.f) & 0xffffu);
        }
        if (lane == 0) ((LAS float*)(lds + DC_AL))[wid] = alpha;
        __syncthreads();
        if (fq < 2) {
#pragma unroll
            for (int i = 0; i < 4; ++i) accL[i] *= ((LAS float*)(lds + DC_AL))[4 * fq + i];
        }
        {
            const int q = fr >> 2, p = fr & 3;
#pragma unroll
            for (int ks = 0; ks < 4; ++ks) {
                const bf16x8 pa = *(const LAS bf16x8*)(lds + DC_P + fr * 256 + (32 * ks + 8 * fq) * 2);
                const unsigned a0 = (unsigned)(uintptr_t)T + (2 * wid + (p >> 1)) * DC_TSTR + (32 * ks + 8 * fq + q) * 16 + (p & 1) * 8;
                s16x4 lo, hh;
                asm volatile("ds_read_b64_tr_b16 %0, %2\n\tds_read_b64_tr_b16 %1, %2 offset:64\n\ts_waitcnt lgkmcnt(0)" : "=&v"(lo), "=&v"(hh) : "v"(a0) : "memory");
                const bf16x8 vf = (bf16x8){lo[0], lo[1], lo[2], lo[3], hh[0], hh[1], hh[2], hh[3]};
                accL = __builtin_amdgcn_mfma_f32_16x16x32_bf16(pa, vf, accL, 0, 0, 0);
            }
        }
        if (more) dec_store_half(pre, Tn, KRn, 1, tid);
        __syncthreads();
    }
    { int l2 = threadIdx.x; asm volatile("" : "+v"(l2)); l2 &= 63; const int fr2 = l2 & 15, fq2 = l2 >> 4;
      float* part = (float*)(F.ws + WS_DPART) + (size_t)(b * 2 + half) * DPART_STRIDE;
      const float ltot = wave_sum(lrun) * 0.5f;
      if (l2 == 0) { part[wid * 132 + 0] = mrun; part[wid * 132 + 1] = ltot; }
      if (fq2 < 2) {
#pragma unroll
          for (int i = 0; i < 4; ++i) part[(4 * fq2 + i) * 132 + 4 + 16 * wid + fr2] = accL[i];
      } }
}
__device__ __forceinline__ v4u norm8_pack(const float (&v)[8], float inv) {
    v4u w; w.x = cvt_pk_bf16(v[0] * inv, v[1] * inv); w.y = cvt_pk_bf16(v[2] * inv, v[3] * inv); w.z = cvt_pk_bf16(v[4] * inv, v[5] * inv); w.w = cvt_pk_bf16(v[6] * inv, v[7] * inv); return w;
}
__device__ __forceinline__ v2u norm4_pack(const float (&v)[4], float inv) { v2u w; w.x = cvt_pk_bf16(v[0] * inv, v[1] * inv); w.y = cvt_pk_bf16(v[2] * inv, v[3] * inv); return w; }
__device__ __forceinline__ void tp_finish_row(bf16* omix_row, const float (&a)[8], const float (&y)[4], const float (&mo)[4], int lane) {
    float sa = 0.f, sy = 0.f, sm = 0.f;
#pragma unroll
    for (int i = 0; i < 8; ++i) sa += a[i] * a[i];
#pragma unroll
    for (int i = 0; i < 4; ++i) { sy += y[i] * y[i]; sm += mo[i] * mo[i]; }
    sa = wave_sum(sa); sy = wave_sum(sy); sm = wave_sum(sm);
    const float ia = __builtin_amdgcn_rsqf(sa * (1.0f / 512.0f) + EPS), iy = __builtin_amdgcn_rsqf(sy * (1.0f / 256.0f) + EPS), im = __builtin_amdgcn_rsqf(sm * (1.0f / 256.0f) + EPS);
    *(v4u*)(omix_row + 8 * lane) = norm8_pack(a, ia);
    *(v2u*)(omix_row + 512 + 4 * lane) = norm4_pack(y, iy);
    *(v2u*)(omix_row + 768 + 4 * lane) = norm4_pack(mo, im);
}
__device__ __forceinline__ void tp_prompt_row(const Frame& F, int r) {
    const int lane = F.lane, t = r & (SEQ - 1);
    const bf16* oab = (const bf16*)(F.ws + WS_OAB); const bf16* omb = (const bf16*)(F.ws + WS_OMB); const bf16* ub = (const bf16*)(F.ws + WS_UB); const bf16* gbb = (const bf16*)(F.ws + WS_GBB);
    const float* cw = F.in[24];
    float a[8], y[4], mo[4];
    { const v4u w = *(const v4u*)(oab + (size_t)r * 512 + 8 * lane); a[0] = bflo(w.x); a[1] = bfhi(w.x); a[2] = bflo(w.y); a[3] = bfhi(w.y); a[4] = bflo(w.z); a[5] = bfhi(w.z); a[6] = bflo(w.w); a[7] = bfhi(w.w); }
    { const v2u w = *(const v2u*)(omb + (size_t)r * 256 + 4 * lane); mo[0] = bflo(w.x); mo[1] = bfhi(w.x); mo[2] = bflo(w.y); mo[3] = bfhi(w.y); }
    { const v2u u0 = *(const v2u*)(ub + (size_t)r * 256 + 4 * lane);
      v2u u1 = (v2u){0u, 0u}, u2 = (v2u){0u, 0u};
      if (t >= 1) u1 = *(const v2u*)(ub + (size_t)(r - 1) * 256 + 4 * lane);
      if (t >= 2) u2 = *(const v2u*)(ub + (size_t)(r - 2) * 256 + 4 * lane);
      const v2u g = *(const v2u*)(gbb + (size_t)r * 256 + 4 * lane);
      const f32x4 w0 = *(const f32x4*)(cw + 4 * lane), w1 = *(const f32x4*)(cw + 256 + 4 * lane), w2 = *(const f32x4*)(cw + 512 + 4 * lane);
      y[0] = bflo(g.x) * (w0[0] * bflo(u2.x) + w1[0] * bflo(u1.x) + w2[0] * bflo(u0.x));
      y[1] = bfhi(g.x) * (w0[1] * bfhi(u2.x) + w1[1] * bfhi(u1.x) + w2[1] * bfhi(u0.x));
      y[2] = bflo(g.y) * (w0[2] * bflo(u2.y) + w1[2] * bflo(u1.y) + w2[2] * bflo(u0.y));
      y[3] = bfhi(g.y) * (w0[3] * bfhi(u2.y) + w1[3] * bfhi(u1.y) + w2[3] * bfhi(u0.y)); }
    tp_finish_row((bf16*)(F.ws + WS_OMIX) + (size_t)r * D, a, y, mo, lane);
}
__device__ __forceinline__ void tp_sample_row(const Frame& F, int b, LAS float* scr) {
    const int lane = F.lane, r = NTOK + b;
    LAS float* lat = scr;
    LAS float* qf = scr + 1024;
    LAS float* pb = scr + 1088;
    LAS float* omo = scr + 1344;
    const float* part = (const float*)(F.ws + WS_DPART) + (size_t)(b * 2) * DPART_STRIDE;
#pragma unroll
    for (int h = 0; h < 8; ++h) {
        const float m0 = part[h * 132], l0 = part[h * 132 + 1], m1 = part[DPART_STRIDE + h * 132], l1 = part[DPART_STRIDE + h * 132 + 1];
        const float M = fmaxf(m0, m1), e0 = __builtin_amdgcn_exp2f(m0 - M), e1 = __builtin_amdgcn_exp2f(m1 - M);
        const float rl = 1.0f / (l0 * e0 + l1 * e1);
#pragma unroll
        for (int j = 0; j < 2; ++j) { const int c = lane + 64 * j; lat[h * 128 + c] = (part[h * 132 + 4 + c] * e0 + part[DPART_STRIDE + h * 132 + 4 + c] * e1) * rl; }
    }
    LDS_WAIT();
    float a[8], y[4], mo[4];
    { const float* wuv = F.in[21]; const int h = lane >> 3;
#pragma unroll
      for (int i = 0; i < 8; ++i) a[i] = 0.f;
      for (int l = 0; l < 128; ++l) { const float x = lat[h * 128 + l]; const f32x4 w0 = *(const f32x4*)(wuv + (size_t)l * 512 + 8 * lane), w1 = *(const f32x4*)(wuv + (size_t)l * 512 + 8 * lane + 4);
          a[0] += x * w0[0]; a[1] += x * w0[1]; a[2] += x * w0[2]; a[3] += x * w0[3]; a[4] += x * w1[0]; a[5] += x * w1[1]; a[6] += x * w1[2]; a[7] += x * w1[3]; } }
    { const bf16* ub = (const bf16*)(F.ws + WS_UB); const bf16* gbb = (const bf16*)(F.ws + WS_GBB); const float* cw = F.in[24]; const float* st = F.in[6] + (size_t)b * 512;
      const v2u u0 = *(const v2u*)(ub + (size_t)r * 256 + 4 * lane); const v2u g = *(const v2u*)(gbb + (size_t)r * 256 + 4 * lane);
      const f32x4 s0 = *(const f32x4*)(st + 4 * lane), s1 = *(const f32x4*)(st + 256 + 4 * lane);
      const f32x4 w0 = *(const f32x4*)(cw + 4 * lane), w1 = *(const f32x4*)(cw + 256 + 4 * lane), w2 = *(const f32x4*)(cw + 512 + 4 * lane);
      y[0] = bflo(g.x) * (w0[0] * s0[0] + w1[0] * s1[0] + w2[0] * bflo(u0.x));
      y[1] = bfhi(g.x) * (w0[1] * s0[1] + w1[1] * s1[1] + w2[1] * bfhi(u0.x));
      y[2] = bflo(g.y) * (w0[2] * s0[2] + w1[2] * s1[2] + w2[2] * bflo(u0.y));
      y[3] = bfhi(g.y) * (w0[3] * s0[3] + w1[3] * s1[3] + w2[3] * bfhi(u0.y)); }
    { const bf16* mqb = (const bf16*)(F.ws + WS_MQB) + (size_t)r * 256; const float* ck = F.in[7] + (size_t)b * (256 * 256); const float* cv = F.in[8] + (size_t)b * (256 * 256);
#pragma unroll 1
      for (int h = 0; h < 4; ++h) {
          qf[lane] = bf2f(mqb[h * 64 + lane]);
          LDS_WAIT();
          float s[4];
#pragma unroll
          for (int j = 0; j < 4; ++j) { const int n = lane + 64 * j; const float* kp = ck + (size_t)n * 256 + h * 64; float acc = 0.f;
#pragma unroll
              for (int d4 = 0; d4 < 16; ++d4) { const f32x4 kv = *(const f32x4*)(kp + 4 * d4); const f32x4 qv = *(const LAS f32x4*)(qf + 4 * d4); acc += kv[0] * qv[0] + kv[1] * qv[1] + kv[2] * qv[2] + kv[3] * qv[3]; }
              s[j] = acc; }
          const float mx = wave_max(fmaxf(fmaxf(s[0], s[1]), fmaxf(s[2], s[3])));
          float ls = 0.f;
#pragma unroll
          for (int j = 0; j < 4; ++j) { s[j] = __builtin_amdgcn_exp2f(s[j] - mx); ls += s[j]; pb[lane + 64 * j] = s[j]; }
          ls = wave_sum(ls);
          LDS_WAIT();
          float o = 0.f;
          for (int n = 0; n < 256; ++n) o += pb[n] * cv[(size_t)n * 256 + h * 64 + lane];
          omo[h * 64 + lane] = o / ls;
          LDS_WAIT();
      }
#pragma unroll
      for (int i = 0; i < 4; ++i) mo[i] = omo[4 * lane + i]; }
    *(v4u*)((bf16*)(F.ws + WS_OAB) + (size_t)r * 512 + 8 * lane) = norm8_pack(a, 1.0f);
    *(v2u*)((bf16*)(F.ws + WS_OMB) + (size_t)r * 256 + 4 * lane) = norm4_pack(mo, 1.0f);
    tp_finish_row((bf16*)(F.ws + WS_OMIX) + (size_t)r * D, a, y, mo, lane);
    LDS_WAIT();
}
__device__ __forceinline__ void tp_phase(const Frame& F) {
    LAS float* scr = (LAS float*)(F.lds + F.wave * 16384);
    if (F.wave == 0) for (int b = F.vcu; b < NS; b += F.G) tp_sample_row(F, b, scr);
    const int gw = F.vcu * NWAVES + F.wave, NGW = F.G * NWAVES;
    for (int r = gw; r < NTOK; r += NGW) tp_prompt_row(F, r);
}
#if DBG_ORACLE
__device__ __forceinline__ void dbg_phase(const Frame& F);
__device__ __forceinline__ void dbg_report(const Frame& F, unsigned* barw);
#endif
#define P_BF(off) ((bf16*)(F.ws + (off)))
#define P_F32(off) ((float*)(F.ws + (off)))
#define W1GU P_BF(WS_W1GU)
#define W1D P_BF(WS_W1D)
#define WIN P_BF(WS_WIN)
#define WUQ P_BF(WS_WUQ)
#define WKV P_BF(WS_WKV)
#define WO P_BF(WS_WO)
#define W2GU P_BF(WS_W2GU)
#define W2D P_BF(WS_W2D)
#define WMEM P_BF(WS_WMEM)
#define rope P_F32(WS_ROPE)
#define ssq0 P_F32(WS_SSQ0)
#define ssq1 P_F32(WS_SSQ1)
#define ssq2 P_F32(WS_SSQ2)
#define msq P_F32(WS_MSQ)
#define ssqm P_F32(WS_SSQM)
#define xb P_BF(WS_XB)
#define act1 P_BF(WS_ACT1)
#define act2 P_BF(WS_ACT2)
#define x1f P_F32(WS_X1F)
#define x1b P_BF(WS_X1B)
#define x2f P_F32(WS_X2F)
#define x2b P_BF(WS_X2B)
#define cqb P_BF(WS_CQB)
#define ckvb P_BF(WS_CKVB)
#define krb P_BF(WS_KRB)
#define ub P_BF(WS_UB)
#define gbb P_BF(WS_GBB)
#define mqb P_BF(WS_MQB)
#define qb P_BF(WS_QB)
#define Kb P_BF(WS_KB)
#define Vb P_BF(WS_VB)
#define memb P_BF(WS_MEMB)
#define memK P_BF(WS_MEMK)
#define memV P_BF(WS_MEMV)
#define oab P_BF(WS_OAB)
#define omb P_BF(WS_OMB)
#define omix P_BF(WS_OMIX)
__global__ void __launch_bounds__(NWAVES * 64, 2) mk_fwd(Args args) {
    extern __shared__ __attribute__((aligned(16))) unsigned char lds_raw[];
    Frame F;
    F.lds = (LAS unsigned char*)lds_raw;
    F.wave = __builtin_amdgcn_readfirstlane((int)threadIdx.x >> 6);
    F.G = gridDim.x; { const int bx = blockIdx.x; F.vcu = (F.G % 8 == 0) ? (bx % 8) * (F.G / 8) + bx / 8 : bx; }
#define PHASE_BEGIN() do { const CAS Args* ka_ = (const CAS Args*)__builtin_amdgcn_kernarg_segment_ptr(); asm volatile("" : "+s"(ka_)); F.in = (InTab)ka_->in; F.out = ka_->out; F.ws = ka_->ws; \
        int t_ = threadIdx.x; asm volatile("" : "+v"(t_)); F.tid = t_; F.lane = t_ & 63; } while (0)
    PHASE_BEGIN();
    for (int u = F.tid; u < (LDS_BYTES - LDSCTL_OFF) / 4; u += NWAVES * 64) ((LAS unsigned*)(F.lds + LDSCTL_OFF))[u] = 0u;
    __syncthreads();
    XcdBarrier bar = xcd_barrier_post((unsigned*)(F.ws + WS_CTL) + CW_BAR, (volatile LAS unsigned*)(F.lds + MISC_OFF) + 8);
    const int lo = args.ph_lo, hi = args.ph_hi;
#ifndef PH_MASK
#define PH_MASK 0xFFFF
#endif
#define IN(k) (((PH_MASK >> (k)) & 1) && lo <= (k) && (k) < hi)
#define SEAM(k) do { if (IN(k) && IN((k) + 1)) xcd_barrier(bar); } while (0)
    const int bx = (int)blockIdx.x;

#ifndef REP_P0
#define REP_P0 1
#endif
#ifndef REP_P4
#define REP_P4 1
#endif
    if (IN(0)) { PHASE_BEGIN(); for (int rep_ = 0; rep_ < REP_P0; ++rep_) p0_prologue(F); }
    SEAM(0);
    if (IN(1)) { PHASE_BEGIN();
        pg8::Gemm g{xb, W1GU, MP, FF2, D}; pg8::StaticOrder S; S.init(MP, FF2, F.G, bx);
        pg8::EpiSwiGLU E{ssq0, act1, FF};
        pg8::gemm_phase<pg8::EpiSwiGLU, pg8::StaticOrder, true, true>(F.lds, g, S, E);
    }
    SEAM(1);
    if (IN(2)) { PHASE_BEGIN();
        pg8::Gemm g{act1, W1D, MP, D, FF}; pg8::StaticOrder S; S.init(MP, D, F.G, bx);
        pg8::EpiResid E{F.in[0], F.in[2], x1f, x1f + (size_t)NTOK * D, x1b, ssq1, 0.5f};
        pg8::gemm_phase<pg8::EpiResid, pg8::StaticOrder, true, true>(F.lds, g, S, E);
    }
    SEAM(2);
    if (IN(3)) { PHASE_BEGIN();
        { pg8::Gemm g{x1b, WIN, MP, INWP, D}; pg8::StaticOrder S; S.init(MP, INWP, F.G, bx);
          pg8::EpiZ E{ssq1, (LAS float*)(F.lds + XCH_OFF), msq, cqb, F.in[19], F.in[23], F.in[28], rope,
                      F.out + O_CKVP, F.out + O_CKVS, F.out + O_KRP, F.out + O_KRS, F.out + O_CONVP, F.out + O_CONVS, ckvb, krb, Kb, ub, gbb, mqb};
          pg8::gemm_phase<pg8::EpiZ, pg8::StaticOrder, true, true>(F.lds, g, S, E); }
        { pg8::Gemm g{memb, WMEM, 1024, 512, D}; pg8::StaticOrder S; S.init(1024, 512, F.G, bx);
          pg8::EpiMem E{ssqm, F.in[29], F.out + O_MKP, F.out + O_MVP, memK, memV};
          pg8::gemm_phase<pg8::EpiMem, pg8::StaticOrder, true, true>(F.lds, g, S, E); }
    }
    SEAM(3);
    if (IN(4)) { PHASE_BEGIN();
      for (int rep_ = 0; rep_ < REP_P4; ++rep_) {
        { pg8::Gemm g{cqb, WUQ, MP, 768, 256}; pg8::StaticOrder S; S.init(MP, 768, F.G, bx);
          pg8::EpiQ E{msq, F.in[17], F.in[18], rope, qb};
          pg8::gemm_phase<pg8::EpiQ, pg8::StaticOrder, true, true>(F.lds, g, S, E); }
        { pg8::Gemm g{ckvb, WKV, NTOK, 1024, 128}; pg8::StaticOrder S; S.init(NTOK, 1024, F.G, bx);
          pg8::EpiKV E{F.in[22], Kb, Vb};
          pg8::gemm_phase<pg8::EpiKV, pg8::StaticOrder, true, true>(F.lds, g, S, E); }
      }
    }
    SEAM(4);
    if (IN(5)) { PHASE_BEGIN();
#ifndef REP_MLA
#define REP_MLA 1
#endif
#ifndef REP_DEC
#define REP_DEC 1
#endif
#ifndef REP_TP
#define REP_TP 1
#endif
        for (int rep_ = 0; rep_ < REP_MLA; ++rep_)
        for (int i = 0;; ++i) {
            int bh, qblk;
            if (F.G == 256) { if (i >= 4) break; const int s = F.vcu & 7; bh = F.vcu >> 3; qblk = (i == 0) ? s : (i == 1) ? 15 - s : (i == 2) ? 16 + s : 31 - s; }
            else { const int u = F.vcu + i * F.G; if (u >= 1024) break; bh = u >> 5; qblk = u & 31; }
            const int b = bh >> 3, h = bh & 7; const size_t row0 = (size_t)b * SEQ + (size_t)qblk * 256;
            attn_unit_simple<96, true>(qb + row0 * 768 + h * 96, 768, Kb + (size_t)bh * SEQ * 96, Vb + (size_t)bh * SEQ * 64, oab + row0 * 512 + h * 64, 512, 4 * (qblk + 1), F.lds);
        }
        for (int u = F.vcu; u < 512; u += F.G) {
            const int b = u >> 7, h = (u >> 5) & 3, qblk = u & 31; const size_t row0 = (size_t)b * SEQ + (size_t)qblk * 256;
            attn_unit_simple<64, false>(mqb + row0 * 256 + h * 64, 256, memK + (size_t)(b * 4 + h) * 256 * 64, memV + (size_t)(b * 4 + h) * 256 * 64, omb + row0 * 256 + h * 64, 256, 4, F.lds);
        }
        __syncthreads();
        for (int rep_ = 0; rep_ < REP_DEC; ++rep_)
        for (int it = F.vcu; it < 2 * NS; it += F.G) decode_item(F, it >> 1, it & 1);
    }
    SEAM(5);
    if (IN(6)) { PHASE_BEGIN(); for (int rep_ = 0; rep_ < REP_TP; ++rep_) tp_phase(F); }
    SEAM(6);
    if (IN(7)) { PHASE_BEGIN();
        pg8::Gemm g{omix, WO, MP, D, D}; pg8::StaticOrder S; S.init(MP, D, F.G, bx);
        pg8::EpiResid E{x1f, x1f + (size_t)NTOK * D, x2f, x2f + (size_t)NTOK * D, x2b, ssq2, 1.0f};
        pg8::gemm_phase<pg8::EpiResid, pg8::StaticOrder, true, true>(F.lds, g, S, E);
    }
    SEAM(7);
    if (IN(8)) { PHASE_BEGIN();
        pg8::Gemm g{x2b, W2GU, MP, FF2, D}; pg8::StaticOrder S; S.init(MP, FF2, F.G, bx);
        pg8::EpiSwiGLU E{ssq2, act2, FF};
        pg8::gemm_phase<pg8::EpiSwiGLU, pg8::StaticOrder, true, true>(F.lds, g, S, E);
    }
    SEAM(8);
    if (IN(9)) { PHASE_BEGIN();
        pg8::Gemm g{act2, W2D, MP, D, FF}; pg8::StaticOrder S; S.init(MP, D, F.G, bx);
        pg8::EpiResid E{x2f, x2f + (size_t)NTOK * D, F.out + O_Y, F.out + O_YS, nullptr, nullptr, 0.5f};
        pg8::gemm_phase<pg8::EpiResid, pg8::StaticOrder, true, true>(F.lds, g, S, E);
    }
#if DBG_ORACLE
    if (IN(9)) { xcd_barrier(bar); PHASE_BEGIN(); dbg_phase(F); xcd_barrier(bar); PHASE_BEGIN(); dbg_report(F, (unsigned*)(F.ws + WS_CTL) + CW_BAR); }
#endif
#undef IN
#undef SEAM
#undef PHASE_BEGIN
}
#undef W1GU
#undef W1D
#undef WIN
#undef WUQ
#undef WKV
#undef WO
#undef W2GU
#undef W2D
#undef WMEM
#undef rope
#undef ssq0
#undef ssq1
#undef ssq2
#undef msq
#undef ssqm
#undef xb
#undef act1
#undef act2
#undef x1f
#undef x1b
#undef x2f
#undef x2b
#undef cqb
#undef ckvb
#undef krb
#undef ub
#undef gbb
#undef mqb
#undef qb
#undef Kb
#undef Vb
#undef memb
#undef memK
#undef memV
#undef oab
#undef omb
#undef omix
#undef P_BF
#undef P_F32

extern "C" void kernel_launch(void* const* d_in, const int* in_sizes, int n_in, void* d_out, int out_size, void* d_ws, size_t ws_size, hipStream_t stream) {
    static int grid = 0;
    if (grid == 0) {
        if (n_in != 38 || (size_t)out_size != O_TOTAL || ws_size < WS_END) { fprintf(stderr, "kernel_launch: unexpected shapes (n_in %d, out %d, ws %zu)\n", n_in, out_size, ws_size); grid = -1; return; }
        int dev = 0, cus = 0, per_cu = 0;
        if (hipGetDevice(&dev) != hipSuccess || hipDeviceGetAttribute(&cus, hipDeviceAttributeMultiprocessorCount, dev) != hipSuccess) { grid = -1; return; }
        if (hipFuncSetAttribute((const void*)mk_fwd, hipFuncAttributeMaxDynamicSharedMemorySize, LDS_BYTES) != hipSuccess) { fprintf(stderr, "kernel_launch: hipFuncSetAttribute failed\n"); grid = -1; return; }
        if (hipOccupancyMaxActiveBlocksPerMultiprocessor(&per_cu, (const void*)mk_fwd, NWAVES * 64, LDS_BYTES) != hipSuccess || per_cu < 1) { fprintf(stderr, "kernel_launch: occupancy query says %d\n", per_cu); }
        (void)hipGetLastError();
        grid = cus;
    }
    if (grid < 0) return;
    (void)hipMemsetAsync((char*)d_ws + WS_CTL, 0, CTL_ZERO_BYTES, stream);
#if DBG_ORACLE
    (void)hipMemsetAsync((char*)d_ws + WS_DBG, 0, 1 * MiB, stream);
#endif
    Args a{};
    for (int i = 0; i < 38; ++i) a.in[i] = (const float*)d_in[i];
    a.out = (float*)d_out; a.ws = (unsigned char*)d_ws;
    a.ph_lo = 0; a.ph_hi = 10;
    hipLaunchKernelGGL(mk_fwd, dim3(grid), dim3(NWAVES * 64), LDS_BYTES, stream, a);
}
```

```cpp
#include <hip/hip_runtime.h>
#include <cstdint>
#include <cstdio>
#include <cmath>
#define DBG_ORACLE 0
#define DBG_TOL 0.03f

namespace pg8 {
#define PG8_LAS __attribute__((address_space(3)))
typedef unsigned short bf16_t;
typedef short bf16x8 __attribute__((ext_vector_type(8)));
typedef float f32x4 __attribute__((ext_vector_type(4)));
typedef unsigned u32x4 __attribute__((ext_vector_type(4)));
constexpr int BM = 256, BK = 64, HALF = 128, HTB = HALF * BK * 2  , STAGE_BYTES = 8 * HTB, NXCD = 8, WGM = 8;

__host__ __device__ __forceinline__ int lds_byte(int r, int c) { const int st = (r >> 4) * 2 + (c >> 5), rr = r & 15, cc = c & 31, ob = rr * 64 + cc * 2; return st * 1024 + (ob ^ (((ob >> 9) & 1) << 5)); }
__host__ __device__ __forceinline__ void stage_rc(int b, int& R, int& C) { const int st = b / 1024, sb = b % 1024, swz = sb ^ (((sb >> 9) & 1) << 5); R = (st >> 1) * 16 + swz / 64; C = (st & 1) * 32 + (swz % 64) / 2; }
__host__ __device__ __forceinline__ int perm32(int rho) { const int n = rho >> 4, i = rho & 15; return 8 * (i >> 2) + 4 * n + (i & 3); }

struct Unit { int pm, pn; };
struct Gemm { const bf16_t* A; const bf16_t* Bt; int M, N, K; };

struct StaticOrder {
    int nM, nN, nwg, G, c;
    __host__ __device__ void init(int M, int N, int G_, int c_) { nM = M / BM; nN = N / BM; nwg = nM * nN; G = G_; c = c_; }
    __host__ __device__ bool next(int i, Unit& u) const {
        const long L = (long)i * G + c; if (L >= nwg) return false;
        int wgid = (int)L; { const int q = nwg / NXCD, r = nwg % NXCD, xcd = wgid % NXCD, off = wgid / NXCD; wgid = (xcd < r ? xcd * (q + 1) : r * (q + 1) + (xcd - r) * q) + off; }
        const int nig = WGM * nN, gid = wgid / nig, fm = gid * WGM, gsz = (nM - fm) < WGM ? (nM - fm) : WGM;
        u.pm = fm + ((wgid % nig) % gsz); u.pn = (wgid % nig) / gsz; return true;
    }
    __device__ __forceinline__ void a_ready(const Unit&) const {}
    __device__ __forceinline__ void done(const Unit&) const {}
};

__device__ __forceinline__ unsigned cvt_pk_bf16(float lo, float hi) { typedef float f2_ __attribute__((ext_vector_type(2))); typedef __bf16 b2_ __attribute__((ext_vector_type(2))); const f2_ v = {lo, hi}; const b2_ b = __builtin_convertvector(v, b2_); return __builtin_bit_cast(unsigned, b); }
typedef float f32x2 __attribute__((ext_vector_type(2)));
constexpr int kNTOK = 32768, kMR = 32896, kSEQ = 8192;
constexpr float kEPS = 1e-6f;
constexpr float kLOG2E = 1.4426950408889634f;
constexpr float kC2Q = 0.10206207261596577f * 1.4426950408889634f;
constexpr float kC2M = 0.125f * 1.4426950408889634f;
typedef unsigned u32x2 __attribute__((ext_vector_type(2)));
__device__ __forceinline__ int fresh_lane() { int l; asm volatile("v_mbcnt_lo_u32_b32 %0, -1, 0\n\tv_mbcnt_hi_u32_b32 %0, -1, %0" : "=v"(l)); return l; }

__device__ __forceinline__ float row_inv_from_parts(const float* parts, int row) {
    const f32x4* p = (const f32x4*)(parts + (size_t)row * 16);
    const f32x4 a = p[0], b = p[1], c = p[2], d = p[3];
    const float s = ((a[0] + a[1]) + (a[2] + a[3])) + ((b[0] + b[1]) + (b[2] + b[3])) + ((c[0] + c[1]) + (c[2] + c[3])) + ((d[0] + d[1]) + (d[2] + d[3]));
    return __builtin_amdgcn_rsqf(s * (1.0f / 1024.0f) + kEPS);
}
__device__ __forceinline__ float silu_mul(float g, float u) {
    const float e = __builtin_amdgcn_exp2f(-g * kLOG2E);
    return g * __builtin_amdgcn_rcpf(1.0f + e) * u;
}

struct EpiSwiGLU {
    static constexpr bool PERM = true, AFTER_DRAIN = false;
    const float* ssq; bf16_t* act; int ldact;
    __device__ __forceinline__ void operator()(const f32x4 (&acc)[2][2][4][2], const Unit& u, int wr, int wc, int fr_, int fq_) const {
        const int ln_ = fresh_lane(), fr = ln_ & 15, fq = ln_ >> 4; (void)fr_; (void)fq_;
#pragma unroll
        for (int ai = 0; ai < 2; ++ai)
#pragma unroll
            for (int m = 0; m < 4; ++m) {
                const int row = u.pm * BM + ai * HALF + wr * 64 + m * 16 + fr;
                const float inv = row_inv_from_parts(ssq, row);
                const f32x4 g0 = acc[ai][0][m][0] * inv, g1 = acc[ai][0][m][1] * inv, u0 = acc[ai][1][m][0] * inv, u1 = acc[ai][1][m][1] * inv;
                u32x4 w;
                w.x = cvt_pk_bf16(silu_mul(g0[0], u0[0]), silu_mul(g0[1], u0[1])); w.y = cvt_pk_bf16(silu_mul(g0[2], u0[2]), silu_mul(g0[3], u0[3]));
                w.z = cvt_pk_bf16(silu_mul(g1[0], u1[0]), silu_mul(g1[1], u1[1])); w.w = cvt_pk_bf16(silu_mul(g1[2], u1[2]), silu_mul(g1[3], u1[3]));
                *(u32x4*)(act + (size_t)row * ldact + u.pn * 128 + wc * 32 + 8 * fq) = w;
                if (m & 1) asm volatile("" ::: "memory");
            }
    }
};

struct EpiResid {
    static constexpr bool PERM = true, AFTER_DRAIN = false;
    const float* base0; const float* base1; float* out0; float* out1; bf16_t* ob; float* ssq_out; float scale;
    __device__ __forceinline__ void operator()(const f32x4 (&acc)[2][2][4][2], const Unit& u, int wr, int wc, int fr_, int fq_) const {
        const int ln_ = fresh_lane(), fr = ln_ & 15, fq = ln_ >> 4; (void)fr_; (void)fq_;
#pragma unroll
        for (int ai = 0; ai < 2; ++ai)
#pragma unroll
            for (int m = 0; m < 4; ++m) {
                const int row = u.pm * BM + ai * HALF + wr * 64 + m * 16 + fr;
                const bool live = row < kMR;
                const int rr = row < kNTOK ? row : row - kNTOK;
                const float* bp = (row < kNTOK ? base0 : base1) + (size_t)rr * 1024;
                float* op = (row < kNTOK ? out0 : out1) + (size_t)rr * 1024;
                float s = 0.f;
#pragma unroll
                for (int bj = 0; bj < 2; ++bj) {
                    const int col = u.pn * BM + bj * HALF + wc * 32 + 8 * fq;
                    f32x4 v0 = (f32x4){0.f, 0.f, 0.f, 0.f}, v1 = v0;
                    if (live) { v0 = *(const f32x4*)(bp + col); v1 = *(const f32x4*)(bp + col + 4); }
                    v0 = v0 + acc[ai][bj][m][0] * scale; v1 = v1 + acc[ai][bj][m][1] * scale;
                    s += (v0[0] * v0[0] + v0[1] * v0[1]) + (v0[2] * v0[2] + v0[3] * v0[3]) + (v1[0] * v1[0] + v1[1] * v1[1]) + (v1[2] * v1[2] + v1[3] * v1[3]);
                    if (live) {
                        *(f32x4*)(op + col) = v0; *(f32x4*)(op + col + 4) = v1;
                        if (ob) { u32x4 w; w.x = cvt_pk_bf16(v0[0], v0[1]); w.y = cvt_pk_bf16(v0[2], v0[3]); w.z = cvt_pk_bf16(v1[0], v1[1]); w.w = cvt_pk_bf16(v1[2], v1[3]);
                            *(u32x4*)(ob + (size_t)row * 1024 + col) = w; }
                    }
                }
                s += __shfl_xor(s, 16); s += __shfl_xor(s, 32);
                if (ssq_out && fq == 0) ssq_out[(size_t)row * 16 + u.pn * 4 + wc] = s;
                asm volatile("" ::: "memory");
            }
    }
};

struct EpiZ {
    static constexpr bool PERM = false, AFTER_DRAIN = false;
    const float* ssq1;
    PG8_LAS float* xch;
    float* msq;
    bf16_t* cqb;
    const float* g_kv; const float* g_kr; const float* g_mq;
    const float* rope;
    float* ckv_p; float* ckv_s; float* kr_p; float* kr_s; float* conv_p; float* conv_s;
    bf16_t* ckvb; bf16_t* krb; bf16_t* Kb; bf16_t* ub; bf16_t* gbb; bf16_t* mqb;
    __device__ __forceinline__ void operator()(const f32x4 (&acc)[2][2][4][2], const Unit& u, int wr, int wc, int fr_, int fq_) const {
        const int ln_ = fresh_lane(), fr = ln_ & 15, fq = ln_ >> 4; (void)fr_; (void)fq_;
        const int pn = u.pn;
        float inv1[2][4]; int rows[2][4];
#pragma unroll
        for (int ai = 0; ai < 2; ++ai)
#pragma unroll
            for (int m = 0; m < 4; ++m) { rows[ai][m] = u.pm * BM + ai * HALF + wr * 64 + m * 16 + fr; inv1[ai][m] = row_inv_from_parts(ssq1, rows[ai][m]); }
        if (pn == 0 || pn == 1) {
#pragma unroll
            for (int ai = 0; ai < 2; ++ai)
#pragma unroll
                for (int m = 0; m < 4; ++m) {
                    float s = 0.f; const float iv = inv1[ai][m];
#pragma unroll
                    for (int bj = 0; bj < 2; ++bj) { if (pn == 1 && bj == 1) continue;
#pragma unroll
                        for (int n = 0; n < 2; ++n) { const f32x4 v = acc[ai][bj][m][n] * iv; s += (v[0] * v[0] + v[1] * v[1]) + (v[2] * v[2] + v[3] * v[3]); } }
                    s += __shfl_xor(s, 16); s += __shfl_xor(s, 32);
                    if (fq == 0) xch[(ai * HALF + wr * 64 + m * 16 + fr) * 4 + wc] = s;
                }
            asm volatile("s_waitcnt lgkmcnt(0)" ::: "memory"); __builtin_amdgcn_s_barrier(); asm volatile("" ::: "memory");
        }
        if (pn == 0) {
#pragma unroll
            for (int ai = 0; ai < 2; ++ai)
#pragma unroll
                for (int m = 0; m < 4; ++m) {
                    const int row = rows[ai][m]; const float iv = inv1[ai][m];
                    const f32x4 t = *(const PG8_LAS f32x4*)(xch + (ai * HALF + wr * 64 + m * 16 + fr) * 4);
                    if (wc == 0 && fq == 0 && row < kMR) msq[row] = ((t[0] + t[1]) + (t[2] + t[3])) * (1.0f / 256.0f);
                    if (row < kMR) {
#pragma unroll
                        for (int bj = 0; bj < 2; ++bj)
#pragma unroll
                            for (int n = 0; n < 2; ++n) { const f32x4 v = acc[ai][bj][m][n] * iv; u32x2 w; w.x = cvt_pk_bf16(v[0], v[1]); w.y = cvt_pk_bf16(v[2], v[3]);
                                *(u32x2*)(cqb + (size_t)row * 256 + bj * HALF + wc * 32 + n * 16 + 4 * fq) = w; }
                    }
                }
        } else if (pn == 1) {
#pragma unroll
            for (int ai = 0; ai < 2; ++ai)
#pragma unroll
                for (int m = 0; m < 4; ++m) {
                    const int row = rows[ai][m]; const float iv = inv1[ai][m];
                    if (row >= kMR) continue;
                    const bool smp = row >= kNTOK; const int rr = smp ? row - kNTOK : row;
                    const f32x4 t = *(const PG8_LAS f32x4*)(xch + (ai * HALF + wr * 64 + m * 16 + fr) * 4);
                    const float ic = __builtin_amdgcn_rsqf(((t[0] + t[1]) + (t[2] + t[3])) * (1.0f / 128.0f) + kEPS);
#pragma unroll
                    for (int n = 0; n < 2; ++n) {
                        const int c = wc * 32 + n * 16 + 4 * fq;
                        const f32x4 g = *(const f32x4*)(g_kv + c);
                        const f32x4 v = acc[ai][0][m][n] * (iv * ic) * g;
                        *(f32x4*)((smp ? ckv_s : ckv_p) + (size_t)rr * 128 + c) = v;
                        u32x2 w; w.x = cvt_pk_bf16(v[0], v[1]); w.y = cvt_pk_bf16(v[2], v[3]);
                        *(u32x2*)(ckvb + (size_t)row * 128 + c) = w;
                    }
                    if (wc == 0) {
                        const f32x4 a = acc[ai][1][m][0] * iv, b = acc[ai][1][m][1] * iv;
                        float s = (a[0] * a[0] + a[1] * a[1]) + (a[2] * a[2] + a[3] * a[3]) + (b[0] * b[0] + b[1] * b[1]) + (b[2] * b[2] + b[3] * b[3]);
                        s += __shfl_xor(s, 16); s += __shfl_xor(s, 32);
                        const float ik = __builtin_amdgcn_rsqf(s * (1.0f / 32.0f) + kEPS);
                        const f32x4 ga = *(const f32x4*)(g_kr + 4 * fq), gb = *(const f32x4*)(g_kr + 16 + 4 * fq);
                        const f32x4 x1 = a * ik * ga, x2 = b * ik * gb;
                        const int pos = smp ? kSEQ : (row & (kSEQ - 1));
                        const f32x4 cs = *(const f32x4*)(rope + (size_t)pos * 32 + 4 * fq), sn = *(const f32x4*)(rope + (size_t)pos * 32 + 16 + 4 * fq);
                        const f32x4 o1 = x1 * cs - x2 * sn, o2 = x1 * sn + x2 * cs;
                        float* kro = (smp ? kr_s : kr_p) + (size_t)rr * 32;
                        *(f32x4*)(kro + 4 * fq) = o1; *(f32x4*)(kro + 16 + 4 * fq) = o2;
                        u32x2 w1, w2; w1.x = cvt_pk_bf16(o1[0], o1[1]); w1.y = cvt_pk_bf16(o1[2], o1[3]); w2.x = cvt_pk_bf16(o2[0], o2[1]); w2.y = cvt_pk_bf16(o2[2], o2[3]);
                        *(u32x2*)(krb + (size_t)row * 32 + 4 * fq) = w1; *(u32x2*)(krb + (size_t)row * 32 + 16 + 4 * fq) = w2;
                        if (!smp) { const int b_ = row >> 13, t_ = row & (kSEQ - 1);
#pragma unroll
                            for (int h = 0; h < 8; ++h) { bf16_t* kp = Kb + ((size_t)(b_ * 8 + h) * kSEQ + t_) * 96 + 64; *(u32x2*)(kp + 4 * fq) = w1; *(u32x2*)(kp + 16 + 4 * fq) = w2; } }
                    }
                    asm volatile("" ::: "memory");
                }
        } else if (pn == 2 || pn == 3) {
#pragma unroll
            for (int ai = 0; ai < 2; ++ai)
#pragma unroll
                for (int m = 0; m < 4; ++m) {
                    const int row = rows[ai][m]; const float iv = inv1[ai][m];
                    if (row >= kMR) continue;
                    const bool smp = row >= kNTOK; const int t_ = row & (kSEQ - 1), b_ = row >> 13;
#pragma unroll
                    for (int n = 0; n < 2; ++n) {
                        const int c = (pn - 2) * 128 + wc * 32 + n * 16 + 4 * fq;
                        const f32x4 v = (acc[ai][0][m][n] * iv) * (acc[ai][1][m][n] * iv);
                        u32x2 w; w.x = cvt_pk_bf16(v[0], v[1]); w.y = cvt_pk_bf16(v[2], v[3]);
                        *(u32x2*)(ub + (size_t)row * 256 + c) = w;
                        if (smp) *(f32x4*)(conv_s + (size_t)(row - kNTOK) * 512 + 256 + c) = v;
                        else if (t_ >= kSEQ - 2) *(f32x4*)(conv_p + (size_t)(b_ * 2 + (t_ - (kSEQ - 2))) * 256 + c) = v;
                    }
                }
        } else if (pn == 4) {
#pragma unroll
            for (int ai = 0; ai < 2; ++ai)
#pragma unroll
                for (int m = 0; m < 4; ++m) {
                    const int row = rows[ai][m]; const float iv = inv1[ai][m];
                    if (row >= kMR) continue;
#pragma unroll
                    for (int bj = 0; bj < 2; ++bj)
#pragma unroll
                        for (int n = 0; n < 2; ++n) { const f32x4 v = acc[ai][bj][m][n] * iv; u32x2 w; w.x = cvt_pk_bf16(v[0], v[1]); w.y = cvt_pk_bf16(v[2], v[3]);
                            *(u32x2*)(gbb + (size_t)row * 256 + bj * HALF + wc * 32 + n * 16 + 4 * fq) = w; }
                }
        } else {
#pragma unroll
            for (int ai = 0; ai < 2; ++ai)
#pragma unroll
                for (int m = 0; m < 4; ++m) {
                    const int row = rows[ai][m]; const float iv = inv1[ai][m];
                    float s = 0.f;
#pragma unroll
                    for (int bj = 0; bj < 2; ++bj)
#pragma unroll
                        for (int n = 0; n < 2; ++n) { const f32x4 v = acc[ai][bj][m][n] * iv; s += (v[0] * v[0] + v[1] * v[1]) + (v[2] * v[2] + v[3] * v[3]); }
                    s += __shfl_xor(s, 16); s += __shfl_xor(s, 32);
                    const float im = __builtin_amdgcn_rsqf(s * (1.0f / 64.0f) + kEPS) * kC2M;
                    if (row >= kMR) continue;
#pragma unroll
                    for (int bj = 0; bj < 2; ++bj)
#pragma unroll
                        for (int n = 0; n < 2; ++n) { const int d = bj * 32 + n * 16 + 4 * fq; const f32x4 g = *(const f32x4*)(g_mq + d);
                            const f32x4 v = acc[ai][bj][m][n] * (iv * im) * g; u32x2 w; w.x = cvt_pk_bf16(v[0], v[1]); w.y = cvt_pk_bf16(v[2], v[3]);
                            *(u32x2*)(mqb + (size_t)row * 256 + wc * 64 + d) = w; }
                }
        }
    }
};

struct EpiQ {
    static constexpr bool PERM = false, AFTER_DRAIN = false;
    const float* msq; const float* g_qn; const float* g_qr; const float* rope; bf16_t* qb;
    __device__ __forceinline__ void operator()(const f32x4 (&acc)[2][2][4][2], const Unit& u, int wr, int wc, int fr_, int fq_) const {
        const int ln_ = fresh_lane(), fr = ln_ & 15, fq = ln_ >> 4; (void)fr_; (void)fq_;
        const int pn = u.pn;
#pragma unroll
        for (int ai = 0; ai < 2; ++ai)
#pragma unroll
            for (int m = 0; m < 4; ++m) {
                const int row = u.pm * BM + ai * HALF + wr * 64 + m * 16 + fr;
                const bool live = row < kMR;
                const float epsq = kEPS * ((live ? msq[row] : 1.0f) + kEPS);
                if (pn < 2) {
                    const int head = 4 * pn + wc; float s = 0.f;
#pragma unroll
                    for (int bj = 0; bj < 2; ++bj)
#pragma unroll
                        for (int n = 0; n < 2; ++n) { const f32x4 v = acc[ai][bj][m][n]; s += (v[0] * v[0] + v[1] * v[1]) + (v[2] * v[2] + v[3] * v[3]); }
                    s += __shfl_xor(s, 16); s += __shfl_xor(s, 32);
                    const float rs = __builtin_amdgcn_rsqf(s * (1.0f / 64.0f) + epsq) * kC2Q;
                    if (live) {
#pragma unroll
                        for (int bj = 0; bj < 2; ++bj)
#pragma unroll
                            for (int n = 0; n < 2; ++n) { const int d = bj * 32 + n * 16 + 4 * fq; const f32x4 g = *(const f32x4*)(g_qn + d);
                                const f32x4 v = acc[ai][bj][m][n] * rs * g; u32x2 w; w.x = cvt_pk_bf16(v[0], v[1]); w.y = cvt_pk_bf16(v[2], v[3]);
                                *(u32x2*)(qb + (size_t)row * 768 + head * 96 + d) = w; }
                    }
                } else {
                    const int pos = row >= kNTOK ? kSEQ : (row & (kSEQ - 1));
                    const f32x4 cs = *(const f32x4*)(rope + (size_t)pos * 32 + 4 * fq), sn = *(const f32x4*)(rope + (size_t)pos * 32 + 16 + 4 * fq);
                    const f32x4 ga = *(const f32x4*)(g_qr + 4 * fq), gb = *(const f32x4*)(g_qr + 16 + 4 * fq);
#pragma unroll
                    for (int bj = 0; bj < 2; ++bj) {
                        const int head = 4 * bj + wc;
                        const f32x4 a = acc[ai][bj][m][0], b = acc[ai][bj][m][1];
                        float s = (a[0] * a[0] + a[1] * a[1]) + (a[2] * a[2] + a[3] * a[3]) + (b[0] * b[0] + b[1] * b[1]) + (b[2] * b[2] + b[3] * b[3]);
                        s += __shfl_xor(s, 16); s += __shfl_xor(s, 32);
                        const float rs = __builtin_amdgcn_rsqf(s * (1.0f / 32.0f) + epsq);
                        const f32x4 x1 = a * rs * ga, x2 = b * rs * gb;
                        const f32x4 o1 = (x1 * cs - x2 * sn) * kC2Q, o2 = (x1 * sn + x2 * cs) * kC2Q;
                        if (live) { u32x2 w1, w2; w1.x = cvt_pk_bf16(o1[0], o1[1]); w1.y = cvt_pk_bf16(o1[2], o1[3]); w2.x = cvt_pk_bf16(o2[0], o2[1]); w2.y = cvt_pk_bf16(o2[2], o2[3]);
                            *(u32x2*)(qb + (size_t)row * 768 + head * 96 + 64 + 4 * fq) = w1; *(u32x2*)(qb + (size_t)row * 768 + head * 96 + 80 + 4 * fq) = w2; }
                    }
                }
                asm volatile("" ::: "memory");
            }
    }
};

struct EpiKV {
    static constexpr bool PERM = false, AFTER_DRAIN = false;
    const float* g_kn; bf16_t* Kb; bf16_t* Vb;
    __device__ __forceinline__ void operator()(const f32x4 (&acc)[2][2][4][2], const Unit& u, int wr, int wc, int fr_, int fq_) const {
        const int ln_ = fresh_lane(), fr = ln_ & 15, fq = ln_ >> 4; (void)fr_; (void)fq_;
        const int pn = u.pn;
#pragma unroll
        for (int ai = 0; ai < 2; ++ai)
#pragma unroll
            for (int m = 0; m < 4; ++m) {
                const int row = u.pm * BM + ai * HALF + wr * 64 + m * 16 + fr;
                const int b_ = row >> 13, t_ = row & (kSEQ - 1);
                if (pn < 2) {
                    const int head = 4 * pn + wc; float s = 0.f;
#pragma unroll
                    for (int bj = 0; bj < 2; ++bj)
#pragma unroll
                        for (int n = 0; n < 2; ++n) { const f32x4 v = acc[ai][bj][m][n]; s += (v[0] * v[0] + v[1] * v[1]) + (v[2] * v[2] + v[3] * v[3]); }
                    s += __shfl_xor(s, 16); s += __shfl_xor(s, 32);
                    const float rs = __builtin_amdgcn_rsqf(s * (1.0f / 64.0f) + kEPS);
                    bf16_t* kp = Kb + ((size_t)(b_ * 8 + head) * kSEQ + t_) * 96;
#pragma unroll
                    for (int bj = 0; bj < 2; ++bj)
#pragma unroll
                        for (int n = 0; n < 2; ++n) { const int d = bj * 32 + n * 16 + 4 * fq; const f32x4 g = *(const f32x4*)(g_kn + d);
                            const f32x4 v = acc[ai][bj][m][n] * rs * g; u32x2 w; w.x = cvt_pk_bf16(v[0], v[1]); w.y = cvt_pk_bf16(v[2], v[3]);
                            *(u32x2*)(kp + d) = w; }
                } else {
#pragma unroll
                    for (int bj = 0; bj < 2; ++bj)
#pragma unroll
                        for (int n = 0; n < 2; ++n) { const int c = (pn - 2) * 256 + bj * HALF + wc * 32 + n * 16 + 4 * fq; const int head = c >> 6, d = c & 63;
                            const f32x4 v = acc[ai][bj][m][n]; u32x2 w; w.x = cvt_pk_bf16(v[0], v[1]); w.y = cvt_pk_bf16(v[2], v[3]);
                            *(u32x2*)(Vb + ((size_t)(b_ * 8 + head) * kSEQ + t_) * 64 + d) = w; }
                }
                asm volatile("" ::: "memory");
            }
    }
};

struct EpiMem {
    static constexpr bool PERM = false, AFTER_DRAIN = false;
    const float* ssqm; const float* g_mk; float* mk_out; float* mv_out; bf16_t* mKb; bf16_t* mVb;
    __device__ __forceinline__ void operator()(const f32x4 (&acc)[2][2][4][2], const Unit& u, int wr, int wc, int fr_, int fq_) const {
        const int ln_ = fresh_lane(), fr = ln_ & 15, fq = ln_ >> 4; (void)fr_; (void)fq_;
        const int pn = u.pn;
#pragma unroll
        for (int ai = 0; ai < 2; ++ai)
#pragma unroll
            for (int m = 0; m < 4; ++m) {
                const int row = u.pm * BM + ai * HALF + wr * 64 + m * 16 + fr;
                const float iv = row_inv_from_parts(ssqm, row);
                const int b_ = row >> 8, n_ = row & 255;
                if (pn == 0) {
                    const int head = wc; float s = 0.f;
#pragma unroll
                    for (int bj = 0; bj < 2; ++bj)
#pragma unroll
                        for (int n = 0; n < 2; ++n) { const f32x4 v = acc[ai][bj][m][n] * iv; s += (v[0] * v[0] + v[1] * v[1]) + (v[2] * v[2] + v[3] * v[3]); }
                    s += __shfl_xor(s, 16); s += __shfl_xor(s, 32);
                    const float rs = __builtin_amdgcn_rsqf(s * (1.0f / 64.0f) + kEPS);
#pragma unroll
                    for (int bj = 0; bj < 2; ++bj)
#pragma unroll
                        for (int n = 0; n < 2; ++n) { const int d = bj * 32 + n * 16 + 4 * fq; const f32x4 g = *(const f32x4*)(g_mk + d);
                            const f32x4 v = acc[ai][bj][m][n] * (iv * rs) * g;
                            *(f32x4*)(mk_out + (size_t)row * 256 + head * 64 + d) = v;
                            u32x2 w; w.x = cvt_pk_bf16(v[0], v[1]); w.y = cvt_pk_bf16(v[2], v[3]);
                            *(u32x2*)(mKb + ((size_t)(b_ * 4 + head) * 256 + n_) * 64 + d) = w; }
                } else {
#pragma unroll
                    for (int bj = 0; bj < 2; ++bj)
#pragma unroll
                        for (int n = 0; n < 2; ++n) { const int c = bj * HALF + wc * 32 + n * 16 + 4 * fq; const int head = c >> 6, d = c & 63;
                            const f32x4 v = acc[ai][bj][m][n] * iv;
                            *(f32x4*)(mv_out + (size_t)row * 256 + c) = v;
                            u32x2 w; w.x = cvt_pk_bf16(v[0], v[1]); w.y = cvt_pk_bf16(v[2], v[3]);
                            *(u32x2*)(mVb + ((size_t)(b_ * 4 + head) * 256 + n_) * 64 + d) = w; }
                }
                asm volatile("" ::: "memory");
            }
    }
};
template <class Epi, class Sched, bool ALIGN_EPI = false, bool SP2 = false>
__device__ __forceinline__ void gemm_phase(PG8_LAS unsigned char* lds, const Gemm g, const Sched& S, const Epi& E) {
    int tid_ = threadIdx.x; asm volatile("" : "+v"(tid_));
    const int tid = tid_, wid = __builtin_amdgcn_readfirstlane(tid >> 6), lane = tid & 63, wr = wid >> 2, wc = wid & 3, fr = lane & 15, fq = lane >> 4;
    const int K = g.K, nt = K / BK;
    unsigned voffA[2], voffB[2];
#pragma unroll
    for (int i = 0; i < 2; ++i) { int R, C; stage_rc(tid * 16 + i * 8192, R, C); const int Rb = Epi::PERM ? ((R & ~31) + perm32(R & 31)) : R;
        voffA[i] = (unsigned)(R * K + C) * 2u; voffB[i] = (unsigned)(Rb * K + C) * 2u; }
    const size_t kstep = (size_t)(BK * 2);
    const size_t hstep = (size_t)HALF * K * 2;
    const size_t tstep = 2 * hstep;
    const unsigned ldsw = (unsigned)wid * 1024u;
    const int aoff = lds_byte(wr * 64 + fr, fq * 8), boff = lds_byte(wc * 32 + fr, fq * 8);
#define PG8_SA(b, h) (((b) * 2 + (h)) * HTB)
#define PG8_SB(b, h) ((4 + (b) * 2 + (h)) * HTB)
#define PG8_STAGE(bufoff, gbase, voff) do { _Pragma("unroll") for (int _i = 0; _i < 2; ++_i) \
        __builtin_amdgcn_global_load_lds((const unsigned*)((const char*)(gbase) + (voff)[_i]), (PG8_LAS unsigned*)(lds + (bufoff) + ldsw + _i * 8192), 16, 0, 0); } while (0)
#define PG8_LDA(dst, b, h) do { _Pragma("unroll") for (int m = 0; m < 4; ++m) _Pragma("unroll") for (int k = 0; k < 2; ++k) dst[m][k] = *(const PG8_LAS bf16x8*)(lds + PG8_SA(b, h) + aoff + m * 2048 + k * 1024); } while (0)
#define PG8_LDB(dst, b, h) do { _Pragma("unroll") for (int n = 0; n < 2; ++n) _Pragma("unroll") for (int k = 0; k < 2; ++k) dst[n][k] = *(const PG8_LAS bf16x8*)(lds + PG8_SB(b, h) + boff + n * 2048 + k * 1024); } while (0)
#define PG8_MMA(ai, bj, At, Bt) do { __builtin_amdgcn_s_setprio(1); _Pragma("unroll") for (int m = 0; m < 4; ++m) _Pragma("unroll") for (int n = 0; n < 2; ++n) _Pragma("unroll") for (int k = 0; k < 2; ++k) \
        acc[ai][bj][m][n] = __builtin_amdgcn_mfma_f32_16x16x32_bf16(Bt[n][k], At[m][k], acc[ai][bj][m][n], 0, 0, 0); __builtin_amdgcn_s_setprio(0); } while (0)
#define PG8_WAIT_V(n) asm volatile("s_waitcnt vmcnt(" #n ")" ::: "memory")
#define PG8_WAIT_L(n) asm volatile("s_waitcnt lgkmcnt(" #n ")" ::: "memory")
#define PG8_BAR __builtin_amdgcn_s_barrier()
#define PG8_SCHED __builtin_amdgcn_sched_barrier(0)
    Unit cur, nxt; int ui = 0;
    if (!S.next(0, cur)) return;
    f32x4 acc[2][2][4][2];
#pragma unroll
    for (int a = 0; a < 2; ++a)
#pragma unroll
        for (int b = 0; b < 2; ++b)
#pragma unroll
            for (int m = 0; m < 4; ++m)
#pragma unroll
                for (int n = 0; n < 2; ++n) acc[a][b][m][n] = (f32x4){0.f, 0.f, 0.f, 0.f};
    bf16x8 At[4][2], B0[2][2], B1[2][2];
    const char* cA = (const char*)g.A + (size_t)cur.pm * tstep; const char* cB = (const char*)g.Bt + (size_t)cur.pn * tstep;
    S.a_ready(cur);
    if constexpr (SP2) {
        PG8_STAGE(PG8_SB(0, 0), cB, voffB); PG8_STAGE(PG8_SB(0, 1), cB + hstep, voffB); PG8_STAGE(PG8_SA(0, 0), cA, voffA); PG8_STAGE(PG8_SA(0, 1), cA + hstep, voffA);
        if (wr == 1) PG8_BAR;
        PG8_WAIT_V(2); PG8_BAR;
        PG8_STAGE(PG8_SB(1, 0), cB + kstep, voffB); PG8_STAGE(PG8_SA(1, 0), cA + kstep, voffA); PG8_STAGE(PG8_SB(1, 1), cB + hstep + kstep, voffB);
        PG8_WAIT_V(6); PG8_BAR;
    } else {
        PG8_STAGE(PG8_SB(0, 0), cB, voffB); PG8_STAGE(PG8_SA(0, 0), cA, voffA); PG8_STAGE(PG8_SB(0, 1), cB + hstep, voffB); PG8_STAGE(PG8_SA(0, 1), cA + hstep, voffA);
        if (wr == 1) PG8_BAR;
        PG8_WAIT_V(4); PG8_BAR;
        PG8_STAGE(PG8_SB(1, 0), cB + kstep, voffB); PG8_STAGE(PG8_SA(1, 0), cA + kstep, voffA); PG8_STAGE(PG8_SB(1, 1), cB + hstep + kstep, voffB);
        PG8_WAIT_V(6); PG8_BAR;
    }
    for (;;) {
        const bool has_next = S.next(ui + 1, nxt);
        const char* nA = has_next ? (const char*)g.A + (size_t)nxt.pm * tstep : cA; const char* nB = has_next ? (const char*)g.Bt + (size_t)nxt.pn * tstep : cB;
        for (int t = 0; t < nt; t += 2) {
            const bool last = (t == nt - 2);
            const char* a1 = cA + (size_t)(t + 1) * kstep;
            const char* a2 = last ? nA : cA + (size_t)(t + 2) * kstep; const char* b2 = last ? nB : cB + (size_t)(t + 2) * kstep;
            const char* a3 = a2 + kstep; const char* b3 = b2 + kstep;
            if (last && has_next) S.a_ready(nxt);
            if constexpr (SP2) {
            PG8_LDB(B0, 0, 0); PG8_LDB(B1, 0, 1); PG8_SCHED; PG8_LDA(At, 0, 0); PG8_STAGE(PG8_SA(1, 1), a1 + hstep, voffA);
            PG8_WAIT_V(8); PG8_WAIT_L(0); PG8_BAR; PG8_MMA(0, 0, At, B0); PG8_MMA(0, 1, At, B1); PG8_BAR; PG8_SCHED;
            PG8_LDA(At, 0, 1); PG8_STAGE(PG8_SB(0, 0), b2, voffB); PG8_STAGE(PG8_SB(0, 1), b2 + hstep, voffB); PG8_STAGE(PG8_SA(0, 0), a2, voffA);
            PG8_WAIT_V(8); PG8_WAIT_L(0); PG8_BAR; PG8_MMA(1, 0, At, B0); PG8_MMA(1, 1, At, B1); PG8_BAR; PG8_SCHED;
            PG8_LDB(B0, 1, 0); PG8_LDB(B1, 1, 1); PG8_SCHED; PG8_LDA(At, 1, 0); PG8_STAGE(PG8_SA(0, 1), a2 + hstep, voffA);
            PG8_WAIT_V(8); PG8_WAIT_L(0); PG8_BAR; PG8_MMA(0, 0, At, B0); PG8_MMA(0, 1, At, B1); PG8_BAR; PG8_SCHED;
            PG8_LDA(At, 1, 1); PG8_STAGE(PG8_SB(1, 0), b3, voffB); PG8_STAGE(PG8_SB(1, 1), b3 + hstep, voffB); PG8_STAGE(PG8_SA(1, 0), a3, voffA);
            PG8_WAIT_V(8); PG8_WAIT_L(0); PG8_BAR; PG8_MMA(1, 0, At, B0); PG8_MMA(1, 1, At, B1); PG8_BAR; PG8_SCHED;
            } else {
            PG8_LDB(B0, 0, 0); PG8_SCHED; PG8_LDA(At, 0, 0); PG8_STAGE(PG8_SA(1, 1), a1 + hstep, voffA);
            PG8_WAIT_L(8); PG8_BAR; PG8_WAIT_L(0); PG8_MMA(0, 0, At, B0); PG8_BAR; PG8_SCHED;
            PG8_LDB(B1, 0, 1); PG8_STAGE(PG8_SB(0, 0), b2, voffB);
            PG8_BAR; PG8_WAIT_L(0); PG8_MMA(0, 1, At, B1); PG8_BAR;
            PG8_LDA(At, 0, 1); PG8_STAGE(PG8_SA(0, 0), a2, voffA);
            PG8_BAR; PG8_WAIT_L(0); PG8_MMA(1, 0, At, B0); PG8_BAR; PG8_SCHED;
            PG8_STAGE(PG8_SB(0, 1), b2 + hstep, voffB);
            PG8_WAIT_V(6); PG8_BAR; PG8_MMA(1, 1, At, B1); PG8_BAR;
            PG8_LDB(B0, 1, 0); PG8_SCHED; PG8_LDA(At, 1, 0); PG8_STAGE(PG8_SA(0, 1), a2 + hstep, voffA);
            PG8_WAIT_L(8); PG8_BAR; PG8_WAIT_L(0); PG8_MMA(0, 0, At, B0); PG8_BAR; PG8_SCHED;
            PG8_LDB(B1, 1, 1); PG8_STAGE(PG8_SB(1, 0), b3, voffB);
            PG8_BAR; PG8_WAIT_L(0); PG8_MMA(0, 1, At, B1); PG8_BAR;
            PG8_LDA(At, 1, 1); PG8_STAGE(PG8_SA(1, 0), a3, voffA);
            PG8_BAR; PG8_WAIT_L(0); PG8_MMA(1, 0, At, B0); PG8_BAR; PG8_SCHED;
            PG8_STAGE(PG8_SB(1, 1), b3 + hstep, voffB);
            PG8_WAIT_V(6); PG8_BAR; PG8_MMA(1, 1, At, B1); PG8_BAR;
            }
        }
        if constexpr (ALIGN_EPI) { if (wr == 0) PG8_BAR; }
        if constexpr (!Epi::AFTER_DRAIN) { E(acc, cur, wr, wc, fr, fq); S.done(cur); }
        if (!has_next) break;
#pragma unroll
        for (int a = 0; a < 2; ++a)
#pragma unroll
            for (int b = 0; b < 2; ++b)
#pragma unroll
                for (int m = 0; m < 4; ++m)
#pragma unroll
                    for (int n = 0; n < 2; ++n) acc[a][b][m][n] = (f32x4){0.f, 0.f, 0.f, 0.f};
        cur = nxt; cA = nA; cB = nB; ++ui;
        if constexpr (ALIGN_EPI) { if (wr == 1) PG8_BAR; }
    }
    PG8_WAIT_V(0);
    if constexpr (!ALIGN_EPI) { if (wr == 0) PG8_BAR; }
    PG8_BAR;
    if constexpr (Epi::AFTER_DRAIN) { E.fused(acc, cur, wr, wc, fr, fq, lds, wid, lane); S.done(cur); }
#undef PG8_SA
#undef PG8_SB
#undef PG8_STAGE
#undef PG8_LDA
#undef PG8_LDB
#undef PG8_MMA
#undef PG8_WAIT_V
#undef PG8_WAIT_L
#undef PG8_BAR
#undef PG8_SCHED
}
}
#define LAS __attribute__((address_space(3)))
#define XB_TMO      128
#define XB_XCNT(j)  (256  + 64 * (j))
#define XB_XSUB(j)  (1280 + 64 * (j))
#define XB_XGEN(j)  (2304 + 64 * (j))
#define XB_TOP      3328
#define XB_TOPGEN   3392
#define XCD_BAR_WORDS 3456
#define XB_SPIN_CAP (1u << 25)

__device__ __forceinline__ unsigned xb_ld(unsigned* p)              { return __hip_atomic_load(p, __ATOMIC_RELAXED, __HIP_MEMORY_SCOPE_AGENT); }
__device__ __forceinline__ unsigned xb_add(unsigned* p, unsigned v) { return __hip_atomic_fetch_add(p, v, __ATOMIC_RELAXED, __HIP_MEMORY_SCOPE_AGENT); }
__device__ __forceinline__ unsigned xb_xcc_id() { return (unsigned)__builtin_amdgcn_s_getreg((3 << 11) | 20) & 0xFu; }
#define XB_SPIN(cond, bar) do { unsigned _sp = 0; while (cond) { __builtin_amdgcn_s_sleep(1); \
    if ((++_sp & 255u) == 0u) { if (xb_ld(&(bar)[XB_TMO])) break; if (_sp > XB_SPIN_CAP) { atomicAdd(&(bar)[XB_TMO], 1u); break; } } } } while (0)

struct XcdBarrier {
    unsigned* bar; unsigned x;
    volatile LAS unsigned* st;
};

__device__ __forceinline__ XcdBarrier xcd_barrier_post(unsigned* bar, volatile LAS unsigned* st) {
    XcdBarrier b; b.bar = bar; b.x = xb_xcc_id(); b.st = st;
    if (threadIdx.x == 0) (void)xb_add(&bar[XB_XCNT(b.x)], 1u);
    return b;
}
__device__ __forceinline__ void xcd_barrier_complete(unsigned* bar, unsigned x, unsigned& nloc, unsigned& nx) {
    const unsigned G = gridDim.x * gridDim.y * gridDim.z;
    unsigned sum, cnt, mine, sp = 0u;
    for (;;) {
        sum = 0u; cnt = 0u; mine = 0u;
#pragma unroll
        for (unsigned j = 0; j < 16; ++j) { const unsigned c = xb_ld(&bar[XB_XCNT(j)]); sum += c; cnt += (c > 0u) ? 1u : 0u; mine = (j == x) ? c : mine; }
        if (sum == G) break;
        __builtin_amdgcn_s_sleep(1);
        if ((++sp & 255u) == 0u) { if (xb_ld(&bar[XB_TMO])) break; if (sp > XB_SPIN_CAP) { atomicAdd(&bar[XB_TMO], 1u); break; } }
    }
    nloc = mine > 0u ? mine : 1u; nx = cnt > 0u ? cnt : 1u;
}

__device__ __forceinline__ void xcd_barrier(const XcdBarrier& b) {
    asm volatile("s_waitcnt vmcnt(0)" ::: "memory");
    __syncthreads();
    if (threadIdx.x == 0) {
        unsigned* bar = b.bar;
        __builtin_amdgcn_s_waitcnt(0);
        unsigned nloc = b.st[0], nx = b.st[1];
        if (nloc == 0u) { xcd_barrier_complete(bar, b.x, nloc, nx); b.st[0] = nloc; b.st[1] = nx; }
        const unsigned old = xb_add(&bar[XB_XSUB(b.x)], 1u);
        const unsigned gen = old / nloc;
        if (old + 1u == (gen + 1u) * nloc) {
            __builtin_amdgcn_fence(__ATOMIC_RELEASE, "agent");
            asm volatile("s_waitcnt vmcnt(0)" ::: "memory");
            const unsigned og = xb_add(&bar[XB_TOP], 1u);
            const unsigned tg = og / nx;
            if (og + 1u == (tg + 1u) * nx) xb_add(&bar[XB_TOPGEN], 1u);
            else XB_SPIN(xb_ld(&bar[XB_TOPGEN]) == tg, bar);
            __builtin_amdgcn_fence(__ATOMIC_ACQUIRE, "agent");
            xb_add(&bar[XB_XGEN(b.x)], 1u);
            asm volatile("s_waitcnt vmcnt(0)" ::: "memory");
        } else {
            XB_SPIN(xb_ld(&bar[XB_XGEN(b.x)]) == gen, bar);
            __builtin_amdgcn_fence(__ATOMIC_ACQUIRE, "agent");
            asm volatile("s_waitcnt vmcnt(0)" ::: "memory");
        }
    }
    __syncthreads();
}
#define GAS __attribute__((address_space(1)))
typedef unsigned short bf16;
typedef unsigned v4u __attribute__((ext_vector_type(4)));
typedef unsigned v2u __attribute__((ext_vector_type(2)));
typedef float f32x4 __attribute__((ext_vector_type(4)));
typedef float f32x16 __attribute__((ext_vector_type(16)));
typedef short bf16x8 __attribute__((ext_vector_type(8)));
typedef short s16x4 __attribute__((ext_vector_type(4)));
#define LDS_WAIT() asm volatile("s_waitcnt lgkmcnt(0)" ::: "memory")
#define VM_WAIT() asm volatile("s_waitcnt vmcnt(0)" ::: "memory")
using pg8::cvt_pk_bf16;
__device__ __forceinline__ float bf2f(unsigned short h) { return __uint_as_float((unsigned)h << 16); }
__device__ __forceinline__ float bflo(unsigned w) { return __uint_as_float(w << 16); }
__device__ __forceinline__ float bfhi(unsigned w) { return __uint_as_float(w & 0xffff0000u); }

constexpr int D = 1024, SEQ = 8192, NB = 4, NTOK = 32768, NS = 128, MR = 32896, MP = 33024;
constexpr int FF = 2816, FF2 = 5632, INW = 1440, INWP = 1536;
constexpr int NPAGES = 128, PAGE = 128, NPHYS = 20480;
constexpr float EPS = 1e-6f;
static_assert(pg8::kNTOK == NTOK && pg8::kMR == MR && pg8::kSEQ == SEQ, "constants");

constexpr size_t O_Y = 0, O_YS = 33554432, O_CKVP = 33685504, O_KRP = 37879808, O_CONVP = 38928384, O_MKP = 38930432, O_MVP = 39192576,
                 O_CKVS = 39454720, O_KRS = 39471104, O_CONVS = 39475200, O_TOTAL = 39540736;

constexpr size_t MiB = 1u << 20;
constexpr size_t WS_CTL = 0, CTL_ZERO_BYTES = 1 * MiB;
constexpr size_t WS_W1GU = 1 * MiB, WS_W1D = WS_W1GU + 12 * MiB, WS_WIN = WS_W1D + 6 * MiB, WS_WUQ = WS_WIN + 3 * MiB, WS_WKV = WS_WUQ + 1 * MiB, WS_WO = WS_WKV + 1 * MiB,
                 WS_W2GU = WS_WO + 2 * MiB, WS_W2D = WS_W2GU + 12 * MiB, WS_WMEM = WS_W2D + 6 * MiB, WS_ROPE = WS_WMEM + 1 * MiB,
                 WS_SSQ0 = WS_ROPE + 2 * MiB, WS_SSQ1 = WS_SSQ0 + 3 * MiB, WS_SSQ2 = WS_SSQ1 + 3 * MiB, WS_MSQ = WS_SSQ2 + 3 * MiB, WS_SSQM = WS_MSQ + 1 * MiB,
                 WS_XB = WS_SSQM + 1 * MiB, WS_ACT1 = WS_XB + 65 * MiB, WS_ACT2 = WS_ACT1 + 178 * MiB, WS_X1F = WS_ACT2 + 178 * MiB, WS_X1B = WS_X1F + 129 * MiB,
                 WS_X2F = WS_X1B + 65 * MiB, WS_X2B = WS_X2F + 129 * MiB, WS_CQB = WS_X2B + 65 * MiB, WS_CKVB = WS_CQB + 17 * MiB, WS_KRB = WS_CKVB + 9 * MiB,
                 WS_UB = WS_KRB + 3 * MiB, WS_GBB = WS_UB + 17 * MiB, WS_MQB = WS_GBB + 17 * MiB, WS_QB = WS_MQB + 17 * MiB, WS_KB = WS_QB + 49 * MiB, WS_VB = WS_KB + 48 * MiB,
                 WS_MEMB = WS_VB + 32 * MiB, WS_MEMK = WS_MEMB + 2 * MiB, WS_MEMV = WS_MEMK + 1 * MiB, WS_OAB = WS_MEMV + 1 * MiB, WS_OMB = WS_OAB + 33 * MiB,
                 WS_OMIX = WS_OMB + 17 * MiB, WS_DPART = WS_OMIX + 65 * MiB, WS_DBG = WS_DPART + 2 * MiB, WS_GU1S = WS_DBG + 1 * MiB, WS_GU2S = WS_GU1S + 3 * MiB, WS_D1S = WS_GU2S + 3 * MiB, WS_D7S = WS_D1S + 1 * MiB, WS_ZS = WS_D7S + 1 * MiB, WS_QS = WS_ZS + 1 * MiB,
                 WS_END = WS_QS + 1 * MiB;
constexpr int CW_BAR = 4096;

constexpr int RING_BYTES = 131072, LDSCTL_OFF = RING_BYTES, MISC_OFF = LDSCTL_OFF + 320, XCH_OFF = RING_BYTES + 512, LDS_BYTES = 147456;
constexpr int NWAVES = 8;

struct Args {
    const float* in[38];
    float* out; unsigned char* ws;
    int ph_lo, ph_hi;
};

#define CAS __attribute__((address_space(4)))
typedef const float* const CAS* InTab;
struct Frame {
    LAS unsigned char* lds;
    int tid, lane, wave, vcu, G;
    InTab in;
    float* out; unsigned char* ws;
};
__device__ __forceinline__ float wave_sum(float v) {
#pragma unroll
    for (int o = 1; o < 64; o <<= 1) v += __shfl_xor(v, o);
    return v;
}
__device__ __forceinline__ float wave_max(float v) {
#pragma unroll
    for (int o = 1; o < 64; o <<= 1) v = fmaxf(v, __shfl_xor(v, o));
    return v;
}

struct TSrc { const float* p; int ld; int col0; };
__device__ __forceinline__ void tr_item(TSrc s, const float* kscale, int K, bf16* WT, int n0, int k0, LAS float* scr, int lane) {
#pragma unroll 8
    for (int i = 0; i < 32; ++i) { const int kk = 2 * i + (lane >> 5);
        float v = 0.f; if (s.p) { v = s.p[(size_t)(k0 + kk) * s.ld + s.col0 + (lane & 31)]; if (kscale) v *= kscale[k0 + kk]; }
        scr[kk * 33 + (lane & 31)] = v; }
    LDS_WAIT(); asm volatile("" ::: "memory");
    const int c = lane & 7;
#pragma unroll
    for (int j = 0; j < 4; ++j) { const int n = (lane >> 3) + 8 * j; const LAS float* q = scr + (8 * c) * 33 + n;
        v4u o; o.x = cvt_pk_bf16(q[0 * 33], q[1 * 33]); o.y = cvt_pk_bf16(q[2 * 33], q[3 * 33]); o.z = cvt_pk_bf16(q[4 * 33], q[5 * 33]); o.w = cvt_pk_bf16(q[6 * 33], q[7 * 33]);
        *(v4u*)(WT + (size_t)(n0 + n) * K + k0 + 8 * c) = o; }
    LDS_WAIT(); asm volatile("" ::: "memory");
}
enum { MAT_W1GU = 0, MAT_W1D, MAT_WIN, MAT_WUQ, MAT_WKV, MAT_WO, MAT_W2GU, MAT_W2D, MAT_WMEM, MAT_N };
__device__ __forceinline__ void mat_dims(int mat, int& N, int& K) {
    switch (mat) {
        case MAT_W1GU: case MAT_W2GU: N = FF2; K = D; break;
        case MAT_W1D: case MAT_W2D: N = D; K = FF; break;
        case MAT_WIN: N = INWP; K = D; break;
        case MAT_WUQ: N = 768; K = 256; break;
        case MAT_WKV: N = 1024; K = 128; break;
        case MAT_WO: N = D; K = D; break;
        default: N = 512; K = D; break;
    }
}
__device__ __forceinline__ void p0_weight_item(const Frame& F, int mat, int item, LAS float* scr) {
    int N, K; mat_dims(mat, N, K);
    const int nkb = K / 64, kb = item % nkb, slot = item / nkb, k0 = kb * 64;
    const int pn = slot >> 3, w = slot & 7, bj = w >> 2, wc = w & 3;
    InTab in = F.in;
    TSrc s{nullptr, 0, 0}; const float* ks = nullptr; bf16* dst = nullptr;
    switch (mat) {
        case MAT_W1GU: s = TSrc{bj == 0 ? in[10] : in[11], FF, 128 * pn + 32 * wc}; ks = in[9]; dst = (bf16*)(F.ws + WS_W1GU); break;
        case MAT_W2GU: s = TSrc{bj == 0 ? in[35] : in[36], FF, 128 * pn + 32 * wc}; ks = in[34]; dst = (bf16*)(F.ws + WS_W2GU); break;
        case MAT_W1D: s = TSrc{in[12], D, 32 * slot}; dst = (bf16*)(F.ws + WS_W1D); break;
        case MAT_W2D: s = TSrc{in[37], D, 32 * slot}; dst = (bf16*)(F.ws + WS_W2D); break;
        case MAT_WIN: {
            int c0 = -1;
            if (pn == 0) c0 = 32 * w;
            else if (pn == 1) c0 = (bj == 0) ? 256 + 32 * wc : (wc == 0 ? 384 : -1);
            else if (pn == 2) c0 = (bj == 0) ? 416 + 32 * wc : 928 + 32 * wc;
            else if (pn == 3) c0 = (bj == 0) ? 416 + 128 + 32 * wc : 928 + 128 + 32 * wc;
            else if (pn == 4) c0 = 672 + 32 * w;
            else c0 = 1184 + 64 * wc + 32 * bj;
            if (c0 >= 0) s = TSrc{in[14], INW, c0};
            ks = in[13]; dst = (bf16*)(F.ws + WS_WIN); break; }
        case MAT_WUQ: s = TSrc{in[16], 768, pn < 2 ? (4 * pn + wc) * 96 + 32 * bj : (4 * bj + wc) * 96 + 64}; ks = in[15]; dst = (bf16*)(F.ws + WS_WUQ); break;
        case MAT_WKV: if (pn < 2) s = TSrc{in[20], 512, (4 * pn + wc) * 64 + 32 * bj}; else s = TSrc{in[21], 512, 256 * (pn - 2) + 32 * w}; dst = (bf16*)(F.ws + WS_WKV); break;
        case MAT_WO: s = TSrc{in[33], D, 32 * slot}; ks = (k0 < 512) ? in[30] : (k0 < 768) ? in[31] - 512 : in[32] - 768; dst = (bf16*)(F.ws + WS_WO); break;
        default: if (pn == 0) s = TSrc{in[26], 256, 64 * wc + 32 * bj}; else s = TSrc{in[27], 256, 32 * w}; ks = in[25]; dst = (bf16*)(F.ws + WS_WMEM); break;
    }
    tr_item(s, ks, K, dst, 32 * slot, k0, scr, F.lane);
}
__device__ __forceinline__ void row_to_bf16_ssq(const float* src, bf16* dst, float* parts, int lane) {
    f32x4 v[4]; float s = 0.f;
#pragma unroll
    for (int j = 0; j < 4; ++j) { v[j] = src ? ((const f32x4*)src)[lane + 64 * j] : (f32x4){0.f, 0.f, 0.f, 0.f}; s += (v[j][0] * v[j][0] + v[j][1] * v[j][1]) + (v[j][2] * v[j][2] + v[j][3] * v[j][3]); }
    s = wave_sum(s);
#pragma unroll
    for (int j = 0; j < 4; ++j) { v2u w; w.x = cvt_pk_bf16(v[j][0], v[j][1]); w.y = cvt_pk_bf16(v[j][2], v[j][3]); ((v2u*)dst)[lane + 64 * j] = w; }
    if (lane < 16) parts[lane] = lane == 0 ? s : 0.f;
}
__device__ __forceinline__ float rope_inv_freq(int i) {
    switch (i) { case 0: return 1.000000000e+00f; case 1: return 5.623413324e-01f; case 2: return 3.162277639e-01f; case 3: return 1.778279394e-01f;
        case 4: return 1.000000015e-01f; case 5: return 5.623413250e-02f; case 6: return 3.162277490e-02f; case 7: return 1.778279431e-02f;
        case 8: return 9.999999776e-03f; case 9: return 5.623413250e-03f; case 10: return 3.162277630e-03f; case 11: return 1.778279431e-03f;
        case 12: return 1.000000047e-03f; case 13: return 5.623413017e-04f; case 14: return 3.162277571e-04f; default: return 1.778279402e-04f; }
}
__device__ __forceinline__ void p0_prologue(const Frame& F) {
    LAS float* scr = (LAS float*)(F.lds + F.wave * 16384);
    const int gw = F.vcu * NWAVES + F.wave, NGW = F.G * NWAVES;
    int base = 0;
#pragma unroll 1
    for (int mat = 0; mat < MAT_N; ++mat) {
        int N, K; mat_dims(mat, N, K);
        const int nit = (N / 32) * (K / 64);
        int first = (gw - base % NGW + NGW) % NGW;
        for (int it = first; it < nit; it += NGW) p0_weight_item(F, mat, it, scr);
        base += nit;
    }
    bf16* xb = (bf16*)(F.ws + WS_XB); float* ssq0 = (float*)(F.ws + WS_SSQ0);
    for (int r = gw; r < MP; r += NGW) {
        const float* src = r < NTOK ? F.in[0] + (size_t)r * D : (r < MR ? F.in[2] + (size_t)(r - NTOK) * D : nullptr);
        row_to_bf16_ssq(src, xb + (size_t)r * D, ssq0 + (size_t)r * 16, F.lane);
    }
    bf16* memb = (bf16*)(F.ws + WS_MEMB); float* ssqm = (float*)(F.ws + WS_SSQM);
    for (int r = gw; r < 1024; r += NGW) row_to_bf16_ssq(F.in[1] + (size_t)r * D, memb + (size_t)r * D, ssqm + (size_t)r * 16, F.lane);
    float* rope = (float*)(F.ws + WS_ROPE);
    const int gt = F.vcu * (NWAVES * 64) + F.tid, NGT = F.G * NWAVES * 64;
    for (int e = gt; e < 8193 * 16; e += NGT) { const int pi = e >> 4, i = e & 15; const float pos = pi == 8192 ? 16384.0f : (float)pi;
        const float ang = pos * rope_inv_freq(i);
        const double rev = (double)ang * 0.15915494309189535;
        const float fr = (float)(rev - floor(rev));
        rope[(size_t)pi * 32 + i] = __builtin_amdgcn_cosf(fr); rope[(size_t)pi * 32 + 16 + i] = __builtin_amdgcn_sinf(fr); }
    { f32x4* z = (f32x4*)(F.ws + WS_GU1S); const int nz = (int)((WS_END - WS_GU1S) / 16); for (int e = gt; e < nz; e += NGT) z[e] = (f32x4){0.f, 0.f, 0.f, 0.f}; }
    for (int e = gt; e < NS * 256; e += NGT) { const int b = e >> 8, c = e & 255; F.out[O_CONVS + (size_t)b * 512 + c] = F.in[6][(size_t)b * 512 + 256 + c]; }
}
__device__ __forceinline__ int crow(int r, int hi) { return (r & 3) + 8 * (r >> 2) + 4 * hi; }
constexpr int AT_BUF = 20480, AT_V = 12288, AT_WS = 2 * AT_BUF, AT_OST = AT_WS + 2048;
template <int DQK>
__device__ __forceinline__ void attn_dma_tile(const bf16* Kt, const bf16* Vt, LAS unsigned char* buf, int wid, int lane) {
    constexpr int NC = DQK / 8;
    __builtin_amdgcn_global_load_lds((const unsigned*)(Kt + (size_t)lane * DQK + wid * 8), (LAS unsigned*)(buf + wid * 1024), 16, 0, 0);
    if (NC > 8 && wid < NC - 8) __builtin_amdgcn_global_load_lds((const unsigned*)(Kt + (size_t)lane * DQK + (8 + wid) * 8), (LAS unsigned*)(buf + (8 + wid) * 1024), 16, 0, 0);
    __builtin_amdgcn_global_load_lds((const unsigned*)(Vt + (size_t)(16 * (wid & 3) + (lane >> 2)) * 64 + (wid >> 2) * 32 + (lane & 3) * 8), (LAS unsigned*)(buf + AT_V + wid * 1024), 16, 0, 0);
}
template <int DQK, bool CAUSAL>
__device__ __forceinline__ void attn_unit_simple(const bf16* Q0, int qpitch, const bf16* Kh, const bf16* Vh, bf16* O0, int opitch, int NT, LAS unsigned char* lds) {
    constexpr int ND = DQK / 16;
    int tid_ = threadIdx.x; asm volatile("" : "+v"(tid_));
    const int tid = tid_, lane = tid & 63, r32 = lane & 31, hi = lane >> 5; const int wid = __builtin_amdgcn_readfirstlane(tid >> 6);
    __syncthreads();
    attn_dma_tile<DQK>(Kh, Vh, lds, wid, lane);
    bf16x8 qr[ND];
#pragma unroll
    for (int d0 = 0; d0 < ND; ++d0) qr[d0] = *(const bf16x8*)(Q0 + (size_t)(wid * 32 + r32) * qpitch + d0 * 16 + hi * 8);
    float mrun = -INFINITY, lrun = 0.f;
    f32x16 o0, o1;
#pragma unroll
    for (int r = 0; r < 16; ++r) { o0[r] = 0.f; o1[r] = 0.f; }
    LAS float* wsf = (LAS float*)(lds + AT_WS) + wid * 64;
    const int qrel = wid * 32 + r32;
    __syncthreads();
    for (int t = 0; t < NT; ++t) {
        LAS unsigned char* kb = lds + (t & 1) * AT_BUF; LAS unsigned char* vbuf = kb + AT_V;
        if (t + 1 < NT) attn_dma_tile<DQK>(Kh + (size_t)(t + 1) * 64 * DQK, Vh + (size_t)(t + 1) * 64 * 64, lds + ((t + 1) & 1) * AT_BUF, wid, lane);
        const int jb = t - (NT - 4);
        if (!(CAUSAL && jb >= 0 && 64 * jb > 32 * wid + 31)) {
        f32x16 p0, p1;
#pragma unroll
        for (int r = 0; r < 16; ++r) { p0[r] = 0.f; p1[r] = 0.f; }
#pragma unroll
        for (int d0 = 0; d0 < ND; ++d0) {
            const bf16x8 k0 = *(const LAS bf16x8*)(kb + (2 * d0 + hi) * 1024 + r32 * 16);
            const bf16x8 k1 = *(const LAS bf16x8*)(kb + (2 * d0 + hi) * 1024 + 512 + r32 * 16);
            p0 = __builtin_amdgcn_mfma_f32_32x32x16_bf16(k0, qr[d0], p0, 0, 0, 0);
            p1 = __builtin_amdgcn_mfma_f32_32x32x16_bf16(k1, qr[d0], p1, 0, 0, 0);
        }
        if (CAUSAL && jb >= 0) {
            const int kb_ = 64 * jb + 4 * hi;
#pragma unroll
            for (int r = 0; r < 16; ++r) { const int kv = kb_ + (r & 3) + 8 * (r >> 2); if (kv > qrel) p0[r] = -INFINITY; if (kv + 32 > qrel) p1[r] = -INFINITY; }
        }
        float rm = p0[0];
#pragma unroll
        for (int r = 1; r < 16; ++r) rm = fmaxf(rm, p0[r]);
#pragma unroll
        for (int r = 0; r < 16; ++r) rm = fmaxf(rm, p1[r]);
        { auto tt = __builtin_amdgcn_permlane32_swap(__float_as_uint(rm), __float_as_uint(rm), false, false); rm = fmaxf(__uint_as_float(tt[0]), __uint_as_float(tt[1])); }
        const float mn = fmaxf(mrun, rm);
        const float alpha = __builtin_amdgcn_exp2f(mrun - mn);
        mrun = mn;
        float ls = 0.f;
#pragma unroll
        for (int r = 0; r < 16; ++r) { p0[r] = __builtin_amdgcn_exp2f(p0[r] - mn); p1[r] = __builtin_amdgcn_exp2f(p1[r] - mn); ls += p0[r] + p1[r]; }
        lrun = lrun * alpha + ls;
        if (hi == 0) wsf[r32] = alpha;
        LDS_WAIT();
#pragma unroll
        for (int r = 0; r < 16; ++r) { const float a = wsf[crow(r, hi)]; o0[r] *= a; o1[r] *= a; }
        bf16x8 pa[4];
        { v4u w;
          w.x = cvt_pk_bf16(p0[0], p0[1]); w.y = cvt_pk_bf16(p0[2], p0[3]); w.z = cvt_pk_bf16(p0[4], p0[5]); w.w = cvt_pk_bf16(p0[6], p0[7]); pa[0] = __builtin_bit_cast(bf16x8, w);
          w.x = cvt_pk_bf16(p0[8], p0[9]); w.y = cvt_pk_bf16(p0[10], p0[11]); w.z = cvt_pk_bf16(p0[12], p0[13]); w.w = cvt_pk_bf16(p0[14], p0[15]); pa[1] = __builtin_bit_cast(bf16x8, w);
          w.x = cvt_pk_bf16(p1[0], p1[1]); w.y = cvt_pk_bf16(p1[2], p1[3]); w.z = cvt_pk_bf16(p1[4], p1[5]); w.w = cvt_pk_bf16(p1[6], p1[7]); pa[2] = __builtin_bit_cast(bf16x8, w);
          w.x = cvt_pk_bf16(p1[8], p1[9]); w.y = cvt_pk_bf16(p1[10], p1[11]); w.z = cvt_pk_bf16(p1[12], p1[13]); w.w = cvt_pk_bf16(p1[14], p1[15]); pa[3] = __builtin_bit_cast(bf16x8, w); }
        const unsigned vb = (unsigned)(uintptr_t)vbuf + ((lane >> 4) & 1) * 32 + (lane & 3) * 8 + (4 * hi + ((lane & 15) >> 2)) * 64;
#pragma unroll
        for (int d0 = 0; d0 < 2; ++d0) {
            s16x4 lo[4], hh[4];
#pragma unroll
            for (int ks = 0; ks < 4; ++ks) {
                asm volatile("ds_read_b64_tr_b16 %0, %1 offset:%2" : "=&v"(lo[ks]) : "v"(vb), "i"(d0 * 4096 + ks * 1024) : "memory");
                asm volatile("ds_read_b64_tr_b16 %0, %1 offset:%2" : "=&v"(hh[ks]) : "v"(vb), "i"(d0 * 4096 + ks * 1024 + 512) : "memory");
            }
            asm volatile("s_waitcnt lgkmcnt(0)" : "+v"(lo[0]), "+v"(lo[1]), "+v"(lo[2]), "+v"(lo[3]), "+v"(hh[0]), "+v"(hh[1]), "+v"(hh[2]), "+v"(hh[3]) :: "memory");
#pragma unroll
            for (int ks = 0; ks < 4; ++ks) {
                const bf16x8 vf = (bf16x8){lo[ks][0], lo[ks][1], lo[ks][2], lo[ks][3], hh[ks][0], hh[ks][1], hh[ks][2], hh[ks][3]};
                if (d0 == 0) o0 = __builtin_amdgcn_mfma_f32_32x32x16_bf16(pa[ks], vf, o0, 0, 0, 0);
                else o1 = __builtin_amdgcn_mfma_f32_32x32x16_bf16(pa[ks], vf, o1, 0, 0, 0);
            }
        }
        }
        __syncthreads();
    }
    lrun += __shfl_xor(lrun, 32);
    if (hi == 0) wsf[32 + r32] = lrun;
    LDS_WAIT();
    LAS bf16* stg = (LAS bf16*)(lds + AT_OST) + wid * 2048;
#pragma unroll
    for (int r = 0; r < 16; ++r) { const int orow = crow(r, hi); const float rl = __builtin_amdgcn_rcpf(wsf[32 + orow]);
        stg[orow * 64 + r32] = (bf16)(cvt_pk_bf16(o0[r] * rl, 0.f) & 0xffffu); stg[orow * 64 + 32 + r32] = (bf16)(cvt_pk_bf16(o1[r] * rl, 0.f) & 0xffffu); }
    LDS_WAIT();
#pragma unroll
    for (int i = 0; i < 4; ++i) { const int row = i * 8 + (lane >> 3), ch = lane & 7; const v4u v = *(const LAS v4u*)(stg + row * 64 + ch * 8);
        *(v4u*)(O0 + (size_t)(wid * 32 + row) * opitch + ch * 8) = v; }
    LDS_WAIT();
}

constexpr int DC_TSTR = 2080, DC_TB = 16 * DC_TSTR, DC_T0 = 0, DC_KR0 = 2 * DC_TB, DC_KRB = 4 * DC_TSTR, DC_P = DC_KR0 + 2 * DC_KRB, DC_AL = DC_P + 4096, DC_Q = DC_AL + 64;
static_assert(DC_Q + 8 * 192 <= RING_BYTES, "decode LDS");
constexpr int DPART_STRIDE = 8 * 132;
struct DecPre { f32x4 c[4]; f32x4 k; };
__device__ __forceinline__ void dec_load_half(DecPre& P, const float* ck, const float* kr, int hf, int tid) {
#pragma unroll
    for (int it = 0; it < 4; ++it) P.c[it] = *(const f32x4*)((const char*)(ck + 2048 * (4 * hf + it)) + (unsigned)tid * 16u);
    P.k = *(const f32x4*)((const char*)(kr + 2048 * hf) + (unsigned)tid * 16u);
}
__device__ __forceinline__ void dec_load_newtok_half(DecPre& P, const bf16* ckn, const bf16* krn, int hf, int tid) {
#pragma unroll
    for (int it = 0; it < 4; ++it) { const int i4 = tid + 512 * (4 * hf + it); f32x4 v = (f32x4){0.f, 0.f, 0.f, 0.f};
        if ((i4 >> 5) == 0) { const v2u w = *(const v2u*)(ckn + 4 * (i4 & 31)); v = (f32x4){bflo(w.x), bfhi(w.x), bflo(w.y), bfhi(w.y)}; } P.c[it] = v; }
    { const int j4 = tid + 512 * hf; f32x4 v = (f32x4){0.f, 0.f, 0.f, 0.f};
        if ((j4 >> 3) == 0) { const v2u w = *(const v2u*)(krn + 4 * (j4 & 7)); v = (f32x4){bflo(w.x), bfhi(w.x), bflo(w.y), bfhi(w.y)}; } P.k = v; }
}
__device__ __forceinline__ void dec_store_half(const DecPre& P, LAS unsigned char* T, LAS unsigned char* KR, int hf, int tid) {
#pragma unroll
    for (int it = 0; it < 4; ++it) { const int i4 = tid + 512 * (4 * hf + it), key = i4 >> 5, l4 = i4 & 31;
        v2u w; w.x = cvt_pk_bf16(P.c[it][0], P.c[it][1]); w.y = cvt_pk_bf16(P.c[it][2], P.c[it][3]);
        *(LAS v2u*)(T + (l4 >> 1) * DC_TSTR + key * 16 + (l4 & 1) * 8) = w; }
    { const int j4 = tid + 512 * hf, key = j4 >> 3, c4 = j4 & 7;
        v2u w; w.x = cvt_pk_bf16(P.k[0], P.k[1]); w.y = cvt_pk_bf16(P.k[2], P.k[3]);
        *(LAS v2u*)(KR + (c4 >> 1) * DC_TSTR + key * 16 + (c4 & 1) * 8) = w; }
}
__device__ __forceinline__ void decode_item(const Frame& F, int b, int half) {
    LAS unsigned char* lds = F.lds;
    int tid_ = F.tid; asm volatile("" : "+v"(tid_));
    const int tid = tid_, lane = tid & 63, wid = F.wave, r32 = lane & 31, hi = lane >> 5, fr = lane & 15, fq = lane >> 4;
    const bf16* wkv = (const bf16*)(F.ws + WS_WKV);
    const float* g_kn = F.in[22];
    __syncthreads();
    LAS bf16* qrow = (LAS bf16*)(lds + DC_Q) + wid * 96;
    { const float* qs = (const float*)(F.ws + WS_QS) + (size_t)b * 768; const float epsq = EPS * (((const float*)(F.ws + WS_MSQ))[NTOK + b] + EPS); const int h = wid;
      const float rn = qs[256 * (h >> 2) + 128 * (lane >> 5) + 32 * (h & 3) + (lane & 31)];
      const float qn = rn * (__builtin_amdgcn_rsqf(wave_sum(rn * rn) * (1.0f / 64.0f) + epsq) * pg8::kC2Q) * F.in[17][lane];
      const float rr = lane < 32 ? qs[512 + 128 * (h >> 2) + 32 * (h & 3) + lane] : 0.f;
      const float w = rr * __builtin_amdgcn_rsqf(wave_sum(rr * rr) * (1.0f / 32.0f) + epsq) * F.in[18][lane & 31]; const float other = __shfl_xor(w, 16);
      const float* rp = (const float*)(F.ws + WS_ROPE) + (size_t)8192 * 32; const int i = lane & 15; const float cs = rp[i], sn = rp[16 + i];
      const float o = ((lane & 16) ? (other * sn + w * cs) : (w * cs - other * sn)) * pg8::kC2Q;
      const bf16 qnb = (bf16)(cvt_pk_bf16(qn, 0.f) & 0xffffu), qrb = (bf16)(cvt_pk_bf16(o, 0.f) & 0xffffu);
      qrow[lane] = qnb; if (lane < 32) qrow[64 + lane] = qrb;
      if (half == 0) { bf16* qg_ = (bf16*)(F.ws + WS_QB) + (size_t)(NTOK + b) * 768 + h * 96; qg_[lane] = qnb; if (lane < 32) qg_[64 + lane] = qrb; }
    }
    LDS_WAIT();
    bf16x8 wA[8][2];
    { const int pn = wid >> 2, wc = wid & 3; const unsigned loff = (unsigned)(r32 * 128 + 8 * hi) * 2u;
#pragma unroll
      for (int dt = 0; dt < 2; ++dt) { const char* rowp = (const char*)(wkv + (size_t)(256 * pn + 128 * dt + 32 * wc) * 128);
#pragma unroll
        for (int s = 0; s < 8; ++s) wA[s][dt] = *(const bf16x8*)(rowp + 32 * s + loff); } }
    float qg[2][16];
#pragma unroll
    for (int dt = 0; dt < 2; ++dt)
#pragma unroll
        for (int r = 0; r < 16; ++r) { const int d = 32 * dt + crow(r, hi); qg[dt][r] = g_kn[d] * bf2f(qrow[d]); }
    bf16x8 qrA;
    { v4u w = (v4u){0u, 0u, 0u, 0u}; if ((fr & 3) == 0) w = *(const LAS v4u*)(qrow + 64 + 8 * fq); qrA = __builtin_bit_cast(bf16x8, w); }
    for (int i = tid; i < 8 * 64; i += 512) ((LAS unsigned*)(lds + DC_P + 8 * 256))[i] = 0u;
    float mrun = -INFINITY, lrun = 0.f;
    f32x4 accL = (f32x4){0.f, 0.f, 0.f, 0.f};
    const int* ptab = (const int*)F.in[5] + b * NPAGES + half * 64;
    const int npg = 64 + (half == 1 ? 1 : 0);
    const bf16* ckn = (const bf16*)(F.ws + WS_CKVB) + (size_t)(NTOK + b) * 128;
    const bf16* krn = (const bf16*)(F.ws + WS_KRB) + (size_t)(NTOK + b) * 32;
    DecPre pre;
    { const int page = __builtin_amdgcn_readfirstlane(ptab[0]); const float* ck0 = F.in[3] + (size_t)page * (PAGE * 128); const float* kr0 = F.in[4] + (size_t)page * (PAGE * 32);
      dec_load_half(pre, ck0, kr0, 0, tid); dec_store_half(pre, lds + DC_T0, lds + DC_KR0, 0, tid);
      dec_load_half(pre, ck0, kr0, 1, tid); dec_store_half(pre, lds + DC_T0, lds + DC_KR0, 1, tid); }
    __syncthreads();
    for (int pg = 0; pg < npg; ++pg) {
        const bool newtok = pg == 64;
        LAS unsigned char* T = lds + DC_T0 + (pg & 1) * DC_TB; LAS unsigned char* KR = lds + DC_KR0 + (pg & 1) * DC_KRB;
        LAS unsigned char* Tn = lds + DC_T0 + ((pg + 1) & 1) * DC_TB; LAS unsigned char* KRn = lds + DC_KR0 + ((pg + 1) & 1) * DC_KRB;
        const bool more = pg + 1 < npg, nextnew = pg + 1 >= 64;
        const float* ckN = nullptr; const float* krN = nullptr;
        if (more && !nextnew) { const int page = __builtin_amdgcn_readfirstlane(ptab[pg + 1]); ckN = F.in[3] + (size_t)page * (PAGE * 128); krN = F.in[4] + (size_t)page * (PAGE * 32); }
        if (more) { if (!nextnew) dec_load_half(pre, ckN, krN, 0, tid); else dec_load_newtok_half(pre, ckn, krn, 0, tid); }
        float sc[4];
#pragma unroll
        for (int g = 0; g < 4; ++g) {
            f32x16 a0, a1;
#pragma unroll
            for (int r = 0; r < 16; ++r) { a0[r] = 0.f; a1[r] = 0.f; }
#pragma unroll
            for (int s = 0; s < 8; ++s) {
                const bf16x8 bfrag = *(const LAS bf16x8*)(T + (2 * s + hi) * DC_TSTR + (32 * g + r32) * 16);
                a0 = __builtin_amdgcn_mfma_f32_32x32x16_bf16(wA[s][0], bfrag, a0, 0, 0, 0);
                a1 = __builtin_amdgcn_mfma_f32_32x32x16_bf16(wA[s][1], bfrag, a1, 0, 0, 0);
            }
            const bf16x8 kf0 = *(const LAS bf16x8*)(KR + fq * DC_TSTR + (32 * g + fr) * 16), kf1 = *(const LAS bf16x8*)(KR + fq * DC_TSTR + (32 * g + 16 + fr) * 16);
            const f32x4 z4 = (f32x4){0.f, 0.f, 0.f, 0.f};
            const f32x4 rr0 = __builtin_amdgcn_mfma_f32_16x16x32_bf16(qrA, kf0, z4, 0, 0, 0), rr1 = __builtin_amdgcn_mfma_f32_16x16x32_bf16(qrA, kf1, z4, 0, 0, 0);
            typedef float f32x2 __attribute__((ext_vector_type(2)));
            f32x2 ssq2 = (f32x2){0.f, 0.f}, dot2 = (f32x2){0.f, 0.f};
#pragma unroll
            for (int r = 0; r < 16; r += 2) {
                const f32x2 x0 = (f32x2){a0[r], a0[r + 1]}, x1 = (f32x2){a1[r], a1[r + 1]};
                ssq2 = x0 * x0 + ssq2; ssq2 = x1 * x1 + ssq2;
                dot2 = x0 * (f32x2){qg[0][r], qg[0][r + 1]} + dot2; dot2 = x1 * (f32x2){qg[1][r], qg[1][r + 1]} + dot2; }
            float ssq = ssq2[0] + ssq2[1], dot = dot2[0] + dot2[1];
            { auto t = __builtin_amdgcn_permlane32_swap(__float_as_uint(ssq), __float_as_uint(ssq), false, false); ssq = __uint_as_float(t[0]) + __uint_as_float(t[1]); }
            { auto t = __builtin_amdgcn_permlane32_swap(__float_as_uint(dot), __float_as_uint(dot), false, false); dot = __uint_as_float(t[0]) + __uint_as_float(t[1]); }
            const float sr = (r32 < 16) ? rr0[0] : rr1[0];
            float sv = dot * __builtin_amdgcn_rsqf(ssq * (1.0f / 64.0f) + EPS) + sr;
            if (newtok && (32 * g + r32) != 0) sv = -INFINITY;
            sc[g] = sv;
            __builtin_amdgcn_sched_barrier(0);
            if (g == 1 && more) {
                dec_store_half(pre, Tn, KRn, 0, tid);
                __builtin_amdgcn_sched_barrier(0);
                if (!nextnew) dec_load_half(pre, ckN, krN, 1, tid); else dec_load_newtok_half(pre, ckn, krn, 1, tid);
                __builtin_amdgcn_sched_barrier(0);
            }
        }
        const float pm = fmaxf(fmaxf(sc[0], sc[1]), fmaxf(sc[2], sc[3]));
        float alpha = 1.0f;
        if (__any(pm > mrun + 8.0f)) {
            const float mn = fmaxf(mrun, wave_max(pm));
            alpha = __builtin_amdgcn_exp2f(mrun - mn);
            mrun = mn; lrun *= alpha;
        }
#pragma unroll
        for (int g = 0; g < 4; ++g) { sc[g] = __builtin_amdgcn_exp2f(sc[g] - mrun); lrun += sc[g]; }
        if (hi == 0) {
#pragma unroll
            for (int g = 0; g < 4; ++g) ((LAS bf16*)(lds + DC_P))[wid * 128 + 32 * g + r32] = (bf16)(cvt_pk_bf16(sc[g], 0.f) & 0xffffu);
        }
        if (lane == 0) ((LAS float*)(lds + DC_AL))[wid] = alpha;
        __syncthreads();
        if (fq < 2) {
#pragma unroll
            for (int i = 0; i < 4; ++i) accL[i] *= ((LAS float*)(lds + DC_AL))[4 * fq + i];
        }
        {
            const int q = fr >> 2, p = fr & 3;
#pragma unroll
            for (int ks = 0; ks < 4; ++ks) {
                const bf16x8 pa = *(const LAS bf16x8*)(lds + DC_P + fr * 256 + (32 * ks + 8 * fq) * 2);
                const unsigned a0 = (unsigned)(uintptr_t)T + (2 * wid + (p >> 1)) * DC_TSTR + (32 * ks + 8 * fq + q) * 16 + (p & 1) * 8;
                s16x4 lo, hh;
                asm volatile("ds_read_b64_tr_b16 %0, %2\n\tds_read_b64_tr_b16 %1, %2 offset:64\n\ts_waitcnt lgkmcnt(0)" : "=&v"(lo), "=&v"(hh) : "v"(a0) : "memory");
                const bf16x8 vf = (bf16x8){lo[0], lo[1], lo[2], lo[3], hh[0], hh[1], hh[2], hh[3]};
                accL = __builtin_amdgcn_mfma_f32_16x16x32_bf16(pa, vf, accL, 0, 0, 0);
            }
        }
        if (more) dec_store_half(pre, Tn, KRn, 1, tid);
        __syncthreads();
    }
    { int l2 = threadIdx.x; asm volatile("" : "+v"(l2)); l2 &= 63; const int fr2 = l2 & 15, fq2 = l2 >> 4;
      float* part = (float*)(F.ws + WS_DPART) + (size_t)(b * 2 + half) * DPART_STRIDE;
      const float ltot = wave_sum(lrun) * 0.5f;
      if (l2 == 0) { part[wid * 132 + 0] = mrun; part[wid * 132 + 1] = ltot; }
      if (fq2 < 2) {
#pragma unroll
          for (int i = 0; i < 4; ++i) part[(4 * fq2 + i) * 132 + 4 + 16 * wid + fr2] = accL[i];
      } }
}
__device__ __forceinline__ v4u norm8_pack(const float (&v)[8], float inv) {
    v4u w; w.x = cvt_pk_bf16(v[0] * inv, v[1] * inv); w.y = cvt_pk_bf16(v[2] * inv, v[3] * inv); w.z = cvt_pk_bf16(v[4] * inv, v[5] * inv); w.w = cvt_pk_bf16(v[6] * inv, v[7] * inv); return w;
}
__device__ __forceinline__ v2u norm4_pack(const float (&v)[4], float inv) { v2u w; w.x = cvt_pk_bf16(v[0] * inv, v[1] * inv); w.y = cvt_pk_bf16(v[2] * inv, v[3] * inv); return w; }
__device__ __forceinline__ void tp_finish_row(bf16* omix_row, const float (&a)[8], const float (&y)[4], const float (&mo)[4], int lane) {
    float sa = 0.f, sy = 0.f, sm = 0.f;
#pragma unroll
    for (int i = 0; i < 8; ++i) sa += a[i] * a[i];
#pragma unroll
    for (int i = 0; i < 4; ++i) { sy += y[i] * y[i]; sm += mo[i] * mo[i]; }
    sa = wave_sum(sa); sy = wave_sum(sy); sm = wave_sum(sm);
    const float ia = __builtin_amdgcn_rsqf(sa * (1.0f / 512.0f) + EPS), iy = __builtin_amdgcn_rsqf(sy * (1.0f / 256.0f) + EPS), im = __builtin_amdgcn_rsqf(sm * (1.0f / 256.0f) + EPS);
    *(v4u*)(omix_row + 8 * lane) = norm8_pack(a, ia);
    *(v2u*)(omix_row + 512 + 4 * lane) = norm4_pack(y, iy);
    *(v2u*)(omix_row + 768 + 4 * lane) = norm4_pack(mo, im);
}
__device__ __forceinline__ void tp_prompt_row(const Frame& F, int r) {
    const int lane = F.lane, t = r & (SEQ - 1);
    const bf16* oab = (const bf16*)(F.ws + WS_OAB); const bf16* omb = (const bf16*)(F.ws + WS_OMB); const bf16* ub = (const bf16*)(F.ws + WS_UB); const bf16* gbb = (const bf16*)(F.ws + WS_GBB);
    const float* cw = F.in[24];
    float a[8], y[4], mo[4];
    { const v4u w = *(const v4u*)(oab + (size_t)r * 512 + 8 * lane); a[0] = bflo(w.x); a[1] = bfhi(w.x); a[2] = bflo(w.y); a[3] = bfhi(w.y); a[4] = bflo(w.z); a[5] = bfhi(w.z); a[6] = bflo(w.w); a[7] = bfhi(w.w); }
    { const v2u w = *(const v2u*)(omb + (size_t)r * 256 + 4 * lane); mo[0] = bflo(w.x); mo[1] = bfhi(w.x); mo[2] = bflo(w.y); mo[3] = bfhi(w.y); }
    { const v2u u0 = *(const v2u*)(ub + (size_t)r * 256 + 4 * lane);
      v2u u1 = (v2u){0u, 0u}, u2 = (v2u){0u, 0u};
      if (t >= 1) u1 = *(const v2u*)(ub + (size_t)(r - 1) * 256 + 4 * lane);
      if (t >= 2) u2 = *(const v2u*)(ub + (size_t)(r - 2) * 256 + 4 * lane);
      const v2u g = *(const v2u*)(gbb + (size_t)r * 256 + 4 * lane);
      const f32x4 w0 = *(const f32x4*)(cw + 4 * lane), w1 = *(const f32x4*)(cw + 256 + 4 * lane), w2 = *(const f32x4*)(cw + 512 + 4 * lane);
      y[0] = bflo(g.x) * (w0[0] * bflo(u2.x) + w1[0] * bflo(u1.x) + w2[0] * bflo(u0.x));
      y[1] = bfhi(g.x) * (w0[1] * bfhi(u2.x) + w1[1] * bfhi(u1.x) + w2[1] * bfhi(u0.x));
      y[2] = bflo(g.y) * (w0[2] * bflo(u2.y) + w1[2] * bflo(u1.y) + w2[2] * bflo(u0.y));
      y[3] = bfhi(g.y) * (w0[3] * bfhi(u2.y) + w1[3] * bfhi(u1.y) + w2[3] * bfhi(u0.y)); }
    tp_finish_row((bf16*)(F.ws + WS_OMIX) + (size_t)r * D, a, y, mo, lane);
}
__device__ __forceinline__ void tp_sample_wg(const Frame& F, int b) {
    const int lane = F.lane, wid = F.wave, r = NTOK + b;
    LAS float* base = (LAS float*)F.lds;
    LAS float* lat = base; LAS float* oA = base + 1024; LAS float* oM = base + 1536; LAS float* yc = base + 1792; LAS float* qf = base + 2048 + (wid & 3) * 64; LAS float* pb = base + 2304 + (wid & 3) * 256;
    __syncthreads();
    { const int h = wid; const float* part = (const float*)(F.ws + WS_DPART) + (size_t)(b * 2) * DPART_STRIDE;
      const float m0 = part[h * 132], l0 = part[h * 132 + 1], m1 = part[DPART_STRIDE + h * 132], l1 = part[DPART_STRIDE + h * 132 + 1];
      const float M = fmaxf(m0, m1), e0 = __builtin_amdgcn_exp2f(m0 - M), e1 = __builtin_amdgcn_exp2f(m1 - M);
      const float rl = 1.0f / (l0 * e0 + l1 * e1);
#pragma unroll
      for (int j = 0; j < 2; ++j) { const int c = lane + 64 * j; lat[h * 128 + c] = (part[h * 132 + 4 + c] * e0 + part[DPART_STRIDE + h * 132 + 4 + c] * e1) * rl; }
      LDS_WAIT();
      const float* wuv = F.in[21] + h * 64 + lane; float a = 0.f;
#pragma unroll 8
      for (int l = 0; l < 128; ++l) a += lat[h * 128 + l] * wuv[(size_t)l * 512];
      oA[h * 64 + lane] = a; }
    if (wid < 4) {
        const int h = wid; const bf16* mqb = (const bf16*)(F.ws + WS_MQB) + (size_t)r * 256; const float* ck = F.in[7] + (size_t)b * (256 * 256); const float* cv = F.in[8] + (size_t)b * (256 * 256);
        qf[lane] = bf2f(mqb[h * 64 + lane]);
        LDS_WAIT();
        float sv[4];
#pragma unroll
        for (int j = 0; j < 4; ++j) { const int n = lane + 64 * j; const float* kp = ck + (size_t)n * 256 + h * 64; float acc = 0.f;
#pragma unroll
            for (int d4 = 0; d4 < 16; ++d4) { const f32x4 kv = *(const f32x4*)(kp + 4 * d4); const f32x4 qv = *(const LAS f32x4*)(qf + 4 * d4); acc += kv[0] * qv[0] + kv[1] * qv[1] + kv[2] * qv[2] + kv[3] * qv[3]; }
            sv[j] = acc; }
        const float mx = wave_max(fmaxf(fmaxf(sv[0], sv[1]), fmaxf(sv[2], sv[3])));
        float ls = 0.f;
#pragma unroll
        for (int j = 0; j < 4; ++j) { sv[j] = __builtin_amdgcn_exp2f(sv[j] - mx); ls += sv[j]; pb[lane + 64 * j] = sv[j]; }
        ls = wave_sum(ls);
        LDS_WAIT();
        float o = 0.f;
#pragma unroll 8
        for (int n = 0; n < 256; ++n) o += pb[n] * cv[(size_t)n * 256 + h * 64 + lane];
        oM[h * 64 + lane] = o / ls;
    } else {
        const int c = (wid - 4) * 64 + lane; const bf16* ub = (const bf16*)(F.ws + WS_UB); const bf16* gbb = (const bf16*)(F.ws + WS_GBB); const float* cw = F.in[24]; const float* st = F.in[6] + (size_t)b * 512;
        yc[c] = bf2f(gbb[(size_t)r * 256 + c]) * (cw[c] * st[c] + cw[256 + c] * st[256 + c] + cw[512 + c] * bf2f(ub[(size_t)r * 256 + c]));
    }
    __syncthreads();
    if (wid == 0) {
        float a[8], y[4], mo[4];
#pragma unroll
        for (int i = 0; i < 8; ++i) a[i] = oA[8 * lane + i];
#pragma unroll
        for (int i = 0; i < 4; ++i) { y[i] = yc[4 * lane + i]; mo[i] = oM[4 * lane + i]; }
        *(v4u*)((bf16*)(F.ws + WS_OAB) + (size_t)r * 512 + 8 * lane) = norm8_pack(a, 1.0f);
        *(v2u*)((bf16*)(F.ws + WS_OMB) + (size_t)r * 256 + 4 * lane) = norm4_pack(mo, 1.0f);
        tp_finish_row((bf16*)(F.ws + WS_OMIX) + (size_t)r * D, a, y, mo, lane);
    }
}
__device__ __forceinline__ void tp_phase(const Frame& F) {
    const int gw = F.vcu * NWAVES + F.wave, NGW = F.G * NWAVES;
    for (int r = gw; r < NTOK; r += NGW) tp_prompt_row(F, r);
}
struct ABf16 {
    const bf16* p; int ld;
    static constexpr bool NEEDS_INV = false;
    __device__ __forceinline__ float row_inv(int) const { return 1.f; }
    __device__ __forceinline__ v4u piece(int row, int k, float) const { return *(const v4u*)(p + (size_t)row * ld + k); }
};
struct ASum {
    const float* a; const float* b; float cb;
    static constexpr bool NEEDS_INV = false;
    __device__ __forceinline__ float row_inv(int) const { return 1.f; }
    __device__ __forceinline__ v4u piece(int row, int k, float) const {
        const f32x4 a0 = *(const f32x4*)(a + (size_t)row * 1024 + k), a1 = *(const f32x4*)(a + (size_t)row * 1024 + k + 4);
        const f32x4 b0 = *(const f32x4*)(b + (size_t)row * 1024 + k), b1 = *(const f32x4*)(b + (size_t)row * 1024 + k + 4);
        const f32x4 v0 = a0 + b0 * cb, v1 = a1 + b1 * cb;
        v4u w; w.x = cvt_pk_bf16(v0[0], v0[1]); w.y = cvt_pk_bf16(v0[2], v0[3]); w.z = cvt_pk_bf16(v1[0], v1[1]); w.w = cvt_pk_bf16(v1[2], v1[3]); return w;
    }
};
struct ASilu {
    const float* gu; const float* ssq;
    static constexpr bool NEEDS_INV = true;
    __device__ __forceinline__ float row_inv(int row) const { return pg8::row_inv_from_parts(ssq, NTOK + row); }
    __device__ __forceinline__ v4u piece(int row, int k, float iv) const {
        const float* gp = gu + (size_t)row * FF2 + 256 * (k >> 7) + (k & 127);
        const f32x4 g0 = *(const f32x4*)gp, g1 = *(const f32x4*)(gp + 4), u0 = *(const f32x4*)(gp + 128), u1 = *(const f32x4*)(gp + 132);
        v4u w;
        w.x = cvt_pk_bf16(pg8::silu_mul(g0[0] * iv, u0[0] * iv), pg8::silu_mul(g0[1] * iv, u0[1] * iv)); w.y = cvt_pk_bf16(pg8::silu_mul(g0[2] * iv, u0[2] * iv), pg8::silu_mul(g0[3] * iv, u0[3] * iv));
        w.z = cvt_pk_bf16(pg8::silu_mul(g1[0] * iv, u1[0] * iv), pg8::silu_mul(g1[1] * iv, u1[1] * iv)); w.w = cvt_pk_bf16(pg8::silu_mul(g1[2] * iv, u1[2] * iv), pg8::silu_mul(g1[3] * iv, u1[3] * iv));
        return w;
    }
};
template <int KB, class AProv>
__device__ __forceinline__ void mini_gemm(const Frame& F, const AProv& A, const bf16* Bt, int K, int N, int item0, float* out, int ldo, float scale) {
    constexpr int PPR = KB / 8, PITCH = (KB + 8) * 2;
    constexpr int A_OFF = 0, B_OFF = 128 * PITCH, INV_OFF = B_OFF + 64 * PITCH;
    static_assert(INV_OFF + 512 <= RING_BYTES && KB % 16 == 0, "mini_gemm LDS");
    int tid_ = F.tid; asm volatile("" : "+v"(tid_));
    const int tid = tid_, lane = tid & 63, r32 = lane & 31, hi = lane >> 5, wid = F.wave, rt = wid >> 1, ct = wid & 1;
    LAS unsigned char* lds = F.lds;
    const int nnb = N / 64, nitems = nnb * (K / KB);
#ifndef MINI_REP
#define MINI_REP 1
#endif
    for (int rep_ = 0; rep_ < MINI_REP; ++rep_)
    for (int it = item0; it < nitems; it += F.G) {
        const int nb = it % nnb, k0 = (it / nnb) * KB, n0 = nb * 64;
        __syncthreads();
        if (AProv::NEEDS_INV) { if (tid < 128) ((LAS float*)(lds + INV_OFF))[tid] = A.row_inv(tid); __syncthreads(); }
#pragma unroll 4
        for (int p = tid; p < 128 * PPR; p += 512) { const int row = p / PPR, c = p - row * PPR;
            const float iv = AProv::NEEDS_INV ? ((LAS float*)(lds + INV_OFF))[row] : 1.f;
            *(LAS v4u*)(lds + A_OFF + row * PITCH + c * 16) = A.piece(row, k0 + 8 * c, iv); }
#pragma unroll 4
        for (int p = tid; p < 64 * PPR; p += 512) { const int n = p / PPR, c = p - n * PPR;
            *(LAS v4u*)(lds + B_OFF + n * PITCH + c * 16) = *(const v4u*)(Bt + (size_t)(n0 + n) * K + k0 + 8 * c); }
        __syncthreads();
        f32x16 acc;
#pragma unroll
        for (int r = 0; r < 16; ++r) acc[r] = 0.f;
        const LAS unsigned char* ap = lds + A_OFF + (32 * rt + r32) * PITCH + 16 * hi; const LAS unsigned char* bp = lds + B_OFF + (32 * ct + r32) * PITCH + 16 * hi;
#pragma unroll
        for (int s = 0; s < KB / 16; ++s) acc = __builtin_amdgcn_mfma_f32_32x32x16_bf16(*(const LAS bf16x8*)(ap + 32 * s), *(const LAS bf16x8*)(bp + 32 * s), acc, 0, 0, 0);
        float* op = out + (size_t)(32 * rt) * ldo + n0 + 32 * ct + r32;
#pragma unroll
        for (int r = 0; r < 16; ++r) unsafeAtomicAdd(op + (size_t)crow(r, hi) * ldo, acc[r] * scale);
    }
    __syncthreads();
}
__device__ __forceinline__ void postz_sample_row(const Frame& F, int b) {
    const int lane = F.lane, r = NTOK + b;
    const float* xr = F.in[2] + (size_t)b * D; const float* d1 = (const float*)(F.ws + WS_D1S) + (size_t)b * D; const float* zr = (const float*)(F.ws + WS_ZS) + (size_t)b * INWP;
    float* x1r = (float*)(F.ws + WS_X1F) + (size_t)r * D;
    float s = 0.f;
#pragma unroll
    for (int j = 0; j < 4; ++j) { const f32x4 v = ((const f32x4*)xr)[lane + 64 * j] + ((const f32x4*)d1)[lane + 64 * j] * 0.5f; ((f32x4*)x1r)[lane + 64 * j] = v; s += (v[0] * v[0] + v[1] * v[1]) + (v[2] * v[2] + v[3] * v[3]); }
    const float inv1 = __builtin_amdgcn_rsqf(wave_sum(s) * (1.0f / 1024.0f) + EPS);
    { const f32x4 v = ((const f32x4*)zr)[lane] * inv1; const float q = wave_sum((v[0] * v[0] + v[1] * v[1]) + (v[2] * v[2] + v[3] * v[3]));
      if (lane == 0) ((float*)(F.ws + WS_MSQ))[r] = q * (1.0f / 256.0f);
      v2u w; w.x = cvt_pk_bf16(v[0], v[1]); w.y = cvt_pk_bf16(v[2], v[3]); ((v2u*)((bf16*)(F.ws + WS_CQB) + (size_t)r * 256))[lane] = w; }
    { const float a0 = zr[256 + 2 * lane] * inv1, a1 = zr[256 + 2 * lane + 1] * inv1; const float ic = __builtin_amdgcn_rsqf(wave_sum(a0 * a0 + a1 * a1) * (1.0f / 128.0f) + EPS);
      const float o0 = a0 * ic * F.in[19][2 * lane], o1 = a1 * ic * F.in[19][2 * lane + 1];
      float* op = F.out + O_CKVS + (size_t)b * 128 + 2 * lane; op[0] = o0; op[1] = o1;
      ((unsigned*)((bf16*)(F.ws + WS_CKVB) + (size_t)r * 128))[lane] = cvt_pk_bf16(o0, o1); }
    { const float a = lane < 32 ? zr[384 + lane] * inv1 : 0.f; const float ik = __builtin_amdgcn_rsqf(wave_sum(a * a) * (1.0f / 32.0f) + EPS);
      const float w = a * ik * F.in[23][lane & 31]; const float other = __shfl_xor(w, 16);
      const float* rp = (const float*)(F.ws + WS_ROPE) + (size_t)8192 * 32; const int i = lane & 15; const float cs = rp[i], sn = rp[16 + i];
      const float o = (lane & 16) ? (other * sn + w * cs) : (w * cs - other * sn);
      if (lane < 32) { F.out[O_KRS + (size_t)b * 32 + lane] = o; ((bf16*)(F.ws + WS_KRB))[(size_t)r * 32 + lane] = (bf16)(cvt_pk_bf16(o, 0.f) & 0xffffu); } }
    { const int j = 4 * lane; const int zo = j < 128 ? 512 + j : 768 + (j - 128);
      const f32x4 ui = *(const f32x4*)(zr + zo) * inv1, gc = *(const f32x4*)(zr + zo + 128) * inv1; const f32x4 u = gc * ui;
      v2u w; w.x = cvt_pk_bf16(u[0], u[1]); w.y = cvt_pk_bf16(u[2], u[3]); ((v2u*)((bf16*)(F.ws + WS_UB) + (size_t)r * 256))[lane] = w;
      *(f32x4*)(F.out + O_CONVS + (size_t)b * 512 + 256 + j) = u;
      const f32x4 gb = *(const f32x4*)(zr + 1024 + j) * inv1; w.x = cvt_pk_bf16(gb[0], gb[1]); w.y = cvt_pk_bf16(gb[2], gb[3]); ((v2u*)((bf16*)(F.ws + WS_GBB) + (size_t)r * 256))[lane] = w;
      const int h = j >> 6, d = j & 63; const f32x4 mq = *(const f32x4*)(zr + 1280 + 128 * (d >> 5) + 32 * h + (d & 31)) * inv1;
      float q = (mq[0] * mq[0] + mq[1] * mq[1]) + (mq[2] * mq[2] + mq[3] * mq[3]);
      q += __shfl_xor(q, 1); q += __shfl_xor(q, 2); q += __shfl_xor(q, 4); q += __shfl_xor(q, 8);
      const float im = __builtin_amdgcn_rsqf(q * (1.0f / 64.0f) + EPS) * pg8::kC2M; const f32x4 g = *(const f32x4*)(F.in[28] + d); const f32x4 o = mq * im * g;
      w.x = cvt_pk_bf16(o[0], o[1]); w.y = cvt_pk_bf16(o[2], o[3]); ((v2u*)((bf16*)(F.ws + WS_MQB) + (size_t)r * 256))[lane] = w; }
}
__device__ __forceinline__ void x2_sample_row(const Frame& F, int b) {
    const int lane = F.lane, r = NTOK + b;
    const float* x1r = (const float*)(F.ws + WS_X1F) + (size_t)r * D; const float* d7 = (const float*)(F.ws + WS_D7S) + (size_t)b * D; float* x2r = (float*)(F.ws + WS_X2F) + (size_t)r * D; float* yr = F.out + O_YS + (size_t)b * D;
    float s = 0.f;
#pragma unroll
    for (int j = 0; j < 4; ++j) { const f32x4 v = ((const f32x4*)x1r)[lane + 64 * j] + ((const f32x4*)d7)[lane + 64 * j]; ((f32x4*)x2r)[lane + 64 * j] = v; ((f32x4*)yr)[lane + 64 * j] = v; s += (v[0] * v[0] + v[1] * v[1]) + (v[2] * v[2] + v[3] * v[3]); }
    s = wave_sum(s);
    if (lane < 16) ((float*)(F.ws + WS_SSQ2))[(size_t)r * 16 + lane] = lane == 0 ? s : 0.f;
}
#if DBG_ORACLE
__device__ __forceinline__ void dbg_phase(const Frame& F);
__device__ __forceinline__ void dbg_report(const Frame& F, unsigned* barw);
#endif
#define P_BF(off) ((bf16*)(F.ws + (off)))
#define P_F32(off) ((float*)(F.ws + (off)))
#define W1GU P_BF(WS_W1GU)
#define W1D P_BF(WS_W1D)
#define WIN P_BF(WS_WIN)
#define WUQ P_BF(WS_WUQ)
#define WKV P_BF(WS_WKV)
#define WO P_BF(WS_WO)
#define W2GU P_BF(WS_W2GU)
#define W2D P_BF(WS_W2D)
#define WMEM P_BF(WS_WMEM)
#define rope P_F32(WS_ROPE)
#define ssq0 P_F32(WS_SSQ0)
#define ssq1 P_F32(WS_SSQ1)
#define ssq2 P_F32(WS_SSQ2)
#define msq P_F32(WS_MSQ)
#define ssqm P_F32(WS_SSQM)
#define xb P_BF(WS_XB)
#define act1 P_BF(WS_ACT1)
#define act2 P_BF(WS_ACT2)
#define x1f P_F32(WS_X1F)
#define x1b P_BF(WS_X1B)
#define x2f P_F32(WS_X2F)
#define x2b P_BF(WS_X2B)
#define cqb P_BF(WS_CQB)
#define ckvb P_BF(WS_CKVB)
#define krb P_BF(WS_KRB)
#define ub P_BF(WS_UB)
#define gbb P_BF(WS_GBB)
#define mqb P_BF(WS_MQB)
#define qb P_BF(WS_QB)
#define Kb P_BF(WS_KB)
#define Vb P_BF(WS_VB)
#define memb P_BF(WS_MEMB)
#define memK P_BF(WS_MEMK)
#define memV P_BF(WS_MEMV)
#define oab P_BF(WS_OAB)
#define omb P_BF(WS_OMB)
#define omix P_BF(WS_OMIX)
__global__ void __launch_bounds__(NWAVES * 64, 2) mk_fwd(Args args) {
    extern __shared__ __attribute__((aligned(16))) unsigned char lds_raw[];
    Frame F;
    F.lds = (LAS unsigned char*)lds_raw;
    F.wave = __builtin_amdgcn_readfirstlane((int)threadIdx.x >> 6);
    F.G = gridDim.x; { const int bx = blockIdx.x; F.vcu = (F.G % 8 == 0) ? (bx % 8) * (F.G / 8) + bx / 8 : bx; }
#define PHASE_BEGIN() do { const CAS Args* ka_ = (const CAS Args*)__builtin_amdgcn_kernarg_segment_ptr(); asm volatile("" : "+s"(ka_)); F.in = (InTab)ka_->in; F.out = ka_->out; F.ws = ka_->ws; \
        int t_ = threadIdx.x; asm volatile("" : "+v"(t_)); F.tid = t_; F.lane = t_ & 63; } while (0)
    PHASE_BEGIN();
    for (int u = F.tid; u < (LDS_BYTES - LDSCTL_OFF) / 4; u += NWAVES * 64) ((LAS unsigned*)(F.lds + LDSCTL_OFF))[u] = 0u;
    __syncthreads();
    XcdBarrier bar = xcd_barrier_post((unsigned*)(F.ws + WS_CTL) + CW_BAR, (volatile LAS unsigned*)(F.lds + MISC_OFF) + 8);
    const int lo = args.ph_lo, hi = args.ph_hi;
#ifndef PH_MASK
#define PH_MASK 0xFFFF
#endif
#define IN(k) (((PH_MASK >> (k)) & 1) && lo <= (k) && (k) < hi)
#define SEAM(k) do { if (IN(k) && IN((k) + 1)) xcd_barrier(bar); } while (0)
    const int bx = (int)blockIdx.x;

#define GU1S P_F32(WS_GU1S)
#define GU2S P_F32(WS_GU2S)
#define D1S P_F32(WS_D1S)
#define D7S P_F32(WS_D7S)
#define ZS P_F32(WS_ZS)
#define QS P_F32(WS_QS)
    if (IN(0)) { PHASE_BEGIN(); p0_prologue(F); }
    SEAM(0);
    if (IN(1)) { PHASE_BEGIN();
        { pg8::Gemm g{xb, W1GU, NTOK, FF2, D}; pg8::StaticOrder S; S.init(NTOK, FF2, F.G, bx);
          pg8::EpiSwiGLU E{ssq0, act1, FF};
          pg8::gemm_phase<pg8::EpiSwiGLU, pg8::StaticOrder, true, true>(F.lds, g, S, E); }
        mini_gemm<256>(F, ABf16{xb + (size_t)NTOK * D, D}, W1GU, D, FF2, F.vcu, GU1S, FF2, 1.0f);
    }
    SEAM(1);
    if (IN(2)) { PHASE_BEGIN();
        { pg8::Gemm g{act1, W1D, NTOK, D, FF}; pg8::StaticOrder S; S.init(NTOK, D, F.G, bx);
          pg8::EpiResid E{F.in[0], F.in[2], x1f, x1f + (size_t)NTOK * D, x1b, ssq1, 0.5f};
          pg8::gemm_phase<pg8::EpiResid, pg8::StaticOrder, true, true>(F.lds, g, S, E); }
        mini_gemm<176>(F, ASilu{GU1S, ssq0}, W1D, FF, D, F.vcu, D1S, D, 1.0f);
    }
    SEAM(2);
    if (IN(3)) { PHASE_BEGIN();
        { pg8::Gemm g{x1b, WIN, NTOK, INWP, D}; pg8::StaticOrder S; S.init(NTOK, INWP, F.G, bx);
          pg8::EpiZ E{ssq1, (LAS float*)(F.lds + XCH_OFF), msq, cqb, F.in[19], F.in[23], F.in[28], rope,
                      F.out + O_CKVP, F.out + O_CKVS, F.out + O_KRP, F.out + O_KRS, F.out + O_CONVP, F.out + O_CONVS, ckvb, krb, Kb, ub, gbb, mqb};
          pg8::gemm_phase<pg8::EpiZ, pg8::StaticOrder, true, true>(F.lds, g, S, E); }
        { pg8::Gemm g{memb, WMEM, 1024, 512, D}; pg8::StaticOrder S; S.init(1024, 512, F.G, (bx + 128) % F.G);
          pg8::EpiMem E{ssqm, F.in[29], F.out + O_MKP, F.out + O_MVP, memK, memV};
          pg8::gemm_phase<pg8::EpiMem, pg8::StaticOrder, true, true>(F.lds, g, S, E); }
        mini_gemm<128>(F, ASum{F.in[2], D1S, 0.5f}, WIN, D, INWP, F.vcu, ZS, INWP, 1.0f);
    }
    SEAM(3);
    if (IN(4)) { PHASE_BEGIN();
        if (F.wave == 0) for (int b = F.vcu; b < NS; b += F.G) postz_sample_row(F, b);
        { pg8::Gemm g{cqb, WUQ, NTOK, 768, 256}; pg8::StaticOrder S; S.init(NTOK, 768, F.G, bx);
          pg8::EpiQ E{msq, F.in[17], F.in[18], rope, qb};
          pg8::gemm_phase<pg8::EpiQ, pg8::StaticOrder, true, true>(F.lds, g, S, E); }
        { pg8::Gemm g{ckvb, WKV, NTOK, 1024, 128}; pg8::StaticOrder S; S.init(NTOK, 1024, F.G, bx);
          pg8::EpiKV E{F.in[22], Kb, Vb};
          pg8::gemm_phase<pg8::EpiKV, pg8::StaticOrder, true, true>(F.lds, g, S, E); }
    }
    SEAM(4);
    if (IN(5)) { PHASE_BEGIN();
        mini_gemm<128>(F, ABf16{cqb + (size_t)NTOK * 256, 256}, WUQ, 256, 768, F.vcu, QS, 768, 1.0f);
        for (int i = 0;; ++i) {
            int bh, qblk;
            if (F.G == 256) { if (i >= 4) break; const int s = F.vcu & 7; bh = F.vcu >> 3; qblk = (i == 0) ? s : (i == 1) ? 15 - s : (i == 2) ? 16 + s : 31 - s; }
            else { const int u = F.vcu + i * F.G; if (u >= 1024) break; bh = u >> 5; qblk = u & 31; }
            const int b = bh >> 3, h = bh & 7; const size_t row0 = (size_t)b * SEQ + (size_t)qblk * 256;
            attn_unit_simple<96, true>(qb + row0 * 768 + h * 96, 768, Kb + (size_t)bh * SEQ * 96, Vb + (size_t)bh * SEQ * 64, oab + row0 * 512 + h * 64, 512, 4 * (qblk + 1), F.lds);
        }
        for (int u = F.vcu; u < 512; u += F.G) {
            const int b = u >> 7, h = (u >> 5) & 3, qblk = u & 31; const size_t row0 = (size_t)b * SEQ + (size_t)qblk * 256;
            attn_unit_simple<64, false>(mqb + row0 * 256 + h * 64, 256, memK + (size_t)(b * 4 + h) * 256 * 64, memV + (size_t)(b * 4 + h) * 256 * 64, omb + row0 * 256 + h * 64, 256, 4, F.lds);
        }
        __syncthreads();
    }
    SEAM(5);
    if (IN(6)) { PHASE_BEGIN();
        for (int it = F.vcu; it < 2 * NS; it += F.G) decode_item(F, it >> 1, it & 1);
        __syncthreads();
        tp_phase(F);
    }
    SEAM(6);
    if (IN(7)) { PHASE_BEGIN();
        for (int b = F.vcu; b < NS; b += F.G) tp_sample_wg(F, b);
        __syncthreads();
        { pg8::Gemm g{omix, WO, NTOK, D, D}; pg8::StaticOrder S; S.init(NTOK, D, F.G, (bx + 128) % F.G);
          pg8::EpiResid E{x1f, x1f + (size_t)NTOK * D, x2f, x2f + (size_t)NTOK * D, x2b, ssq2, 1.0f};
          pg8::gemm_phase<pg8::EpiResid, pg8::StaticOrder, true, true>(F.lds, g, S, E); }
    }
    SEAM(7);
    if (IN(8)) { PHASE_BEGIN();
        { pg8::Gemm g{x2b, W2GU, NTOK, FF2, D}; pg8::StaticOrder S; S.init(NTOK, FF2, F.G, bx);
          pg8::EpiSwiGLU E{ssq2, act2, FF};
          pg8::gemm_phase<pg8::EpiSwiGLU, pg8::StaticOrder, true, true>(F.lds, g, S, E); }
        mini_gemm<128>(F, ABf16{omix + (size_t)NTOK * D, D}, WO, D, D, F.vcu, D7S, D, 1.0f);
    }
    SEAM(8);
    if (IN(9)) { PHASE_BEGIN();
        { pg8::Gemm g{act2, W2D, NTOK, D, FF}; pg8::StaticOrder S; S.init(NTOK, D, F.G, bx);
          pg8::EpiResid E{x2f, x2f + (size_t)NTOK * D, F.out + O_Y, F.out + O_YS, nullptr, nullptr, 0.5f};
          pg8::gemm_phase<pg8::EpiResid, pg8::StaticOrder, true, true>(F.lds, g, S, E); }
        if (F.wave == 0) for (int b = F.vcu; b < NS; b += F.G) x2_sample_row(F, b);
        mini_gemm<256>(F, ASum{x1f + (size_t)NTOK * D, D7S, 1.0f}, W2GU, D, FF2, F.vcu, GU2S, FF2, 1.0f);
    }
    SEAM(9);
    if (IN(10)) { PHASE_BEGIN();
        mini_gemm<176>(F, ASilu{GU2S, ssq2}, W2D, FF, D, F.vcu, F.out + O_YS, D, 0.5f);
    }
#if DBG_ORACLE
    if (IN(10)) { xcd_barrier(bar); PHASE_BEGIN(); dbg_phase(F); xcd_barrier(bar); PHASE_BEGIN(); dbg_report(F, (unsigned*)(F.ws + WS_CTL) + CW_BAR); }
#endif
#undef IN
#undef SEAM
#undef PHASE_BEGIN
}
#undef W1GU
#undef W1D
#undef WIN
#undef WUQ
#undef WKV
#undef WO
#undef W2GU
#undef W2D
#undef WMEM
#undef rope
#undef ssq0
#undef ssq1
#undef ssq2
#undef msq
#undef ssqm
#undef xb
#undef act1
#undef act2
#undef x1f
#undef x1b
#undef x2f
#undef x2b
#undef cqb
#undef ckvb
#undef krb
#undef ub
#undef gbb
#undef mqb
#undef qb
#undef Kb
#undef Vb
#undef memb
#undef memK
#undef memV
#undef oab
#undef omb
#undef omix
#undef P_BF
#undef P_F32

extern "C" void kernel_launch(void* const* d_in, const int* in_sizes, int n_in, void* d_out, int out_size, void* d_ws, size_t ws_size, hipStream_t stream) {
    static int grid = 0;
    if (grid == 0) {
        if (n_in != 38 || (size_t)out_size != O_TOTAL || ws_size < WS_END) { fprintf(stderr, "kernel_launch: unexpected shapes (n_in %d, out %d, ws %zu)\n", n_in, out_size, ws_size); grid = -1; return; }
        int dev = 0, cus = 0, per_cu = 0;
        if (hipGetDevice(&dev) != hipSuccess || hipDeviceGetAttribute(&cus, hipDeviceAttributeMultiprocessorCount, dev) != hipSuccess) { grid = -1; return; }
        if (hipFuncSetAttribute((const void*)mk_fwd, hipFuncAttributeMaxDynamicSharedMemorySize, LDS_BYTES) != hipSuccess) { fprintf(stderr, "kernel_launch: hipFuncSetAttribute failed\n"); grid = -1; return; }
        if (hipOccupancyMaxActiveBlocksPerMultiprocessor(&per_cu, (const void*)mk_fwd, NWAVES * 64, LDS_BYTES) != hipSuccess || per_cu < 1) { fprintf(stderr, "kernel_launch: occupancy query says %d\n", per_cu); }
        (void)hipGetLastError();
        grid = cus;
    }
    if (grid < 0) return;
    (void)hipMemsetAsync((char*)d_ws + WS_CTL, 0, CTL_ZERO_BYTES, stream);
#if DBG_ORACLE
    (void)hipMemsetAsync((char*)d_ws + WS_DBG, 0, 1 * MiB, stream);
#endif
    Args a{};
    for (int i = 0; i < 38; ++i) a.in[i] = (const float*)d_in[i];
    a.out = (float*)d_out; a.ws = (unsigned char*)d_ws;
    a.ph_lo = 0; a.ph_hi = 11;
    hipLaunchKernelGGL(mk_fwd, dim3(grid), dim3(NWAVES * 64), LDS_BYTES, stream, a);
}
```

```cpp
#include <hip/hip_runtime.h>
#include <cstdint>
#include <cstdio>
#include <cmath>
#define DBG_ORACLE 0
#define DBG_TOL 0.03f
#define AT_ROLL 1
#define NT_ACT 1
#define NT_Y 1
#ifndef PROBE_MFMA2
#define PROBE_MFMA2 0
#endif
#ifndef PROBE_VALU2
#define PROBE_VALU2 0
#endif
#ifndef PROBE_DUP
#define PROBE_DUP 1
#endif
#ifndef DEC_FLIP
#define DEC_FLIP 0
#endif
#ifndef DEC_SKEW
#define DEC_SKEW 0
#endif
#ifndef AT_ROLL
#define AT_ROLL 0
#endif
#ifndef AT_VPRE
#define AT_VPRE 0
#endif
#ifndef AT_VPIPE
#define AT_VPIPE 0
#endif
#ifndef PG8_AMID
#define PG8_AMID 0
#endif
#ifndef NT_ACT
#define NT_ACT 0
#endif
#ifndef NT_OUT
#define NT_OUT 0
#endif
#ifndef NT_Y
#define NT_Y 0
#endif
#ifndef NT_OB
#define NT_OB 0
#endif
#ifndef DEC_NT
#define DEC_NT 0
#endif
#ifndef NT_O
#define NT_O 0
#endif
#ifndef AT_DMAMID
#define AT_DMAMID 0
#endif
#ifndef AT_XPRE
#define AT_XPRE 0
#endif
#ifndef WT_OUT
#define WT_OUT 0
#endif
#ifndef WT_OB
#define WT_OB 0
#endif
#ifndef WT_O
#define WT_O 0
#endif
#ifndef WT_TP
#define WT_TP 0
#endif
#ifndef P0_PIPE
#define P0_PIPE 0
#endif
#ifndef DEC_PRIO
#define DEC_PRIO 0
#endif
#ifndef MLA_PRIO
#define MLA_PRIO 0
#endif
#ifndef TS_BUILD
#define TS_BUILD 0
#endif
namespace pg8 {
#define PG8_LAS __attribute__((address_space(3)))
typedef unsigned short bf16_t;
typedef short bf16x8 __attribute__((ext_vector_type(8)));
typedef float f32x4 __attribute__((ext_vector_type(4)));
typedef unsigned u32x4 __attribute__((ext_vector_type(4)));
constexpr int BM = 256, BK = 64, HALF = 128, HTB = HALF * BK * 2  , STAGE_BYTES = 8 * HTB, NXCD = 8, WGM = 8;

__host__ __device__ __forceinline__ int lds_byte(int r, int c) { const int st = (r >> 4) * 2 + (c >> 5), rr = r & 15, cc = c & 31, ob = rr * 64 + cc * 2; return st * 1024 + (ob ^ (((ob >> 9) & 1) << 5)); }
__host__ __device__ __forceinline__ void stage_rc(int b, int& R, int& C) { const int st = b / 1024, sb = b % 1024, swz = sb ^ (((sb >> 9) & 1) << 5); R = (st >> 1) * 16 + swz / 64; C = (st & 1) * 32 + (swz % 64) / 2; }
__host__ __device__ __forceinline__ int perm32(int rho) { const int n = rho >> 4, i = rho & 15; return 8 * (i >> 2) + 4 * n + (i & 3); }

struct Unit { int pm, pn; };
struct Gemm { const bf16_t* A; const bf16_t* Bt; int M, N, K; };

struct StaticOrder {
    int nM, nN, nwg, G, c;
    __host__ __device__ void init(int M, int N, int G_, int c_) { nM = M / BM; nN = N / BM; nwg = nM * nN; G = G_; c = c_; }
    __host__ __device__ bool next(int i, Unit& u) const {
        const long L = (long)i * G + c; if (L >= nwg) return false;
        int wgid = (int)L; { const int q = nwg / NXCD, r = nwg % NXCD, xcd = wgid % NXCD, off = wgid / NXCD; wgid = (xcd < r ? xcd * (q + 1) : r * (q + 1) + (xcd - r) * q) + off; }
        const int nig = WGM * nN, gid = wgid / nig, fm = gid * WGM, gsz = (nM - fm) < WGM ? (nM - fm) : WGM;
        u.pm = fm + ((wgid % nig) % gsz); u.pn = (wgid % nig) / gsz; return true;
    }
    __device__ __forceinline__ void a_ready(const Unit&) const {}
    __device__ __forceinline__ void done(const Unit&) const {}
};

__device__ __forceinline__ unsigned cvt_pk_bf16(float lo, float hi) { typedef float f2_ __attribute__((ext_vector_type(2))); typedef __bf16 b2_ __attribute__((ext_vector_type(2))); const f2_ v = {lo, hi}; const b2_ b = __builtin_convertvector(v, b2_); return __builtin_bit_cast(unsigned, b); }
typedef float f32x2 __attribute__((ext_vector_type(2)));
constexpr int kNTOK = 32768, kMR = 32896, kSEQ = 8192;
constexpr float kEPS = 1e-6f;
constexpr float kLOG2E = 1.4426950408889634f;
constexpr float kC2Q = 0.10206207261596577f * 1.4426950408889634f;
constexpr float kC2M = 0.125f * 1.4426950408889634f;
typedef unsigned u32x2 __attribute__((ext_vector_type(2)));
__device__ __forceinline__ void st_wt(u32x4* p, u32x4 v) { asm volatile("global_store_dwordx4 %0, %1, off sc0 sc1\n\ts_nop 0" :: "v"(p), "v"(v) : "memory"); }
__device__ __forceinline__ void st_wt(f32x4* p, f32x4 v) { asm volatile("global_store_dwordx4 %0, %1, off sc0 sc1\n\ts_nop 0" :: "v"(p), "v"(v) : "memory"); }
__device__ __forceinline__ void st_wt(u32x2* p, u32x2 v) { asm volatile("global_store_dwordx2 %0, %1, off sc0 sc1\n\ts_nop 0" :: "v"(p), "v"(v) : "memory"); }
#if WT_OUT
#define EPI_ST(T_, ptr_, val_) st_wt((T_*)(ptr_), (val_))
#elif NT_OUT
#define EPI_ST(T_, ptr_, val_) __builtin_nontemporal_store((val_), (T_*)(ptr_))
#else
#define EPI_ST(T_, ptr_, val_) (*(T_*)(ptr_) = (val_))
#endif
#if WT_OB
#define EPI_STOB(T_, ptr_, val_) st_wt((T_*)(ptr_), (val_))
#elif NT_OB
#define EPI_STOB(T_, ptr_, val_) __builtin_nontemporal_store((val_), (T_*)(ptr_))
#else
#define EPI_STOB(T_, ptr_, val_) (*(T_*)(ptr_) = (val_))
#endif
#if NT_Y
#define EPI_STY(T_, ptr_, val_) __builtin_nontemporal_store((val_), (T_*)(ptr_))
#else
#define EPI_STY(T_, ptr_, val_) (*(T_*)(ptr_) = (val_))
#endif
__device__ __forceinline__ int fresh_lane() { int l; asm volatile("v_mbcnt_lo_u32_b32 %0, -1, 0\n\tv_mbcnt_hi_u32_b32 %0, -1, %0" : "=v"(l)); return l; }

__device__ __forceinline__ float sum_fq(float s) {
    { auto t = __builtin_amdgcn_permlane16_swap(__float_as_uint(s), __float_as_uint(s), false, false); s = __uint_as_float(t[0]) + __uint_as_float(t[1]); }
    { auto t = __builtin_amdgcn_permlane32_swap(__float_as_uint(s), __float_as_uint(s), false, false); s = __uint_as_float(t[0]) + __uint_as_float(t[1]); }
    return s;
}
__device__ __forceinline__ float row_inv_from_parts(const float* ssq, int row) {
    return __builtin_amdgcn_rsqf(ssq[row] * (1.0f / 1024.0f) + kEPS);
}
__device__ __forceinline__ float silu_mul(float g, float u) {
    const float e = __builtin_amdgcn_exp2f(-g * kLOG2E);
    return g * __builtin_amdgcn_rcpf(1.0f + e) * u;
}

struct EpiSwiGLU {
    static constexpr bool PERM = true, AFTER_DRAIN = false;
    const float* ssq; bf16_t* act; int ldact;
    __device__ __forceinline__ void operator()(const f32x4 (&acc)[2][2][4][2], const Unit& u, int wr, int wc, int fr_, int fq_) const {
        const int ln_ = fresh_lane(), fr = ln_ & 15, fq = ln_ >> 4; (void)fr_; (void)fq_;
        const int rr0 = wr * 64 + fr;
        const float* sp = ssq + (size_t)(u.pm * BM + rr0);
        bf16_t* ap = act + ((size_t)(u.pm * (ldact >> 6) + u.pn * 2 + (wc >> 1)) * BM + rr0) * BK + (wc & 1) * 32 + 8 * fq;
        f32x4 ones = (f32x4){1.0f, 1.0f, 1.0f, 1.0f}; asm volatile("" : "+v"(ones));
        float ss[2][4];
#pragma unroll
        for (int ai = 0; ai < 2; ++ai)
#pragma unroll
            for (int m = 0; m < 4; ++m) ss[ai][m] = sp[ai * HALF + m * 16];
        asm volatile("" : "+v"(ss[0][0]), "+v"(ss[0][1]), "+v"(ss[0][2]), "+v"(ss[0][3]), "+v"(ss[1][0]), "+v"(ss[1][1]), "+v"(ss[1][2]), "+v"(ss[1][3]));
#pragma unroll
        for (int ai = 0; ai < 2; ++ai)
#pragma unroll
            for (int m = 0; m < 4; ++m) {
                const float inv = __builtin_amdgcn_rsqf(ss[ai][m] * (1.0f / 1024.0f) + kEPS);
                const float a = inv * -kLOG2E, b = inv * inv;
                const f32x4 g0 = acc[ai][0][m][0], g1 = acc[ai][0][m][1];
                const f32x4 t0 = g0 * a, t1 = g1 * a;
                f32x4 e0, e1;
#pragma unroll
                for (int i = 0; i < 4; ++i) { e0[i] = __builtin_amdgcn_exp2f(t0[i]); e1[i] = __builtin_amdgcn_exp2f(t1[i]); }
                const f32x4 d0 = e0 + ones, d1 = e1 + ones;
                f32x4 r0, r1;
#pragma unroll
                for (int i = 0; i < 4; ++i) { r0[i] = __builtin_amdgcn_rcpf(d0[i]); r1[i] = __builtin_amdgcn_rcpf(d1[i]); }
                const f32x4 o0 = (g0 * acc[ai][1][m][0]) * r0 * b, o1 = (g1 * acc[ai][1][m][1]) * r1 * b;
                u32x4 w;
                w.x = cvt_pk_bf16(o0[0], o0[1]); w.y = cvt_pk_bf16(o0[2], o0[3]); w.z = cvt_pk_bf16(o1[0], o1[1]); w.w = cvt_pk_bf16(o1[2], o1[3]);
#if NT_ACT
                __builtin_nontemporal_store(w, (u32x4*)(ap + (ai * HALF + m * 16) * BK));
#else
                *(u32x4*)(ap + (ai * HALF + m * 16) * BK) = w;
#endif
                if (m & 1) asm volatile("" ::: "memory");
            }
    }
};

template <bool BASE_BF16, bool FINAL = false>
struct EpiResid {
    static constexpr bool PERM = true, AFTER_DRAIN = false;
    const void* base0; float* out0; bf16_t* ob; float* ssq_out; float scale;
    __device__ __forceinline__ void operator()(const f32x4 (&acc)[2][2][4][2], const Unit& u, int wr, int wc, int fr_, int fq_) const {
        const int ln_ = fresh_lane(), fr = ln_ & 15, fq = ln_ >> 4; (void)fr_; (void)fq_;
        u32x4 raw[2][4][2];
        if (BASE_BF16) {
#pragma unroll
            for (int ai = 0; ai < 2; ++ai)
#pragma unroll
                for (int m = 0; m < 4; ++m)
#pragma unroll
                    for (int bj = 0; bj < 2; ++bj)
                        raw[ai][m][bj] = *(const u32x4*)((const bf16_t*)base0 + (size_t)(u.pm * BM + ai * HALF + wr * 64 + m * 16 + fr) * 1024 + u.pn * BM + bj * HALF + wc * 32 + 8 * fq);
        }
#pragma unroll
        for (int ai = 0; ai < 2; ++ai) {
            f32x4 bv[BASE_BF16 ? 1 : 4][2][2];
            if (!BASE_BF16) {
#pragma unroll
                for (int m = 0; m < 4; ++m) {
                    const int row = u.pm * BM + ai * HALF + wr * 64 + m * 16 + fr;
#pragma unroll
                    for (int bj = 0; bj < 2; ++bj) { const int col = u.pn * BM + bj * HALF + wc * 32 + 8 * fq;
                        const float* bp = (const float*)base0 + (size_t)row * 1024 + col; bv[m][bj][0] = *(const f32x4*)bp; bv[m][bj][1] = *(const f32x4*)(bp + 4); }
                }
            }
#pragma unroll
            for (int m = 0; m < 4; ++m) {
                const int row = u.pm * BM + ai * HALF + wr * 64 + m * 16 + fr;
                float s = 0.f;
#pragma unroll
                for (int bj = 0; bj < 2; ++bj) {
                    const int col = u.pn * BM + bj * HALF + wc * 32 + 8 * fq;
                    f32x4 b0, b1;
                    if (BASE_BF16) { const u32x4 w = raw[ai][m][bj];
                        b0 = (f32x4){__uint_as_float(w.x << 16), __uint_as_float(w.x & 0xffff0000u), __uint_as_float(w.y << 16), __uint_as_float(w.y & 0xffff0000u)};
                        b1 = (f32x4){__uint_as_float(w.z << 16), __uint_as_float(w.z & 0xffff0000u), __uint_as_float(w.w << 16), __uint_as_float(w.w & 0xffff0000u)}; }
                    else { b0 = bv[BASE_BF16 ? 0 : m][bj][0]; b1 = bv[BASE_BF16 ? 0 : m][bj][1]; }
                    const f32x4 v0 = b0 + acc[ai][bj][m][0] * scale, v1 = b1 + acc[ai][bj][m][1] * scale;
                    if (!FINAL) s += (v0[0] * v0[0] + v0[1] * v0[1]) + (v0[2] * v0[2] + v0[3] * v0[3]) + (v1[0] * v1[0] + v1[1] * v1[1]) + (v1[2] * v1[2] + v1[3] * v1[3]);
                    if (FINAL) { float* op = out0 + (size_t)row * 1024 + col; EPI_STY(f32x4, op, v0); EPI_STY(f32x4, op + 4, v1); }
                    if (!FINAL) { u32x4 w; w.x = cvt_pk_bf16(v0[0], v0[1]); w.y = cvt_pk_bf16(v0[2], v0[3]); w.z = cvt_pk_bf16(v1[0], v1[1]); w.w = cvt_pk_bf16(v1[2], v1[3]);
                        EPI_STOB(u32x4, ob + (size_t)row * 1024 + col, w); }
                }
                if (!FINAL) { s = sum_fq(s);
                if (fq == 0) unsafeAtomicAdd(ssq_out + row, s); }
            }
            asm volatile("" ::: "memory");
        }
    }
};

struct EpiZ {
    static constexpr bool PERM = false, AFTER_DRAIN = false;
    const float* ssq1;
    PG8_LAS float* xch;
    float* msq;
    bf16_t* cqb;
    const float* g_kv; const float* g_kr; const float* g_mq;
    const float* rope;
    float* ckv_p; float* ckv_s; float* kr_p; float* kr_s; float* conv_p; float* conv_s;
    bf16_t* ckvb; bf16_t* krb; bf16_t* Kb; bf16_t* ub; bf16_t* gbb; bf16_t* mqb;
    __device__ __forceinline__ void operator()(const f32x4 (&acc)[2][2][4][2], const Unit& u, int wr, int wc, int fr_, int fq_) const {
        const int ln_ = fresh_lane(), fr = ln_ & 15, fq = ln_ >> 4; (void)fr_; (void)fq_;
        const int pn = u.pn;
        float inv1[2][4]; int rows[2][4];
#pragma unroll
        for (int ai = 0; ai < 2; ++ai)
#pragma unroll
            for (int m = 0; m < 4; ++m) { rows[ai][m] = u.pm * BM + ai * HALF + wr * 64 + m * 16 + fr; inv1[ai][m] = row_inv_from_parts(ssq1, rows[ai][m]); }
        if (pn == 0 || pn == 1) {
#pragma unroll
            for (int ai = 0; ai < 2; ++ai)
#pragma unroll
                for (int m = 0; m < 4; ++m) {
                    float s = 0.f; const float iv = inv1[ai][m];
#pragma unroll
                    for (int bj = 0; bj < 2; ++bj) { if (pn == 1 && bj == 1) continue;
#pragma unroll
                        for (int n = 0; n < 2; ++n) { const f32x4 v = acc[ai][bj][m][n] * iv; s += (v[0] * v[0] + v[1] * v[1]) + (v[2] * v[2] + v[3] * v[3]); } }
                    s += __shfl_xor(s, 16); s += __shfl_xor(s, 32);
                    if (fq == 0) xch[(ai * HALF + wr * 64 + m * 16 + fr) * 4 + wc] = s;
                }
            asm volatile("s_waitcnt lgkmcnt(0)" ::: "memory"); __builtin_amdgcn_s_barrier(); asm volatile("" ::: "memory");
        }
        if (pn == 0) {
#pragma unroll
            for (int ai = 0; ai < 2; ++ai)
#pragma unroll
                for (int m = 0; m < 4; ++m) {
                    const int row = rows[ai][m]; const float iv = inv1[ai][m];
                    const f32x4 t = *(const PG8_LAS f32x4*)(xch + (ai * HALF + wr * 64 + m * 16 + fr) * 4);
                    if (wc == 0 && fq == 0 && row < kMR) msq[row] = ((t[0] + t[1]) + (t[2] + t[3])) * (1.0f / 256.0f);
                    if (row < kMR) {
#pragma unroll
                        for (int bj = 0; bj < 2; ++bj)
#pragma unroll
                            for (int n = 0; n < 2; ++n) { const f32x4 v = acc[ai][bj][m][n] * iv; u32x2 w; w.x = cvt_pk_bf16(v[0], v[1]); w.y = cvt_pk_bf16(v[2], v[3]);
                                EPI_ST(u32x2, cqb + (size_t)row * 256 + bj * HALF + wc * 32 + n * 16 + 4 * fq, w); }
                    }
                }
        } else if (pn == 1) {
            f32x4 gkv[2];
#pragma unroll
            for (int n = 0; n < 2; ++n) gkv[n] = *(const f32x4*)(g_kv + wc * 32 + n * 16 + 4 * fq);
            const f32x4 ga = *(const f32x4*)(g_kr + 4 * fq), gb = *(const f32x4*)(g_kr + 16 + 4 * fq);
#pragma unroll
            for (int ai = 0; ai < 2; ++ai) {
#pragma unroll
              for (int mh = 0; mh < 2; ++mh) {
                f32x4 cs[2], sn[2];
                if (wc == 0) {
#pragma unroll
                    for (int mm = 0; mm < 2; ++mm) { const int pos = rows[ai][2 * mh + mm] & (kSEQ - 1); cs[mm] = *(const f32x4*)(rope + (size_t)pos * 32 + 4 * fq); sn[mm] = *(const f32x4*)(rope + (size_t)pos * 32 + 16 + 4 * fq); }
                }
#pragma unroll
                for (int mm = 0; mm < 2; ++mm) { const int m = 2 * mh + mm;
                    const int row = rows[ai][m]; const float iv = inv1[ai][m];
                    const f32x4 t = *(const PG8_LAS f32x4*)(xch + (ai * HALF + wr * 64 + m * 16 + fr) * 4);
                    const float ic = __builtin_amdgcn_rsqf(((t[0] + t[1]) + (t[2] + t[3])) * (1.0f / 128.0f) + kEPS);
#pragma unroll
                    for (int n = 0; n < 2; ++n) {
                        const int c = wc * 32 + n * 16 + 4 * fq;
                        const f32x4 v = acc[ai][0][m][n] * (iv * ic) * gkv[n];
                        EPI_ST(f32x4, ckv_p + (size_t)row * 128 + c, v);
                        u32x2 w; w.x = cvt_pk_bf16(v[0], v[1]); w.y = cvt_pk_bf16(v[2], v[3]);
                        EPI_ST(u32x2, ckvb + (size_t)row * 128 + c, w);
                    }
                    if (wc == 0) {
                        const f32x4 a = acc[ai][1][m][0] * iv, b = acc[ai][1][m][1] * iv;
                        float s = (a[0] * a[0] + a[1] * a[1]) + (a[2] * a[2] + a[3] * a[3]) + (b[0] * b[0] + b[1] * b[1]) + (b[2] * b[2] + b[3] * b[3]);
                        s += __shfl_xor(s, 16); s += __shfl_xor(s, 32);
                        const float ik = __builtin_amdgcn_rsqf(s * (1.0f / 32.0f) + kEPS);
                        const f32x4 x1 = a * ik * ga, x2 = b * ik * gb;
                        const f32x4 o1 = x1 * cs[mm] - x2 * sn[mm], o2 = x1 * sn[mm] + x2 * cs[mm];
                        float* kro = kr_p + (size_t)row * 32;
                        *(f32x4*)(kro + 4 * fq) = o1; *(f32x4*)(kro + 16 + 4 * fq) = o2;
                        u32x2 w1, w2; w1.x = cvt_pk_bf16(o1[0], o1[1]); w1.y = cvt_pk_bf16(o1[2], o1[3]); w2.x = cvt_pk_bf16(o2[0], o2[1]); w2.y = cvt_pk_bf16(o2[2], o2[3]);
                        *(u32x2*)(krb + (size_t)row * 32 + 4 * fq) = w1; *(u32x2*)(krb + (size_t)row * 32 + 16 + 4 * fq) = w2;
                    }
                }
                asm volatile("" ::: "memory");
              }
            }
        } else if (pn == 2 || pn == 3) {
#pragma unroll
            for (int ai = 0; ai < 2; ++ai)
#pragma unroll
                for (int m = 0; m < 4; ++m) {
                    const int row = rows[ai][m]; const float iv = inv1[ai][m];
                    if (row >= kMR) continue;
                    const bool smp = row >= kNTOK; const int t_ = row & (kSEQ - 1), b_ = row >> 13;
#pragma unroll
                    for (int n = 0; n < 2; ++n) {
                        const int c = (pn - 2) * 128 + wc * 32 + n * 16 + 4 * fq;
                        const f32x4 v = (acc[ai][0][m][n] * iv) * (acc[ai][1][m][n] * iv);
                        u32x2 w; w.x = cvt_pk_bf16(v[0], v[1]); w.y = cvt_pk_bf16(v[2], v[3]);
                        EPI_ST(u32x2, ub + (size_t)row * 256 + c, w);
                        if (smp) *(f32x4*)(conv_s + (size_t)(row - kNTOK) * 512 + 256 + c) = v;
                        else if (t_ >= kSEQ - 2) *(f32x4*)(conv_p + (size_t)(b_ * 2 + (t_ - (kSEQ - 2))) * 256 + c) = v;
                    }
                }
        } else if (pn == 4) {
#pragma unroll
            for (int ai = 0; ai < 2; ++ai)
#pragma unroll
                for (int m = 0; m < 4; ++m) {
                    const int row = rows[ai][m]; const float iv = inv1[ai][m];
                    if (row >= kMR) continue;
#pragma unroll
                    for (int bj = 0; bj < 2; ++bj)
#pragma unroll
                        for (int n = 0; n < 2; ++n) { const f32x4 v = acc[ai][bj][m][n] * iv; u32x2 w; w.x = cvt_pk_bf16(v[0], v[1]); w.y = cvt_pk_bf16(v[2], v[3]);
                            EPI_ST(u32x2, gbb + (size_t)row * 256 + bj * HALF + wc * 32 + n * 16 + 4 * fq, w); }
                }
        } else {
            f32x4 gmq[2][2];
#pragma unroll
            for (int bj = 0; bj < 2; ++bj)
#pragma unroll
                for (int n = 0; n < 2; ++n) gmq[bj][n] = *(const f32x4*)(g_mq + bj * 32 + n * 16 + 4 * fq);
#pragma unroll
            for (int ai = 0; ai < 2; ++ai)
#pragma unroll
                for (int m = 0; m < 4; ++m) {
                    const int row = rows[ai][m]; const float iv = inv1[ai][m];
                    float s = 0.f;
#pragma unroll
                    for (int bj = 0; bj < 2; ++bj)
#pragma unroll
                        for (int n = 0; n < 2; ++n) { const f32x4 v = acc[ai][bj][m][n] * iv; s += (v[0] * v[0] + v[1] * v[1]) + (v[2] * v[2] + v[3] * v[3]); }
                    s += __shfl_xor(s, 16); s += __shfl_xor(s, 32);
                    const float im = __builtin_amdgcn_rsqf(s * (1.0f / 64.0f) + kEPS) * kC2M;
                    if (row >= kMR) continue;
#pragma unroll
                    for (int bj = 0; bj < 2; ++bj)
#pragma unroll
                        for (int n = 0; n < 2; ++n) { const int d = bj * 32 + n * 16 + 4 * fq;
                            const f32x4 v = acc[ai][bj][m][n] * (iv * im) * gmq[bj][n]; u32x2 w; w.x = cvt_pk_bf16(v[0], v[1]); w.y = cvt_pk_bf16(v[2], v[3]);
                            EPI_ST(u32x2, mqb + (size_t)row * 256 + wc * 64 + d, w); }
                }
        }
    }
};

struct EpiQ {
    static constexpr bool PERM = false, AFTER_DRAIN = false;
    const float* msq; const float* g_qn; const float* g_qr; const float* rope; bf16_t* qb;
    __device__ __forceinline__ void operator()(const f32x4 (&acc)[2][2][4][2], const Unit& u, int wr, int wc, int fr_, int fq_) const {
        const int ln_ = fresh_lane(), fr = ln_ & 15, fq = ln_ >> 4; (void)fr_; (void)fq_;
        const int pn = u.pn;
        float epsq[2][4];
#pragma unroll
        for (int ai = 0; ai < 2; ++ai)
#pragma unroll
            for (int m = 0; m < 4; ++m) epsq[ai][m] = kEPS * (msq[u.pm * BM + ai * HALF + wr * 64 + m * 16 + fr] + kEPS);
        if (pn < 2) {
            const int head = 4 * pn + wc;
            f32x4 g[2][2];
#pragma unroll
            for (int bj = 0; bj < 2; ++bj)
#pragma unroll
                for (int n = 0; n < 2; ++n) g[bj][n] = *(const f32x4*)(g_qn + bj * 32 + n * 16 + 4 * fq);
#pragma unroll
            for (int ai = 0; ai < 2; ++ai) {
#pragma unroll
                for (int m = 0; m < 4; ++m) {
                    const int row = u.pm * BM + ai * HALF + wr * 64 + m * 16 + fr; float s = 0.f;
#pragma unroll
                    for (int bj = 0; bj < 2; ++bj)
#pragma unroll
                        for (int n = 0; n < 2; ++n) { const f32x4 v = acc[ai][bj][m][n]; s += (v[0] * v[0] + v[1] * v[1]) + (v[2] * v[2] + v[3] * v[3]); }
                    s += __shfl_xor(s, 16); s += __shfl_xor(s, 32);
                    const float rs = __builtin_amdgcn_rsqf(s * (1.0f / 64.0f) + epsq[ai][m]) * kC2Q;
#pragma unroll
                    for (int bj = 0; bj < 2; ++bj)
#pragma unroll
                        for (int n = 0; n < 2; ++n) { const int d = bj * 32 + n * 16 + 4 * fq;
                            const f32x4 v = acc[ai][bj][m][n] * rs * g[bj][n]; u32x2 w; w.x = cvt_pk_bf16(v[0], v[1]); w.y = cvt_pk_bf16(v[2], v[3]);
                            EPI_ST(u32x2, qb + (size_t)row * 768 + head * 96 + d, w); }
                }
                asm volatile("" ::: "memory");
            }
        } else {
            const f32x4 ga = *(const f32x4*)(g_qr + 4 * fq), gb = *(const f32x4*)(g_qr + 16 + 4 * fq);
#pragma unroll
            for (int ai = 0; ai < 2; ++ai) {
                f32x4 cs[4], sn[4];
#pragma unroll
                for (int m = 0; m < 4; ++m) { const int row = u.pm * BM + ai * HALF + wr * 64 + m * 16 + fr; const int pos = row & (kSEQ - 1);
                    cs[m] = *(const f32x4*)(rope + (size_t)pos * 32 + 4 * fq); sn[m] = *(const f32x4*)(rope + (size_t)pos * 32 + 16 + 4 * fq); }
#pragma unroll
                for (int m = 0; m < 4; ++m) {
                    const int row = u.pm * BM + ai * HALF + wr * 64 + m * 16 + fr;
#pragma unroll
                    for (int bj = 0; bj < 2; ++bj) {
                        const int head = 4 * bj + wc;
                        const f32x4 a = acc[ai][bj][m][0], b = acc[ai][bj][m][1];
                        float s = (a[0] * a[0] + a[1] * a[1]) + (a[2] * a[2] + a[3] * a[3]) + (b[0] * b[0] + b[1] * b[1]) + (b[2] * b[2] + b[3] * b[3]);
                        s += __shfl_xor(s, 16); s += __shfl_xor(s, 32);
                        const float rs = __builtin_amdgcn_rsqf(s * (1.0f / 32.0f) + epsq[ai][m]);
                        const f32x4 x1 = a * rs * ga, x2 = b * rs * gb;
                        const f32x4 o1 = (x1 * cs[m] - x2 * sn[m]) * kC2Q, o2 = (x1 * sn[m] + x2 * cs[m]) * kC2Q;
                        u32x2 w1, w2; w1.x = cvt_pk_bf16(o1[0], o1[1]); w1.y = cvt_pk_bf16(o1[2], o1[3]); w2.x = cvt_pk_bf16(o2[0], o2[1]); w2.y = cvt_pk_bf16(o2[2], o2[3]);
                        EPI_ST(u32x2, qb + (size_t)row * 768 + head * 96 + 64 + 4 * fq, w1); EPI_ST(u32x2, qb + (size_t)row * 768 + head * 96 + 80 + 4 * fq, w2);
                    }
                }
                asm volatile("" ::: "memory");
            }
        }
    }
};

struct EpiKV {
    static constexpr bool PERM = false, AFTER_DRAIN = false;
    const float* g_kn; bf16_t* Kb; bf16_t* Vb;
    __device__ __forceinline__ void operator()(const f32x4 (&acc)[2][2][4][2], const Unit& u, int wr, int wc, int fr_, int fq_) const {
        const int ln_ = fresh_lane(), fr = ln_ & 15, fq = ln_ >> 4; (void)fr_; (void)fq_;
        const int pn = u.pn;
        f32x4 gk[2][2];
#pragma unroll
        for (int bj = 0; bj < 2; ++bj)
#pragma unroll
            for (int n = 0; n < 2; ++n) gk[bj][n] = *(const f32x4*)(g_kn + bj * 32 + n * 16 + 4 * fq);
#pragma unroll
        for (int ai = 0; ai < 2; ++ai)
#pragma unroll
            for (int m = 0; m < 4; ++m) {
                const int row = u.pm * BM + ai * HALF + wr * 64 + m * 16 + fr;
                const int b_ = row >> 13, t_ = row & (kSEQ - 1);
                if (pn < 2) {
                    const int head = 4 * pn + wc; float s = 0.f;
#pragma unroll
                    for (int bj = 0; bj < 2; ++bj)
#pragma unroll
                        for (int n = 0; n < 2; ++n) { const f32x4 v = acc[ai][bj][m][n]; s += (v[0] * v[0] + v[1] * v[1]) + (v[2] * v[2] + v[3] * v[3]); }
                    s += __shfl_xor(s, 16); s += __shfl_xor(s, 32);
                    const float rs = __builtin_amdgcn_rsqf(s * (1.0f / 64.0f) + kEPS);
                    bf16_t* kp = Kb + ((size_t)(b_ * 8 + head) * kSEQ + t_) * 64;
#pragma unroll
                    for (int bj = 0; bj < 2; ++bj)
#pragma unroll
                        for (int n = 0; n < 2; ++n) { const int d = bj * 32 + n * 16 + 4 * fq;
                            const f32x4 v = acc[ai][bj][m][n] * rs * gk[bj][n]; u32x2 w; w.x = cvt_pk_bf16(v[0], v[1]); w.y = cvt_pk_bf16(v[2], v[3]);
                            EPI_ST(u32x2, kp + d, w); }
                } else {
#pragma unroll
                    for (int bj = 0; bj < 2; ++bj)
#pragma unroll
                        for (int n = 0; n < 2; ++n) { const int c = (pn - 2) * 256 + bj * HALF + wc * 32 + n * 16 + 4 * fq; const int head = c >> 6, d = c & 63;
                            const f32x4 v = acc[ai][bj][m][n]; u32x2 w; w.x = cvt_pk_bf16(v[0], v[1]); w.y = cvt_pk_bf16(v[2], v[3]);
                            EPI_ST(u32x2, Vb + ((size_t)(b_ * 8 + head) * kSEQ + t_) * 64 + d, w); }
                }
                if (m == 3) asm volatile("" ::: "memory");
            }
    }
};

struct EpiMem {
    static constexpr bool PERM = false, AFTER_DRAIN = false;
    const float* ssqm; const float* g_mk; float* mk_out; float* mv_out; bf16_t* mKb; bf16_t* mVb;
    __device__ __forceinline__ void operator()(const f32x4 (&acc)[2][2][4][2], const Unit& u, int wr, int wc, int fr_, int fq_) const {
        const int ln_ = fresh_lane(), fr = ln_ & 15, fq = ln_ >> 4; (void)fr_; (void)fq_;
        const int pn = u.pn;
#pragma unroll
        for (int ai = 0; ai < 2; ++ai)
#pragma unroll
            for (int m = 0; m < 4; ++m) {
                const int row = u.pm * BM + ai * HALF + wr * 64 + m * 16 + fr;
                const float iv = row_inv_from_parts(ssqm, row);
                const int b_ = row >> 8, n_ = row & 255;
                if (pn == 0) {
                    const int head = wc; float s = 0.f;
#pragma unroll
                    for (int bj = 0; bj < 2; ++bj)
#pragma unroll
                        for (int n = 0; n < 2; ++n) { const f32x4 v = acc[ai][bj][m][n] * iv; s += (v[0] * v[0] + v[1] * v[1]) + (v[2] * v[2] + v[3] * v[3]); }
                    s += __shfl_xor(s, 16); s += __shfl_xor(s, 32);
                    const float rs = __builtin_amdgcn_rsqf(s * (1.0f / 64.0f) + kEPS);
#pragma unroll
                    for (int bj = 0; bj < 2; ++bj)
#pragma unroll
                        for (int n = 0; n < 2; ++n) { const int d = bj * 32 + n * 16 + 4 * fq; const f32x4 g = *(const f32x4*)(g_mk + d);
                            const f32x4 v = acc[ai][bj][m][n] * (iv * rs) * g;
                            *(f32x4*)(mk_out + (size_t)row * 256 + head * 64 + d) = v;
                            u32x2 w; w.x = cvt_pk_bf16(v[0], v[1]); w.y = cvt_pk_bf16(v[2], v[3]);
                            *(u32x2*)(mKb + ((size_t)(b_ * 4 + head) * 256 + n_) * 64 + d) = w; }
                } else {
#pragma unroll
                    for (int bj = 0; bj < 2; ++bj)
#pragma unroll
                        for (int n = 0; n < 2; ++n) { const int c = bj * HALF + wc * 32 + n * 16 + 4 * fq; const int head = c >> 6, d = c & 63;
                            const f32x4 v = acc[ai][bj][m][n] * iv;
                            *(f32x4*)(mv_out + (size_t)row * 256 + c) = v;
                            u32x2 w; w.x = cvt_pk_bf16(v[0], v[1]); w.y = cvt_pk_bf16(v[2], v[3]);
                            *(u32x2*)(mVb + ((size_t)(b_ * 4 + head) * 256 + n_) * 64 + d) = w; }
                }
                asm volatile("" ::: "memory");
            }
    }
};
template <class Epi, class Sched, bool ALIGN_EPI = false, bool SP2 = false, bool ABLK = false, int KD = 1>
__device__ __forceinline__ void gemm_phase(PG8_LAS unsigned char* lds, const Gemm g, const Sched& S, const Epi& E) {
    int tid_ = threadIdx.x; asm volatile("" : "+v"(tid_));
    const int tid = tid_, wid = __builtin_amdgcn_readfirstlane(tid >> 6), lane = tid & 63, wr = wid >> 2, wc = wid & 3, fr = lane & 15, fq = lane >> 4;
    const int K = g.K, nt = K / BK;
    unsigned voffA[2], voffB[2];
#pragma unroll
    for (int i = 0; i < 2; ++i) { int R, C; stage_rc(tid * 16 + i * 8192, R, C); const int Rb = Epi::PERM ? ((R & ~31) + perm32(R & 31)) : R;
        voffA[i] = ABLK ? (unsigned)(R * BK + C) * 2u : (unsigned)(R * K + C) * 2u; voffB[i] = (unsigned)(Rb * K + C) * 2u; }
    const size_t kstep = (size_t)(BK * 2);
    const size_t hstep = (size_t)HALF * K * 2;
    const size_t tstep = 2 * hstep;
    const size_t kstepA = ABLK ? (size_t)(BM * BK * 2) : kstep, hstepA = ABLK ? (size_t)(HALF * BK * 2) : hstep, tstepA = ABLK ? (size_t)nt * (BM * BK * 2) : tstep;
    const unsigned ldsw = (unsigned)wid * 1024u;
    const int aoff = lds_byte(wr * 64 + fr, fq * 8), boff = lds_byte(wc * 32 + fr, fq * 8);
#define PG8_SA(b, h) (((b) * 2 + (h)) * HTB)
#define PG8_SB(b, h) ((4 + (b) * 2 + (h)) * HTB)
#define PG8_STAGE(bufoff, gbase, voff) do { _Pragma("unroll") for (int _i = 0; _i < 2; ++_i) \
        __builtin_amdgcn_global_load_lds((const unsigned*)((const char*)(gbase) + (voff)[_i]), (PG8_LAS unsigned*)(lds + (bufoff) + ldsw + _i * 8192), 16, 0, 0); } while (0)
#define PG8_LDA(dst, b, h) do { _Pragma("unroll") for (int m = 0; m < 4; ++m) _Pragma("unroll") for (int k = 0; k < 2; ++k) dst[m][k] = *(const PG8_LAS bf16x8*)(lds + PG8_SA(b, h) + aoff + m * 2048 + k * 1024); } while (0)
#define PG8_LDB(dst, b, h) do { _Pragma("unroll") for (int n = 0; n < 2; ++n) _Pragma("unroll") for (int k = 0; k < 2; ++k) dst[n][k] = *(const PG8_LAS bf16x8*)(lds + PG8_SB(b, h) + boff + n * 2048 + k * 1024); } while (0)
#define PG8_MMA(ai, bj, At, Bt) do { __builtin_amdgcn_s_setprio(1); _Pragma("unroll") for (int m = 0; m < 4; ++m) _Pragma("unroll") for (int n = 0; n < 2; ++n) _Pragma("unroll") for (int k = 0; k < 2; ++k) \
        acc[ai][bj][m][n] = __builtin_amdgcn_mfma_f32_16x16x32_bf16(Bt[n][k], At[m][k], acc[ai][bj][m][n], 0, 0, 0); __builtin_amdgcn_s_setprio(0); } while (0)
#define PG8_WAIT_V(n) asm volatile("s_waitcnt vmcnt(" #n ")" ::: "memory")
#define PG8_WAIT_L(n) asm volatile("s_waitcnt lgkmcnt(" #n ")" ::: "memory")
#define PG8_BAR __builtin_amdgcn_s_barrier()
#define PG8_SCHED __builtin_amdgcn_sched_barrier(0)
    Unit cur, nxt; int ui = 0;
    if (!S.next(0, cur)) return;
    f32x4 acc[2][2][4][2];
#pragma unroll
    for (int a = 0; a < 2; ++a)
#pragma unroll
        for (int b = 0; b < 2; ++b)
#pragma unroll
            for (int m = 0; m < 4; ++m)
#pragma unroll
                for (int n = 0; n < 2; ++n) acc[a][b][m][n] = (f32x4){0.f, 0.f, 0.f, 0.f};
    bf16x8 At[4][2], B0[2][2], B1[2][2];
    const char* cA = (const char*)g.A + (size_t)cur.pm * tstepA; const char* cB = (const char*)g.Bt + (size_t)cur.pn * tstep;
    S.a_ready(cur);
    if constexpr (SP2) {
        PG8_STAGE(PG8_SB(0, 0), cB, voffB); PG8_STAGE(PG8_SB(0, 1), cB + hstep, voffB); PG8_STAGE(PG8_SA(0, 0), cA, voffA); PG8_STAGE(PG8_SA(0, 1), cA + hstepA, voffA);
        if (wr == 1) PG8_BAR;
        PG8_WAIT_V(2); PG8_BAR;
        PG8_STAGE(PG8_SB(1, 0), cB + kstep, voffB); PG8_STAGE(PG8_SA(1, 0), cA + kstepA, voffA); PG8_STAGE(PG8_SB(1, 1), cB + hstep + kstep, voffB);
        PG8_WAIT_V(6); PG8_BAR;
    } else {
        PG8_STAGE(PG8_SB(0, 0), cB, voffB); PG8_STAGE(PG8_SA(0, 0), cA, voffA); PG8_STAGE(PG8_SB(0, 1), cB + hstep, voffB); PG8_STAGE(PG8_SA(0, 1), cA + hstepA, voffA);
        if (wr == 1) PG8_BAR;
        PG8_WAIT_V(4); PG8_BAR;
        PG8_STAGE(PG8_SB(1, 0), cB + kstep, voffB); PG8_STAGE(PG8_SA(1, 0), cA + kstepA, voffA); PG8_STAGE(PG8_SB(1, 1), cB + hstep + kstep, voffB);
        PG8_WAIT_V(6); PG8_BAR;
    }
    for (;;) {
        const bool has_next = S.next(ui + 1, nxt);
        const char* nA = has_next ? (const char*)g.A + (size_t)nxt.pm * tstepA : cA; const char* nB = has_next ? (const char*)g.Bt + (size_t)nxt.pn * tstep : cB;
        for (int kd = 0; kd < KD; ++kd) {
        const bool fin = (kd == KD - 1);
        const char* nA_ = fin ? nA : cA; const char* nB_ = fin ? nB : cB;
        for (int t = 0; t < nt; t += 2) {
            const bool last = (t == nt - 2);
            const char* a1 = cA + (size_t)(t + 1) * kstepA;
            const char* a2 = last ? nA_ : cA + (size_t)(t + 2) * kstepA; const char* b2 = last ? nB_ : cB + (size_t)(t + 2) * kstep;
            const char* a3 = a2 + kstepA; const char* b3 = b2 + kstep;
            if (last && has_next && fin) S.a_ready(nxt);
            if constexpr (SP2) {
            PG8_LDB(B0, 0, 0); PG8_LDB(B1, 0, 1); PG8_SCHED; PG8_LDA(At, 0, 0); PG8_STAGE(PG8_SA(1, 1), a1 + hstepA, voffA);
            PG8_WAIT_V(8); PG8_WAIT_L(0); PG8_BAR; PG8_MMA(0, 0, At, B0); PG8_MMA(0, 1, At, B1); PG8_BAR; PG8_SCHED;
#if PG8_AMID
            PG8_LDA(At, 0, 1); PG8_STAGE(PG8_SB(0, 0), b2, voffB); PG8_STAGE(PG8_SB(0, 1), b2 + hstep, voffB);
            PG8_WAIT_V(6); PG8_WAIT_L(0); PG8_BAR; PG8_MMA(1, 0, At, B0); PG8_SCHED; PG8_STAGE(PG8_SA(0, 0), a2, voffA); PG8_SCHED; PG8_MMA(1, 1, At, B1); PG8_BAR; PG8_SCHED;
#else
            PG8_LDA(At, 0, 1); PG8_STAGE(PG8_SB(0, 0), b2, voffB); PG8_STAGE(PG8_SB(0, 1), b2 + hstep, voffB); PG8_STAGE(PG8_SA(0, 0), a2, voffA);
            PG8_WAIT_V(8); PG8_WAIT_L(0); PG8_BAR; PG8_MMA(1, 0, At, B0); PG8_MMA(1, 1, At, B1); PG8_BAR; PG8_SCHED;
#endif
            PG8_LDB(B0, 1, 0); PG8_LDB(B1, 1, 1); PG8_SCHED; PG8_LDA(At, 1, 0); PG8_STAGE(PG8_SA(0, 1), a2 + hstepA, voffA);
            PG8_WAIT_V(8); PG8_WAIT_L(0); PG8_BAR; PG8_MMA(0, 0, At, B0); PG8_MMA(0, 1, At, B1); PG8_BAR; PG8_SCHED;
#if PG8_AMID
            PG8_LDA(At, 1, 1); PG8_STAGE(PG8_SB(1, 0), b3, voffB); PG8_STAGE(PG8_SB(1, 1), b3 + hstep, voffB);
            PG8_WAIT_V(6); PG8_WAIT_L(0); PG8_BAR; PG8_MMA(1, 0, At, B0); PG8_SCHED; PG8_STAGE(PG8_SA(1, 0), a3, voffA); PG8_SCHED; PG8_MMA(1, 1, At, B1); PG8_BAR; PG8_SCHED;
#else
            PG8_LDA(At, 1, 1); PG8_STAGE(PG8_SB(1, 0), b3, voffB); PG8_STAGE(PG8_SB(1, 1), b3 + hstep, voffB); PG8_STAGE(PG8_SA(1, 0), a3, voffA);
            PG8_WAIT_V(8); PG8_WAIT_L(0); PG8_BAR; PG8_MMA(1, 0, At, B0); PG8_MMA(1, 1, At, B1); PG8_BAR; PG8_SCHED;
#endif
            } else {
            PG8_LDB(B0, 0, 0); PG8_SCHED; PG8_LDA(At, 0, 0); PG8_STAGE(PG8_SA(1, 1), a1 + hstepA, voffA);
            PG8_WAIT_L(8); PG8_BAR; PG8_WAIT_L(0); PG8_MMA(0, 0, At, B0); PG8_BAR; PG8_SCHED;
            PG8_LDB(B1, 0, 1); PG8_STAGE(PG8_SB(0, 0), b2, voffB);
            PG8_BAR; PG8_WAIT_L(0); PG8_MMA(0, 1, At, B1); PG8_BAR;
            PG8_LDA(At, 0, 1); PG8_STAGE(PG8_SA(0, 0), a2, voffA);
            PG8_BAR; PG8_WAIT_L(0); PG8_MMA(1, 0, At, B0); PG8_BAR; PG8_SCHED;
            PG8_STAGE(PG8_SB(0, 1), b2 + hstep, voffB);
            PG8_WAIT_V(6); PG8_BAR; PG8_MMA(1, 1, At, B1); PG8_BAR;
            PG8_LDB(B0, 1, 0); PG8_SCHED; PG8_LDA(At, 1, 0); PG8_STAGE(PG8_SA(0, 1), a2 + hstepA, voffA);
            PG8_WAIT_L(8); PG8_BAR; PG8_WAIT_L(0); PG8_MMA(0, 0, At, B0); PG8_BAR; PG8_SCHED;
            PG8_LDB(B1, 1, 1); PG8_STAGE(PG8_SB(1, 0), b3, voffB);
            PG8_BAR; PG8_WAIT_L(0); PG8_MMA(0, 1, At, B1); PG8_BAR;
            PG8_LDA(At, 1, 1); PG8_STAGE(PG8_SA(1, 0), a3, voffA);
            PG8_BAR; PG8_WAIT_L(0); PG8_MMA(1, 0, At, B0); PG8_BAR; PG8_SCHED;
            PG8_STAGE(PG8_SB(1, 1), b3 + hstep, voffB);
            PG8_WAIT_V(6); PG8_BAR; PG8_MMA(1, 1, At, B1); PG8_BAR;
            }
        }
        if (KD > 1 && !fin) {
#pragma unroll
            for (int a = 0; a < 2; ++a)
#pragma unroll
                for (int b = 0; b < 2; ++b)
#pragma unroll
                    for (int m = 0; m < 4; ++m)
#pragma unroll
                        for (int n = 0; n < 2; ++n) { asm volatile("" :: "v"(acc[a][b][m][n])); acc[a][b][m][n] = (f32x4){0.f, 0.f, 0.f, 0.f}; }
        }
        }
        if constexpr (ALIGN_EPI) { if (wr == 0) PG8_BAR; }
        if constexpr (!Epi::AFTER_DRAIN) { E(acc, cur, wr, wc, fr, fq); S.done(cur); }
        if (!has_next) break;
#pragma unroll
        for (int a = 0; a < 2; ++a)
#pragma unroll
            for (int b = 0; b < 2; ++b)
#pragma unroll
                for (int m = 0; m < 4; ++m)
#pragma unroll
                    for (int n = 0; n < 2; ++n) acc[a][b][m][n] = (f32x4){0.f, 0.f, 0.f, 0.f};
        cur = nxt; cA = nA; cB = nB; ++ui;
        if constexpr (ALIGN_EPI) { if (wr == 1) PG8_BAR; }
    }
    PG8_WAIT_V(0);
    if constexpr (!ALIGN_EPI) { if (wr == 0) PG8_BAR; }
    PG8_BAR;
    if constexpr (Epi::AFTER_DRAIN) { E.fused(acc, cur, wr, wc, fr, fq, lds, wid, lane); S.done(cur); }
#undef PG8_SA
#undef PG8_SB
#undef PG8_STAGE
#undef PG8_LDA
#undef PG8_LDB
#undef PG8_MMA
#undef PG8_WAIT_V
#undef PG8_WAIT_L
#undef PG8_BAR
#undef PG8_SCHED
}
}
#define LAS __attribute__((address_space(3)))
#define XB_TMO      128
#define XB_XCNT(j)  (256  + 64 * (j))
#define XB_XSUB(j)  (1280 + 64 * (j))
#define XB_XGEN(j)  (2304 + 64 * (j))
#define XB_TOP      3328
#define XB_TOPGEN   3392
#define XCD_BAR_WORDS 3456
#define XB_SPIN_CAP (1u << 25)

__device__ __forceinline__ unsigned xb_ld(unsigned* p)              { return __hip_atomic_load(p, __ATOMIC_RELAXED, __HIP_MEMORY_SCOPE_AGENT); }
__device__ __forceinline__ unsigned xb_add(unsigned* p, unsigned v) { return __hip_atomic_fetch_add(p, v, __ATOMIC_RELAXED, __HIP_MEMORY_SCOPE_AGENT); }
__device__ __forceinline__ unsigned xb_xcc_id() { return (unsigned)__builtin_amdgcn_s_getreg((3 << 11) | 20) & 0xFu; }
#define XB_SPIN(cond, bar) do { unsigned _sp = 0; while (cond) { __builtin_amdgcn_s_sleep(1); \
    if ((++_sp & 255u) == 0u) { if (xb_ld(&(bar)[XB_TMO])) break; if (_sp > XB_SPIN_CAP) { atomicAdd(&(bar)[XB_TMO], 1u); break; } } } } while (0)

struct XcdBarrier {
    unsigned* bar; unsigned x;
    volatile LAS unsigned* st;
};

__device__ __forceinline__ XcdBarrier xcd_barrier_post(unsigned* bar, volatile LAS unsigned* st) {
    XcdBarrier b; b.bar = bar; b.x = xb_xcc_id(); b.st = st;
    if (threadIdx.x == 0) (void)xb_add(&bar[XB_XCNT(b.x)], 1u);
    return b;
}
__device__ __forceinline__ void xcd_barrier_complete(unsigned* bar, unsigned x, unsigned& nloc, unsigned& nx) {
    const unsigned G = gridDim.x * gridDim.y * gridDim.z;
    unsigned sum, cnt, mine, sp = 0u;
    for (;;) {
        sum = 0u; cnt = 0u; mine = 0u;
#pragma unroll
        for (unsigned j = 0; j < 16; ++j) { const unsigned c = xb_ld(&bar[XB_XCNT(j)]); sum += c; cnt += (c > 0u) ? 1u : 0u; mine = (j == x) ? c : mine; }
        if (sum == G) break;
        __builtin_amdgcn_s_sleep(1);
        if ((++sp & 255u) == 0u) { if (xb_ld(&bar[XB_TMO])) break; if (sp > XB_SPIN_CAP) { atomicAdd(&bar[XB_TMO], 1u); break; } }
    }
    nloc = mine > 0u ? mine : 1u; nx = cnt > 0u ? cnt : 1u;
}

__device__ __forceinline__ void xcd_barrier(const XcdBarrier& b) {
    asm volatile("s_waitcnt vmcnt(0)" ::: "memory");
    __syncthreads();
    if (threadIdx.x == 0) {
        unsigned* bar = b.bar;
        __builtin_amdgcn_s_waitcnt(0);
        unsigned nloc = b.st[0], nx = b.st[1];
        if (nloc == 0u) { xcd_barrier_complete(bar, b.x, nloc, nx); b.st[0] = nloc; b.st[1] = nx; }
        const unsigned old = xb_add(&bar[XB_XSUB(b.x)], 1u);
        const unsigned gen = old / nloc;
        if (old + 1u == (gen + 1u) * nloc) {
            __builtin_amdgcn_fence(__ATOMIC_RELEASE, "agent");
            asm volatile("s_waitcnt vmcnt(0)" ::: "memory");
            const unsigned og = xb_add(&bar[XB_TOP], 1u);
            const unsigned tg = og / nx;
            if (og + 1u == (tg + 1u) * nx) xb_add(&bar[XB_TOPGEN], 1u);
            else XB_SPIN(xb_ld(&bar[XB_TOPGEN]) == tg, bar);
            __builtin_amdgcn_fence(__ATOMIC_ACQUIRE, "agent");
            xb_add(&bar[XB_XGEN(b.x)], 1u);
            asm volatile("s_waitcnt vmcnt(0)" ::: "memory");
        } else {
            XB_SPIN(xb_ld(&bar[XB_XGEN(b.x)]) == gen, bar);
            __builtin_amdgcn_fence(__ATOMIC_ACQUIRE, "agent");
            asm volatile("s_waitcnt vmcnt(0)" ::: "memory");
        }
    }
    __syncthreads();
}
#define GAS __attribute__((address_space(1)))
typedef unsigned short bf16;
typedef unsigned v4u __attribute__((ext_vector_type(4)));
typedef unsigned v2u __attribute__((ext_vector_type(2)));
typedef float f32x4 __attribute__((ext_vector_type(4)));
typedef float f32x16 __attribute__((ext_vector_type(16)));
typedef short bf16x8 __attribute__((ext_vector_type(8)));
typedef short s16x4 __attribute__((ext_vector_type(4)));
#define LDS_WAIT() asm volatile("s_waitcnt lgkmcnt(0)" ::: "memory")
#define VM_WAIT() asm volatile("s_waitcnt vmcnt(0)" ::: "memory")
using pg8::cvt_pk_bf16;
__device__ __forceinline__ float bf2f(unsigned short h) { return __uint_as_float((unsigned)h << 16); }
__device__ __forceinline__ float bflo(unsigned w) { return __uint_as_float(w << 16); }
__device__ __forceinline__ float bfhi(unsigned w) { return __uint_as_float(w & 0xffff0000u); }

constexpr int D = 1024, SEQ = 8192, NB = 4, NTOK = 32768, NS = 128, MR = 32896, MP = 33024;
constexpr int FF = 2816, FF2 = 5632, INW = 1440, INWP = 1536;
constexpr int NPAGES = 128, PAGE = 128, NPHYS = 20480;
constexpr float EPS = 1e-6f;
static_assert(pg8::kNTOK == NTOK && pg8::kMR == MR && pg8::kSEQ == SEQ, "constants");

constexpr size_t O_Y = 0, O_YS = 33554432, O_CKVP = 33685504, O_KRP = 37879808, O_CONVP = 38928384, O_MKP = 38930432, O_MVP = 39192576,
                 O_CKVS = 39454720, O_KRS = 39471104, O_CONVS = 39475200, O_TOTAL = 39540736;

constexpr size_t MiB = 1u << 20;
constexpr size_t WS_CTL = 0, CTL_ZERO_BYTES = 1 * MiB;
constexpr size_t WS_W1GU = 1 * MiB, WS_W1D = WS_W1GU + 12 * MiB, WS_WIN = WS_W1D + 6 * MiB, WS_WUQ = WS_WIN + 3 * MiB, WS_WKV = WS_WUQ + 1 * MiB, WS_WO = WS_WKV + 1 * MiB,
                 WS_W2GU = WS_WO + 2 * MiB, WS_W2D = WS_W2GU + 12 * MiB, WS_WMEM = WS_W2D + 6 * MiB, WS_ROPE = WS_WMEM + 1 * MiB,
                 WS_SSQ0 = WS_ROPE + 2 * MiB, WS_SSQ1 = WS_SSQ0 + 3 * MiB, WS_SSQ2 = WS_SSQ1 + 3 * MiB, WS_MSQ = WS_SSQ2 + 3 * MiB, WS_SSQM = WS_MSQ + 1 * MiB,
                 WS_XB = WS_SSQM + 1 * MiB, WS_ACT1 = WS_XB + 65 * MiB, WS_ACT2 = WS_ACT1 + 178 * MiB, WS_X1F = WS_ACT2 + 178 * MiB, WS_X1B = WS_X1F + 129 * MiB,
                 WS_X2F = WS_X1B + 65 * MiB, WS_X2B = WS_X2F + 129 * MiB, WS_CQB = WS_X2B + 65 * MiB, WS_CKVB = WS_CQB + 17 * MiB, WS_KRB = WS_CKVB + 9 * MiB,
                 WS_UB = WS_KRB + 3 * MiB, WS_GBB = WS_UB + 17 * MiB, WS_MQB = WS_GBB + 17 * MiB, WS_QB = WS_MQB + 17 * MiB, WS_KB = WS_QB + 49 * MiB, WS_VB = WS_KB + 48 * MiB,
                 WS_MEMB = WS_VB + 32 * MiB, WS_MEMK = WS_MEMB + 2 * MiB, WS_MEMV = WS_MEMK + 1 * MiB, WS_OAB = WS_MEMV + 1 * MiB, WS_OMB = WS_OAB + 33 * MiB,
                 WS_OMIX = WS_OMB + 17 * MiB, WS_DPART = WS_OMIX + 65 * MiB, WS_DBG = WS_DPART + 2 * MiB, WS_GU1S = WS_DBG + 1 * MiB, WS_GU2S = WS_GU1S + 3 * MiB, WS_D1S = WS_GU2S + 3 * MiB, WS_D7S = WS_D1S + 1 * MiB, WS_ZS = WS_D7S + 1 * MiB, WS_QS = WS_ZS + 1 * MiB, WS_MEMRAW = WS_QS + 1 * MiB,
                 WS_END = WS_MEMRAW + 2 * MiB;
constexpr int CW_BAR = 4096;

constexpr int RING_BYTES = 131072, LDSCTL_OFF = RING_BYTES, MISC_OFF = LDSCTL_OFF + 320, XCH_OFF = RING_BYTES + 512, LDS_BYTES = 147456;
constexpr int NWAVES = 8;

struct Args {
    const float* in[38];
    float* out; unsigned char* ws;
    int ph_lo, ph_hi;
};

#define CAS __attribute__((address_space(4)))
typedef const float* const CAS* InTab;
struct Frame {
    LAS unsigned char* lds;
    int tid, lane, wave, vcu, G;
    InTab in;
    float* out; unsigned char* ws;
};
__device__ __forceinline__ float wave_sum(float v) {
#pragma unroll
    for (int o = 1; o < 64; o <<= 1) v += __shfl_xor(v, o);
    return v;
}
__device__ __forceinline__ float wave_max(float v) {
#pragma unroll
    for (int o = 1; o < 64; o <<= 1) v = fmaxf(v, __shfl_xor(v, o));
    return v;
}

struct TSrc { const float* p; int ld; int col0; };
__device__ __forceinline__ void tr_item(TSrc s, const float* kscale, int K, bf16* WT, int n0, int k0, LAS float* scr, int lane) {
    f32x4 v[8];
#pragma unroll
    for (int i = 0; i < 8; ++i) { const int idx = lane + 64 * i, kk = idx >> 3, n4 = idx & 7;
        v[i] = (f32x4){0.f, 0.f, 0.f, 0.f};
        if (s.p) { v[i] = *(const f32x4*)(s.p + (size_t)(k0 + kk) * s.ld + s.col0 + 4 * n4); if (kscale) v[i] = v[i] * kscale[k0 + kk]; } }
#pragma unroll
    for (int i = 0; i < 8; ++i) { const int idx = lane + 64 * i, kk = idx >> 3, n4 = idx & 7; LAS float* d = scr + kk * 33 + 4 * n4; d[0] = v[i][0]; d[1] = v[i][1]; d[2] = v[i][2]; d[3] = v[i][3]; }
    LDS_WAIT(); asm volatile("" ::: "memory");
    const int c = lane & 7;
#pragma unroll
    for (int j = 0; j < 4; ++j) { const int n = (lane >> 3) + 8 * j; const LAS float* q = scr + (8 * c) * 33 + n;
        v4u o; o.x = cvt_pk_bf16(q[0 * 33], q[1 * 33]); o.y = cvt_pk_bf16(q[2 * 33], q[3 * 33]); o.z = cvt_pk_bf16(q[4 * 33], q[5 * 33]); o.w = cvt_pk_bf16(q[6 * 33], q[7 * 33]);
        *(v4u*)(WT + (size_t)(n0 + n) * K + k0 + 8 * c) = o; }
    LDS_WAIT(); asm volatile("" ::: "memory");
}
enum { MAT_W1GU = 0, MAT_W1D, MAT_WIN, MAT_WUQ, MAT_WKV, MAT_WO, MAT_W2GU, MAT_W2D, MAT_WMEM, MAT_N };
__device__ __forceinline__ void mat_dims(int mat, int& N, int& K) {
    switch (mat) {
        case MAT_W1GU: case MAT_W2GU: N = FF2; K = D; break;
        case MAT_W1D: case MAT_W2D: N = D; K = FF; break;
        case MAT_WIN: N = INWP; K = D; break;
        case MAT_WUQ: N = 768; K = 256; break;
        case MAT_WKV: N = 1024; K = 128; break;
        case MAT_WO: N = D; K = D; break;
        default: N = 512; K = D; break;
    }
}
__device__ __forceinline__ void p0_weight_item(const Frame& F, int mat, int item, LAS float* scr) {
    int N, K; mat_dims(mat, N, K);
    const int nkb = K / 64, kb = item % nkb, slot = item / nkb, k0 = kb * 64;
    const int pn = slot >> 3, w = slot & 7, bj = w >> 2, wc = w & 3;
    InTab in = F.in;
    TSrc s{nullptr, 0, 0}; const float* ks = nullptr; bf16* dst = nullptr;
    switch (mat) {
        case MAT_W1GU: s = TSrc{bj == 0 ? in[10] : in[11], FF, 128 * pn + 32 * wc}; ks = in[9]; dst = (bf16*)(F.ws + WS_W1GU); break;
        case MAT_W2GU: s = TSrc{bj == 0 ? in[35] : in[36], FF, 128 * pn + 32 * wc}; ks = in[34]; dst = (bf16*)(F.ws + WS_W2GU); break;
        case MAT_W1D: s = TSrc{in[12], D, 32 * slot}; dst = (bf16*)(F.ws + WS_W1D); break;
        case MAT_W2D: s = TSrc{in[37], D, 32 * slot}; dst = (bf16*)(F.ws + WS_W2D); break;
        case MAT_WIN: {
            int c0 = -1;
            if (pn == 0) c0 = 32 * w;
            else if (pn == 1) c0 = (bj == 0) ? 256 + 32 * wc : (wc == 0 ? 384 : -1);
            else if (pn == 2) c0 = (bj == 0) ? 416 + 32 * wc : 928 + 32 * wc;
            else if (pn == 3) c0 = (bj == 0) ? 416 + 128 + 32 * wc : 928 + 128 + 32 * wc;
            else if (pn == 4) c0 = 672 + 32 * w;
            else c0 = 1184 + 64 * wc + 32 * bj;
            if (c0 >= 0) s = TSrc{in[14], INW, c0};
            ks = in[13]; dst = (bf16*)(F.ws + WS_WIN); break; }
        case MAT_WUQ: s = TSrc{in[16], 768, pn < 2 ? (4 * pn + wc) * 96 + 32 * bj : (4 * bj + wc) * 96 + 64}; ks = in[15]; dst = (bf16*)(F.ws + WS_WUQ); break;
        case MAT_WKV: if (pn < 2) s = TSrc{in[20], 512, (4 * pn + wc) * 64 + 32 * bj}; else s = TSrc{in[21], 512, 256 * (pn - 2) + 32 * w}; dst = (bf16*)(F.ws + WS_WKV); break;
        case MAT_WO: s = TSrc{in[33], D, 32 * slot}; ks = (k0 < 512) ? in[30] : (k0 < 768) ? in[31] - 512 : in[32] - 768; dst = (bf16*)(F.ws + WS_WO); break;
        default: if (pn == 0) s = TSrc{in[26], 256, 64 * wc + 32 * bj}; else s = TSrc{in[27], 256, 32 * w}; ks = in[25]; dst = (bf16*)(F.ws + WS_WMEM); break;
    }
    tr_item(s, ks, K, dst, 32 * slot, k0, scr, F.lane);
}
__device__ __forceinline__ void row_to_bf16_ssq(const float* src, bf16* dst, float* parts, int lane) {
    f32x4 v[4]; float s = 0.f;
#pragma unroll
    for (int j = 0; j < 4; ++j) { v[j] = src ? ((const f32x4*)src)[lane + 64 * j] : (f32x4){0.f, 0.f, 0.f, 0.f}; s += (v[j][0] * v[j][0] + v[j][1] * v[j][1]) + (v[j][2] * v[j][2] + v[j][3] * v[j][3]); }
    s = wave_sum(s);
#pragma unroll
    for (int j = 0; j < 4; ++j) { v2u w; w.x = cvt_pk_bf16(v[j][0], v[j][1]); w.y = cvt_pk_bf16(v[j][2], v[j][3]); ((v2u*)dst)[lane + 64 * j] = w; }
    if (lane == 0) parts[0] = s;
}
__device__ __forceinline__ float rope_inv_freq(int i) {
    switch (i) { case 0: return 1.000000000e+00f; case 1: return 5.623413324e-01f; case 2: return 3.162277639e-01f; case 3: return 1.778279394e-01f;
        case 4: return 1.000000015e-01f; case 5: return 5.623413250e-02f; case 6: return 3.162277490e-02f; case 7: return 1.778279431e-02f;
        case 8: return 9.999999776e-03f; case 9: return 5.623413250e-03f; case 10: return 3.162277630e-03f; case 11: return 1.778279431e-03f;
        case 12: return 1.000000047e-03f; case 13: return 5.623413017e-04f; case 14: return 3.162277571e-04f; default: return 1.778279402e-04f; }
}
__device__ __forceinline__ void p0_prologue(const Frame& F) {
    LAS float* scr = (LAS float*)(F.lds + F.wave * 16384);
    const int gw = F.vcu * NWAVES + F.wave, NGW = F.G * NWAVES;
    int base = 0;
#pragma unroll 1
    for (int mat = 0; mat < MAT_N; ++mat) {
        int N, K; mat_dims(mat, N, K);
        const int nit = (N / 32) * (K / 64);
        int first = (gw - base % NGW + NGW) % NGW;
        for (int it = first; it < nit; it += NGW) p0_weight_item(F, mat, it, scr);
        base += nit;
    }
    bf16* xb = (bf16*)(F.ws + WS_XB); float* ssq0 = (float*)(F.ws + WS_SSQ0);
#if P0_PIPE
    {
        auto srcp = [&](int r) -> const float* { return r < NTOK ? F.in[0] + (size_t)r * D : (r < MR ? F.in[2] + (size_t)(r - NTOK) * D : nullptr); };
        f32x4 va[4], vb[4];
        { const int r = gw, r2 = gw + NGW; const float* src = r < MP ? srcp(r) : nullptr; const float* src2 = r2 < MP ? srcp(r2) : nullptr;
#pragma unroll
          for (int j = 0; j < 4; ++j) { va[j] = src ? ((const f32x4*)src)[F.lane + 64 * j] : (f32x4){0.f, 0.f, 0.f, 0.f}; vb[j] = src2 ? ((const f32x4*)src2)[F.lane + 64 * j] : (f32x4){0.f, 0.f, 0.f, 0.f}; } }
        for (int r = gw; r < MP; r += 2 * NGW) {
            const int r2 = r + NGW, rn = r + 2 * NGW, rn2 = r + 3 * NGW;
            f32x4 na[4], nb[4];
            { const float* src = rn < MP ? srcp(rn) : nullptr; const float* src2 = rn2 < MP ? srcp(rn2) : nullptr;
#pragma unroll
              for (int j = 0; j < 4; ++j) { na[j] = src ? ((const f32x4*)src)[F.lane + 64 * j] : (f32x4){0.f, 0.f, 0.f, 0.f}; nb[j] = src2 ? ((const f32x4*)src2)[F.lane + 64 * j] : (f32x4){0.f, 0.f, 0.f, 0.f}; } }
            float sa = 0.f, sb = 0.f;
#pragma unroll
            for (int j = 0; j < 4; ++j) { sa += (va[j][0] * va[j][0] + va[j][1] * va[j][1]) + (va[j][2] * va[j][2] + va[j][3] * va[j][3]); sb += (vb[j][0] * vb[j][0] + vb[j][1] * vb[j][1]) + (vb[j][2] * vb[j][2] + vb[j][3] * vb[j][3]); }
            sa = wave_sum(sa); sb = wave_sum(sb);
#pragma unroll
            for (int j = 0; j < 4; ++j) { v2u w; w.x = cvt_pk_bf16(va[j][0], va[j][1]); w.y = cvt_pk_bf16(va[j][2], va[j][3]); ((v2u*)(xb + (size_t)r * D))[F.lane + 64 * j] = w; }
            if (F.lane == 0) ssq0[r] = sa;
            if (r2 < MP) {
#pragma unroll
                for (int j = 0; j < 4; ++j) { v2u w; w.x = cvt_pk_bf16(vb[j][0], vb[j][1]); w.y = cvt_pk_bf16(vb[j][2], vb[j][3]); ((v2u*)(xb + (size_t)r2 * D))[F.lane + 64 * j] = w; }
                if (F.lane == 0) ssq0[r2] = sb;
            }
#pragma unroll
            for (int j = 0; j < 4; ++j) { va[j] = na[j]; vb[j] = nb[j]; }
        }
    }
#else
    for (int r = gw; r < MP; r += 2 * NGW) {
        const int r2 = r + NGW;
        const float* src = r < NTOK ? F.in[0] + (size_t)r * D : (r < MR ? F.in[2] + (size_t)(r - NTOK) * D : nullptr);
        const float* src2 = r2 < NTOK ? F.in[0] + (size_t)r2 * D : (r2 < MR ? F.in[2] + (size_t)(r2 - NTOK) * D : nullptr);
        f32x4 va[4], vb[4];
#pragma unroll
        for (int j = 0; j < 4; ++j) { va[j] = src ? ((const f32x4*)src)[F.lane + 64 * j] : (f32x4){0.f, 0.f, 0.f, 0.f}; vb[j] = (r2 < MP && src2) ? ((const f32x4*)src2)[F.lane + 64 * j] : (f32x4){0.f, 0.f, 0.f, 0.f}; }
        float sa = 0.f, sb = 0.f;
#pragma unroll
        for (int j = 0; j < 4; ++j) { sa += (va[j][0] * va[j][0] + va[j][1] * va[j][1]) + (va[j][2] * va[j][2] + va[j][3] * va[j][3]); sb += (vb[j][0] * vb[j][0] + vb[j][1] * vb[j][1]) + (vb[j][2] * vb[j][2] + vb[j][3] * vb[j][3]); }
        sa = wave_sum(sa); sb = wave_sum(sb);
#pragma unroll
        for (int j = 0; j < 4; ++j) { v2u w; w.x = cvt_pk_bf16(va[j][0], va[j][1]); w.y = cvt_pk_bf16(va[j][2], va[j][3]); ((v2u*)(xb + (size_t)r * D))[F.lane + 64 * j] = w; }
        if (F.lane == 0) ssq0[r] = sa;
        if (r2 < MP) {
#pragma unroll
            for (int j = 0; j < 4; ++j) { v2u w; w.x = cvt_pk_bf16(vb[j][0], vb[j][1]); w.y = cvt_pk_bf16(vb[j][2], vb[j][3]); ((v2u*)(xb + (size_t)r2 * D))[F.lane + 64 * j] = w; }
            if (F.lane == 0) ssq0[r2] = sb;
        }
    }
#endif
    bf16* memb = (bf16*)(F.ws + WS_MEMB); float* ssqm = (float*)(F.ws + WS_SSQM);
    for (int r = gw; r < 1024; r += NGW) row_to_bf16_ssq(F.in[1] + (size_t)r * D, memb + (size_t)r * D, ssqm + r, F.lane);
    float* rope = (float*)(F.ws + WS_ROPE);
    const int gt = F.vcu * (NWAVES * 64) + F.tid, NGT = F.G * NWAVES * 64;
    for (int e = gt; e < 8193 * 16; e += NGT) { const int pi = e >> 4, i = e & 15; const float pos = pi == 8192 ? 16384.0f : (float)pi;
        const float ang = pos * rope_inv_freq(i);
        const double rev = (double)ang * 0.15915494309189535;
        const float fr = (float)(rev - floor(rev));
        rope[(size_t)pi * 32 + i] = __builtin_amdgcn_cosf(fr); rope[(size_t)pi * 32 + 16 + i] = __builtin_amdgcn_sinf(fr); }
    for (int e = gt; e < MP; e += NGT) { ((float*)(F.ws + WS_SSQ1))[e] = 0.f; ((float*)(F.ws + WS_SSQ2))[e] = 0.f; }
    { f32x4* z = (f32x4*)(F.ws + WS_GU1S); const int nz = (int)((WS_END - WS_GU1S) / 16); for (int e = gt; e < nz; e += NGT) z[e] = (f32x4){0.f, 0.f, 0.f, 0.f}; }
    for (int e = gt; e < NS * 256; e += NGT) { const int b = e >> 8, c = e & 255; F.out[O_CONVS + (size_t)b * 512 + c] = F.in[6][(size_t)b * 512 + 256 + c]; }
}
__device__ __forceinline__ int crow(int r, int hi) { return (r & 3) + 8 * (r >> 2) + 4 * hi; }
constexpr int AT_BUF = 20480, AT_V = 12288, AT_WS = 3 * AT_BUF, AT_OST = AT_WS + 2048;
template <int DQK>
__device__ __forceinline__ void attn_dma_tile(const bf16* Kt, const bf16* Krt, const bf16* Vt, LAS unsigned char* buf, int wid, int lane) {
    constexpr int NC = DQK / 8;
    __builtin_amdgcn_global_load_lds((const unsigned*)(Kt + (size_t)lane * 64 + wid * 8), (LAS unsigned*)(buf + wid * 1024), 16, 0, 0);
    if (NC > 8 && wid < NC - 8) __builtin_amdgcn_global_load_lds((const unsigned*)(Krt + (size_t)lane * (DQK - 64) + wid * 8), (LAS unsigned*)(buf + (8 + wid) * 1024), 16, 0, 0);
    __builtin_amdgcn_global_load_lds((const unsigned*)(Vt + (size_t)(16 * (wid & 3) + (lane >> 2)) * 64 + (wid >> 2) * 32 + (lane & 3) * 8), (LAS unsigned*)(buf + AT_V + wid * 1024), 16, 0, 0);
}
template <int DQK, bool CAUSAL, class Mid>
__device__ __forceinline__ void at_qk(f32x16& p0, f32x16& p1, const bf16x8 (&qr)[DQK / 16], const f32x16& negm, LAS unsigned char* kb, int jb, int qrel, int r32, int hi, Mid mid) {
#if AT_ROLL
#define ATK_R(dst, off) asm volatile("ds_read_b128 %0, %1 offset:%2" : "=v"(dst) : "v"(ka0), "n"(off) : "memory")
    const unsigned ka0 = (unsigned)(uintptr_t)kb + hi * 1024 + r32 * 16;
    bf16x8 ke0, ke1, ko0, ko1;
    ATK_R(ke0, 0); ATK_R(ke1, 512); ATK_R(ko0, 2048); ATK_R(ko1, 2048 + 512);
    __builtin_amdgcn_sched_barrier(0);
    mid();
    __builtin_amdgcn_sched_barrier(0);
#pragma unroll
    for (int d0 = 0; d0 < DQK / 16; ++d0) {
        bf16x8& k0 = (d0 & 1) ? ko0 : ke0; bf16x8& k1 = (d0 & 1) ? ko1 : ke1;
        if (d0 + 1 < DQK / 16) asm volatile("s_waitcnt lgkmcnt(2)" : "+v"(k0), "+v"(k1) :: "memory"); else asm volatile("s_waitcnt lgkmcnt(0)" : "+v"(k0), "+v"(k1) :: "memory");
        __builtin_amdgcn_sched_barrier(0);
        if (d0 == 0) { p0 = __builtin_amdgcn_mfma_f32_32x32x16_bf16(k0, qr[0], negm, 0, 0, 0); p1 = __builtin_amdgcn_mfma_f32_32x32x16_bf16(k1, qr[0], negm, 0, 0, 0); }
        else { p0 = __builtin_amdgcn_mfma_f32_32x32x16_bf16(k0, qr[d0], p0, 0, 0, 0); p1 = __builtin_amdgcn_mfma_f32_32x32x16_bf16(k1, qr[d0], p1, 0, 0, 0); }
        __builtin_amdgcn_sched_barrier(0);
        if (d0 + 2 < DQK / 16) { if (d0 & 1) { ATK_R(ko0, 2048 * (d0 + 2)); ATK_R(ko1, 2048 * (d0 + 2) + 512); } else { ATK_R(ke0, 2048 * (d0 + 2)); ATK_R(ke1, 2048 * (d0 + 2) + 512); } }
        __builtin_amdgcn_sched_barrier(0);
    }
#undef ATK_R
#else
    mid();
#pragma unroll
    for (int d0 = 0; d0 < DQK / 16; ++d0) {
        const bf16x8 k0 = *(const LAS bf16x8*)(kb + (2 * d0 + hi) * 1024 + r32 * 16);
        const bf16x8 k1 = *(const LAS bf16x8*)(kb + (2 * d0 + hi) * 1024 + 512 + r32 * 16);
        if (d0 == 0) { p0 = __builtin_amdgcn_mfma_f32_32x32x16_bf16(k0, qr[0], negm, 0, 0, 0); p1 = __builtin_amdgcn_mfma_f32_32x32x16_bf16(k1, qr[0], negm, 0, 0, 0); }
        else { p0 = __builtin_amdgcn_mfma_f32_32x32x16_bf16(k0, qr[d0], p0, 0, 0, 0); p1 = __builtin_amdgcn_mfma_f32_32x32x16_bf16(k1, qr[d0], p1, 0, 0, 0); }
    }
#endif
    if (CAUSAL && jb >= 0) {
        const int kb_ = 64 * jb + 4 * hi;
#pragma unroll
        for (int r = 0; r < 16; ++r) { const int kv = kb_ + (r & 3) + 8 * (r >> 2); if (kv > qrel) p0[r] = -INFINITY; if (kv + 32 > qrel) p1[r] = -INFINITY; }
    }
}
__device__ __forceinline__ void at_sp(f32x16& p0, f32x16& p1, f32x16& negm, f32x16& o0, f32x16& o1, float& mhat, float& lrun, bool first, LAS float* wsf, LAS unsigned char* vbuf, int lane, int r32, int hi) {
#if AT_VPRE
    const unsigned vb = (unsigned)(uintptr_t)vbuf + ((lane >> 4) & 1) * 32 + (lane & 3) * 8 + (4 * hi + ((lane & 15) >> 2)) * 64;
    s16x4 vlo[2][4], vhh[2][4];
#pragma unroll
    for (int d0 = 0; d0 < 2; ++d0)
#pragma unroll
        for (int ks = 0; ks < 4; ++ks) {
            asm volatile("ds_read_b64_tr_b16 %0, %1 offset:%2" : "=v"(vlo[d0][ks]) : "v"(vb), "i"(d0 * 4096 + ks * 1024) : "memory");
            asm volatile("ds_read_b64_tr_b16 %0, %1 offset:%2" : "=v"(vhh[d0][ks]) : "v"(vb), "i"(d0 * 4096 + ks * 1024 + 512) : "memory");
        }
#endif
    float rm;
    { float a = fmaxf(fmaxf(p0[0], p0[1]), p1[0]), b2 = fmaxf(fmaxf(p0[2], p0[3]), p1[1]); a = fmaxf(fmaxf(a, p1[2]), p1[3]);
#pragma unroll
      for (int r = 4; r < 16; r += 4) { a = fmaxf(fmaxf(a, p0[r]), p0[r + 1]); b2 = fmaxf(fmaxf(b2, p0[r + 2]), p0[r + 3]); a = fmaxf(fmaxf(a, p1[r]), p1[r + 1]); b2 = fmaxf(fmaxf(b2, p1[r + 2]), p1[r + 3]); }
      rm = fmaxf(a, b2); }
    { auto tt = __builtin_amdgcn_permlane32_swap(__float_as_uint(rm), __float_as_uint(rm), false, false); rm = fmaxf(__uint_as_float(tt[0]), __uint_as_float(tt[1])); }
    if (first || __any(rm > 8.0f)) {
        const float dl = first ? rm : fmaxf(rm, 0.f);
        const float alpha = __builtin_amdgcn_exp2f(-dl);
        mhat += dl; lrun *= alpha;
#pragma unroll
        for (int r = 0; r < 16; ++r) { p0[r] -= dl; p1[r] -= dl; negm[r] = -mhat; }
        asm volatile("" : "+v"(negm));
        if (hi == 0) wsf[r32] = alpha;
        LDS_WAIT();
#pragma unroll
        for (int r = 0; r < 16; ++r) { const float a = wsf[crow(r, hi)]; o0[r] *= a; o1[r] *= a; }
    }
    typedef float f32x2 __attribute__((ext_vector_type(2)));
    f32x2 ls2 = (f32x2){0.f, 0.f};
#pragma unroll
    for (int r = 0; r < 16; ++r) { p0[r] = __builtin_amdgcn_exp2f(p0[r]); p1[r] = __builtin_amdgcn_exp2f(p1[r]); }
#pragma unroll
    for (int r = 0; r < 16; r += 2) { ls2 = ls2 + (f32x2){p0[r], p0[r + 1]}; ls2 = ls2 + (f32x2){p1[r], p1[r + 1]}; }
    lrun += ls2[0] + ls2[1];
    bf16x8 pa[4];
    { v4u w;
      w.x = cvt_pk_bf16(p0[0], p0[1]); w.y = cvt_pk_bf16(p0[2], p0[3]); w.z = cvt_pk_bf16(p0[4], p0[5]); w.w = cvt_pk_bf16(p0[6], p0[7]); pa[0] = __builtin_bit_cast(bf16x8, w);
      w.x = cvt_pk_bf16(p0[8], p0[9]); w.y = cvt_pk_bf16(p0[10], p0[11]); w.z = cvt_pk_bf16(p0[12], p0[13]); w.w = cvt_pk_bf16(p0[14], p0[15]); pa[1] = __builtin_bit_cast(bf16x8, w);
      w.x = cvt_pk_bf16(p1[0], p1[1]); w.y = cvt_pk_bf16(p1[2], p1[3]); w.z = cvt_pk_bf16(p1[4], p1[5]); w.w = cvt_pk_bf16(p1[6], p1[7]); pa[2] = __builtin_bit_cast(bf16x8, w);
      w.x = cvt_pk_bf16(p1[8], p1[9]); w.y = cvt_pk_bf16(p1[10], p1[11]); w.z = cvt_pk_bf16(p1[12], p1[13]); w.w = cvt_pk_bf16(p1[14], p1[15]); pa[3] = __builtin_bit_cast(bf16x8, w); }
#if AT_VPRE
    asm volatile("s_waitcnt lgkmcnt(0)" : "+v"(vlo[0][0]), "+v"(vlo[0][1]), "+v"(vlo[0][2]), "+v"(vlo[0][3]), "+v"(vhh[0][0]), "+v"(vhh[0][1]), "+v"(vhh[0][2]), "+v"(vhh[0][3]),
                 "+v"(vlo[1][0]), "+v"(vlo[1][1]), "+v"(vlo[1][2]), "+v"(vlo[1][3]), "+v"(vhh[1][0]), "+v"(vhh[1][1]), "+v"(vhh[1][2]), "+v"(vhh[1][3]) :: "memory");
#pragma unroll
    for (int d0 = 0; d0 < 2; ++d0)
#pragma unroll
        for (int ks = 0; ks < 4; ++ks) {
            const bf16x8 vf = (bf16x8){vlo[d0][ks][0], vlo[d0][ks][1], vlo[d0][ks][2], vlo[d0][ks][3], vhh[d0][ks][0], vhh[d0][ks][1], vhh[d0][ks][2], vhh[d0][ks][3]};
            if (d0 == 0) o0 = __builtin_amdgcn_mfma_f32_32x32x16_bf16(pa[ks], vf, o0, 0, 0, 0);
            else o1 = __builtin_amdgcn_mfma_f32_32x32x16_bf16(pa[ks], vf, o1, 0, 0, 0);
        }
#elif AT_VPIPE
    const unsigned vb = (unsigned)(uintptr_t)vbuf + ((lane >> 4) & 1) * 32 + (lane & 3) * 8 + (4 * hi + ((lane & 15) >> 2)) * 64;
    s16x4 lo[2][4], hh[2][4];
#pragma unroll
    for (int ks = 0; ks < 4; ++ks) {
        asm volatile("ds_read_b64_tr_b16 %0, %1 offset:%2" : "=&v"(lo[0][ks]) : "v"(vb), "i"(ks * 1024) : "memory");
        asm volatile("ds_read_b64_tr_b16 %0, %1 offset:%2" : "=&v"(hh[0][ks]) : "v"(vb), "i"(ks * 1024 + 512) : "memory");
    }
    asm volatile("s_waitcnt lgkmcnt(0)" : "+v"(lo[0][0]), "+v"(lo[0][1]), "+v"(lo[0][2]), "+v"(lo[0][3]), "+v"(hh[0][0]), "+v"(hh[0][1]), "+v"(hh[0][2]), "+v"(hh[0][3]) :: "memory");
#pragma unroll
    for (int ks = 0; ks < 4; ++ks) {
        asm volatile("ds_read_b64_tr_b16 %0, %1 offset:%2" : "=&v"(lo[1][ks]) : "v"(vb), "i"(4096 + ks * 1024) : "memory");
        asm volatile("ds_read_b64_tr_b16 %0, %1 offset:%2" : "=&v"(hh[1][ks]) : "v"(vb), "i"(4096 + ks * 1024 + 512) : "memory");
    }
    __builtin_amdgcn_sched_barrier(0);
#pragma unroll
    for (int ks = 0; ks < 4; ++ks) {
        const bf16x8 vf = (bf16x8){lo[0][ks][0], lo[0][ks][1], lo[0][ks][2], lo[0][ks][3], hh[0][ks][0], hh[0][ks][1], hh[0][ks][2], hh[0][ks][3]};
        o0 = __builtin_amdgcn_mfma_f32_32x32x16_bf16(pa[ks], vf, o0, 0, 0, 0);
    }
    __builtin_amdgcn_sched_barrier(0);
    asm volatile("s_waitcnt lgkmcnt(0)" : "+v"(lo[1][0]), "+v"(lo[1][1]), "+v"(lo[1][2]), "+v"(lo[1][3]), "+v"(hh[1][0]), "+v"(hh[1][1]), "+v"(hh[1][2]), "+v"(hh[1][3]) :: "memory");
#pragma unroll
    for (int ks = 0; ks < 4; ++ks) {
        const bf16x8 vf = (bf16x8){lo[1][ks][0], lo[1][ks][1], lo[1][ks][2], lo[1][ks][3], hh[1][ks][0], hh[1][ks][1], hh[1][ks][2], hh[1][ks][3]};
        o1 = __builtin_amdgcn_mfma_f32_32x32x16_bf16(pa[ks], vf, o1, 0, 0, 0);
    }
#else
    const unsigned vb = (unsigned)(uintptr_t)vbuf + ((lane >> 4) & 1) * 32 + (lane & 3) * 8 + (4 * hi + ((lane & 15) >> 2)) * 64;
#pragma unroll
    for (int d0 = 0; d0 < 2; ++d0) {
        s16x4 lo[4], hh[4];
#pragma unroll
        for (int ks = 0; ks < 4; ++ks) {
            asm volatile("ds_read_b64_tr_b16 %0, %1 offset:%2" : "=&v"(lo[ks]) : "v"(vb), "i"(d0 * 4096 + ks * 1024) : "memory");
            asm volatile("ds_read_b64_tr_b16 %0, %1 offset:%2" : "=&v"(hh[ks]) : "v"(vb), "i"(d0 * 4096 + ks * 1024 + 512) : "memory");
        }
        asm volatile("s_waitcnt lgkmcnt(0)" : "+v"(lo[0]), "+v"(lo[1]), "+v"(lo[2]), "+v"(lo[3]), "+v"(hh[0]), "+v"(hh[1]), "+v"(hh[2]), "+v"(hh[3]) :: "memory");
#pragma unroll
        for (int ks = 0; ks < 4; ++ks) {
            const bf16x8 vf = (bf16x8){lo[ks][0], lo[ks][1], lo[ks][2], lo[ks][3], hh[ks][0], hh[ks][1], hh[ks][2], hh[ks][3]};
            if (d0 == 0) o0 = __builtin_amdgcn_mfma_f32_32x32x16_bf16(pa[ks], vf, o0, 0, 0, 0);
            else o1 = __builtin_amdgcn_mfma_f32_32x32x16_bf16(pa[ks], vf, o1, 0, 0, 0);
        }
    }
#endif
}
#define AT_ENDWAIT(more) do { if (more) { if (DQK > 64 && wid < DQK / 8 - 8) asm volatile("s_waitcnt vmcnt(3) lgkmcnt(0)\n\ts_barrier" ::: "memory"); else asm volatile("s_waitcnt vmcnt(2) lgkmcnt(0)\n\ts_barrier" ::: "memory"); } \
        else asm volatile("s_waitcnt vmcnt(0) lgkmcnt(0)\n\ts_barrier" ::: "memory"); } while (0)
template <int DQK, bool CAUSAL>
__device__ __forceinline__ void attn_unit_simple(const bf16* Q0, int qpitch, const bf16* Kh, const bf16* Kr, const bf16* Vh, bf16* O0, int opitch, int NT, LAS unsigned char* lds,
                                                 bf16x8 (&qr)[DQK / 16], bool primed, const bf16* nQ0, const bf16* nKh, const bf16* nKr, const bf16* nVh, int nNT) {
    constexpr int ND = DQK / 16;
    int tid_ = threadIdx.x; asm volatile("" : "+v"(tid_));
    const int tid = tid_, lane = tid & 63, r32 = lane & 31, hi = lane >> 5; const int wid = __builtin_amdgcn_readfirstlane(tid >> 6);
    if (!primed) {
        __syncthreads();
        attn_dma_tile<DQK>(Kh, Kr, Vh, lds, wid, lane);
        if (NT > 1) attn_dma_tile<DQK>(Kh + (size_t)64 * 64, Kr + (size_t)64 * (DQK - 64), Vh + (size_t)64 * 64, lds + AT_BUF, wid, lane);
#pragma unroll
        for (int d0 = 0; d0 < ND; ++d0) qr[d0] = *(const bf16x8*)(Q0 + (size_t)(wid * 32 + r32) * qpitch + d0 * 16 + hi * 8);
    }
    float mhat = 0.f, lrun = 0.f;
    f32x16 o0, o1, negm, p0, p1;
#pragma unroll
    for (int r = 0; r < 16; ++r) { o0[r] = 0.f; o1[r] = 0.f; negm[r] = 0.f; }
    asm volatile("" : "+v"(negm));
    LAS float* wsf = (LAS float*)(lds + AT_WS) + wid * 64;
    const int qrel = wid * 32 + r32;
    __syncthreads();
    const int NB = CAUSAL ? NT - 4 : NT;
    for (int t = 0; t < NB; ++t) {
        const bool more = t + 2 < NT;
        LAS unsigned char* kb = lds + (t % 3) * AT_BUF;
#if AT_DMAMID
        at_qk<DQK, false>(p0, p1, qr, negm, kb, -1, qrel, r32, hi, [&]() __attribute__((always_inline)) { if (more) attn_dma_tile<DQK>(Kh + (size_t)(t + 2) * 64 * 64, Kr + (size_t)(t + 2) * 64 * (DQK - 64), Vh + (size_t)(t + 2) * 64 * 64, lds + ((t + 2) % 3) * AT_BUF, wid, lane); });
#else
        if (more) attn_dma_tile<DQK>(Kh + (size_t)(t + 2) * 64 * 64, Kr + (size_t)(t + 2) * 64 * (DQK - 64), Vh + (size_t)(t + 2) * 64 * 64, lds + ((t + 2) % 3) * AT_BUF, wid, lane);
        at_qk<DQK, false>(p0, p1, qr, negm, kb, -1, qrel, r32, hi, []() {});
#endif
        at_sp(p0, p1, negm, o0, o1, mhat, lrun, t == 0, wsf, kb + AT_V, lane, r32, hi);
        AT_ENDWAIT(more);
    }
    if (CAUSAL) {
        for (int t = NB; t < NT; ++t) {
            const bool more = t + 2 < NT;
            if (more) attn_dma_tile<DQK>(Kh + (size_t)(t + 2) * 64 * 64, Kr + (size_t)(t + 2) * 64 * (DQK - 64), Vh + (size_t)(t + 2) * 64 * 64, lds + ((t + 2) % 3) * AT_BUF, wid, lane);
            const int jb = t - NB;
            if (!(64 * jb > 32 * wid + 31)) { LAS unsigned char* kb = lds + (t % 3) * AT_BUF;
                at_qk<DQK, true>(p0, p1, qr, negm, kb, jb, qrel, r32, hi, []() {});
                at_sp(p0, p1, negm, o0, o1, mhat, lrun, t == 0, wsf, kb + AT_V, lane, r32, hi); }
            AT_ENDWAIT(more);
        }
    }
    if (nQ0) {
        attn_dma_tile<DQK>(nKh, nKr, nVh, lds, wid, lane);
        if (nNT > 1) attn_dma_tile<DQK>(nKh + (size_t)64 * 64, nKr + (size_t)64 * (DQK - 64), nVh + (size_t)64 * 64, lds + AT_BUF, wid, lane);
#pragma unroll
        for (int d0 = 0; d0 < ND; ++d0) qr[d0] = *(const bf16x8*)(nQ0 + (size_t)(wid * 32 + r32) * qpitch + d0 * 16 + hi * 8);
    }
    lrun += __shfl_xor(lrun, 32);
    if (hi == 0) wsf[32 + r32] = lrun;
    LDS_WAIT();
    LAS bf16* stg = (LAS bf16*)(lds + AT_OST) + wid * 2048;
#pragma unroll
    for (int r = 0; r < 16; ++r) { const int orow = crow(r, hi); const float rl = __builtin_amdgcn_rcpf(wsf[32 + orow]);
        stg[orow * 64 + r32] = (bf16)(cvt_pk_bf16(o0[r] * rl, 0.f) & 0xffffu); stg[orow * 64 + 32 + r32] = (bf16)(cvt_pk_bf16(o1[r] * rl, 0.f) & 0xffffu); }
    LDS_WAIT();
#pragma unroll
    for (int i = 0; i < 4; ++i) { const int row = i * 8 + (lane >> 3), ch = lane & 7; const v4u v = *(const LAS v4u*)(stg + row * 64 + ch * 8);
#if NT_O
        __builtin_nontemporal_store(v, (v4u*)(O0 + (size_t)(wid * 32 + row) * opitch + ch * 8)); }
#else
        *(v4u*)(O0 + (size_t)(wid * 32 + row) * opitch + ch * 8) = v; }
#endif
    LDS_WAIT();
}

#undef AT_ENDWAIT
constexpr int DC_TSTR = 2080, DC_TB = 16 * DC_TSTR, DC_T0 = 0, DC_KR0 = 2 * DC_TB, DC_KRB = 4 * DC_TSTR, DC_P = DC_KR0 + 2 * DC_KRB, DC_AL = DC_P + 4096, DC_Q = DC_AL + 64, DC_QA = DC_Q + 8 * 192;
static_assert(DC_QA + 8 * 1024 <= RING_BYTES, "decode LDS");
constexpr int DC_STG = DC_QA + 8 * 1024, DC_STGK = XCH_OFF;
static_assert(DC_STG + 32768 <= RING_BYTES && DC_STGK + 8192 <= LDS_BYTES, "decode staging");
constexpr int DPART_STRIDE = 8 * 132;
template <bool B> struct BoolTag { static constexpr bool value = B; };
struct DecPre { f32x4 c[4]; f32x4 k; };
__device__ __forceinline__ void dec_load_half(DecPre& P, const float* ck, const float* kr, int hf, int tid) {
#pragma unroll
    for (int it = 0; it < 4; ++it) P.c[it] = *(const f32x4*)((const char*)(ck + 2048 * (4 * hf + it)) + (unsigned)tid * 16u);
    P.k = *(const f32x4*)((const char*)(kr + 2048 * hf) + (unsigned)tid * 16u);
}
#if DEC_NT
#define DEC_NT_SFX " nt"
#define DEC_NT_AUX 2
#else
#define DEC_NT_SFX ""
#define DEC_NT_AUX 0
#endif
__device__ __forceinline__ void dec_load_half_raw(DecPre& P, const float* ck, const float* kr, int hf, int tid) {
    const unsigned vo = (unsigned)tid * 16u;
#pragma unroll
    for (int it = 0; it < 4; ++it) { const float* bp = ck + 2048 * (4 * hf + it); asm volatile("global_load_dwordx4 %0, %1, %2" DEC_NT_SFX : "=v"(P.c[it]) : "v"(vo), "s"(bp) : "memory"); }
    { const float* bp = kr + 2048 * hf; asm volatile("global_load_dwordx4 %0, %1, %2" DEC_NT_SFX : "=v"(P.k) : "v"(vo), "s"(bp) : "memory"); }
}
template <int N> __device__ __forceinline__ void dec_wait_pre(DecPre& P) {
    asm volatile("s_waitcnt vmcnt(%5)" : "+v"(P.c[0]), "+v"(P.c[1]), "+v"(P.c[2]), "+v"(P.c[3]), "+v"(P.k) : "n"(N) : "memory");
}
__device__ __forceinline__ void dec_load_newtok_half(DecPre& P, const bf16* ckn, const bf16* krn, int hf, int tid) {
#pragma unroll
    for (int it = 0; it < 4; ++it) { const int i4 = tid + 512 * (4 * hf + it); f32x4 v = (f32x4){0.f, 0.f, 0.f, 0.f};
        if ((i4 >> 5) == 0) { const v2u w = *(const v2u*)(ckn + 4 * (i4 & 31)); v = (f32x4){bflo(w.x), bfhi(w.x), bflo(w.y), bfhi(w.y)}; } P.c[it] = v; }
    { const int j4 = tid + 512 * hf; f32x4 v = (f32x4){0.f, 0.f, 0.f, 0.f};
        if ((j4 >> 3) == 0) { const v2u w = *(const v2u*)(krn + 4 * (j4 & 7)); v = (f32x4){bflo(w.x), bfhi(w.x), bflo(w.y), bfhi(w.y)}; } P.k = v; }
}
__device__ __forceinline__ void dec_store_half(const DecPre& P, LAS unsigned char* T, LAS unsigned char* KR, int hf, int tid) {
#pragma unroll
    for (int it = 0; it < 4; ++it) { const int i4 = tid + 512 * (4 * hf + it), key = i4 >> 5, l4 = i4 & 31;
        v2u w; w.x = cvt_pk_bf16(P.c[it][0], P.c[it][1]); w.y = cvt_pk_bf16(P.c[it][2], P.c[it][3]);
        *(LAS v2u*)(T + (l4 >> 1) * DC_TSTR + key * 16 + (l4 & 1) * 8) = w; }
    { const int j4 = tid + 512 * hf, key = j4 >> 3, c4 = j4 & 7;
        v2u w; w.x = cvt_pk_bf16(P.k[0], P.k[1]); w.y = cvt_pk_bf16(P.k[2], P.k[3]);
        *(LAS v2u*)(KR + (c4 >> 1) * DC_TSTR + key * 16 + (c4 & 1) * 8) = w; }
}
__device__ __forceinline__ void dec_dma_half(const float* ck, const float* kr, int hf, int tid, int wid, LAS unsigned char* lds) {
#pragma unroll
    for (int it = 0; it < 4; ++it)
        __builtin_amdgcn_global_load_lds((const unsigned*)((const char*)(ck + 2048 * (4 * hf + it)) + (unsigned)tid * 16u), (LAS unsigned*)(lds + DC_STG + it * 8192 + wid * 1024), 16, 0, DEC_NT_AUX);
    __builtin_amdgcn_global_load_lds((const unsigned*)((const char*)(kr + 2048 * hf) + (unsigned)tid * 16u), (LAS unsigned*)(lds + DC_STGK + wid * 1024), 16, 0, DEC_NT_AUX);
}
__device__ __forceinline__ void dec_stage_to_pre(DecPre& P, int tid, LAS unsigned char* lds) {
#pragma unroll
    for (int it = 0; it < 4; ++it) P.c[it] = *(const LAS f32x4*)(lds + DC_STG + it * 8192 + tid * 16);
    P.k = *(const LAS f32x4*)(lds + DC_STGK + tid * 16);
}
__device__ __forceinline__ void decode_item(const Frame& F, int b, int half) {
    LAS unsigned char* lds = F.lds;
    int tid_ = F.tid; asm volatile("" : "+v"(tid_));
    const int tid = tid_, lane = tid & 63, wid = F.wave, r32 = lane & 31, hi = lane >> 5, fr = lane & 15, fq = lane >> 4;
    const bf16* wkv = (const bf16*)(F.ws + WS_WKV);
    const float* g_kn = F.in[22];
    __syncthreads();
#if DEC_PRIO
    if (wid >= 4) __builtin_amdgcn_s_setprio(1);
#endif
    LAS bf16* qrow = (LAS bf16*)(lds + DC_Q) + wid * 96;
    { const float* qs = (const float*)(F.ws + WS_QS) + (size_t)b * 768; const float epsq = EPS * (((const float*)(F.ws + WS_MSQ))[NTOK + b] + EPS); const int h = wid;
      const float rn = qs[256 * (h >> 2) + 128 * (lane >> 5) + 32 * (h & 3) + (lane & 31)];
      const float qn = rn * (__builtin_amdgcn_rsqf(wave_sum(rn * rn) * (1.0f / 64.0f) + epsq) * pg8::kC2Q) * F.in[17][lane];
      const float rr = lane < 32 ? qs[512 + 128 * (h >> 2) + 32 * (h & 3) + lane] : 0.f;
      const float w = rr * __builtin_amdgcn_rsqf(wave_sum(rr * rr) * (1.0f / 32.0f) + epsq) * F.in[18][lane & 31]; const float other = __shfl_xor(w, 16);
      const float* rp = (const float*)(F.ws + WS_ROPE) + (size_t)8192 * 32; const int i = lane & 15; const float cs = rp[i], sn = rp[16 + i];
      const float o = ((lane & 16) ? (other * sn + w * cs) : (w * cs - other * sn)) * pg8::kC2Q;
      const bf16 qnb = (bf16)(cvt_pk_bf16(qn, 0.f) & 0xffffu), qrb = (bf16)(cvt_pk_bf16(o, 0.f) & 0xffffu);
      qrow[lane] = qnb; if (lane < 32) qrow[64 + lane] = qrb;
      if (half == 0) { bf16* qg_ = (bf16*)(F.ws + WS_QB) + (size_t)(NTOK + b) * 768 + h * 96; qg_[lane] = qnb; if (lane < 32) qg_[64 + lane] = qrb; }
    }
    LDS_WAIT();
    bf16x8 wA[8][2];
    { const int pn = wid >> 2, wc = wid & 3; const unsigned loff = (unsigned)(r32 * 128 + 8 * hi) * 2u;
#pragma unroll
      for (int dt = 0; dt < 2; ++dt) { const char* rowp = (const char*)(wkv + (size_t)(256 * pn + 128 * dt + 32 * wc) * 128);
#pragma unroll
        for (int s = 0; s < 8; ++s) wA[s][dt] = *(const bf16x8*)(rowp + 32 * s + loff); } }
    float qg[2][16];
#pragma unroll
    for (int dt = 0; dt < 2; ++dt)
#pragma unroll
        for (int r = 0; r < 16; ++r) { const int d = 32 * dt + crow(r, hi); qg[dt][r] = g_kn[d] * bf2f(qrow[d]); }
    { v4u w = (v4u){0u, 0u, 0u, 0u}; if ((fr & 3) == 0) w = *(const LAS v4u*)(qrow + 64 + 8 * fq); *(LAS v4u*)(lds + DC_QA + wid * 1024 + lane * 16) = w; }
    for (int i = tid; i < 8 * 64; i += 512) ((LAS unsigned*)(lds + DC_P + 8 * 256))[i] = 0u;
    float mrun = -INFINITY, lrun = 0.f;
    f32x4 accL = (f32x4){0.f, 0.f, 0.f, 0.f};
    const int* ptab = (const int*)F.in[5] + b * NPAGES + half * 64;
    const int ptv = ptab[lane];
    const int npg = 64 + (half == 1 ? 1 : 0);
    const bf16* ckn = (const bf16*)(F.ws + WS_CKVB) + (size_t)(NTOK + b) * 128;
    const bf16* krn = (const bf16*)(F.ws + WS_KRB) + (size_t)(NTOK + b) * 32;
    DecPre pre;
    { const int page = __builtin_amdgcn_readlane(ptv, 0); const float* ck0 = F.in[3] + (size_t)page * (PAGE * 128); const float* kr0 = F.in[4] + (size_t)page * (PAGE * 32);
      dec_load_half(pre, ck0, kr0, 0, tid); dec_store_half(pre, lds + DC_T0, lds + DC_KR0, 0, tid);
      dec_load_half(pre, ck0, kr0, 1, tid); dec_store_half(pre, lds + DC_T0, lds + DC_KR0, 1, tid); }
    { const int page = __builtin_amdgcn_readlane(ptv, 1); const float* ck1 = F.in[3] + (size_t)page * (PAGE * 128); const float* kr1 = F.in[4] + (size_t)page * (PAGE * 32);
      dec_load_half_raw(pre, ck1, kr1, 0, tid); dec_dma_half(ck1, kr1, 1, tid, wid, lds); }
    asm volatile("s_waitcnt lgkmcnt(0)\n\ts_barrier" ::: "memory");
    auto page_body = [&](const int pg, auto steady_tag) __attribute__((always_inline)) {
        constexpr bool STEADY = decltype(steady_tag)::value;
        const bool newtok = !STEADY && pg == 64;
        LAS unsigned char* T = lds + DC_T0 + (pg & 1) * DC_TB; LAS unsigned char* KR = lds + DC_KR0 + (pg & 1) * DC_KRB;
        LAS unsigned char* Tn = lds + DC_T0 + ((pg + 1) & 1) * DC_TB; LAS unsigned char* KRn = lds + DC_KR0 + ((pg + 1) & 1) * DC_KRB;
        const bool more = STEADY || pg + 1 < npg, nextnew = !STEADY && pg + 1 >= 64, more2 = STEADY || pg + 2 < npg, next2new = !STEADY && pg + 2 >= 64, real2 = more2 && !next2new;
        const float* ck2 = nullptr; const float* kr2 = nullptr;
        if (real2) { const int page = __builtin_amdgcn_readlane(ptv, pg + 2); ck2 = F.in[3] + (size_t)page * (PAGE * 128); kr2 = F.in[4] + (size_t)page * (PAGE * 32); }
        float sc[4], sr4[4];
#define DS_R128(dst, addr, off) asm volatile("ds_read_b128 %0, %1 offset:%2" : "=v"(dst) : "v"(addr), "n"(off) : "memory")
#define LW3(bb) asm volatile("s_waitcnt lgkmcnt(3)" : "+v"(bb) :: "memory")
#define SB() __builtin_amdgcn_sched_barrier(0)
        typedef float f32x2 __attribute__((ext_vector_type(2)));
#if PROBE_VALU2
#define VP(acc_, dt_, r_, sv_, dv_) do { const f32x2 x_ = (f32x2){acc_[r_], acc_[(r_) + 1]}; sv_ = x_ * x_ + sv_; dv_ = x_ * (f32x2){qg[dt_][r_], qg[dt_][(r_) + 1]} + dv_; \
        asm volatile("v_pk_fma_f32 %0, %1, %1, %0\n\tv_pk_fma_f32 %0, %1, %1, %0" : "+v"(dumv) : "v"(x_)); } while (0)
        f32x2 dumv = (f32x2){0.f, 0.f};
#else
#define VP(acc_, dt_, r_, sv_, dv_) do { const f32x2 x_ = (f32x2){acc_[r_], acc_[(r_) + 1]}; sv_ = x_ * x_ + sv_; dv_ = x_ * (f32x2){qg[dt_][r_], qg[dt_][(r_) + 1]} + dv_; } while (0)
#endif
        const unsigned tb0 = (unsigned)(uintptr_t)T + hi * DC_TSTR + r32 * 16, kb0 = (unsigned)(uintptr_t)KR + fq * DC_TSTR + fr * 16, qa0 = (unsigned)(uintptr_t)(lds + DC_QA) + wid * 1024 + lane * 16;
        bf16x8 b0, b1, b2, b3;
        {
            bf16x8 qrA, kf[8];
            DS_R128(qrA, qa0, 0);
            DS_R128(kf[0], kb0, 0); DS_R128(kf[1], kb0, 256); DS_R128(kf[2], kb0, 512); DS_R128(kf[3], kb0, 768); DS_R128(kf[4], kb0, 1024); DS_R128(kf[5], kb0, 1280); DS_R128(kf[6], kb0, 1536); DS_R128(kf[7], kb0, 1792);
            DS_R128(b0, tb0, 0); DS_R128(b1, tb0, 2 * DC_TSTR); DS_R128(b2, tb0, 4 * DC_TSTR); DS_R128(b3, tb0, 6 * DC_TSTR);
            SB();
            asm volatile("s_waitcnt lgkmcnt(4)" : "+v"(qrA), "+v"(kf[0]), "+v"(kf[1]), "+v"(kf[2]), "+v"(kf[3]), "+v"(kf[4]), "+v"(kf[5]), "+v"(kf[6]), "+v"(kf[7]) :: "memory");
            SB();
            const f32x4 z4 = (f32x4){0.f, 0.f, 0.f, 0.f};
#pragma unroll
            for (int g = 0; g < 4; ++g) {
                const f32x4 rr0 = __builtin_amdgcn_mfma_f32_16x16x32_bf16(qrA, kf[2 * g], z4, 0, 0, 0), rr1 = __builtin_amdgcn_mfma_f32_16x16x32_bf16(qrA, kf[2 * g + 1], z4, 0, 0, 0);
                sr4[g] = (r32 < 16) ? rr0[0] : rr1[0];
            }
            SB();
        }
        f32x16 a0, a1;
        f32x2 s0v, d0v, s1v, d1v; const f32x2 z2 = (f32x2){0.f, 0.f};
#define DEC_FIN(gg) do { float ssq = (s0v[0] + s0v[1]) + (s1v[0] + s1v[1]), dot = (d0v[0] + d0v[1]) + (d1v[0] + d1v[1]); \
            { auto t = __builtin_amdgcn_permlane32_swap(__float_as_uint(ssq), __float_as_uint(ssq), false, false); ssq = __uint_as_float(t[0]) + __uint_as_float(t[1]); } \
            { auto t = __builtin_amdgcn_permlane32_swap(__float_as_uint(dot), __float_as_uint(dot), false, false); dot = __uint_as_float(t[0]) + __uint_as_float(t[1]); } \
            float sv = dot * __builtin_amdgcn_rsqf(ssq * (1.0f / 64.0f) + EPS) + sr4[gg]; \
            if (newtok && (32 * (gg) + r32) != 0) sv = -INFINITY; \
            sc[gg] = sv; } while (0)
#pragma unroll
        for (int g = 0; g < 4; ++g) {
#pragma unroll
            for (int r = 0; r < 16; ++r) a0[r] = 0.f;
            if (g > 0) { s1v = (f32x2){0.f, 0.f}; d1v = (f32x2){0.f, 0.f}; }
            SB();
#define XS(i_, bb, off_, VAL) LW3(bb); SB(); a0 = __builtin_amdgcn_mfma_f32_32x32x16_bf16(wA[i_][0], bb, a0, 0, 0, 0); SB(); DS_R128(bb, tb0, off_); SB(); if (g > 0) { VAL; } SB()
            XS(0, b0,  8 * DC_TSTR + 512 * g, (void)0);
            XS(1, b1, 10 * DC_TSTR + 512 * g, VP(a1, 1, 0, s1v, d1v));
            XS(2, b2, 12 * DC_TSTR + 512 * g, VP(a1, 1, 2, s1v, d1v));
            XS(3, b3, 14 * DC_TSTR + 512 * g, VP(a1, 1, 4, s1v, d1v));
            XS(4, b0,  0 * DC_TSTR + 512 * g, VP(a1, 1, 6, s1v, d1v));
            XS(5, b1,  2 * DC_TSTR + 512 * g, VP(a1, 1, 8, s1v, d1v));
            XS(6, b2,  4 * DC_TSTR + 512 * g, VP(a1, 1, 10, s1v, d1v));
            XS(7, b3,  6 * DC_TSTR + 512 * g, VP(a1, 1, 12, s1v, d1v); VP(a1, 1, 14, s1v, d1v));
#undef XS
#pragma unroll
            for (int r = 0; r < 16; ++r) a1[r] = 0.f;
            SB();
#define YS(i_, bb, WAITST, READST, VAL) WAITST; SB(); a1 = __builtin_amdgcn_mfma_f32_32x32x16_bf16(wA[i_][1], bb, a1, 0, 0, 0); SB(); READST; SB(); VAL; SB()
            YS(0, b0, LW3(b0), DS_R128(b0, tb0,  8 * DC_TSTR + 512 * g), if (g > 0) DEC_FIN(g - 1); s0v = z2; d0v = z2);
            YS(1, b1, LW3(b1), DS_R128(b1, tb0, 10 * DC_TSTR + 512 * g), VP(a0, 0, 0, s0v, d0v));
            YS(2, b2, LW3(b2), DS_R128(b2, tb0, 12 * DC_TSTR + 512 * g), VP(a0, 0, 2, s0v, d0v));
            YS(3, b3, LW3(b3), DS_R128(b3, tb0, 14 * DC_TSTR + 512 * g), VP(a0, 0, 4, s0v, d0v));
            if (g < 3) {
                YS(4, b0, LW3(b0), DS_R128(b0, tb0, 0 * DC_TSTR + 512 * (g + 1)), VP(a0, 0, 6, s0v, d0v));
                YS(5, b1, LW3(b1), DS_R128(b1, tb0, 2 * DC_TSTR + 512 * (g + 1)), VP(a0, 0, 8, s0v, d0v));
                YS(6, b2, LW3(b2), DS_R128(b2, tb0, 4 * DC_TSTR + 512 * (g + 1)), VP(a0, 0, 10, s0v, d0v));
                YS(7, b3, LW3(b3), DS_R128(b3, tb0, 6 * DC_TSTR + 512 * (g + 1)), VP(a0, 0, 12, s0v, d0v); VP(a0, 0, 14, s0v, d0v));
            } else {
                YS(4, b0, LW3(b0), (void)0, VP(a0, 0, 6, s0v, d0v));
                YS(5, b1, asm volatile("s_waitcnt lgkmcnt(2)" : "+v"(b1) :: "memory"), (void)0, VP(a0, 0, 8, s0v, d0v));
                YS(6, b2, asm volatile("s_waitcnt lgkmcnt(1)" : "+v"(b2) :: "memory"), (void)0, VP(a0, 0, 10, s0v, d0v));
                YS(7, b3, asm volatile("s_waitcnt lgkmcnt(0)" : "+v"(b3) :: "memory"), (void)0, VP(a0, 0, 12, s0v, d0v); VP(a0, 0, 14, s0v, d0v));
            }
#undef YS
            if (g == 1 && more) {
                if (STEADY) dec_wait_pre<5>(pre); else dec_wait_pre<0>(pre);
                dec_store_half(pre, Tn, KRn, 0, tid);
                __builtin_amdgcn_sched_barrier(0);
                if (more2) { if (!next2new) dec_load_half_raw(pre, ck2, kr2, 0, tid); else dec_load_newtok_half(pre, ckn, krn, 0, tid); }
                __builtin_amdgcn_sched_barrier(0);
            }
        }
        s1v = (f32x2){0.f, 0.f}; d1v = (f32x2){0.f, 0.f};
#pragma unroll
        for (int r = 0; r < 16; r += 2) VP(a1, 1, r, s1v, d1v);
        DEC_FIN(3);
#undef DS_R128
#undef LW3
#undef SB
#undef VP
#undef DEC_FIN
        const float pm = fmaxf(fmaxf(sc[0], sc[1]), fmaxf(sc[2], sc[3]));
        float alpha = 1.0f;
        if (__any(pm > mrun + 8.0f)) {
            const float mn = fmaxf(mrun, wave_max(pm));
            alpha = __builtin_amdgcn_exp2f(mrun - mn);
            mrun = mn; lrun *= alpha;
        }
#pragma unroll
        for (int g = 0; g < 4; ++g) { sc[g] = __builtin_amdgcn_exp2f(sc[g] - mrun); lrun += sc[g]; }
        if (hi == 0) {
#pragma unroll
            for (int g = 0; g < 4; ++g) ((LAS bf16*)(lds + DC_P))[wid * 128 + 32 * g + r32] = (bf16)(cvt_pk_bf16(sc[g], 0.f) & 0xffffu);
        }
        if (lane == 0) ((LAS float*)(lds + DC_AL))[wid] = alpha;
        asm volatile("s_waitcnt lgkmcnt(0)\n\ts_barrier" ::: "memory");
        DecPre st;
        if (more && !nextnew) {
            if (real2) asm volatile("s_waitcnt vmcnt(5)" ::: "memory"); else asm volatile("s_waitcnt vmcnt(0)" ::: "memory");
            dec_stage_to_pre(st, tid, lds);
        }
        {
            const int q = fr >> 2, p = fr & 3;
            const f32x4 al4 = *(const LAS f32x4*)(lds + DC_AL + (fq & 1) * 16);
            bf16x8 pa[4];
#pragma unroll
            for (int ks = 0; ks < 4; ++ks) pa[ks] = *(const LAS bf16x8*)(lds + DC_P + fr * 256 + (32 * ks + 8 * fq) * 2);
            const unsigned a0 = (unsigned)(uintptr_t)T + (2 * wid + (p >> 1)) * DC_TSTR + (8 * fq + q) * 16 + (p & 1) * 8;
            s16x4 lo0, hh0, lo1, hh1, lo2, hh2, lo3, hh3;
            asm volatile("ds_read_b64_tr_b16 %0, %8\n\tds_read_b64_tr_b16 %1, %8 offset:64\n\tds_read_b64_tr_b16 %2, %8 offset:512\n\tds_read_b64_tr_b16 %3, %8 offset:576\n\t"
                         "ds_read_b64_tr_b16 %4, %8 offset:1024\n\tds_read_b64_tr_b16 %5, %8 offset:1088\n\tds_read_b64_tr_b16 %6, %8 offset:1536\n\tds_read_b64_tr_b16 %7, %8 offset:1600\n\ts_waitcnt lgkmcnt(0)"
                         : "=&v"(lo0), "=&v"(hh0), "=&v"(lo1), "=&v"(hh1), "=&v"(lo2), "=&v"(hh2), "=&v"(lo3), "=&v"(hh3) : "v"(a0) : "memory");
            accL = accL * al4;
            accL = __builtin_amdgcn_mfma_f32_16x16x32_bf16(pa[0], (bf16x8){lo0[0], lo0[1], lo0[2], lo0[3], hh0[0], hh0[1], hh0[2], hh0[3]}, accL, 0, 0, 0);
            accL = __builtin_amdgcn_mfma_f32_16x16x32_bf16(pa[1], (bf16x8){lo1[0], lo1[1], lo1[2], lo1[3], hh1[0], hh1[1], hh1[2], hh1[3]}, accL, 0, 0, 0);
            accL = __builtin_amdgcn_mfma_f32_16x16x32_bf16(pa[2], (bf16x8){lo2[0], lo2[1], lo2[2], lo2[3], hh2[0], hh2[1], hh2[2], hh2[3]}, accL, 0, 0, 0);
            accL = __builtin_amdgcn_mfma_f32_16x16x32_bf16(pa[3], (bf16x8){lo3[0], lo3[1], lo3[2], lo3[3], hh3[0], hh3[1], hh3[2], hh3[3]}, accL, 0, 0, 0);
        }
        if (more && !nextnew) {
            dec_store_half(st, Tn, KRn, 1, tid);
            if (real2) dec_dma_half(ck2, kr2, 1, tid, wid, lds);
        }
        asm volatile("s_waitcnt lgkmcnt(0)\n\ts_barrier" ::: "memory");
    };
    for (int pg = 0; pg < 62; ++pg) page_body(pg, BoolTag<true>{});
    for (int pg = 62; pg < npg; ++pg) page_body(pg, BoolTag<false>{});
#if DEC_PRIO
    __builtin_amdgcn_s_setprio(0);
#endif
    { int l2 = threadIdx.x; asm volatile("" : "+v"(l2)); l2 &= 63; const int fr2 = l2 & 15, fq2 = l2 >> 4;
      float* part = (float*)(F.ws + WS_DPART) + (size_t)(b * 2 + half) * DPART_STRIDE;
      const float ltot = wave_sum(lrun) * 0.5f;
      if (l2 == 0) { part[wid * 132 + 0] = mrun; part[wid * 132 + 1] = ltot; }
      if (fq2 < 2) {
#pragma unroll
          for (int i = 0; i < 4; ++i) part[(4 * fq2 + i) * 132 + 4 + 16 * wid + fr2] = accL[i];
      } }
}
__device__ __forceinline__ v4u norm8_pack(const float (&v)[8], float inv) {
    v4u w; w.x = cvt_pk_bf16(v[0] * inv, v[1] * inv); w.y = cvt_pk_bf16(v[2] * inv, v[3] * inv); w.z = cvt_pk_bf16(v[4] * inv, v[5] * inv); w.w = cvt_pk_bf16(v[6] * inv, v[7] * inv); return w;
}
__device__ __forceinline__ v2u norm4_pack(const float (&v)[4], float inv) { v2u w; w.x = cvt_pk_bf16(v[0] * inv, v[1] * inv); w.y = cvt_pk_bf16(v[2] * inv, v[3] * inv); return w; }
__device__ __forceinline__ void tp_finish_row(bf16* omix_row, const float (&a)[8], const float (&y)[4], const float (&mo)[4], int lane, int parts = 3) {
    if (parts & 1) {
        float sa = 0.f;
#pragma unroll
        for (int i = 0; i < 8; ++i) sa += a[i] * a[i];
        sa = wave_sum(sa);
        const float ia = __builtin_amdgcn_rsqf(sa * (1.0f / 512.0f) + EPS);
        *(v4u*)(omix_row + 8 * lane) = norm8_pack(a, ia);
    }
    if (parts & 2) {
        float sy = 0.f, sm = 0.f;
#pragma unroll
        for (int i = 0; i < 4; ++i) { sy += y[i] * y[i]; sm += mo[i] * mo[i]; }
        sy = wave_sum(sy); sm = wave_sum(sm);
        const float iy = __builtin_amdgcn_rsqf(sy * (1.0f / 256.0f) + EPS), im = __builtin_amdgcn_rsqf(sm * (1.0f / 256.0f) + EPS);
        *(v2u*)(omix_row + 512 + 4 * lane) = norm4_pack(y, iy);
        *(v2u*)(omix_row + 768 + 4 * lane) = norm4_pack(mo, im);
    }
}
__device__ __forceinline__ void tp_prompt_row(const Frame& F, int r) {
    const int lane = F.lane, t = r & (SEQ - 1);
    const bf16* oab = (const bf16*)(F.ws + WS_OAB); const bf16* omb = (const bf16*)(F.ws + WS_OMB); const bf16* ub = (const bf16*)(F.ws + WS_UB); const bf16* gbb = (const bf16*)(F.ws + WS_GBB);
    const float* cw = F.in[24];
    float a[8], y[4], mo[4];
    { const v4u w = *(const v4u*)(oab + (size_t)r * 512 + 8 * lane); a[0] = bflo(w.x); a[1] = bfhi(w.x); a[2] = bflo(w.y); a[3] = bfhi(w.y); a[4] = bflo(w.z); a[5] = bfhi(w.z); a[6] = bflo(w.w); a[7] = bfhi(w.w); }
    { const v2u w = *(const v2u*)(omb + (size_t)r * 256 + 4 * lane); mo[0] = bflo(w.x); mo[1] = bfhi(w.x); mo[2] = bflo(w.y); mo[3] = bfhi(w.y); }
    { const v2u u0 = *(const v2u*)(ub + (size_t)r * 256 + 4 * lane);
      v2u u1 = (v2u){0u, 0u}, u2 = (v2u){0u, 0u};
      if (t >= 1) u1 = *(const v2u*)(ub + (size_t)(r - 1) * 256 + 4 * lane);
      if (t >= 2) u2 = *(const v2u*)(ub + (size_t)(r - 2) * 256 + 4 * lane);
      const v2u g = *(const v2u*)(gbb + (size_t)r * 256 + 4 * lane);
      const f32x4 w0 = *(const f32x4*)(cw + 4 * lane), w1 = *(const f32x4*)(cw + 256 + 4 * lane), w2 = *(const f32x4*)(cw + 512 + 4 * lane);
      y[0] = bflo(g.x) * (w0[0] * bflo(u2.x) + w1[0] * bflo(u1.x) + w2[0] * bflo(u0.x));
      y[1] = bfhi(g.x) * (w0[1] * bfhi(u2.x) + w1[1] * bfhi(u1.x) + w2[1] * bfhi(u0.x));
      y[2] = bflo(g.y) * (w0[2] * bflo(u2.y) + w1[2] * bflo(u1.y) + w2[2] * bflo(u0.y));
      y[3] = bfhi(g.y) * (w0[3] * bfhi(u2.y) + w1[3] * bfhi(u1.y) + w2[3] * bfhi(u0.y)); }
    tp_finish_row((bf16*)(F.ws + WS_OMIX) + (size_t)r * D, a, y, mo, lane);
}
__device__ __forceinline__ void tp_sample_wg(const Frame& F, int b, int parts = 3) {
    const int lane = F.lane, wid = F.wave, r = NTOK + b;
    LAS float* base = (LAS float*)F.lds;
    LAS float* lat = base; LAS float* oA = base + 1024; LAS float* oM = base + 1536; LAS float* yc = base + 1792; LAS float* qf = base + 2048 + (wid & 3) * 64; LAS float* pb = base + 2304 + (wid & 3) * 256;
    __syncthreads();
    if (parts & 1) { const int h = wid; const float* part = (const float*)(F.ws + WS_DPART) + (size_t)(b * 2) * DPART_STRIDE;
      const float m0 = part[h * 132], l0 = part[h * 132 + 1], m1 = part[DPART_STRIDE + h * 132], l1 = part[DPART_STRIDE + h * 132 + 1];
      const float M = fmaxf(m0, m1), e0 = __builtin_amdgcn_exp2f(m0 - M), e1 = __builtin_amdgcn_exp2f(m1 - M);
      const float rl = 1.0f / (l0 * e0 + l1 * e1);
#pragma unroll
      for (int j = 0; j < 2; ++j) { const int c = lane + 64 * j; lat[h * 128 + c] = (part[h * 132 + 4 + c] * e0 + part[DPART_STRIDE + h * 132 + 4 + c] * e1) * rl; }
      LDS_WAIT();
      const float* wuv = F.in[21] + h * 64 + lane; float a = 0.f;
#pragma unroll 32
      for (int l = 0; l < 128; ++l) a += lat[h * 128 + l] * wuv[(size_t)l * 512];
      oA[h * 64 + lane] = a; }
    if (!(parts & 2)) {}
    else if (wid < 4) {
        const int h = wid; const bf16* mqb = (const bf16*)(F.ws + WS_MQB) + (size_t)r * 256; const float* ck = F.in[7] + (size_t)b * (256 * 256); const float* cv = F.in[8] + (size_t)b * (256 * 256);
        qf[lane] = bf2f(mqb[h * 64 + lane]);
        LDS_WAIT();
        float sv[4];
#pragma unroll
        for (int j = 0; j < 4; ++j) { const int n = lane + 64 * j; const float* kp = ck + (size_t)n * 256 + h * 64; float acc = 0.f;
#pragma unroll
            for (int d4 = 0; d4 < 16; ++d4) { const f32x4 kv = *(const f32x4*)(kp + 4 * d4); const f32x4 qv = *(const LAS f32x4*)(qf + 4 * d4); acc += kv[0] * qv[0] + kv[1] * qv[1] + kv[2] * qv[2] + kv[3] * qv[3]; }
            sv[j] = acc; }
        const float mx = wave_max(fmaxf(fmaxf(sv[0], sv[1]), fmaxf(sv[2], sv[3])));
        float ls = 0.f;
#pragma unroll
        for (int j = 0; j < 4; ++j) { sv[j] = __builtin_amdgcn_exp2f(sv[j] - mx); ls += sv[j]; pb[lane + 64 * j] = sv[j]; }
        ls = wave_sum(ls);
        LDS_WAIT();
        float o = 0.f;
#pragma unroll 32
        for (int n = 0; n < 256; ++n) o += pb[n] * cv[(size_t)n * 256 + h * 64 + lane];
        oM[h * 64 + lane] = o / ls;
    } else {
        const int c = (wid - 4) * 64 + lane; const bf16* ub = (const bf16*)(F.ws + WS_UB); const bf16* gbb = (const bf16*)(F.ws + WS_GBB); const float* cw = F.in[24]; const float* st = F.in[6] + (size_t)b * 512;
        yc[c] = bf2f(gbb[(size_t)r * 256 + c]) * (cw[c] * st[c] + cw[256 + c] * st[256 + c] + cw[512 + c] * bf2f(ub[(size_t)r * 256 + c]));
    }
    __syncthreads();
    if (wid == 0) {
        float a[8], y[4], mo[4];
#pragma unroll
        for (int i = 0; i < 8; ++i) a[i] = (parts & 1) ? oA[8 * lane + i] : 0.f;
#pragma unroll
        for (int i = 0; i < 4; ++i) { y[i] = (parts & 2) ? yc[4 * lane + i] : 0.f; mo[i] = (parts & 2) ? oM[4 * lane + i] : 0.f; }
        if (parts & 1) *(v4u*)((bf16*)(F.ws + WS_OAB) + (size_t)r * 512 + 8 * lane) = norm8_pack(a, 1.0f);
        if (parts & 2) *(v2u*)((bf16*)(F.ws + WS_OMB) + (size_t)r * 256 + 4 * lane) = norm4_pack(mo, 1.0f);
        tp_finish_row((bf16*)(F.ws + WS_OMIX) + (size_t)r * D, a, y, mo, lane, parts);
    }
}
__device__ __forceinline__ void tp_phase(const Frame& F) {
    const int gw = F.vcu * NWAVES + F.wave, NGW = F.G * NWAVES;
    for (int r = gw; r < NTOK; r += NGW) tp_prompt_row(F, r);
}
struct ABf16 {
    const bf16* p; int ld;
    static constexpr bool NEEDS_INV = false;
    __device__ __forceinline__ float row_inv(int) const { return 1.f; }
    __device__ __forceinline__ v4u piece(int row, int k, float) const { return *(const v4u*)(p + (size_t)row * ld + k); }
};
struct ASum {
    const float* a; const float* b; float cb;
    static constexpr bool NEEDS_INV = false;
    __device__ __forceinline__ float row_inv(int) const { return 1.f; }
    __device__ __forceinline__ v4u piece(int row, int k, float) const {
        const f32x4 a0 = *(const f32x4*)(a + (size_t)row * 1024 + k), a1 = *(const f32x4*)(a + (size_t)row * 1024 + k + 4);
        const f32x4 b0 = *(const f32x4*)(b + (size_t)row * 1024 + k), b1 = *(const f32x4*)(b + (size_t)row * 1024 + k + 4);
        const f32x4 v0 = a0 + b0 * cb, v1 = a1 + b1 * cb;
        v4u w; w.x = cvt_pk_bf16(v0[0], v0[1]); w.y = cvt_pk_bf16(v0[2], v0[3]); w.z = cvt_pk_bf16(v1[0], v1[1]); w.w = cvt_pk_bf16(v1[2], v1[3]); return w;
    }
};
struct ASilu {
    const float* gu; const float* ssq;
    static constexpr bool NEEDS_INV = true;
    __device__ __forceinline__ float row_inv(int row) const { return pg8::row_inv_from_parts(ssq, NTOK + row); }
    __device__ __forceinline__ v4u piece(int row, int k, float iv) const {
        const float* gp = gu + (size_t)row * FF2 + 256 * (k >> 7) + (k & 127);
        const f32x4 g0 = *(const f32x4*)gp, g1 = *(const f32x4*)(gp + 4), u0 = *(const f32x4*)(gp + 128), u1 = *(const f32x4*)(gp + 132);
        v4u w;
        w.x = cvt_pk_bf16(pg8::silu_mul(g0[0] * iv, u0[0] * iv), pg8::silu_mul(g0[1] * iv, u0[1] * iv)); w.y = cvt_pk_bf16(pg8::silu_mul(g0[2] * iv, u0[2] * iv), pg8::silu_mul(g0[3] * iv, u0[3] * iv));
        w.z = cvt_pk_bf16(pg8::silu_mul(g1[0] * iv, u1[0] * iv), pg8::silu_mul(g1[1] * iv, u1[1] * iv)); w.w = cvt_pk_bf16(pg8::silu_mul(g1[2] * iv, u1[2] * iv), pg8::silu_mul(g1[3] * iv, u1[3] * iv));
        return w;
    }
};
template <int KB, class AProv, int CH = 1>
__device__ __forceinline__ void mini_gemm(const Frame& F, const AProv& A, const bf16* Bt, int K, int N, int item0, float* out, int ldo, float scale) {
    constexpr int PPR = KB / 8, PITCH = (KB + 8) * 2;
    constexpr int A_OFF = 0, B_OFF = 128 * PITCH, INV_OFF = B_OFF + 64 * PITCH;
    static_assert(INV_OFF + 512 <= RING_BYTES && KB % 16 == 0 && (CH == 1 || !AProv::NEEDS_INV), "mini_gemm LDS");
    int tid_ = F.tid; asm volatile("" : "+v"(tid_));
    const int tid = tid_, lane = tid & 63, r32 = lane & 31, hi = lane >> 5, wid = F.wave, rt = wid >> 1, ct = wid & 1;
    LAS unsigned char* lds = F.lds;
    const int nnb = N / 64, nitems = nnb * (K / (KB * CH));
    constexpr int NPA = (128 * PPR + 511) / 512, NPB = (64 * PPR + 511) / 512;
#ifndef MINI_REP
#define MINI_REP 1
#endif
    for (int rep_ = 0; rep_ < MINI_REP; ++rep_)
    for (int it = item0; it < nitems; it += F.G) {
        const int nb = it % nnb, kbase = (it / nnb) * (KB * CH), n0 = nb * 64;
        asm volatile("s_waitcnt lgkmcnt(0)\n\ts_barrier" ::: "memory");
        if (AProv::NEEDS_INV) { if (tid < 128) ((LAS float*)(lds + INV_OFF))[tid] = A.row_inv(tid); __syncthreads(); }
        v4u va[NPA], vb[NPB];
        auto load_chunk = [&](int k0) __attribute__((always_inline)) {
#pragma unroll
            for (int j = 0; j < NPA; ++j) { const int p = tid + 512 * j; const int row = p / PPR, c = p - row * PPR;
                va[j] = (v4u){0u, 0u, 0u, 0u};
                if (p < 128 * PPR) { const float iv = AProv::NEEDS_INV ? ((LAS float*)(lds + INV_OFF))[row] : 1.f; va[j] = A.piece(row, k0 + 8 * c, iv); } }
#pragma unroll
            for (int j = 0; j < NPB; ++j) { const int p = tid + 512 * j; const int n = p / PPR, c = p - n * PPR;
                vb[j] = (v4u){0u, 0u, 0u, 0u};
                if (p < 64 * PPR) vb[j] = *(const v4u*)(Bt + (size_t)(n0 + n) * K + k0 + 8 * c); } };
        load_chunk(kbase);
        f32x16 acc;
#pragma unroll
        for (int r = 0; r < 16; ++r) acc[r] = 0.f;
#pragma unroll
        for (int ch = 0; ch < CH; ++ch) {
            if (ch > 0) asm volatile("s_waitcnt lgkmcnt(0)\n\ts_barrier" ::: "memory");
#pragma unroll
            for (int j = 0; j < NPA; ++j) { const int p = tid + 512 * j; const int row = p / PPR, c = p - row * PPR; if (p < 128 * PPR) *(LAS v4u*)(lds + A_OFF + row * PITCH + c * 16) = va[j]; }
#pragma unroll
            for (int j = 0; j < NPB; ++j) { const int p = tid + 512 * j; const int n = p / PPR, c = p - n * PPR; if (p < 64 * PPR) *(LAS v4u*)(lds + B_OFF + n * PITCH + c * 16) = vb[j]; }
            if (ch + 1 < CH) load_chunk(kbase + (ch + 1) * KB);
            asm volatile("s_waitcnt lgkmcnt(0)\n\ts_barrier" ::: "memory");
            const LAS unsigned char* ap = lds + A_OFF + (32 * rt + r32) * PITCH + 16 * hi; const LAS unsigned char* bp = lds + B_OFF + (32 * ct + r32) * PITCH + 16 * hi;
#pragma unroll
            for (int s = 0; s < KB / 16; ++s) acc = __builtin_amdgcn_mfma_f32_32x32x16_bf16(*(const LAS bf16x8*)(ap + 32 * s), *(const LAS bf16x8*)(bp + 32 * s), acc, 0, 0, 0);
        }
        float* op = out + (size_t)(32 * rt) * ldo + n0 + 32 * ct + r32;
#pragma unroll
        for (int r = 0; r < 16; ++r) unsafeAtomicAdd(op + (size_t)crow(r, hi) * ldo, acc[r] * scale);
    }
    asm volatile("s_waitcnt lgkmcnt(0)\n\ts_barrier" ::: "memory");
}
__device__ __forceinline__ void postz_sample_row(const Frame& F, int b) {
    const int lane = F.lane, r = NTOK + b;
    const float* xr = F.in[2] + (size_t)b * D; const float* d1 = (const float*)(F.ws + WS_D1S) + (size_t)b * D; const float* zr = (const float*)(F.ws + WS_ZS) + (size_t)b * INWP;
    float* x1r = (float*)(F.ws + WS_X1F) + (size_t)r * D;
    float s = 0.f;
#pragma unroll
    for (int j = 0; j < 4; ++j) { const f32x4 v = ((const f32x4*)xr)[lane + 64 * j] + ((const f32x4*)d1)[lane + 64 * j] * 0.5f; ((f32x4*)x1r)[lane + 64 * j] = v; s += (v[0] * v[0] + v[1] * v[1]) + (v[2] * v[2] + v[3] * v[3]); }
    const float inv1 = __builtin_amdgcn_rsqf(wave_sum(s) * (1.0f / 1024.0f) + EPS);
    { const f32x4 v = ((const f32x4*)zr)[lane] * inv1; const float q = wave_sum((v[0] * v[0] + v[1] * v[1]) + (v[2] * v[2] + v[3] * v[3]));
      if (lane == 0) ((float*)(F.ws + WS_MSQ))[r] = q * (1.0f / 256.0f);
      v2u w; w.x = cvt_pk_bf16(v[0], v[1]); w.y = cvt_pk_bf16(v[2], v[3]); ((v2u*)((bf16*)(F.ws + WS_CQB) + (size_t)r * 256))[lane] = w; }
    { const float a0 = zr[256 + 2 * lane] * inv1, a1 = zr[256 + 2 * lane + 1] * inv1; const float ic = __builtin_amdgcn_rsqf(wave_sum(a0 * a0 + a1 * a1) * (1.0f / 128.0f) + EPS);
      const float o0 = a0 * ic * F.in[19][2 * lane], o1 = a1 * ic * F.in[19][2 * lane + 1];
      float* op = F.out + O_CKVS + (size_t)b * 128 + 2 * lane; op[0] = o0; op[1] = o1;
      ((unsigned*)((bf16*)(F.ws + WS_CKVB) + (size_t)r * 128))[lane] = cvt_pk_bf16(o0, o1); }
    { const float a = lane < 32 ? zr[384 + lane] * inv1 : 0.f; const float ik = __builtin_amdgcn_rsqf(wave_sum(a * a) * (1.0f / 32.0f) + EPS);
      const float w = a * ik * F.in[23][lane & 31]; const float other = __shfl_xor(w, 16);
      const float* rp = (const float*)(F.ws + WS_ROPE) + (size_t)8192 * 32; const int i = lane & 15; const float cs = rp[i], sn = rp[16 + i];
      const float o = (lane & 16) ? (other * sn + w * cs) : (w * cs - other * sn);
      if (lane < 32) { F.out[O_KRS + (size_t)b * 32 + lane] = o; ((bf16*)(F.ws + WS_KRB))[(size_t)r * 32 + lane] = (bf16)(cvt_pk_bf16(o, 0.f) & 0xffffu); } }
    { const int j = 4 * lane; const int zo = j < 128 ? 512 + j : 768 + (j - 128);
      const f32x4 ui = *(const f32x4*)(zr + zo) * inv1, gc = *(const f32x4*)(zr + zo + 128) * inv1; const f32x4 u = gc * ui;
      v2u w; w.x = cvt_pk_bf16(u[0], u[1]); w.y = cvt_pk_bf16(u[2], u[3]); ((v2u*)((bf16*)(F.ws + WS_UB) + (size_t)r * 256))[lane] = w;
      *(f32x4*)(F.out + O_CONVS + (size_t)b * 512 + 256 + j) = u;
      const f32x4 gb = *(const f32x4*)(zr + 1024 + j) * inv1; w.x = cvt_pk_bf16(gb[0], gb[1]); w.y = cvt_pk_bf16(gb[2], gb[3]); ((v2u*)((bf16*)(F.ws + WS_GBB) + (size_t)r * 256))[lane] = w;
      const int h = j >> 6, d = j & 63; const f32x4 mq = *(const f32x4*)(zr + 1280 + 128 * (d >> 5) + 32 * h + (d & 31)) * inv1;
      float q = (mq[0] * mq[0] + mq[1] * mq[1]) + (mq[2] * mq[2] + mq[3] * mq[3]);
      q += __shfl_xor(q, 1); q += __shfl_xor(q, 2); q += __shfl_xor(q, 4); q += __shfl_xor(q, 8);
      const float im = __builtin_amdgcn_rsqf(q * (1.0f / 64.0f) + EPS) * pg8::kC2M; const f32x4 g = *(const f32x4*)(F.in[28] + d); const f32x4 o = mq * im * g;
      w.x = cvt_pk_bf16(o[0], o[1]); w.y = cvt_pk_bf16(o[2], o[3]); ((v2u*)((bf16*)(F.ws + WS_MQB) + (size_t)r * 256))[lane] = w; }
}
__device__ __forceinline__ void q_sample_gemv(const Frame& F, int b) {
    const int lane = F.lane, wid = F.wave, r = NTOK + b;
    LAS float* cq = (LAS float*)F.lds;
    __syncthreads();
    { const bf16* cqr = (const bf16*)(F.ws + WS_CQB) + (size_t)r * 256; if (F.tid < 256) cq[F.tid] = bf2f(cqr[F.tid]); }
    __syncthreads();
    const bf16* W = (const bf16*)(F.ws + WS_WUQ);
    float* qs = (float*)(F.ws + WS_QS) + (size_t)b * 768;
    for (int jj = 0; jj < 2; ++jj) {
        const int j = lane + 64 * jj; if (j >= 96) break;
        const int n = 96 * wid + j;
        const bf16* wrow = W + (size_t)n * 256;
        float acc = 0.f;
#pragma unroll 8
        for (int c = 0; c < 32; ++c) { const v4u w = *(const v4u*)(wrow + 8 * c); const f32x4 c0 = *(const LAS f32x4*)(cq + 8 * c), c1 = *(const LAS f32x4*)(cq + 8 * c + 4);
            acc += (bflo(w.x) * c0[0] + bfhi(w.x) * c0[1]) + (bflo(w.y) * c0[2] + bfhi(w.y) * c0[3]) + (bflo(w.z) * c1[0] + bfhi(w.z) * c1[1]) + (bflo(w.w) * c1[2] + bfhi(w.w) * c1[3]); }
        qs[n] = acc;
    }
    __syncthreads();
}
__device__ __forceinline__ void x2_sample_row(const Frame& F, int b) {
    const int lane = F.lane, r = NTOK + b;
    const float* x1r = (const float*)(F.ws + WS_X1F) + (size_t)r * D; const float* d7 = (const float*)(F.ws + WS_D7S) + (size_t)b * D; float* x2r = (float*)(F.ws + WS_X2F) + (size_t)r * D; float* yr = F.out + O_YS + (size_t)b * D;
    float s = 0.f;
#pragma unroll
    for (int j = 0; j < 4; ++j) { const f32x4 v = ((const f32x4*)x1r)[lane + 64 * j] + ((const f32x4*)d7)[lane + 64 * j]; ((f32x4*)x2r)[lane + 64 * j] = v; ((f32x4*)yr)[lane + 64 * j] = v; s += (v[0] * v[0] + v[1] * v[1]) + (v[2] * v[2] + v[3] * v[3]); }
    s = wave_sum(s);
    if (lane == 0) ((float*)(F.ws + WS_SSQ2))[r] = s;
}
__device__ __forceinline__ void memkv_post_row(const Frame& F, int row) {
    const int lane = F.lane; const float* raw = (const float*)(F.ws + WS_MEMRAW) + (size_t)row * 512;
    const float iv = pg8::row_inv_from_parts((const float*)(F.ws + WS_SSQM), row);
    const int b_ = row >> 8, n_ = row & 255;
    { const int j = 4 * lane, h = j >> 6, d = j & 63;
      const f32x4 v = *(const f32x4*)(raw + 128 * (d >> 5) + 32 * h + (d & 31)) * iv;
      float q = (v[0] * v[0] + v[1] * v[1]) + (v[2] * v[2] + v[3] * v[3]);
      q += __shfl_xor(q, 1); q += __shfl_xor(q, 2); q += __shfl_xor(q, 4); q += __shfl_xor(q, 8);
      const f32x4 o = v * __builtin_amdgcn_rsqf(q * (1.0f / 64.0f) + EPS) * *(const f32x4*)(F.in[29] + d);
      *(f32x4*)(F.out + O_MKP + (size_t)row * 256 + j) = o;
      v2u w; w.x = cvt_pk_bf16(o[0], o[1]); w.y = cvt_pk_bf16(o[2], o[3]); *(v2u*)((bf16*)(F.ws + WS_MEMK) + ((size_t)(b_ * 4 + h) * 256 + n_) * 64 + d) = w; }
    { const int j = 4 * lane, h = j >> 6, d = j & 63;
      const f32x4 o = *(const f32x4*)(raw + 256 + j) * iv;
      *(f32x4*)(F.out + O_MVP + (size_t)row * 256 + j) = o;
      v2u w; w.x = cvt_pk_bf16(o[0], o[1]); w.y = cvt_pk_bf16(o[2], o[3]); *(v2u*)((bf16*)(F.ws + WS_MEMV) + ((size_t)(b_ * 4 + h) * 256 + n_) * 64 + d) = w; }
}
#if DBG_ORACLE
__device__ __forceinline__ void dbg_phase(const Frame& F);
__device__ __forceinline__ void dbg_report(const Frame& F, unsigned* barw);
#endif
#ifndef KD_G1
#define KD_G1 1
#endif
#ifndef KD_G2
#define KD_G2 1
#endif
#ifndef REP_X
#define REP_X 1
#endif
#ifndef ALIGN_SWIGLU
#define ALIGN_SWIGLU true
#endif
#ifndef STREAM_PROBE
#define STREAM_PROBE 0
#endif
#ifndef REP_DEC
#define REP_DEC 1
#endif
#ifndef REP_MLA
#define REP_MLA 1
#endif
#ifndef REP_GA
#define REP_GA 1
#endif
#ifndef REP_GB
#define REP_GB 1
#endif
#ifndef REP_GC
#define REP_GC 1
#endif
#define P_BF(off) ((bf16*)(F.ws + (off)))
#define P_F32(off) ((float*)(F.ws + (off)))
#define W1GU P_BF(WS_W1GU)
#define W1D P_BF(WS_W1D)
#define WIN P_BF(WS_WIN)
#define WUQ P_BF(WS_WUQ)
#define WKV P_BF(WS_WKV)
#define WO P_BF(WS_WO)
#define W2GU P_BF(WS_W2GU)
#define W2D P_BF(WS_W2D)
#define WMEM P_BF(WS_WMEM)
#define rope P_F32(WS_ROPE)
#define ssq0 P_F32(WS_SSQ0)
#define ssq1 P_F32(WS_SSQ1)
#define ssq2 P_F32(WS_SSQ2)
#define msq P_F32(WS_MSQ)
#define ssqm P_F32(WS_SSQM)
#define xb P_BF(WS_XB)
#define act1 P_BF(WS_ACT1)
#define act2 P_BF(WS_ACT2)
#define x1f P_F32(WS_X1F)
#define x1b P_BF(WS_X1B)
#define x2f P_F32(WS_X2F)
#define x2b P_BF(WS_X2B)
#define cqb P_BF(WS_CQB)
#define ckvb P_BF(WS_CKVB)
#define krb P_BF(WS_KRB)
#define ub P_BF(WS_UB)
#define gbb P_BF(WS_GBB)
#define mqb P_BF(WS_MQB)
#define qb P_BF(WS_QB)
#define Kb P_BF(WS_KB)
#define Vb P_BF(WS_VB)
#define memb P_BF(WS_MEMB)
#define memK P_BF(WS_MEMK)
#define memV P_BF(WS_MEMV)
#define oab P_BF(WS_OAB)
#define omb P_BF(WS_OMB)
#define omix P_BF(WS_OMIX)
__global__ void __launch_bounds__(NWAVES * 64, 2) mk_fwd(Args args) {
    extern __shared__ __attribute__((aligned(16))) unsigned char lds_raw[];
    Frame F;
    F.lds = (LAS unsigned char*)lds_raw;
    F.wave = __builtin_amdgcn_readfirstlane((int)threadIdx.x >> 6);
    F.G = gridDim.x; { const int bx = blockIdx.x; F.vcu = (F.G % 8 == 0) ? (bx % 8) * (F.G / 8) + bx / 8 : bx; }
#define PHASE_BEGIN() do { const CAS Args* ka_ = (const CAS Args*)__builtin_amdgcn_kernarg_segment_ptr(); asm volatile("" : "+s"(ka_)); F.in = (InTab)ka_->in; F.out = ka_->out; F.ws = ka_->ws; \
        int t_ = threadIdx.x; asm volatile("" : "+v"(t_)); F.tid = t_; F.lane = t_ & 63; } while (0)
    PHASE_BEGIN();
    for (int u = F.tid; u < (LDS_BYTES - LDSCTL_OFF) / 4; u += NWAVES * 64) ((LAS unsigned*)(F.lds + LDSCTL_OFF))[u] = 0u;
    __syncthreads();
    XcdBarrier bar = xcd_barrier_post((unsigned*)(F.ws + WS_CTL) + CW_BAR, (volatile LAS unsigned*)(F.lds + MISC_OFF) + 8);
    const int lo = args.ph_lo, hi = args.ph_hi;
#ifndef PH_MASK
#define PH_MASK 0xFFFF
#endif
#define IN(k) (((PH_MASK >> (k)) & 1) && lo <= (k) && (k) < hi)
#if TS_BUILD
#define TS_MARK(k) do { if (blockIdx.x == 0 && threadIdx.x == 0) ((unsigned long long*)(F.ws + WS_DBG))[(k)] = __builtin_amdgcn_s_memrealtime(); } while (0)
#else
#define TS_MARK(k) do {} while (0)
#endif
#define SEAM(k) do { if (IN(k) && IN((k) + 1)) xcd_barrier(bar); TS_MARK((k) + 1); } while (0)
    const int bx = (int)blockIdx.x;

#define GU1S P_F32(WS_GU1S)
#define GU2S P_F32(WS_GU2S)
#define D1S P_F32(WS_D1S)
#define D7S P_F32(WS_D7S)
#define ZS P_F32(WS_ZS)
#define QS P_F32(WS_QS)
    TS_MARK(0);
#ifndef REP_P0
#define REP_P0 1
#endif
    if (IN(0)) { PHASE_BEGIN(); for (int rep_ = 0; rep_ < REP_P0; ++rep_) p0_prologue(F); }
    SEAM(0);
    if (IN(1)) { PHASE_BEGIN();
        mini_gemm<256, ABf16, 2>(F, ABf16{xb + (size_t)NTOK * D, D}, W1GU, D, FF2, F.vcu, GU1S, FF2, 1.0f);
        { pg8::Gemm g{xb, W1GU, NTOK, FF2, D}; pg8::StaticOrder S; S.init(NTOK, FF2, F.G, bx);
          pg8::EpiSwiGLU E{ssq0, act1, FF};
#ifndef REP_G1
#define REP_G1 1
#endif
          for (int rep_ = 0; rep_ < REP_G1; ++rep_)
          pg8::gemm_phase<pg8::EpiSwiGLU, pg8::StaticOrder, ALIGN_SWIGLU, true, false, KD_G1>(F.lds, g, S, E); }
    }
    SEAM(1);
    if (IN(2)) { PHASE_BEGIN();
        mini_gemm<176>(F, ASilu{GU1S, ssq0}, W1D, FF, D, F.vcu, D1S, D, 1.0f);
        for (int rb = 0; rb < 8; ++rb)
            mini_gemm<256>(F, ABf16{memb + (size_t)rb * 128 * D, D}, WMEM, D, 512, (F.vcu + F.G - 32 * rb) % F.G, P_F32(WS_MEMRAW) + (size_t)rb * 128 * 512, 512, 1.0f);
        { pg8::Gemm g{act1, W1D, NTOK, D, FF}; pg8::StaticOrder S; S.init(NTOK, D, F.G, bx);
          pg8::EpiResid<false> E{F.in[0], nullptr, x1b, ssq1, 0.5f};
          for (int rep_ = 0; rep_ < REP_GA; ++rep_)
          pg8::gemm_phase<pg8::EpiResid<false>, pg8::StaticOrder, true, true, true, KD_G2>(F.lds, g, S, E); }
    }
    SEAM(2);
    if (IN(3)) { PHASE_BEGIN();
        { const int gw = F.vcu * NWAVES + F.wave, NGW = F.G * NWAVES; for (int r = gw; r < 1024; r += NGW) memkv_post_row(F, r); }
        mini_gemm<128>(F, ASum{F.in[2], D1S, 0.5f}, WIN, D, INWP, F.vcu, ZS, INWP, 1.0f);
        { pg8::Gemm g{x1b, WIN, NTOK, INWP, D}; pg8::StaticOrder S; S.init(NTOK, INWP, F.G, bx);
          pg8::EpiZ E{ssq1, (LAS float*)(F.lds + XCH_OFF), msq, cqb, F.in[19], F.in[23], F.in[28], rope,
                      F.out + O_CKVP, F.out + O_CKVS, F.out + O_KRP, F.out + O_KRS, F.out + O_CONVP, F.out + O_CONVS, ckvb, krb, Kb, ub, gbb, mqb};
          for (int rep_ = 0; rep_ < REP_GB; ++rep_)
          pg8::gemm_phase<pg8::EpiZ, pg8::StaticOrder, true, true>(F.lds, g, S, E); }
    }
    SEAM(3);
    if (IN(4)) { PHASE_BEGIN();
        for (int rep_ = 0; rep_ < REP_X; ++rep_)
        {
            if (F.G == 256) { if (bx >= 128 && F.wave == 0) postz_sample_row(F, bx - 128); }
            else if (F.wave == 0) for (int b = F.vcu; b < NS; b += F.G) postz_sample_row(F, b); }
        { pg8::Gemm g{cqb, WUQ, NTOK, 768, 256}; pg8::StaticOrder S; S.init(NTOK, 768, F.G, bx);
          pg8::EpiQ E{msq, F.in[17], F.in[18], rope, qb};
          pg8::gemm_phase<pg8::EpiQ, pg8::StaticOrder, true, true>(F.lds, g, S, E); }
        { pg8::Gemm g{ckvb, WKV, NTOK, 1024, 128}; pg8::StaticOrder S; S.init(NTOK, 1024, F.G, bx);
          pg8::EpiKV E{F.in[22], Kb, Vb};
          pg8::gemm_phase<pg8::EpiKV, pg8::StaticOrder, true, true>(F.lds, g, S, E); }
    }
    SEAM(4);
    if (IN(5)) { PHASE_BEGIN();
        mini_gemm<128>(F, ABf16{cqb + (size_t)NTOK * 256, 256}, WUQ, 256, 768, F.vcu, QS, 768, 1.0f);
        if (F.G == 256 && F.vcu >= 128) tp_sample_wg(F, F.vcu - 128, 2);
        for (int rep_ = 0; rep_ < REP_MLA; ++rep_) {
            auto mla_unit = [&](int i, int& bh, int& qblk) -> bool {
                if (F.G == 256) { if (i >= 4) return false; const int s = F.vcu & 7; bh = F.vcu >> 3; qblk = (i == 0) ? s : (i == 1) ? 15 - s : (i == 2) ? 16 + s : 31 - s; return true; }
                const int u = F.vcu + i * F.G; if (u >= 1024) return false; bh = u >> 5; qblk = u & 31; return true; };
            bf16x8 qr[6]; bool primed = false;
            for (int i = 0;; ++i) {
                int bh, qblk, nbh = 0, nqblk = 0;
                if (!mla_unit(i, bh, qblk)) break;
                const bool hn = AT_XPRE && mla_unit(i + 1, nbh, nqblk);
                const int b = bh >> 3, h = bh & 7; const size_t row0 = (size_t)b * SEQ + (size_t)qblk * 256;
                const int nb = nbh >> 3, nh = nbh & 7; const size_t nrow0 = (size_t)nb * SEQ + (size_t)nqblk * 256;
                attn_unit_simple<96, true>(qb + row0 * 768 + h * 96, 768, Kb + (size_t)bh * SEQ * 64, krb + (size_t)b * SEQ * 32, Vb + (size_t)bh * SEQ * 64, oab + row0 * 512 + h * 64, 512, 4 * (qblk + 1), F.lds,
                                           qr, primed, hn ? qb + nrow0 * 768 + nh * 96 : nullptr, Kb + (size_t)nbh * SEQ * 64, krb + (size_t)nb * SEQ * 32, Vb + (size_t)nbh * SEQ * 64, 4 * (nqblk + 1));
                primed = hn;
            }
        }
        for (int rep_ = 0; rep_ < REP_X; ++rep_) {
            bf16x8 qr[4]; bool primed = false;
            for (int u = F.vcu; u < 512; u += F.G) {
                const int b = u >> 7, h = (u >> 5) & 3, qblk = u & 31; const size_t row0 = (size_t)b * SEQ + (size_t)qblk * 256;
                const int nu = u + F.G; const bool hn = AT_XPRE && nu < 512;
                const int nb = nu >> 7, nh = (nu >> 5) & 3, nqblk = nu & 31; const size_t nrow0 = (size_t)nb * SEQ + (size_t)nqblk * 256;
                attn_unit_simple<64, false>(mqb + row0 * 256 + h * 64, 256, memK + (size_t)(b * 4 + h) * 256 * 64, nullptr, memV + (size_t)(b * 4 + h) * 256 * 64, omb + row0 * 256 + h * 64, 256, 4, F.lds,
                                            qr, primed, hn ? mqb + nrow0 * 256 + nh * 64 : nullptr, memK + (size_t)(nb * 4 + nh) * 256 * 64, nullptr, memV + (size_t)(nb * 4 + nh) * 256 * 64, 4);
                primed = hn;
            }
        }
        __syncthreads();
    }
    SEAM(5);
    if (IN(6)) { PHASE_BEGIN();
        for (int rep_ = 0; rep_ < REP_DEC; ++rep_)
        for (int it = F.vcu; it < 2 * NS; it += F.G) decode_item(F, it >> 1, it & 1);
#if STREAM_PROBE
        {
          f32x4 accp = (f32x4){0.f, 0.f, 0.f, 0.f};
          for (int it = F.vcu; it < 2 * NS; it += F.G) { const int b = it >> 1, half = it & 1; const int* ptab = (const int*)F.in[5] + b * NPAGES + half * 64;
              for (int pg = 0; pg < 64; ++pg) { const int page = __builtin_amdgcn_readfirstlane(ptab[pg]); const float* ck = F.in[3] + (size_t)page * (PAGE * 128); const float* kr = F.in[4] + (size_t)page * (PAGE * 32);
#pragma unroll
                  for (int j = 0; j < 8; ++j) accp = accp + *(const f32x4*)((const char*)(ck + 2048 * j) + (unsigned)F.tid * 16u);
#pragma unroll
                  for (int j = 0; j < 2; ++j) accp = accp + *(const f32x4*)((const char*)(kr + 2048 * j) + (unsigned)F.tid * 16u); } }
          ((f32x4*)(F.ws + WS_DBG))[F.vcu * 512 + F.tid] = accp; }
#endif
        __syncthreads();
        for (int rep_ = 0; rep_ < REP_X; ++rep_) tp_phase(F);
    }
    SEAM(6);
    if (IN(7)) { PHASE_BEGIN();
        for (int rep_ = 0; rep_ < REP_X; ++rep_)
        if (F.G == 256) { if (F.vcu < 128) tp_sample_wg(F, F.vcu, 1); }
        else for (int b = F.vcu; b < NS; b += F.G) tp_sample_wg(F, b);
        __syncthreads();
        { pg8::Gemm g{omix, WO, NTOK, D, D}; pg8::StaticOrder S; S.init(NTOK, D, F.G, (bx + 128) % F.G);
          pg8::EpiResid<true> E{x1b, nullptr, x2b, ssq2, 1.0f};
          for (int rep_ = 0; rep_ < REP_GC; ++rep_)
          pg8::gemm_phase<pg8::EpiResid<true>, pg8::StaticOrder, true, true>(F.lds, g, S, E); }
    }
    SEAM(7);
    if (IN(8)) { PHASE_BEGIN();
        mini_gemm<128>(F, ABf16{omix + (size_t)NTOK * D, D}, WO, D, D, F.vcu, D7S, D, 1.0f);
        { pg8::Gemm g{x2b, W2GU, NTOK, FF2, D}; pg8::StaticOrder S; S.init(NTOK, FF2, F.G, bx);
          pg8::EpiSwiGLU E{ssq2, act2, FF};
          pg8::gemm_phase<pg8::EpiSwiGLU, pg8::StaticOrder, ALIGN_SWIGLU, true>(F.lds, g, S, E); }
    }
    SEAM(8);
    if (IN(9)) { PHASE_BEGIN();
        if (F.wave == 0) {
            if (F.G == 256) { if (F.vcu >= 128) x2_sample_row(F, F.vcu - 128); }
            else for (int b = F.vcu; b < NS; b += F.G) x2_sample_row(F, b); }
        mini_gemm<256, ASum, 2>(F, ASum{x1f + (size_t)NTOK * D, D7S, 1.0f}, W2GU, D, FF2, F.vcu, GU2S, FF2, 1.0f);
        { pg8::Gemm g{act2, W2D, NTOK, D, FF}; pg8::StaticOrder S; S.init(NTOK, D, F.G, bx);
          pg8::EpiResid<true, true> E{x2b, F.out + O_Y, nullptr, nullptr, 0.5f};
          pg8::gemm_phase<pg8::EpiResid<true, true>, pg8::StaticOrder, true, true, true>(F.lds, g, S, E); }
    }
    SEAM(9);
    if (IN(10)) { PHASE_BEGIN();
        mini_gemm<176>(F, ASilu{GU2S, ssq2}, W2D, FF, D, F.vcu, F.out + O_YS, D, 0.5f);
    }
#if TS_BUILD
    { xcd_barrier(bar); PHASE_BEGIN();
      if (blockIdx.x == 0 && F.tid == 0) { const unsigned long long* ts = (const unsigned long long*)(F.ws + WS_DBG); const unsigned long long tend = __builtin_amdgcn_s_memrealtime();
        const float dA = (float)((TS_A == 10 ? tend : ts[TS_A + 1]) - ts[TS_A]) * 0.01f, dB = (float)((TS_B == 10 ? tend : ts[TS_B + 1]) - ts[TS_B]) * 0.01f;
        { const float x = dA * 0.01f; const int e = (int)x; float p10 = 1000.f; for (int i = 0; i < e; ++i) p10 *= 10.f; F.out[0] = (1.0f + 9.0f * (x - (float)e)) * p10; }
        (void)dB;
      } }
#endif
#if DBG_ORACLE
    if (IN(10)) { xcd_barrier(bar); PHASE_BEGIN(); dbg_phase(F); xcd_barrier(bar); PHASE_BEGIN(); dbg_report(F, (unsigned*)(F.ws + WS_CTL) + CW_BAR); }
#endif
#undef IN
#undef SEAM
#undef PHASE_BEGIN
}
#undef W1GU
#undef W1D
#undef WIN
#undef WUQ
#undef WKV
#undef WO
#undef W2GU
#undef W2D
#undef WMEM
#undef rope
#undef ssq0
#undef ssq1
#undef ssq2
#undef msq
#undef ssqm
#undef xb
#undef act1
#undef act2
#undef x1f
#undef x1b
#undef x2f
#undef x2b
#undef cqb
#undef ckvb
#undef krb
#undef ub
#undef gbb
#undef mqb
#undef qb
#undef Kb
#undef Vb
#undef memb
#undef memK
#undef memV
#undef oab
#undef omb
#undef omix
#undef P_BF
#undef P_F32

extern "C" void kernel_launch(void* const* d_in, const int* in_sizes, int n_in, void* d_out, int out_size, void* d_ws, size_t ws_size, hipStream_t stream) {
    static int grid = 0;
    if (grid == 0) {
        if (n_in != 38 || (size_t)out_size != O_TOTAL || ws_size < WS_END) { fprintf(stderr, "kernel_launch: unexpected shapes (n_in %d, out %d, ws %zu)\n", n_in, out_size, ws_size); grid = -1; return; }
        int dev = 0, cus = 0, per_cu = 0;
        if (hipGetDevice(&dev) != hipSuccess || hipDeviceGetAttribute(&cus, hipDeviceAttributeMultiprocessorCount, dev) != hipSuccess) { grid = -1; return; }
        if (hipFuncSetAttribute((const void*)mk_fwd, hipFuncAttributeMaxDynamicSharedMemorySize, LDS_BYTES) != hipSuccess) { fprintf(stderr, "kernel_launch: hipFuncSetAttribute failed\n"); grid = -1; return; }
        if (hipOccupancyMaxActiveBlocksPerMultiprocessor(&per_cu, (const void*)mk_fwd, NWAVES * 64, LDS_BYTES) != hipSuccess || per_cu < 1) { fprintf(stderr, "kernel_launch: occupancy query says %d\n", per_cu); }
        (void)hipGetLastError();
        grid = cus;
    }
    if (grid < 0) return;
    (void)hipMemsetAsync((char*)d_ws + WS_CTL, 0, CTL_ZERO_BYTES, stream);
#if DBG_ORACLE
    (void)hipMemsetAsync((char*)d_ws + WS_DBG, 0, 1 * MiB, stream);
#endif
    Args a{};
    for (int i = 0; i < 38; ++i) a.in[i] = (const float*)d_in[i];
    a.out = (float*)d_out; a.ws = (unsigned char*)d_ws;
    a.ph_lo = 0; a.ph_hi = 11;
    hipLaunchKernelGGL(mk_fwd, dim3(grid), dim3(NWAVES * 64), LDS_BYTES, stream, a);
}
```

```cpp
#include <hip/hip_runtime.h>
#include <cstdint>
#include <cstdio>
#include <cmath>
#define DBG_ORACLE 0
#define DBG_TOL 0.03f
#define AT_ROLL 1
#define NT_ACT 1
#define NT_Y 1
#ifndef PROBE_MFMA2
#define PROBE_MFMA2 0
#endif
#ifndef PROBE_VALU2
#define PROBE_VALU2 0
#endif
#ifndef PROBE_DUP
#define PROBE_DUP 1
#endif
#ifndef DEC_FLIP
#define DEC_FLIP 0
#endif
#ifndef DEC_SKEW
#define DEC_SKEW 0
#endif
#ifndef AT_ROLL
#define AT_ROLL 0
#endif
#ifndef AT_VPRE
#define AT_VPRE 0
#endif
#ifndef AT_VPIPE
#define AT_VPIPE 0
#endif
#ifndef PG8_AMID
#define PG8_AMID 0
#endif
#ifndef NT_ACT
#define NT_ACT 0
#endif
#ifndef NT_OUT
#define NT_OUT 0
#endif
#ifndef NT_Y
#define NT_Y 0
#endif
#ifndef NT_OB
#define NT_OB 0
#endif
#ifndef DEC_NT
#define DEC_NT 0
#endif
#ifndef NT_O
#define NT_O 0
#endif
#ifndef AT_DMAMID
#define AT_DMAMID 0
#endif
#ifndef AT_XPRE
#define AT_XPRE 0
#endif
#ifndef WT_OUT
#define WT_OUT 0
#endif
#ifndef WT_OB
#define WT_OB 0
#endif
#ifndef WT_O
#define WT_O 0
#endif
#ifndef WT_TP
#define WT_TP 0
#endif
#ifndef P0_PIPE
#define P0_PIPE 0
#endif
#ifndef DEC_PRIO
#define DEC_PRIO 0
#endif
#ifndef MLA_PRIO
#define MLA_PRIO 0
#endif
#ifndef TS_BUILD
#define TS_BUILD 0
#endif
namespace pg8 {
#define PG8_LAS __attribute__((address_space(3)))
typedef unsigned short bf16_t;
typedef short bf16x8 __attribute__((ext_vector_type(8)));
typedef float f32x4 __attribute__((ext_vector_type(4)));
typedef unsigned u32x4 __attribute__((ext_vector_type(4)));
constexpr int BM = 256, BK = 64, HALF = 128, HTB = HALF * BK * 2  , STAGE_BYTES = 8 * HTB, NXCD = 8, WGM = 8;

__host__ __device__ __forceinline__ int lds_byte(int r, int c) { const int st = (r >> 4) * 2 + (c >> 5), rr = r & 15, cc = c & 31, ob = rr * 64 + cc * 2; return st * 1024 + (ob ^ (((ob >> 9) & 1) << 5)); }
__host__ __device__ __forceinline__ void stage_rc(int b, int& R, int& C) { const int st = b / 1024, sb = b % 1024, swz = sb ^ (((sb >> 9) & 1) << 5); R = (st >> 1) * 16 + swz / 64; C = (st & 1) * 32 + (swz % 64) / 2; }
__host__ __device__ __forceinline__ int perm32(int rho) { const int n = rho >> 4, i = rho & 15; return 8 * (i >> 2) + 4 * n + (i & 3); }

struct Unit { int pm, pn; };
struct Gemm { const bf16_t* A; const bf16_t* Bt; int M, N, K; };

struct StaticOrder {
    int nM, nN, nwg, G, c;
    __host__ __device__ void init(int M, int N, int G_, int c_) { nM = M / BM; nN = N / BM; nwg = nM * nN; G = G_; c = c_; }
    __host__ __device__ bool next(int i, Unit& u) const {
        const long L = (long)i * G + c; if (L >= nwg) return false;
        int wgid = (int)L; { const int q = nwg / NXCD, r = nwg % NXCD, xcd = wgid % NXCD, off = wgid / NXCD; wgid = (xcd < r ? xcd * (q + 1) : r * (q + 1) + (xcd - r) * q) + off; }
        const int nig = WGM * nN, gid = wgid / nig, fm = gid * WGM, gsz = (nM - fm) < WGM ? (nM - fm) : WGM;
        u.pm = fm + ((wgid % nig) % gsz); u.pn = (wgid % nig) / gsz; return true;
    }
    __device__ __forceinline__ void a_ready(const Unit&) const {}
    __device__ __forceinline__ void done(const Unit&) const {}
};

__device__ __forceinline__ unsigned cvt_pk_bf16(float lo, float hi) { typedef float f2_ __attribute__((ext_vector_type(2))); typedef __bf16 b2_ __attribute__((ext_vector_type(2))); const f2_ v = {lo, hi}; const b2_ b = __builtin_convertvector(v, b2_); return __builtin_bit_cast(unsigned, b); }
typedef float f32x2 __attribute__((ext_vector_type(2)));
constexpr int kNTOK = 32768, kMR = 32896, kSEQ = 8192;
constexpr float kEPS = 1e-6f;
constexpr float kLOG2E = 1.4426950408889634f;
constexpr float kC2Q = 0.10206207261596577f * 1.4426950408889634f;
constexpr float kC2M = 0.125f * 1.4426950408889634f;
typedef unsigned u32x2 __attribute__((ext_vector_type(2)));
__device__ __forceinline__ void st_wt(u32x4* p, u32x4 v) { asm volatile("global_store_dwordx4 %0, %1, off sc0 sc1\n\ts_nop 0" :: "v"(p), "v"(v) : "memory"); }
__device__ __forceinline__ void st_wt(f32x4* p, f32x4 v) { asm volatile("global_store_dwordx4 %0, %1, off sc0 sc1\n\ts_nop 0" :: "v"(p), "v"(v) : "memory"); }
__device__ __forceinline__ void st_wt(u32x2* p, u32x2 v) { asm volatile("global_store_dwordx2 %0, %1, off sc0 sc1\n\ts_nop 0" :: "v"(p), "v"(v) : "memory"); }
#if WT_OUT
#define EPI_ST(T_, ptr_, val_) st_wt((T_*)(ptr_), (val_))
#elif NT_OUT
#define EPI_ST(T_, ptr_, val_) __builtin_nontemporal_store((val_), (T_*)(ptr_))
#else
#define EPI_ST(T_, ptr_, val_) (*(T_*)(ptr_) = (val_))
#endif
#if WT_OB
#define EPI_STOB(T_, ptr_, val_) st_wt((T_*)(ptr_), (val_))
#elif NT_OB
#define EPI_STOB(T_, ptr_, val_) __builtin_nontemporal_store((val_), (T_*)(ptr_))
#else
#define EPI_STOB(T_, ptr_, val_) (*(T_*)(ptr_) = (val_))
#endif
#if NT_Y
#define EPI_STY(T_, ptr_, val_) __builtin_nontemporal_store((val_), (T_*)(ptr_))
#else
#define EPI_STY(T_, ptr_, val_) (*(T_*)(ptr_) = (val_))
#endif
__device__ __forceinline__ int fresh_lane() { int l; asm volatile("v_mbcnt_lo_u32_b32 %0, -1, 0\n\tv_mbcnt_hi_u32_b32 %0, -1, %0" : "=v"(l)); return l; }

__device__ __forceinline__ float sum_fq(float s) {
    { auto t = __builtin_amdgcn_permlane16_swap(__float_as_uint(s), __float_as_uint(s), false, false); s = __uint_as_float(t[0]) + __uint_as_float(t[1]); }
    { auto t = __builtin_amdgcn_permlane32_swap(__float_as_uint(s), __float_as_uint(s), false, false); s = __uint_as_float(t[0]) + __uint_as_float(t[1]); }
    return s;
}
__device__ __forceinline__ float row_inv_from_parts(const float* ssq, int row) {
    return __builtin_amdgcn_rsqf(ssq[row] * (1.0f / 1024.0f) + kEPS);
}
__device__ __forceinline__ float silu_mul(float g, float u) {
    const float e = __builtin_amdgcn_exp2f(-g * kLOG2E);
    return g * __builtin_amdgcn_rcpf(1.0f + e) * u;
}

struct EpiSwiGLU {
    static constexpr bool PERM = true, AFTER_DRAIN = false;
    const float* ssq; bf16_t* act; int ldact;
    __device__ __forceinline__ void operator()(const f32x4 (&acc)[2][2][4][2], const Unit& u, int wr, int wc, int fr_, int fq_) const {
        const int ln_ = fresh_lane(), fr = ln_ & 15, fq = ln_ >> 4; (void)fr_; (void)fq_;
        const int rr0 = wr * 64 + fr;
        const float* sp = ssq + (size_t)(u.pm * BM + rr0);
        bf16_t* ap = act + ((size_t)(u.pm * (ldact >> 6) + u.pn * 2 + (wc >> 1)) * BM + rr0) * BK + (wc & 1) * 32 + 8 * fq;
        f32x4 ones = (f32x4){1.0f, 1.0f, 1.0f, 1.0f}; asm volatile("" : "+v"(ones));
        float ss[2][4];
#pragma unroll
        for (int ai = 0; ai < 2; ++ai)
#pragma unroll
            for (int m = 0; m < 4; ++m) ss[ai][m] = sp[ai * HALF + m * 16];
        asm volatile("" : "+v"(ss[0][0]), "+v"(ss[0][1]), "+v"(ss[0][2]), "+v"(ss[0][3]), "+v"(ss[1][0]), "+v"(ss[1][1]), "+v"(ss[1][2]), "+v"(ss[1][3]));
#pragma unroll
        for (int ai = 0; ai < 2; ++ai)
#pragma unroll
            for (int m = 0; m < 4; ++m) {
                const float inv = __builtin_amdgcn_rsqf(ss[ai][m] * (1.0f / 1024.0f) + kEPS);
                const float a = inv * -kLOG2E, b = inv * inv;
                const f32x4 g0 = acc[ai][0][m][0], g1 = acc[ai][0][m][1];
                const f32x4 t0 = g0 * a, t1 = g1 * a;
                f32x4 e0, e1;
#pragma unroll
                for (int i = 0; i < 4; ++i) { e0[i] = __builtin_amdgcn_exp2f(t0[i]); e1[i] = __builtin_amdgcn_exp2f(t1[i]); }
                const f32x4 d0 = e0 + ones, d1 = e1 + ones;
                f32x4 r0, r1;
#pragma unroll
                for (int i = 0; i < 4; ++i) { r0[i] = __builtin_amdgcn_rcpf(d0[i]); r1[i] = __builtin_amdgcn_rcpf(d1[i]); }
                const f32x4 o0 = (g0 * acc[ai][1][m][0]) * r0 * b, o1 = (g1 * acc[ai][1][m][1]) * r1 * b;
                u32x4 w;
                w.x = cvt_pk_bf16(o0[0], o0[1]); w.y = cvt_pk_bf16(o0[2], o0[3]); w.z = cvt_pk_bf16(o1[0], o1[1]); w.w = cvt_pk_bf16(o1[2], o1[3]);
#if NT_ACT
                __builtin_nontemporal_store(w, (u32x4*)(ap + (ai * HALF + m * 16) * BK));
#else
                *(u32x4*)(ap + (ai * HALF + m * 16) * BK) = w;
#endif
                if (m & 1) asm volatile("" ::: "memory");
            }
    }
};

template <bool BASE_BF16, bool FINAL = false>
struct EpiResid {
    static constexpr bool PERM = true, AFTER_DRAIN = false;
    const void* base0; float* out0; bf16_t* ob; float* ssq_out; float scale;
    __device__ __forceinline__ void operator()(const f32x4 (&acc)[2][2][4][2], const Unit& u, int wr, int wc, int fr_, int fq_) const {
        const int ln_ = fresh_lane(), fr = ln_ & 15, fq = ln_ >> 4; (void)fr_; (void)fq_;
        u32x4 raw[2][4][2];
        if (BASE_BF16) {
#pragma unroll
            for (int ai = 0; ai < 2; ++ai)
#pragma unroll
                for (int m = 0; m < 4; ++m)
#pragma unroll
                    for (int bj = 0; bj < 2; ++bj)
                        raw[ai][m][bj] = *(const u32x4*)((const bf16_t*)base0 + (size_t)(u.pm * BM + ai * HALF + wr * 64 + m * 16 + fr) * 1024 + u.pn * BM + bj * HALF + wc * 32 + 8 * fq);
        }
#pragma unroll
        for (int ai = 0; ai < 2; ++ai) {
            f32x4 bv[BASE_BF16 ? 1 : 4][2][2];
            if (!BASE_BF16) {
#pragma unroll
                for (int m = 0; m < 4; ++m) {
                    const int row = u.pm * BM + ai * HALF + wr * 64 + m * 16 + fr;
#pragma unroll
                    for (int bj = 0; bj < 2; ++bj) { const int col = u.pn * BM + bj * HALF + wc * 32 + 8 * fq;
                        const float* bp = (const float*)base0 + (size_t)row * 1024 + col; bv[m][bj][0] = *(const f32x4*)bp; bv[m][bj][1] = *(const f32x4*)(bp + 4); }
                }
            }
#pragma unroll
            for (int m = 0; m < 4; ++m) {
                const int row = u.pm * BM + ai * HALF + wr * 64 + m * 16 + fr;
                float s = 0.f;
#pragma unroll
                for (int bj = 0; bj < 2; ++bj) {
                    const int col = u.pn * BM + bj * HALF + wc * 32 + 8 * fq;
                    f32x4 b0, b1;
                    if (BASE_BF16) { const u32x4 w = raw[ai][m][bj];
                        b0 = (f32x4){__uint_as_float(w.x << 16), __uint_as_float(w.x & 0xffff0000u), __uint_as_float(w.y << 16), __uint_as_float(w.y & 0xffff0000u)};
                        b1 = (f32x4){__uint_as_float(w.z << 16), __uint_as_float(w.z & 0xffff0000u), __uint_as_float(w.w << 16), __uint_as_float(w.w & 0xffff0000u)}; }
                    else { b0 = bv[BASE_BF16 ? 0 : m][bj][0]; b1 = bv[BASE_BF16 ? 0 : m][bj][1]; }
                    const f32x4 v0 = b0 + acc[ai][bj][m][0] * scale, v1 = b1 + acc[ai][bj][m][1] * scale;
                    if (!FINAL) s += (v0[0] * v0[0] + v0[1] * v0[1]) + (v0[2] * v0[2] + v0[3] * v0[3]) + (v1[0] * v1[0] + v1[1] * v1[1]) + (v1[2] * v1[2] + v1[3] * v1[3]);
                    if (FINAL) { float* op = out0 + (size_t)row * 1024 + col; EPI_STY(f32x4, op, v0); EPI_STY(f32x4, op + 4, v1); }
                    if (!FINAL) { u32x4 w; w.x = cvt_pk_bf16(v0[0], v0[1]); w.y = cvt_pk_bf16(v0[2], v0[3]); w.z = cvt_pk_bf16(v1[0], v1[1]); w.w = cvt_pk_bf16(v1[2], v1[3]);
                        EPI_STOB(u32x4, ob + (size_t)row * 1024 + col, w); }
                }
                if (!FINAL) { s = sum_fq(s);
                if (fq == 0) unsafeAtomicAdd(ssq_out + row, s); }
            }
            asm volatile("" ::: "memory");
        }
    }
};

struct EpiZ {
    static constexpr bool PERM = false, AFTER_DRAIN = false;
    const float* ssq1;
    PG8_LAS float* xch;
    float* msq;
    bf16_t* cqb;
    const float* g_kv; const float* g_kr; const float* g_mq;
    const float* rope;
    float* ckv_p; float* ckv_s; float* kr_p; float* kr_s; float* conv_p; float* conv_s;
    bf16_t* ckvb; bf16_t* krb; bf16_t* Kb; bf16_t* ub; bf16_t* gbb; bf16_t* mqb;
    __device__ __forceinline__ void operator()(const f32x4 (&acc)[2][2][4][2], const Unit& u, int wr, int wc, int fr_, int fq_) const {
        const int ln_ = fresh_lane(), fr = ln_ & 15, fq = ln_ >> 4; (void)fr_; (void)fq_;
        const int pn = u.pn;
        float inv1[2][4]; int rows[2][4];
#pragma unroll
        for (int ai = 0; ai < 2; ++ai)
#pragma unroll
            for (int m = 0; m < 4; ++m) { rows[ai][m] = u.pm * BM + ai * HALF + wr * 64 + m * 16 + fr; inv1[ai][m] = row_inv_from_parts(ssq1, rows[ai][m]); }
        if (pn == 0 || pn == 1) {
#pragma unroll
            for (int ai = 0; ai < 2; ++ai)
#pragma unroll
                for (int m = 0; m < 4; ++m) {
                    float s = 0.f; const float iv = inv1[ai][m];
#pragma unroll
                    for (int bj = 0; bj < 2; ++bj) { if (pn == 1 && bj == 1) continue;
#pragma unroll
                        for (int n = 0; n < 2; ++n) { const f32x4 v = acc[ai][bj][m][n] * iv; s += (v[0] * v[0] + v[1] * v[1]) + (v[2] * v[2] + v[3] * v[3]); } }
                    s += __shfl_xor(s, 16); s += __shfl_xor(s, 32);
                    if (fq == 0) xch[(ai * HALF + wr * 64 + m * 16 + fr) * 4 + wc] = s;
                }
            asm volatile("s_waitcnt lgkmcnt(0)" ::: "memory"); __builtin_amdgcn_s_barrier(); asm volatile("" ::: "memory");
        }
        if (pn == 0) {
#pragma unroll
            for (int ai = 0; ai < 2; ++ai)
#pragma unroll
                for (int m = 0; m < 4; ++m) {
                    const int row = rows[ai][m]; const float iv = inv1[ai][m];
                    const f32x4 t = *(const PG8_LAS f32x4*)(xch + (ai * HALF + wr * 64 + m * 16 + fr) * 4);
                    if (wc == 0 && fq == 0 && row < kMR) msq[row] = ((t[0] + t[1]) + (t[2] + t[3])) * (1.0f / 256.0f);
                    if (row < kMR) {
#pragma unroll
                        for (int bj = 0; bj < 2; ++bj)
#pragma unroll
                            for (int n = 0; n < 2; ++n) { const f32x4 v = acc[ai][bj][m][n] * iv; u32x2 w; w.x = cvt_pk_bf16(v[0], v[1]); w.y = cvt_pk_bf16(v[2], v[3]);
                                EPI_ST(u32x2, cqb + (size_t)row * 256 + bj * HALF + wc * 32 + n * 16 + 4 * fq, w); }
                    }
                }
        } else if (pn == 1) {
            f32x4 gkv[2];
#pragma unroll
            for (int n = 0; n < 2; ++n) gkv[n] = *(const f32x4*)(g_kv + wc * 32 + n * 16 + 4 * fq);
            const f32x4 ga = *(const f32x4*)(g_kr + 4 * fq), gb = *(const f32x4*)(g_kr + 16 + 4 * fq);
#pragma unroll
            for (int ai = 0; ai < 2; ++ai) {
#pragma unroll
              for (int mh = 0; mh < 2; ++mh) {
                f32x4 cs[2], sn[2];
                if (wc == 0) {
#pragma unroll
                    for (int mm = 0; mm < 2; ++mm) { const int pos = rows[ai][2 * mh + mm] & (kSEQ - 1); cs[mm] = *(const f32x4*)(rope + (size_t)pos * 32 + 4 * fq); sn[mm] = *(const f32x4*)(rope + (size_t)pos * 32 + 16 + 4 * fq); }
                }
#pragma unroll
                for (int mm = 0; mm < 2; ++mm) { const int m = 2 * mh + mm;
                    const int row = rows[ai][m]; const float iv = inv1[ai][m];
                    const f32x4 t = *(const PG8_LAS f32x4*)(xch + (ai * HALF + wr * 64 + m * 16 + fr) * 4);
                    const float ic = __builtin_amdgcn_rsqf(((t[0] + t[1]) + (t[2] + t[3])) * (1.0f / 128.0f) + kEPS);
#pragma unroll
                    for (int n = 0; n < 2; ++n) {
                        const int c = wc * 32 + n * 16 + 4 * fq;
                        const f32x4 v = acc[ai][0][m][n] * (iv * ic) * gkv[n];
                        EPI_ST(f32x4, ckv_p + (size_t)row * 128 + c, v);
                        u32x2 w; w.x = cvt_pk_bf16(v[0], v[1]); w.y = cvt_pk_bf16(v[2], v[3]);
                        EPI_ST(u32x2, ckvb + (size_t)row * 128 + c, w);
                    }
                    if (wc == 0) {
                        const f32x4 a = acc[ai][1][m][0] * iv, b = acc[ai][1][m][1] * iv;
                        float s = (a[0] * a[0] + a[1] * a[1]) + (a[2] * a[2] + a[3] * a[3]) + (b[0] * b[0] + b[1] * b[1]) + (b[2] * b[2] + b[3] * b[3]);
                        s += __shfl_xor(s, 16); s += __shfl_xor(s, 32);
                        const float ik = __builtin_amdgcn_rsqf(s * (1.0f / 32.0f) + kEPS);
                        const f32x4 x1 = a * ik * ga, x2 = b * ik * gb;
                        const f32x4 o1 = x1 * cs[mm] - x2 * sn[mm], o2 = x1 * sn[mm] + x2 * cs[mm];
                        float* kro = kr_p + (size_t)row * 32;
                        *(f32x4*)(kro + 4 * fq) = o1; *(f32x4*)(kro + 16 + 4 * fq) = o2;
                        u32x2 w1, w2; w1.x = cvt_pk_bf16(o1[0], o1[1]); w1.y = cvt_pk_bf16(o1[2], o1[3]); w2.x = cvt_pk_bf16(o2[0], o2[1]); w2.y = cvt_pk_bf16(o2[2], o2[3]);
                        *(u32x2*)(krb + (size_t)row * 32 + 4 * fq) = w1; *(u32x2*)(krb + (size_t)row * 32 + 16 + 4 * fq) = w2;
                    }
                }
                asm volatile("" ::: "memory");
              }
            }
        } else if (pn == 2 || pn == 3) {
#pragma unroll
            for (int ai = 0; ai < 2; ++ai)
#pragma unroll
                for (int m = 0; m < 4; ++m) {
                    const int row = rows[ai][m]; const float iv = inv1[ai][m];
                    if (row >= kMR) continue;
                    const bool smp = row >= kNTOK; const int t_ = row & (kSEQ - 1), b_ = row >> 13;
#pragma unroll
                    for (int n = 0; n < 2; ++n) {
                        const int c = (pn - 2) * 128 + wc * 32 + n * 16 + 4 * fq;
                        const f32x4 v = (acc[ai][0][m][n] * iv) * (acc[ai][1][m][n] * iv);
                        u32x2 w; w.x = cvt_pk_bf16(v[0], v[1]); w.y = cvt_pk_bf16(v[2], v[3]);
                        EPI_ST(u32x2, ub + (size_t)row * 256 + c, w);
                        if (smp) *(f32x4*)(conv_s + (size_t)(row - kNTOK) * 512 + 256 + c) = v;
                        else if (t_ >= kSEQ - 2) *(f32x4*)(conv_p + (size_t)(b_ * 2 + (t_ - (kSEQ - 2))) * 256 + c) = v;
                    }
                }
        } else if (pn == 4) {
#pragma unroll
            for (int ai = 0; ai < 2; ++ai)
#pragma unroll
                for (int m = 0; m < 4; ++m) {
                    const int row = rows[ai][m]; const float iv = inv1[ai][m];
                    if (row >= kMR) continue;
#pragma unroll
                    for (int bj = 0; bj < 2; ++bj)
#pragma unroll
                        for (int n = 0; n < 2; ++n) { const f32x4 v = acc[ai][bj][m][n] * iv; u32x2 w; w.x = cvt_pk_bf16(v[0], v[1]); w.y = cvt_pk_bf16(v[2], v[3]);
                            EPI_ST(u32x2, gbb + (size_t)row * 256 + bj * HALF + wc * 32 + n * 16 + 4 * fq, w); }
                }
        } else {
            f32x4 gmq[2][2];
#pragma unroll
            for (int bj = 0; bj < 2; ++bj)
#pragma unroll
                for (int n = 0; n < 2; ++n) gmq[bj][n] = *(const f32x4*)(g_mq + bj * 32 + n * 16 + 4 * fq);
#pragma unroll
            for (int ai = 0; ai < 2; ++ai)
#pragma unroll
                for (int m = 0; m < 4; ++m) {
                    const int row = rows[ai][m]; const float iv = inv1[ai][m];
                    float s = 0.f;
#pragma unroll
                    for (int bj = 0; bj < 2; ++bj)
#pragma unroll
                        for (int n = 0; n < 2; ++n) { const f32x4 v = acc[ai][bj][m][n] * iv; s += (v[0] * v[0] + v[1] * v[1]) + (v[2] * v[2] + v[3] * v[3]); }
                    s += __shfl_xor(s, 16); s += __shfl_xor(s, 32);
                    const float im = __builtin_amdgcn_rsqf(s * (1.0f / 64.0f) + kEPS) * kC2M;
                    if (row >= kMR) continue;
#pragma unroll
                    for (int bj = 0; bj < 2; ++bj)
#pragma unroll
                        for (int n = 0; n < 2; ++n) { const int d = bj * 32 + n * 16 + 4 * fq;
                            const f32x4 v = acc[ai][bj][m][n] * (iv * im) * gmq[bj][n]; u32x2 w; w.x = cvt_pk_bf16(v[0], v[1]); w.y = cvt_pk_bf16(v[2], v[3]);
                            EPI_ST(u32x2, mqb + (size_t)row * 256 + wc * 64 + d, w); }
                }
        }
    }
};

struct EpiQ {
    static constexpr bool PERM = false, AFTER_DRAIN = false;
    const float* msq; const float* g_qn; const float* g_qr; const float* rope; bf16_t* qb;
    __device__ __forceinline__ void operator()(const f32x4 (&acc)[2][2][4][2], const Unit& u, int wr, int wc, int fr_, int fq_) const {
        const int ln_ = fresh_lane(), fr = ln_ & 15, fq = ln_ >> 4; (void)fr_; (void)fq_;
        const int pn = u.pn;
        float epsq[2][4];
#pragma unroll
        for (int ai = 0; ai < 2; ++ai)
#pragma unroll
            for (int m = 0; m < 4; ++m) epsq[ai][m] = kEPS * (msq[u.pm * BM + ai * HALF + wr * 64 + m * 16 + fr] + kEPS);
        if (pn < 2) {
            const int head = 4 * pn + wc;
            f32x4 g[2][2];
#pragma unroll
            for (int bj = 0; bj < 2; ++bj)
#pragma unroll
                for (int n = 0; n < 2; ++n) g[bj][n] = *(const f32x4*)(g_qn + bj * 32 + n * 16 + 4 * fq);
#pragma unroll
            for (int ai = 0; ai < 2; ++ai) {
#pragma unroll
                for (int m = 0; m < 4; ++m) {
                    const int row = u.pm * BM + ai * HALF + wr * 64 + m * 16 + fr; float s = 0.f;
#pragma unroll
                    for (int bj = 0; bj < 2; ++bj)
#pragma unroll
                        for (int n = 0; n < 2; ++n) { const f32x4 v = acc[ai][bj][m][n]; s += (v[0] * v[0] + v[1] * v[1]) + (v[2] * v[2] + v[3] * v[3]); }
                    s += __shfl_xor(s, 16); s += __shfl_xor(s, 32);
                    const float rs = __builtin_amdgcn_rsqf(s * (1.0f / 64.0f) + epsq[ai][m]) * kC2Q;
#pragma unroll
                    for (int bj = 0; bj < 2; ++bj)
#pragma unroll
                        for (int n = 0; n < 2; ++n) { const int d = bj * 32 + n * 16 + 4 * fq;
                            const f32x4 v = acc[ai][bj][m][n] * rs * g[bj][n]; u32x2 w; w.x = cvt_pk_bf16(v[0], v[1]); w.y = cvt_pk_bf16(v[2], v[3]);
                            EPI_ST(u32x2, qb + (size_t)row * 768 + head * 96 + d, w); }
                }
                asm volatile("" ::: "memory");
            }
        } else {
            const f32x4 ga = *(const f32x4*)(g_qr + 4 * fq), gb = *(const f32x4*)(g_qr + 16 + 4 * fq);
#pragma unroll
            for (int ai = 0; ai < 2; ++ai) {
                f32x4 cs[4], sn[4];
#pragma unroll
                for (int m = 0; m < 4; ++m) { const int row = u.pm * BM + ai * HALF + wr * 64 + m * 16 + fr; const int pos = row & (kSEQ - 1);
                    cs[m] = *(const f32x4*)(rope + (size_t)pos * 32 + 4 * fq); sn[m] = *(const f32x4*)(rope + (size_t)pos * 32 + 16 + 4 * fq); }
#pragma unroll
                for (int m = 0; m < 4; ++m) {
                    const int row = u.pm * BM + ai * HALF + wr * 64 + m * 16 + fr;
#pragma unroll
                    for (int bj = 0; bj < 2; ++bj) {
                        const int head = 4 * bj + wc;
                        const f32x4 a = acc[ai][bj][m][0], b = acc[ai][bj][m][1];
                        float s = (a[0] * a[0] + a[1] * a[1]) + (a[2] * a[2] + a[3] * a[3]) + (b[0] * b[0] + b[1] * b[1]) + (b[2] * b[2] + b[3] * b[3]);
                        s += __shfl_xor(s, 16); s += __shfl_xor(s, 32);
                        const float rs = __builtin_amdgcn_rsqf(s * (1.0f / 32.0f) + epsq[ai][m]);
                        const f32x4 x1 = a * rs * ga, x2 = b * rs * gb;
                        const f32x4 o1 = (x1 * cs[m] - x2 * sn[m]) * kC2Q, o2 = (x1 * sn[m] + x2 * cs[m]) * kC2Q;
                        u32x2 w1, w2; w1.x = cvt_pk_bf16(o1[0], o1[1]); w1.y = cvt_pk_bf16(o1[2], o1[3]); w2.x = cvt_pk_bf16(o2[0], o2[1]); w2.y = cvt_pk_bf16(o2[2], o2[3]);
                        EPI_ST(u32x2, qb + (size_t)row * 768 + head * 96 + 64 + 4 * fq, w1); EPI_ST(u32x2, qb + (size_t)row * 768 + head * 96 + 80 + 4 * fq, w2);
                    }
                }
                asm volatile("" ::: "memory");
            }
        }
    }
};

struct EpiKV {
    static constexpr bool PERM = false, AFTER_DRAIN = false;
    const float* g_kn; bf16_t* Kb; bf16_t* Vb;
    __device__ __forceinline__ void operator()(const f32x4 (&acc)[2][2][4][2], const Unit& u, int wr, int wc, int fr_, int fq_) const {
        const int ln_ = fresh_lane(), fr = ln_ & 15, fq = ln_ >> 4; (void)fr_; (void)fq_;
        const int pn = u.pn;
        f32x4 gk[2][2];
#pragma unroll
        for (int bj = 0; bj < 2; ++bj)
#pragma unroll
            for (int n = 0; n < 2; ++n) gk[bj][n] = *(const f32x4*)(g_kn + bj * 32 + n * 16 + 4 * fq);
#pragma unroll
        for (int ai = 0; ai < 2; ++ai)
#pragma unroll
            for (int m = 0; m < 4; ++m) {
                const int row = u.pm * BM + ai * HALF + wr * 64 + m * 16 + fr;
                const int b_ = row >> 13, t_ = row & (kSEQ - 1);
                if (pn < 2) {
                    const int head = 4 * pn + wc; float s = 0.f;
#pragma unroll
                    for (int bj = 0; bj < 2; ++bj)
#pragma unroll
                        for (int n = 0; n < 2; ++n) { const f32x4 v = acc[ai][bj][m][n]; s += (v[0] * v[0] + v[1] * v[1]) + (v[2] * v[2] + v[3] * v[3]); }
                    s += __shfl_xor(s, 16); s += __shfl_xor(s, 32);
                    const float rs = __builtin_amdgcn_rsqf(s * (1.0f / 64.0f) + kEPS);
                    bf16_t* kp = Kb + ((size_t)(b_ * 8 + head) * kSEQ + t_) * 64;
#pragma unroll
                    for (int bj = 0; bj < 2; ++bj)
#pragma unroll
                        for (int n = 0; n < 2; ++n) { const int d = bj * 32 + n * 16 + 4 * fq;
                            const f32x4 v = acc[ai][bj][m][n] * rs * gk[bj][n]; u32x2 w; w.x = cvt_pk_bf16(v[0], v[1]); w.y = cvt_pk_bf16(v[2], v[3]);
                            EPI_ST(u32x2, kp + d, w); }
                } else {
#pragma unroll
                    for (int bj = 0; bj < 2; ++bj)
#pragma unroll
                        for (int n = 0; n < 2; ++n) { const int c = (pn - 2) * 256 + bj * HALF + wc * 32 + n * 16 + 4 * fq; const int head = c >> 6, d = c & 63;
                            const f32x4 v = acc[ai][bj][m][n]; u32x2 w; w.x = cvt_pk_bf16(v[0], v[1]); w.y = cvt_pk_bf16(v[2], v[3]);
                            EPI_ST(u32x2, Vb + ((size_t)(b_ * 8 + head) * kSEQ + t_) * 64 + d, w); }
                }
                if (m == 3) asm volatile("" ::: "memory");
            }
    }
};

struct EpiMem {
    static constexpr bool PERM = false, AFTER_DRAIN = false;
    const float* ssqm; const float* g_mk; float* mk_out; float* mv_out; bf16_t* mKb; bf16_t* mVb;
    __device__ __forceinline__ void operator()(const f32x4 (&acc)[2][2][4][2], const Unit& u, int wr, int wc, int fr_, int fq_) const {
        const int ln_ = fresh_lane(), fr = ln_ & 15, fq = ln_ >> 4; (void)fr_; (void)fq_;
        const int pn = u.pn;
#pragma unroll
        for (int ai = 0; ai < 2; ++ai)
#pragma unroll
            for (int m = 0; m < 4; ++m) {
                const int row = u.pm * BM + ai * HALF + wr * 64 + m * 16 + fr;
                const float iv = row_inv_from_parts(ssqm, row);
                const int b_ = row >> 8, n_ = row & 255;
                if (pn == 0) {
                    const int head = wc; float s = 0.f;
#pragma unroll
                    for (int bj = 0; bj < 2; ++bj)
#pragma unroll
                        for (int n = 0; n < 2; ++n) { const f32x4 v = acc[ai][bj][m][n] * iv; s += (v[0] * v[0] + v[1] * v[1]) + (v[2] * v[2] + v[3] * v[3]); }
                    s += __shfl_xor(s, 16); s += __shfl_xor(s, 32);
                    const float rs = __builtin_amdgcn_rsqf(s * (1.0f / 64.0f) + kEPS);
#pragma unroll
                    for (int bj = 0; bj < 2; ++bj)
#pragma unroll
                        for (int n = 0; n < 2; ++n) { const int d = bj * 32 + n * 16 + 4 * fq; const f32x4 g = *(const f32x4*)(g_mk + d);
                            const f32x4 v = acc[ai][bj][m][n] * (iv * rs) * g;
                            *(f32x4*)(mk_out + (size_t)row * 256 + head * 64 + d) = v;
                            u32x2 w; w.x = cvt_pk_bf16(v[0], v[1]); w.y = cvt_pk_bf16(v[2], v[3]);
                            *(u32x2*)(mKb + ((size_t)(b_ * 4 + head) * 256 + n_) * 64 + d) = w; }
                } else {
#pragma unroll
                    for (int bj = 0; bj < 2; ++bj)
#pragma unroll
                        for (int n = 0; n < 2; ++n) { const int c = bj * HALF + wc * 32 + n * 16 + 4 * fq; const int head = c >> 6, d = c & 63;
                            const f32x4 v = acc[ai][bj][m][n] * iv;
                            *(f32x4*)(mv_out + (size_t)row * 256 + c) = v;
                            u32x2 w; w.x = cvt_pk_bf16(v[0], v[1]); w.y = cvt_pk_bf16(v[2], v[3]);
                            *(u32x2*)(mVb + ((size_t)(b_ * 4 + head) * 256 + n_) * 64 + d) = w; }
                }
                asm volatile("" ::: "memory");
            }
    }
};
template <class Epi, class Sched, bool ALIGN_EPI = false, bool SP2 = false, bool ABLK = false, int KD = 1>
__device__ __forceinline__ void gemm_phase(PG8_LAS unsigned char* lds, const Gemm g, const Sched& S, const Epi& E) {
    int tid_ = threadIdx.x; asm volatile("" : "+v"(tid_));
    const int tid = tid_, wid = __builtin_amdgcn_readfirstlane(tid >> 6), lane = tid & 63, wr = wid >> 2, wc = wid & 3, fr = lane & 15, fq = lane >> 4;
    const int K = g.K, nt = K / BK;
    unsigned voffA[2], voffB[2];
#pragma unroll
    for (int i = 0; i < 2; ++i) { int R, C; stage_rc(tid * 16 + i * 8192, R, C); const int Rb = Epi::PERM ? ((R & ~31) + perm32(R & 31)) : R;
        voffA[i] = ABLK ? (unsigned)(R * BK + C) * 2u : (unsigned)(R * K + C) * 2u; voffB[i] = (unsigned)(Rb * K + C) * 2u; }
    const size_t kstep = (size_t)(BK * 2);
    const size_t hstep = (size_t)HALF * K * 2;
    const size_t tstep = 2 * hstep;
    const size_t kstepA = ABLK ? (size_t)(BM * BK * 2) : kstep, hstepA = ABLK ? (size_t)(HALF * BK * 2) : hstep, tstepA = ABLK ? (size_t)nt * (BM * BK * 2) : tstep;
    const unsigned ldsw = (unsigned)wid * 1024u;
    const int aoff = lds_byte(wr * 64 + fr, fq * 8), boff = lds_byte(wc * 32 + fr, fq * 8);
#define PG8_SA(b, h) (((b) * 2 + (h)) * HTB)
#define PG8_SB(b, h) ((4 + (b) * 2 + (h)) * HTB)
#define PG8_STAGE(bufoff, gbase, voff) do { _Pragma("unroll") for (int _i = 0; _i < 2; ++_i) \
        __builtin_amdgcn_global_load_lds((const unsigned*)((const char*)(gbase) + (voff)[_i]), (PG8_LAS unsigned*)(lds + (bufoff) + ldsw + _i * 8192), 16, 0, 0); } while (0)
#define PG8_LDA(dst, b, h) do { _Pragma("unroll") for (int m = 0; m < 4; ++m) _Pragma("unroll") for (int k = 0; k < 2; ++k) dst[m][k] = *(const PG8_LAS bf16x8*)(lds + PG8_SA(b, h) + aoff + m * 2048 + k * 1024); } while (0)
#define PG8_LDB(dst, b, h) do { _Pragma("unroll") for (int n = 0; n < 2; ++n) _Pragma("unroll") for (int k = 0; k < 2; ++k) dst[n][k] = *(const PG8_LAS bf16x8*)(lds + PG8_SB(b, h) + boff + n * 2048 + k * 1024); } while (0)
#define PG8_MMA(ai, bj, At, Bt) do { __builtin_amdgcn_s_setprio(1); _Pragma("unroll") for (int m = 0; m < 4; ++m) _Pragma("unroll") for (int n = 0; n < 2; ++n) _Pragma("unroll") for (int k = 0; k < 2; ++k) \
        acc[ai][bj][m][n] = __builtin_amdgcn_mfma_f32_16x16x32_bf16(Bt[n][k], At[m][k], acc[ai][bj][m][n], 0, 0, 0); __builtin_amdgcn_s_setprio(0); } while (0)
#define PG8_WAIT_V(n) asm volatile("s_waitcnt vmcnt(" #n ")" ::: "memory")
#define PG8_WAIT_L(n) asm volatile("s_waitcnt lgkmcnt(" #n ")" ::: "memory")
#define PG8_BAR __builtin_amdgcn_s_barrier()
#define PG8_SCHED __builtin_amdgcn_sched_barrier(0)
    Unit cur, nxt; int ui = 0;
    if (!S.next(0, cur)) return;
    f32x4 acc[2][2][4][2];
#pragma unroll
    for (int a = 0; a < 2; ++a)
#pragma unroll
        for (int b = 0; b < 2; ++b)
#pragma unroll
            for (int m = 0; m < 4; ++m)
#pragma unroll
                for (int n = 0; n < 2; ++n) acc[a][b][m][n] = (f32x4){0.f, 0.f, 0.f, 0.f};
    bf16x8 At[4][2], B0[2][2], B1[2][2];
    const char* cA = (const char*)g.A + (size_t)cur.pm * tstepA; const char* cB = (const char*)g.Bt + (size_t)cur.pn * tstep;
    S.a_ready(cur);
    if constexpr (SP2) {
        PG8_STAGE(PG8_SB(0, 0), cB, voffB); PG8_STAGE(PG8_SB(0, 1), cB + hstep, voffB); PG8_STAGE(PG8_SA(0, 0), cA, voffA); PG8_STAGE(PG8_SA(0, 1), cA + hstepA, voffA);
        if (wr == 1) PG8_BAR;
        PG8_WAIT_V(2); PG8_BAR;
        PG8_STAGE(PG8_SB(1, 0), cB + kstep, voffB); PG8_STAGE(PG8_SA(1, 0), cA + kstepA, voffA); PG8_STAGE(PG8_SB(1, 1), cB + hstep + kstep, voffB);
        PG8_WAIT_V(6); PG8_BAR;
    } else {
        PG8_STAGE(PG8_SB(0, 0), cB, voffB); PG8_STAGE(PG8_SA(0, 0), cA, voffA); PG8_STAGE(PG8_SB(0, 1), cB + hstep, voffB); PG8_STAGE(PG8_SA(0, 1), cA + hstepA, voffA);
        if (wr == 1) PG8_BAR;
        PG8_WAIT_V(4); PG8_BAR;
        PG8_STAGE(PG8_SB(1, 0), cB + kstep, voffB); PG8_STAGE(PG8_SA(1, 0), cA + kstepA, voffA); PG8_STAGE(PG8_SB(1, 1), cB + hstep + kstep, voffB);
        PG8_WAIT_V(6); PG8_BAR;
    }
    for (;;) {
        const bool has_next = S.next(ui + 1, nxt);
        const char* nA = has_next ? (const char*)g.A + (size_t)nxt.pm * tstepA : cA; const char* nB = has_next ? (const char*)g.Bt + (size_t)nxt.pn * tstep : cB;
        for (int kd = 0; kd < KD; ++kd) {
        const bool fin = (kd == KD - 1);
        const char* nA_ = fin ? nA : cA; const char* nB_ = fin ? nB : cB;
        for (int t = 0; t < nt; t += 2) {
            const bool last = (t == nt - 2);
            const char* a1 = cA + (size_t)(t + 1) * kstepA;
            const char* a2 = last ? nA_ : cA + (size_t)(t + 2) * kstepA; const char* b2 = last ? nB_ : cB + (size_t)(t + 2) * kstep;
            const char* a3 = a2 + kstepA; const char* b3 = b2 + kstep;
            if (last && has_next && fin) S.a_ready(nxt);
            if constexpr (SP2) {
            PG8_LDB(B0, 0, 0); PG8_LDB(B1, 0, 1); PG8_SCHED; PG8_LDA(At, 0, 0); PG8_STAGE(PG8_SA(1, 1), a1 + hstepA, voffA);
            PG8_WAIT_V(8); PG8_WAIT_L(0); PG8_BAR; PG8_MMA(0, 0, At, B0); PG8_MMA(0, 1, At, B1); PG8_BAR; PG8_SCHED;
#if PG8_AMID
            PG8_LDA(At, 0, 1); PG8_STAGE(PG8_SB(0, 0), b2, voffB); PG8_STAGE(PG8_SB(0, 1), b2 + hstep, voffB);
            PG8_WAIT_V(6); PG8_WAIT_L(0); PG8_BAR; PG8_MMA(1, 0, At, B0); PG8_SCHED; PG8_STAGE(PG8_SA(0, 0), a2, voffA); PG8_SCHED; PG8_MMA(1, 1, At, B1); PG8_BAR; PG8_SCHED;
#else
            PG8_LDA(At, 0, 1); PG8_STAGE(PG8_SB(0, 0), b2, voffB); PG8_STAGE(PG8_SB(0, 1), b2 + hstep, voffB); PG8_STAGE(PG8_SA(0, 0), a2, voffA);
            PG8_WAIT_V(8); PG8_WAIT_L(0); PG8_BAR; PG8_MMA(1, 0, At, B0); PG8_MMA(1, 1, At, B1); PG8_BAR; PG8_SCHED;
#endif
            PG8_LDB(B0, 1, 0); PG8_LDB(B1, 1, 1); PG8_SCHED; PG8_LDA(At, 1, 0); PG8_STAGE(PG8_SA(0, 1), a2 + hstepA, voffA);
            PG8_WAIT_V(8); PG8_WAIT_L(0); PG8_BAR; PG8_MMA(0, 0, At, B0); PG8_MMA(0, 1, At, B1); PG8_BAR; PG8_SCHED;
#if PG8_AMID
            PG8_LDA(At, 1, 1); PG8_STAGE(PG8_SB(1, 0), b3, voffB); PG8_STAGE(PG8_SB(1, 1), b3 + hstep, voffB);
            PG8_WAIT_V(6); PG8_WAIT_L(0); PG8_BAR; PG8_MMA(1, 0, At, B0); PG8_SCHED; PG8_STAGE(PG8_SA(1, 0), a3, voffA); PG8_SCHED; PG8_MMA(1, 1, At, B1); PG8_BAR; PG8_SCHED;
#else
            PG8_LDA(At, 1, 1); PG8_STAGE(PG8_SB(1, 0), b3, voffB); PG8_STAGE(PG8_SB(1, 1), b3 + hstep, voffB); PG8_STAGE(PG8_SA(1, 0), a3, voffA);
            PG8_WAIT_V(8); PG8_WAIT_L(0); PG8_BAR; PG8_MMA(1, 0, At, B0); PG8_MMA(1, 1, At, B1); PG8_BAR; PG8_SCHED;
#endif
            } else {
            PG8_LDB(B0, 0, 0); PG8_SCHED; PG8_LDA(At, 0, 0); PG8_STAGE(PG8_SA(1, 1), a1 + hstepA, voffA);
            PG8_WAIT_L(8); PG8_BAR; PG8_WAIT_L(0); PG8_MMA(0, 0, At, B0); PG8_BAR; PG8_SCHED;
            PG8_LDB(B1, 0, 1); PG8_STAGE(PG8_SB(0, 0), b2, voffB);
            PG8_BAR; PG8_WAIT_L(0); PG8_MMA(0, 1, At, B1); PG8_BAR;
            PG8_LDA(At, 0, 1); PG8_STAGE(PG8_SA(0, 0), a2, voffA);
            PG8_BAR; PG8_WAIT_L(0); PG8_MMA(1, 0, At, B0); PG8_BAR; PG8_SCHED;
            PG8_STAGE(PG8_SB(0, 1), b2 + hstep, voffB);
            PG8_WAIT_V(6); PG8_BAR; PG8_MMA(1, 1, At, B1); PG8_BAR;
            PG8_LDB(B0, 1, 0); PG8_SCHED; PG8_LDA(At, 1, 0); PG8_STAGE(PG8_SA(0, 1), a2 + hstepA, voffA);
            PG8_WAIT_L(8); PG8_BAR; PG8_WAIT_L(0); PG8_MMA(0, 0, At, B0); PG8_BAR; PG8_SCHED;
            PG8_LDB(B1, 1, 1); PG8_STAGE(PG8_SB(1, 0), b3, voffB);
            PG8_BAR; PG8_WAIT_L(0); PG8_MMA(0, 1, At, B1); PG8_BAR;
            PG8_LDA(At, 1, 1); PG8_STAGE(PG8_SA(1, 0), a3, voffA);
            PG8_BAR; PG8_WAIT_L(0); PG8_MMA(1, 0, At, B0); PG8_BAR; PG8_SCHED;
            PG8_STAGE(PG8_SB(1, 1), b3 + hstep, voffB);
            PG8_WAIT_V(6); PG8_BAR; PG8_MMA(1, 1, At, B1); PG8_BAR;
            }
        }
        if (KD > 1 && !fin) {
#pragma unroll
            for (int a = 0; a < 2; ++a)
#pragma unroll
                for (int b = 0; b < 2; ++b)
#pragma unroll
                    for (int m = 0; m < 4; ++m)
#pragma unroll
                        for (int n = 0; n < 2; ++n) { asm volatile("" :: "v"(acc[a][b][m][n])); acc[a][b][m][n] = (f32x4){0.f, 0.f, 0.f, 0.f}; }
        }
        }
        if constexpr (ALIGN_EPI) { if (wr == 0) PG8_BAR; }
        if constexpr (!Epi::AFTER_DRAIN) { E(acc, cur, wr, wc, fr, fq); S.done(cur); }
        if (!has_next) break;
#pragma unroll
        for (int a = 0; a < 2; ++a)
#pragma unroll
            for (int b = 0; b < 2; ++b)
#pragma unroll
                for (int m = 0; m < 4; ++m)
#pragma unroll
                    for (int n = 0; n < 2; ++n) acc[a][b][m][n] = (f32x4){0.f, 0.f, 0.f, 0.f};
        cur = nxt; cA = nA; cB = nB; ++ui;
        if constexpr (ALIGN_EPI) { if (wr == 1) PG8_BAR; }
    }
    PG8_WAIT_V(0);
    if constexpr (!ALIGN_EPI) { if (wr == 0) PG8_BAR; }
    PG8_BAR;
    if constexpr (Epi::AFTER_DRAIN) { E.fused(acc, cur, wr, wc, fr, fq, lds, wid, lane); S.done(cur); }
#undef PG8_SA
#undef PG8_SB
#undef PG8_STAGE
#undef PG8_LDA
#undef PG8_LDB
#undef PG8_MMA
#undef PG8_WAIT_V
#undef PG8_WAIT_L
#undef PG8_BAR
#undef PG8_SCHED
}
}
#define LAS __attribute__((address_space(3)))
#define XB_TMO      128
#define XB_XCNT(j)  (256  + 64 * (j))
#define XB_XSUB(j)  (1280 + 64 * (j))
#define XB_XGEN(j)  (2304 + 64 * (j))
#define XB_TOP      3328
#define XB_TOPGEN   3392
#define XCD_BAR_WORDS 3456
#define XB_SPIN_CAP (1u << 25)

__device__ __forceinline__ unsigned xb_ld(unsigned* p)              { return __hip_atomic_load(p, __ATOMIC_RELAXED, __HIP_MEMORY_SCOPE_AGENT); }
__device__ __forceinline__ unsigned xb_add(unsigned* p, unsigned v) { return __hip_atomic_fetch_add(p, v, __ATOMIC_RELAXED, __HIP_MEMORY_SCOPE_AGENT); }
__device__ __forceinline__ unsigned xb_xcc_id() { return (unsigned)__builtin_amdgcn_s_getreg((3 << 11) | 20) & 0xFu; }
#define XB_SPIN(cond, bar) do { unsigned _sp = 0; while (cond) { __builtin_amdgcn_s_sleep(1); \
    if ((++_sp & 255u) == 0u) { if (xb_ld(&(bar)[XB_TMO])) break; if (_sp > XB_SPIN_CAP) { atomicAdd(&(bar)[XB_TMO], 1u); break; } } } } while (0)

struct XcdBarrier {
    unsigned* bar; unsigned x;
    volatile LAS unsigned* st;
};

__device__ __forceinline__ XcdBarrier xcd_barrier_post(unsigned* bar, volatile LAS unsigned* st) {
    XcdBarrier b; b.bar = bar; b.x = xb_xcc_id(); b.st = st;
    if (threadIdx.x == 0) (void)xb_add(&bar[XB_XCNT(b.x)], 1u);
    return b;
}
__device__ __forceinline__ void xcd_barrier_complete(unsigned* bar, unsigned x, unsigned& nloc, unsigned& nx) {
    const unsigned G = gridDim.x * gridDim.y * gridDim.z;
    unsigned sum, cnt, mine, sp = 0u;
    for (;;) {
        sum = 0u; cnt = 0u; mine = 0u;
#pragma unroll
        for (unsigned j = 0; j < 16; ++j) { const unsigned c = xb_ld(&bar[XB_XCNT(j)]); sum += c; cnt += (c > 0u) ? 1u : 0u; mine = (j == x) ? c : mine; }
        if (sum == G) break;
        __builtin_amdgcn_s_sleep(1);
        if ((++sp & 255u) == 0u) { if (xb_ld(&bar[XB_TMO])) break; if (sp > XB_SPIN_CAP) { atomicAdd(&bar[XB_TMO], 1u); break; } }
    }
    nloc = mine > 0u ? mine : 1u; nx = cnt > 0u ? cnt : 1u;
}

__device__ __forceinline__ void xcd_barrier(const XcdBarrier& b) {
    asm volatile("s_waitcnt vmcnt(0)" ::: "memory");
    __syncthreads();
    if (threadIdx.x == 0) {
        unsigned* bar = b.bar;
        __builtin_amdgcn_s_waitcnt(0);
        unsigned nloc = b.st[0], nx = b.st[1];
        if (nloc == 0u) { xcd_barrier_complete(bar, b.x, nloc, nx); b.st[0] = nloc; b.st[1] = nx; }
        const unsigned old = xb_add(&bar[XB_XSUB(b.x)], 1u);
        const unsigned gen = old / nloc;
        if (old + 1u == (gen + 1u) * nloc) {
            __builtin_amdgcn_fence(__ATOMIC_RELEASE, "agent");
            asm volatile("s_waitcnt vmcnt(0)" ::: "memory");
            const unsigned og = xb_add(&bar[XB_TOP], 1u);
            const unsigned tg = og / nx;
            if (og + 1u == (tg + 1u) * nx) xb_add(&bar[XB_TOPGEN], 1u);
            else XB_SPIN(xb_ld(&bar[XB_TOPGEN]) == tg, bar);
            __builtin_amdgcn_fence(__ATOMIC_ACQUIRE, "agent");
            xb_add(&bar[XB_XGEN(b.x)], 1u);
            asm volatile("s_waitcnt vmcnt(0)" ::: "memory");
        } else {
            XB_SPIN(xb_ld(&bar[XB_XGEN(b.x)]) == gen, bar);
            __builtin_amdgcn_fence(__ATOMIC_ACQUIRE, "agent");
            asm volatile("s_waitcnt vmcnt(0)" ::: "memory");
        }
    }
    __syncthreads();
}
#define GAS __attribute__((address_space(1)))
typedef unsigned short bf16;
typedef unsigned v4u __attribute__((ext_vector_type(4)));
typedef unsigned v2u __attribute__((ext_vector_type(2)));
typedef float f32x4 __attribute__((ext_vector_type(4)));
typedef float f32x16 __attribute__((ext_vector_type(16)));
typedef short bf16x8 __attribute__((ext_vector_type(8)));
typedef short s16x4 __attribute__((ext_vector_type(4)));
#define LDS_WAIT() asm volatile("s_waitcnt lgkmcnt(0)" ::: "memory")
#define VM_WAIT() asm volatile("s_waitcnt vmcnt(0)" ::: "memory")
using pg8::cvt_pk_bf16;
__device__ __forceinline__ float bf2f(unsigned short h) { return __uint_as_float((unsigned)h << 16); }
__device__ __forceinline__ float bflo(unsigned w) { return __uint_as_float(w << 16); }
__device__ __forceinline__ float bfhi(unsigned w) { return __uint_as_float(w & 0xffff0000u); }

constexpr int D = 1024, SEQ = 8192, NB = 4, NTOK = 32768, NS = 128, MR = 32896, MP = 33024;
constexpr int FF = 2816, FF2 = 5632, INW = 1440, INWP = 1536;
constexpr int NPAGES = 128, PAGE = 128, NPHYS = 20480;
constexpr float EPS = 1e-6f;
static_assert(pg8::kNTOK == NTOK && pg8::kMR == MR && pg8::kSEQ == SEQ, "constants");

constexpr size_t O_Y = 0, O_YS = 33554432, O_CKVP = 33685504, O_KRP = 37879808, O_CONVP = 38928384, O_MKP = 38930432, O_MVP = 39192576,
                 O_CKVS = 39454720, O_KRS = 39471104, O_CONVS = 39475200, O_TOTAL = 39540736;

constexpr size_t MiB = 1u << 20;
constexpr size_t WS_CTL = 0, CTL_ZERO_BYTES = 1 * MiB;
constexpr size_t WS_W1GU = 1 * MiB, WS_W1D = WS_W1GU + 12 * MiB, WS_WIN = WS_W1D + 6 * MiB, WS_WUQ = WS_WIN + 3 * MiB, WS_WKV = WS_WUQ + 1 * MiB, WS_WO = WS_WKV + 1 * MiB,
                 WS_W2GU = WS_WO + 2 * MiB, WS_W2D = WS_W2GU + 12 * MiB, WS_WMEM = WS_W2D + 6 * MiB, WS_ROPE = WS_WMEM + 1 * MiB,
                 WS_SSQ0 = WS_ROPE + 2 * MiB, WS_SSQ1 = WS_SSQ0 + 3 * MiB, WS_SSQ2 = WS_SSQ1 + 3 * MiB, WS_MSQ = WS_SSQ2 + 3 * MiB, WS_SSQM = WS_MSQ + 1 * MiB,
                 WS_XB = WS_SSQM + 1 * MiB, WS_ACT1 = WS_XB + 65 * MiB, WS_ACT2 = WS_ACT1 + 178 * MiB, WS_X1F = WS_ACT2 + 178 * MiB, WS_X1B = WS_X1F + 129 * MiB,
                 WS_X2F = WS_X1B + 65 * MiB, WS_X2B = WS_X2F + 129 * MiB, WS_CQB = WS_X2B + 65 * MiB, WS_CKVB = WS_CQB + 17 * MiB, WS_KRB = WS_CKVB + 9 * MiB,
                 WS_UB = WS_KRB + 3 * MiB, WS_GBB = WS_UB + 17 * MiB, WS_MQB = WS_GBB + 17 * MiB, WS_QB = WS_MQB + 17 * MiB, WS_KB = WS_QB + 49 * MiB, WS_VB = WS_KB + 48 * MiB,
                 WS_MEMB = WS_VB + 32 * MiB, WS_MEMK = WS_MEMB + 2 * MiB, WS_MEMV = WS_MEMK + 1 * MiB, WS_OAB = WS_MEMV + 1 * MiB, WS_OMB = WS_OAB + 33 * MiB,
                 WS_OMIX = WS_OMB + 17 * MiB, WS_DPART = WS_OMIX + 65 * MiB, WS_DBG = WS_DPART + 2 * MiB, WS_GU1S = WS_DBG + 1 * MiB, WS_GU2S = WS_GU1S + 3 * MiB, WS_D1S = WS_GU2S + 3 * MiB, WS_D7S = WS_D1S + 1 * MiB, WS_ZS = WS_D7S + 1 * MiB, WS_QS = WS_ZS + 1 * MiB, WS_MEMRAW = WS_QS + 1 * MiB,
                 WS_END = WS_MEMRAW + 2 * MiB;
constexpr int CW_BAR = 4096;

constexpr int RING_BYTES = 131072, LDSCTL_OFF = RING_BYTES, MISC_OFF = LDSCTL_OFF + 320, XCH_OFF = RING_BYTES + 512, LDS_BYTES = 147456;
constexpr int NWAVES = 8;

struct Args {
    const float* in[38];
    float* out; unsigned char* ws;
    int ph_lo, ph_hi;
};

#define CAS __attribute__((address_space(4)))
typedef const float* const CAS* InTab;
struct Frame {
    LAS unsigned char* lds;
    int tid, lane, wave, vcu, G;
    InTab in;
    float* out; unsigned char* ws;
};
__device__ __forceinline__ float wave_sum(float v) {
#pragma unroll
    for (int o = 1; o < 64; o <<= 1) v += __shfl_xor(v, o);
    return v;
}
__device__ __forceinline__ float wave_max(float v) {
#pragma unroll
    for (int o = 1; o < 64; o <<= 1) v = fmaxf(v, __shfl_xor(v, o));
    return v;
}

struct TSrc { const float* p; int ld; int col0; };
__device__ __forceinline__ void tr_item(TSrc s, const float* kscale, int K, bf16* WT, int n0, int k0, LAS float* scr, int lane) {
    f32x4 v[8];
#pragma unroll
    for (int i = 0; i < 8; ++i) { const int idx = lane + 64 * i, kk = idx >> 3, n4 = idx & 7;
        v[i] = (f32x4){0.f, 0.f, 0.f, 0.f};
        if (s.p) { v[i] = *(const f32x4*)(s.p + (size_t)(k0 + kk) * s.ld + s.col0 + 4 * n4); if (kscale) v[i] = v[i] * kscale[k0 + kk]; } }
#pragma unroll
    for (int i = 0; i < 8; ++i) { const int idx = lane + 64 * i, kk = idx >> 3, n4 = idx & 7; LAS float* d = scr + kk * 33 + 4 * n4; d[0] = v[i][0]; d[1] = v[i][1]; d[2] = v[i][2]; d[3] = v[i][3]; }
    LDS_WAIT(); asm volatile("" ::: "memory");
    const int c = lane & 7;
#pragma unroll
    for (int j = 0; j < 4; ++j) { const int n = (lane >> 3) + 8 * j; const LAS float* q = scr + (8 * c) * 33 + n;
        v4u o; o.x = cvt_pk_bf16(q[0 * 33], q[1 * 33]); o.y = cvt_pk_bf16(q[2 * 33], q[3 * 33]); o.z = cvt_pk_bf16(q[4 * 33], q[5 * 33]); o.w = cvt_pk_bf16(q[6 * 33], q[7 * 33]);
        *(v4u*)(WT + (size_t)(n0 + n) * K + k0 + 8 * c) = o; }
    LDS_WAIT(); asm volatile("" ::: "memory");
}
enum { MAT_W1GU = 0, MAT_W1D, MAT_WIN, MAT_WUQ, MAT_WKV, MAT_WO, MAT_W2GU, MAT_W2D, MAT_WMEM, MAT_N };
__device__ __forceinline__ void mat_dims(int mat, int& N, int& K) {
    switch (mat) {
        case MAT_W1GU: case MAT_W2GU: N = FF2; K = D; break;
        case MAT_W1D: case MAT_W2D: N = D; K = FF; break;
        case MAT_WIN: N = INWP; K = D; break;
        case MAT_WUQ: N = 768; K = 256; break;
        case MAT_WKV: N = 1024; K = 128; break;
        case MAT_WO: N = D; K = D; break;
        default: N = 512; K = D; break;
    }
}
__device__ __forceinline__ void p0_weight_item(const Frame& F, int mat, int item, LAS float* scr) {
    int N, K; mat_dims(mat, N, K);
    const int nkb = K / 64, kb = item % nkb, slot = item / nkb, k0 = kb * 64;
    const int pn = slot >> 3, w = slot & 7, bj = w >> 2, wc = w & 3;
    InTab in = F.in;
    TSrc s{nullptr, 0, 0}; const float* ks = nullptr; bf16* dst = nullptr;
    switch (mat) {
        case MAT_W1GU: s = TSrc{bj == 0 ? in[10] : in[11], FF, 128 * pn + 32 * wc}; ks = in[9]; dst = (bf16*)(F.ws + WS_W1GU); break;
        case MAT_W2GU: s = TSrc{bj == 0 ? in[35] : in[36], FF, 128 * pn + 32 * wc}; ks = in[34]; dst = (bf16*)(F.ws + WS_W2GU); break;
        case MAT_W1D: s = TSrc{in[12], D, 32 * slot}; dst = (bf16*)(F.ws + WS_W1D); break;
        case MAT_W2D: s = TSrc{in[37], D, 32 * slot}; dst = (bf16*)(F.ws + WS_W2D); break;
        case MAT_WIN: {
            int c0 = -1;
            if (pn == 0) c0 = 32 * w;
            else if (pn == 1) c0 = (bj == 0) ? 256 + 32 * wc : (wc == 0 ? 384 : -1);
            else if (pn == 2) c0 = (bj == 0) ? 416 + 32 * wc : 928 + 32 * wc;
            else if (pn == 3) c0 = (bj == 0) ? 416 + 128 + 32 * wc : 928 + 128 + 32 * wc;
            else if (pn == 4) c0 = 672 + 32 * w;
            else c0 = 1184 + 64 * wc + 32 * bj;
            if (c0 >= 0) s = TSrc{in[14], INW, c0};
            ks = in[13]; dst = (bf16*)(F.ws + WS_WIN); break; }
        case MAT_WUQ: s = TSrc{in[16], 768, pn < 2 ? (4 * pn + wc) * 96 + 32 * bj : (4 * bj + wc) * 96 + 64}; ks = in[15]; dst = (bf16*)(F.ws + WS_WUQ); break;
        case MAT_WKV: if (pn < 2) s = TSrc{in[20], 512, (4 * pn + wc) * 64 + 32 * bj}; else s = TSrc{in[21], 512, 256 * (pn - 2) + 32 * w}; dst = (bf16*)(F.ws + WS_WKV); break;
        case MAT_WO: s = TSrc{in[33], D, 32 * slot}; ks = (k0 < 512) ? in[30] : (k0 < 768) ? in[31] - 512 : in[32] - 768; dst = (bf16*)(F.ws + WS_WO); break;
        default: if (pn == 0) s = TSrc{in[26], 256, 64 * wc + 32 * bj}; else s = TSrc{in[27], 256, 32 * w}; ks = in[25]; dst = (bf16*)(F.ws + WS_WMEM); break;
    }
    tr_item(s, ks, K, dst, 32 * slot, k0, scr, F.lane);
}
__device__ __forceinline__ void row_to_bf16_ssq(const float* src, bf16* dst, float* parts, int lane) {
    f32x4 v[4]; float s = 0.f;
#pragma unroll
    for (int j = 0; j < 4; ++j) { v[j] = src ? ((const f32x4*)src)[lane + 64 * j] : (f32x4){0.f, 0.f, 0.f, 0.f}; s += (v[j][0] * v[j][0] + v[j][1] * v[j][1]) + (v[j][2] * v[j][2] + v[j][3] * v[j][3]); }
    s = wave_sum(s);
#pragma unroll
    for (int j = 0; j < 4; ++j) { v2u w; w.x = cvt_pk_bf16(v[j][0], v[j][1]); w.y = cvt_pk_bf16(v[j][2], v[j][3]); ((v2u*)dst)[lane + 64 * j] = w; }
    if (lane == 0) parts[0] = s;
}
__device__ __forceinline__ float rope_inv_freq(int i) {
    switch (i) { case 0: return 1.000000000e+00f; case 1: return 5.623413324e-01f; case 2: return 3.162277639e-01f; case 3: return 1.778279394e-01f;
        case 4: return 1.000000015e-01f; case 5: return 5.623413250e-02f; case 6: return 3.162277490e-02f; case 7: return 1.778279431e-02f;
        case 8: return 9.999999776e-03f; case 9: return 5.623413250e-03f; case 10: return 3.162277630e-03f; case 11: return 1.778279431e-03f;
        case 12: return 1.000000047e-03f; case 13: return 5.623413017e-04f; case 14: return 3.162277571e-04f; default: return 1.778279402e-04f; }
}
__device__ __forceinline__ void p0_prologue(const Frame& F) {
    LAS float* scr = (LAS float*)(F.lds + F.wave * 16384);
    const int gw = F.vcu * NWAVES + F.wave, NGW = F.G * NWAVES;
    int base = 0;
#pragma unroll 1
    for (int mat = 0; mat < MAT_N; ++mat) {
        int N, K; mat_dims(mat, N, K);
        const int nit = (N / 32) * (K / 64);
        int first = (gw - base % NGW + NGW) % NGW;
        for (int it = first; it < nit; it += NGW) p0_weight_item(F, mat, it, scr);
        base += nit;
    }
    bf16* xb = (bf16*)(F.ws + WS_XB); float* ssq0 = (float*)(F.ws + WS_SSQ0);
#if P0_PIPE
    {
        auto srcp = [&](int r) -> const float* { return r < NTOK ? F.in[0] + (size_t)r * D : (r < MR ? F.in[2] + (size_t)(r - NTOK) * D : nullptr); };
        f32x4 va[4], vb[4];
        { const int r = gw, r2 = gw + NGW; const float* src = r < MP ? srcp(r) : nullptr; const float* src2 = r2 < MP ? srcp(r2) : nullptr;
#pragma unroll
          for (int j = 0; j < 4; ++j) { va[j] = src ? ((const f32x4*)src)[F.lane + 64 * j] : (f32x4){0.f, 0.f, 0.f, 0.f}; vb[j] = src2 ? ((const f32x4*)src2)[F.lane + 64 * j] : (f32x4){0.f, 0.f, 0.f, 0.f}; } }
        for (int r = gw; r < MP; r += 2 * NGW) {
            const int r2 = r + NGW, rn = r + 2 * NGW, rn2 = r + 3 * NGW;
            f32x4 na[4], nb[4];
            { const float* src = rn < MP ? srcp(rn) : nullptr; const float* src2 = rn2 < MP ? srcp(rn2) : nullptr;
#pragma unroll
              for (int j = 0; j < 4; ++j) { na[j] = src ? ((const f32x4*)src)[F.lane + 64 * j] : (f32x4){0.f, 0.f, 0.f, 0.f}; nb[j] = src2 ? ((const f32x4*)src2)[F.lane + 64 * j] : (f32x4){0.f, 0.f, 0.f, 0.f}; } }
            float sa = 0.f, sb = 0.f;
#pragma unroll
            for (int j = 0; j < 4; ++j) { sa += (va[j][0] * va[j][0] + va[j][1] * va[j][1]) + (va[j][2] * va[j][2] + va[j][3] * va[j][3]); sb += (vb[j][0] * vb[j][0] + vb[j][1] * vb[j][1]) + (vb[j][2] * vb[j][2] + vb[j][3] * vb[j][3]); }
            sa = wave_sum(sa); sb = wave_sum(sb);
#pragma unroll
            for (int j = 0; j < 4; ++j) { v2u w; w.x = cvt_pk_bf16(va[j][0], va[j][1]); w.y = cvt_pk_bf16(va[j][2], va[j][3]); ((v2u*)(xb + (size_t)r * D))[F.lane + 64 * j] = w; }
            if (F.lane == 0) ssq0[r] = sa;
            if (r2 < MP) {
#pragma unroll
                for (int j = 0; j < 4; ++j) { v2u w; w.x = cvt_pk_bf16(vb[j][0], vb[j][1]); w.y = cvt_pk_bf16(vb[j][2], vb[j][3]); ((v2u*)(xb + (size_t)r2 * D))[F.lane + 64 * j] = w; }
                if (F.lane == 0) ssq0[r2] = sb;
            }
#pragma unroll
            for (int j = 0; j < 4; ++j) { va[j] = na[j]; vb[j] = nb[j]; }
        }
    }
#else
    for (int r = gw; r < MP; r += 2 * NGW) {
        const int r2 = r + NGW;
        const float* src = r < NTOK ? F.in[0] + (size_t)r * D : (r < MR ? F.in[2] + (size_t)(r - NTOK) * D : nullptr);
        const float* src2 = r2 < NTOK ? F.in[0] + (size_t)r2 * D : (r2 < MR ? F.in[2] + (size_t)(r2 - NTOK) * D : nullptr);
        f32x4 va[4], vb[4];
#pragma unroll
        for (int j = 0; j < 4; ++j) { va[j] = src ? ((const f32x4*)src)[F.lane + 64 * j] : (f32x4){0.f, 0.f, 0.f, 0.f}; vb[j] = (r2 < MP && src2) ? ((const f32x4*)src2)[F.lane + 64 * j] : (f32x4){0.f, 0.f, 0.f, 0.f}; }
        float sa = 0.f, sb = 0.f;
#pragma unroll
        for (int j = 0; j < 4; ++j) { sa += (va[j][0] * va[j][0] + va[j][1] * va[j][1]) + (va[j][2] * va[j][2] + va[j][3] * va[j][3]); sb += (vb[j][0] * vb[j][0] + vb[j][1] * vb[j][1]) + (vb[j][2] * vb[j][2] + vb[j][3] * vb[j][3]); }
        sa = wave_sum(sa); sb = wave_sum(sb);
#pragma unroll
        for (int j = 0; j < 4; ++j) { v2u w; w.x = cvt_pk_bf16(va[j][0], va[j][1]); w.y = cvt_pk_bf16(va[j][2], va[j][3]); ((v2u*)(xb + (size_t)r * D))[F.lane + 64 * j] = w; }
        if (F.lane == 0) ssq0[r] = sa;
        if (r2 < MP) {
#pragma unroll
            for (int j = 0; j < 4; ++j) { v2u w; w.x = cvt_pk_bf16(vb[j][0], vb[j][1]); w.y = cvt_pk_bf16(vb[j][2], vb[j][3]); ((v2u*)(xb + (size_t)r2 * D))[F.lane + 64 * j] = w; }
            if (F.lane == 0) ssq0[r2] = sb;
        }
    }
#endif
    bf16* memb = (bf16*)(F.ws + WS_MEMB); float* ssqm = (float*)(F.ws + WS_SSQM);
    for (int r = gw; r < 1024; r += NGW) row_to_bf16_ssq(F.in[1] + (size_t)r * D, memb + (size_t)r * D, ssqm + r, F.lane);
    float* rope = (float*)(F.ws + WS_ROPE);
    const int gt = F.vcu * (NWAVES * 64) + F.tid, NGT = F.G * NWAVES * 64;
    for (int e = gt; e < 8193 * 16; e += NGT) { const int pi = e >> 4, i = e & 15; const float pos = pi == 8192 ? 16384.0f : (float)pi;
        const float ang = pos * rope_inv_freq(i);
        const double rev = (double)ang * 0.15915494309189535;
        const float fr = (float)(rev - floor(rev));
        rope[(size_t)pi * 32 + i] = __builtin_amdgcn_cosf(fr); rope[(size_t)pi * 32 + 16 + i] = __builtin_amdgcn_sinf(fr); }
    for (int e = gt; e < MP; e += NGT) { ((float*)(F.ws + WS_SSQ1))[e] = 0.f; ((float*)(F.ws + WS_SSQ2))[e] = 0.f; }
    { f32x4* z = (f32x4*)(F.ws + WS_GU1S); const int nz = (int)((WS_END - WS_GU1S) / 16); for (int e = gt; e < nz; e += NGT) z[e] = (f32x4){0.f, 0.f, 0.f, 0.f}; }
    for (int e = gt; e < NS * 256; e += NGT) { const int b = e >> 8, c = e & 255; F.out[O_CONVS + (size_t)b * 512 + c] = F.in[6][(size_t)b * 512 + 256 + c]; }
}
__device__ __forceinline__ int crow(int r, int hi) { return (r & 3) + 8 * (r >> 2) + 4 * hi; }
constexpr int AT_BUF = 20480, AT_V = 12288, AT_WS = 3 * AT_BUF, AT_OST = AT_WS + 2048;
template <int DQK>
__device__ __forceinline__ void attn_dma_tile(const bf16* Kt, const bf16* Krt, const bf16* Vt, LAS unsigned char* buf, int wid, int lane) {
    constexpr int NC = DQK / 8;
    __builtin_amdgcn_global_load_lds((const unsigned*)(Kt + (size_t)lane * 64 + wid * 8), (LAS unsigned*)(buf + wid * 1024), 16, 0, 0);
    if (NC > 8 && wid < NC - 8) __builtin_amdgcn_global_load_lds((const unsigned*)(Krt + (size_t)lane * (DQK - 64) + wid * 8), (LAS unsigned*)(buf + (8 + wid) * 1024), 16, 0, 0);
    __builtin_amdgcn_global_load_lds((const unsigned*)(Vt + (size_t)(16 * (wid & 3) + (lane >> 2)) * 64 + (wid >> 2) * 32 + (lane & 3) * 8), (LAS unsigned*)(buf + AT_V + wid * 1024), 16, 0, 0);
}
template <int DQK, bool CAUSAL, class Mid>
__device__ __forceinline__ void at_qk(f32x16& p0, f32x16& p1, const bf16x8 (&qr)[DQK / 16], const f32x16& negm, LAS unsigned char* kb, int jb, int qrel, int r32, int hi, Mid mid) {
#if AT_ROLL
#define ATK_R(dst, off) asm volatile("ds_read_b128 %0, %1 offset:%2" : "=v"(dst) : "v"(ka0), "n"(off) : "memory")
    const unsigned ka0 = (unsigned)(uintptr_t)kb + hi * 1024 + r32 * 16;
    bf16x8 ke0, ke1, ko0, ko1;
    ATK_R(ke0, 0); ATK_R(ke1, 512); ATK_R(ko0, 2048); ATK_R(ko1, 2048 + 512);
    __builtin_amdgcn_sched_barrier(0);
    mid();
    __builtin_amdgcn_sched_barrier(0);
#pragma unroll
    for (int d0 = 0; d0 < DQK / 16; ++d0) {
        bf16x8& k0 = (d0 & 1) ? ko0 : ke0; bf16x8& k1 = (d0 & 1) ? ko1 : ke1;
        if (d0 + 1 < DQK / 16) asm volatile("s_waitcnt lgkmcnt(2)" : "+v"(k0), "+v"(k1) :: "memory"); else asm volatile("s_waitcnt lgkmcnt(0)" : "+v"(k0), "+v"(k1) :: "memory");
        __builtin_amdgcn_sched_barrier(0);
        if (d0 == 0) { p0 = __builtin_amdgcn_mfma_f32_32x32x16_bf16(k0, qr[0], negm, 0, 0, 0); p1 = __builtin_amdgcn_mfma_f32_32x32x16_bf16(k1, qr[0], negm, 0, 0, 0); }
        else { p0 = __builtin_amdgcn_mfma_f32_32x32x16_bf16(k0, qr[d0], p0, 0, 0, 0); p1 = __builtin_amdgcn_mfma_f32_32x32x16_bf16(k1, qr[d0], p1, 0, 0, 0); }
        __builtin_amdgcn_sched_barrier(0);
        if (d0 + 2 < DQK / 16) { if (d0 & 1) { ATK_R(ko0, 2048 * (d0 + 2)); ATK_R(ko1, 2048 * (d0 + 2) + 512); } else { ATK_R(ke0, 2048 * (d0 + 2)); ATK_R(ke1, 2048 * (d0 + 2) + 512); } }
        __builtin_amdgcn_sched_barrier(0);
    }
#undef ATK_R
#else
    mid();
#pragma unroll
    for (int d0 = 0; d0 < DQK / 16; ++d0) {
        const bf16x8 k0 = *(const LAS bf16x8*)(kb + (2 * d0 + hi) * 1024 + r32 * 16);
        const bf16x8 k1 = *(const LAS bf16x8*)(kb + (2 * d0 + hi) * 1024 + 512 + r32 * 16);
        if (d0 == 0) { p0 = __builtin_amdgcn_mfma_f32_32x32x16_bf16(k0, qr[0], negm, 0, 0, 0); p1 = __builtin_amdgcn_mfma_f32_32x32x16_bf16(k1, qr[0], negm, 0, 0, 0); }
        else { p0 = __builtin_amdgcn_mfma_f32_32x32x16_bf16(k0, qr[d0], p0, 0, 0, 0); p1 = __builtin_amdgcn_mfma_f32_32x32x16_bf16(k1, qr[d0], p1, 0, 0, 0); }
    }
#endif
    if (CAUSAL && jb >= 0) {
        const int kb_ = 64 * jb + 4 * hi;
#pragma unroll
        for (int r = 0; r < 16; ++r) { const int kv = kb_ + (r & 3) + 8 * (r >> 2); if (kv > qrel) p0[r] = -INFINITY; if (kv + 32 > qrel) p1[r] = -INFINITY; }
    }
}
__device__ __forceinline__ void at_sp(f32x16& p0, f32x16& p1, f32x16& negm, f32x16& o0, f32x16& o1, float& mhat, float& lrun, bool first, LAS float* wsf, LAS unsigned char* vbuf, int lane, int r32, int hi) {
#if AT_VPRE
    const unsigned vb = (unsigned)(uintptr_t)vbuf + ((lane >> 4) & 1) * 32 + (lane & 3) * 8 + (4 * hi + ((lane & 15) >> 2)) * 64;
    s16x4 vlo[2][4], vhh[2][4];
#pragma unroll
    for (int d0 = 0; d0 < 2; ++d0)
#pragma unroll
        for (int ks = 0; ks < 4; ++ks) {
            asm volatile("ds_read_b64_tr_b16 %0, %1 offset:%2" : "=v"(vlo[d0][ks]) : "v"(vb), "i"(d0 * 4096 + ks * 1024) : "memory");
            asm volatile("ds_read_b64_tr_b16 %0, %1 offset:%2" : "=v"(vhh[d0][ks]) : "v"(vb), "i"(d0 * 4096 + ks * 1024 + 512) : "memory");
        }
#endif
    float rm;
    { float a = fmaxf(fmaxf(p0[0], p0[1]), p1[0]), b2 = fmaxf(fmaxf(p0[2], p0[3]), p1[1]); a = fmaxf(fmaxf(a, p1[2]), p1[3]);
#pragma unroll
      for (int r = 4; r < 16; r += 4) { a = fmaxf(fmaxf(a, p0[r]), p0[r + 1]); b2 = fmaxf(fmaxf(b2, p0[r + 2]), p0[r + 3]); a = fmaxf(fmaxf(a, p1[r]), p1[r + 1]); b2 = fmaxf(fmaxf(b2, p1[r + 2]), p1[r + 3]); }
      rm = fmaxf(a, b2); }
    { auto tt = __builtin_amdgcn_permlane32_swap(__float_as_uint(rm), __float_as_uint(rm), false, false); rm = fmaxf(__uint_as_float(tt[0]), __uint_as_float(tt[1])); }
    if (first || __any(rm > 8.0f)) {
        const float dl = first ? rm : fmaxf(rm, 0.f);
        const float alpha = __builtin_amdgcn_exp2f(-dl);
        mhat += dl; lrun *= alpha;
#pragma unroll
        for (int r = 0; r < 16; ++r) { p0[r] -= dl; p1[r] -= dl; negm[r] = -mhat; }
        asm volatile("" : "+v"(negm));
        if (hi == 0) wsf[r32] = alpha;
        LDS_WAIT();
#pragma unroll
        for (int r = 0; r < 16; ++r) { const float a = wsf[crow(r, hi)]; o0[r] *= a; o1[r] *= a; }
    }
    typedef float f32x2 __attribute__((ext_vector_type(2)));
    f32x2 ls2 = (f32x2){0.f, 0.f};
#pragma unroll
    for (int r = 0; r < 16; ++r) { p0[r] = __builtin_amdgcn_exp2f(p0[r]); p1[r] = __builtin_amdgcn_exp2f(p1[r]); }
#pragma unroll
    for (int r = 0; r < 16; r += 2) { ls2 = ls2 + (f32x2){p0[r], p0[r + 1]}; ls2 = ls2 + (f32x2){p1[r], p1[r + 1]}; }
    lrun += ls2[0] + ls2[1];
    bf16x8 pa[4];
    { v4u w;
      w.x = cvt_pk_bf16(p0[0], p0[1]); w.y = cvt_pk_bf16(p0[2], p0[3]); w.z = cvt_pk_bf16(p0[4], p0[5]); w.w = cvt_pk_bf16(p0[6], p0[7]); pa[0] = __builtin_bit_cast(bf16x8, w);
      w.x = cvt_pk_bf16(p0[8], p0[9]); w.y = cvt_pk_bf16(p0[10], p0[11]); w.z = cvt_pk_bf16(p0[12], p0[13]); w.w = cvt_pk_bf16(p0[14], p0[15]); pa[1] = __builtin_bit_cast(bf16x8, w);
      w.x = cvt_pk_bf16(p1[0], p1[1]); w.y = cvt_pk_bf16(p1[2], p1[3]); w.z = cvt_pk_bf16(p1[4], p1[5]); w.w = cvt_pk_bf16(p1[6], p1[7]); pa[2] = __builtin_bit_cast(bf16x8, w);
      w.x = cvt_pk_bf16(p1[8], p1[9]); w.y = cvt_pk_bf16(p1[10], p1[11]); w.z = cvt_pk_bf16(p1[12], p1[13]); w.w = cvt_pk_bf16(p1[14], p1[15]); pa[3] = __builtin_bit_cast(bf16x8, w); }
#if AT_VPRE
    asm volatile("s_waitcnt lgkmcnt(0)" : "+v"(vlo[0][0]), "+v"(vlo[0][1]), "+v"(vlo[0][2]), "+v"(vlo[0][3]), "+v"(vhh[0][0]), "+v"(vhh[0][1]), "+v"(vhh[0][2]), "+v"(vhh[0][3]),
                 "+v"(vlo[1][0]), "+v"(vlo[1][1]), "+v"(vlo[1][2]), "+v"(vlo[1][3]), "+v"(vhh[1][0]), "+v"(vhh[1][1]), "+v"(vhh[1][2]), "+v"(vhh[1][3]) :: "memory");
#pragma unroll
    for (int d0 = 0; d0 < 2; ++d0)
#pragma unroll
        for (int ks = 0; ks < 4; ++ks) {
            const bf16x8 vf = (bf16x8){vlo[d0][ks][0], vlo[d0][ks][1], vlo[d0][ks][2], vlo[d0][ks][3], vhh[d0][ks][0], vhh[d0][ks][1], vhh[d0][ks][2], vhh[d0][ks][3]};
            if (d0 == 0) o0 = __builtin_amdgcn_mfma_f32_32x32x16_bf16(pa[ks], vf, o0, 0, 0, 0);
            else o1 = __builtin_amdgcn_mfma_f32_32x32x16_bf16(pa[ks], vf, o1, 0, 0, 0);
        }
#elif AT_VPIPE
    const unsigned vb = (unsigned)(uintptr_t)vbuf + ((lane >> 4) & 1) * 32 + (lane & 3) * 8 + (4 * hi + ((lane & 15) >> 2)) * 64;
    s16x4 lo[2][4], hh[2][4];
#pragma unroll
    for (int ks = 0; ks < 4; ++ks) {
        asm volatile("ds_read_b64_tr_b16 %0, %1 offset:%2" : "=&v"(lo[0][ks]) : "v"(vb), "i"(ks * 1024) : "memory");
        asm volatile("ds_read_b64_tr_b16 %0, %1 offset:%2" : "=&v"(hh[0][ks]) : "v"(vb), "i"(ks * 1024 + 512) : "memory");
    }
    asm volatile("s_waitcnt lgkmcnt(0)" : "+v"(lo[0][0]), "+v"(lo[0][1]), "+v"(lo[0][2]), "+v"(lo[0][3]), "+v"(hh[0][0]), "+v"(hh[0][1]), "+v"(hh[0][2]), "+v"(hh[0][3]) :: "memory");
#pragma unroll
    for (int ks = 0; ks < 4; ++ks) {
        asm volatile("ds_read_b64_tr_b16 %0, %1 offset:%2" : "=&v"(lo[1][ks]) : "v"(vb), "i"(4096 + ks * 1024) : "memory");
        asm volatile("ds_read_b64_tr_b16 %0, %1 offset:%2" : "=&v"(hh[1][ks]) : "v"(vb), "i"(4096 + ks * 1024 + 512) : "memory");
    }
    __builtin_amdgcn_sched_barrier(0);
#pragma unroll
    for (int ks = 0; ks < 4; ++ks) {
        const bf16x8 vf = (bf16x8){lo[0][ks][0], lo[0][ks][1], lo[0][ks][2], lo[0][ks][3], hh[0][ks][0], hh[0][ks][1], hh[0][ks][2], hh[0][ks][3]};
        o0 = __builtin_amdgcn_mfma_f32_32x32x16_bf16(pa[ks], vf, o0, 0, 0, 0);
    }
    __builtin_amdgcn_sched_barrier(0);
    asm volatile("s_waitcnt lgkmcnt(0)" : "+v"(lo[1][0]), "+v"(lo[1][1]), "+v"(lo[1][2]), "+v"(lo[1][3]), "+v"(hh[1][0]), "+v"(hh[1][1]), "+v"(hh[1][2]), "+v"(hh[1][3]) :: "memory");
#pragma unroll
    for (int ks = 0; ks < 4; ++ks) {
        const bf16x8 vf = (bf16x8){lo[1][ks][0], lo[1][ks][1], lo[1][ks][2], lo[1][ks][3], hh[1][ks][0], hh[1][ks][1], hh[1][ks][2], hh[1][ks][3]};
        o1 = __builtin_amdgcn_mfma_f32_32x32x16_bf16(pa[ks], vf, o1, 0, 0, 0);
    }
#else
    const unsigned vb = (unsigned)(uintptr_t)vbuf + ((lane >> 4) & 1) * 32 + (lane & 3) * 8 + (4 * hi + ((lane & 15) >> 2)) * 64;
#pragma unroll
    for (int d0 = 0; d0 < 2; ++d0) {
        s16x4 lo[4], hh[4];
#pragma unroll
        for (int ks = 0; ks < 4; ++ks) {
            asm volatile("ds_read_b64_tr_b16 %0, %1 offset:%2" : "=&v"(lo[ks]) : "v"(vb), "i"(d0 * 4096 + ks * 1024) : "memory");
            asm volatile("ds_read_b64_tr_b16 %0, %1 offset:%2" : "=&v"(hh[ks]) : "v"(vb), "i"(d0 * 4096 + ks * 1024 + 512) : "memory");
        }
        asm volatile("s_waitcnt lgkmcnt(0)" : "+v"(lo[0]), "+v"(lo[1]), "+v"(lo[2]), "+v"(lo[3]), "+v"(hh[0]), "+v"(hh[1]), "+v"(hh[2]), "+v"(hh[3]) :: "memory");
#pragma unroll
        for (int ks = 0; ks < 4; ++ks) {
            const bf16x8 vf = (bf16x8){lo[ks][0], lo[ks][1], lo[ks][2], lo[ks][3], hh[ks][0], hh[ks][1], hh[ks][2], hh[ks][3]};
            if (d0 == 0) o0 = __builtin_amdgcn_mfma_f32_32x32x16_bf16(pa[ks], vf, o0, 0, 0, 0);
            else o1 = __builtin_amdgcn_mfma_f32_32x32x16_bf16(pa[ks], vf, o1, 0, 0, 0);
        }
    }
#endif
}
#define AT_ENDWAIT(more) do { if (more) { if (DQK > 64 && wid < DQK / 8 - 8) asm volatile("s_waitcnt vmcnt(3) lgkmcnt(0)\n\ts_barrier" ::: "memory"); else asm volatile("s_waitcnt vmcnt(2) lgkmcnt(0)\n\ts_barrier" ::: "memory"); } \
        else asm volatile("s_waitcnt vmcnt(0) lgkmcnt(0)\n\ts_barrier" ::: "memory"); } while (0)
template <int DQK, bool CAUSAL>
__device__ __forceinline__ void attn_unit_simple(const bf16* Q0, int qpitch, const bf16* Kh, const bf16* Kr, const bf16* Vh, bf16* O0, int opitch, int NT, LAS unsigned char* lds,
                                                 bf16x8 (&qr)[DQK / 16], bool primed, const bf16* nQ0, const bf16* nKh, const bf16* nKr, const bf16* nVh, int nNT) {
    constexpr int ND = DQK / 16;
    int tid_ = threadIdx.x; asm volatile("" : "+v"(tid_));
    const int tid = tid_, lane = tid & 63, r32 = lane & 31, hi = lane >> 5; const int wid = __builtin_amdgcn_readfirstlane(tid >> 6);
    if (!primed) {
        __syncthreads();
        attn_dma_tile<DQK>(Kh, Kr, Vh, lds, wid, lane);
        if (NT > 1) attn_dma_tile<DQK>(Kh + (size_t)64 * 64, Kr + (size_t)64 * (DQK - 64), Vh + (size_t)64 * 64, lds + AT_BUF, wid, lane);
#pragma unroll
        for (int d0 = 0; d0 < ND; ++d0) qr[d0] = *(const bf16x8*)(Q0 + (size_t)(wid * 32 + r32) * qpitch + d0 * 16 + hi * 8);
    }
    float mhat = 0.f, lrun = 0.f;
    f32x16 o0, o1, negm, p0, p1;
#pragma unroll
    for (int r = 0; r < 16; ++r) { o0[r] = 0.f; o1[r] = 0.f; negm[r] = 0.f; }
    asm volatile("" : "+v"(negm));
    LAS float* wsf = (LAS float*)(lds + AT_WS) + wid * 64;
    const int qrel = wid * 32 + r32;
    __syncthreads();
    const int NB = CAUSAL ? NT - 4 : NT;
    for (int t = 0; t < NB; ++t) {
        const bool more = t + 2 < NT;
        LAS unsigned char* kb = lds + (t % 3) * AT_BUF;
#if AT_DMAMID
        at_qk<DQK, false>(p0, p1, qr, negm, kb, -1, qrel, r32, hi, [&]() __attribute__((always_inline)) { if (more) attn_dma_tile<DQK>(Kh + (size_t)(t + 2) * 64 * 64, Kr + (size_t)(t + 2) * 64 * (DQK - 64), Vh + (size_t)(t + 2) * 64 * 64, lds + ((t + 2) % 3) * AT_BUF, wid, lane); });
#else
        if (more) attn_dma_tile<DQK>(Kh + (size_t)(t + 2) * 64 * 64, Kr + (size_t)(t + 2) * 64 * (DQK - 64), Vh + (size_t)(t + 2) * 64 * 64, lds + ((t + 2) % 3) * AT_BUF, wid, lane);
        at_qk<DQK, false>(p0, p1, qr, negm, kb, -1, qrel, r32, hi, []() {});
#endif
        at_sp(p0, p1, negm, o0, o1, mhat, lrun, t == 0, wsf, kb + AT_V, lane, r32, hi);
        AT_ENDWAIT(more);
    }
    if (CAUSAL) {
        for (int t = NB; t < NT; ++t) {
            const bool more = t + 2 < NT;
            if (more) attn_dma_tile<DQK>(Kh + (size_t)(t + 2) * 64 * 64, Kr + (size_t)(t + 2) * 64 * (DQK - 64), Vh + (size_t)(t + 2) * 64 * 64, lds + ((t + 2) % 3) * AT_BUF, wid, lane);
            const int jb = t - NB;
            if (!(64 * jb > 32 * wid + 31)) { LAS unsigned char* kb = lds + (t % 3) * AT_BUF;
                at_qk<DQK, true>(p0, p1, qr, negm, kb, jb, qrel, r32, hi, []() {});
                at_sp(p0, p1, negm, o0, o1, mhat, lrun, t == 0, wsf, kb + AT_V, lane, r32, hi); }
            AT_ENDWAIT(more);
        }
    }
    if (nQ0) {
        attn_dma_tile<DQK>(nKh, nKr, nVh, lds, wid, lane);
        if (nNT > 1) attn_dma_tile<DQK>(nKh + (size_t)64 * 64, nKr + (size_t)64 * (DQK - 64), nVh + (size_t)64 * 64, lds + AT_BUF, wid, lane);
#pragma unroll
        for (int d0 = 0; d0 < ND; ++d0) qr[d0] = *(const bf16x8*)(nQ0 + (size_t)(wid * 32 + r32) * qpitch + d0 * 16 + hi * 8);
    }
    lrun += __shfl_xor(lrun, 32);
    if (hi == 0) wsf[32 + r32] = lrun;
    LDS_WAIT();
    LAS bf16* stg = (LAS bf16*)(lds + AT_OST) + wid * 2048;
#pragma unroll
    for (int r = 0; r < 16; ++r) { const int orow = crow(r, hi); const float rl = __builtin_amdgcn_rcpf(wsf[32 + orow]);
        stg[orow * 64 + r32] = (bf16)(cvt_pk_bf16(o0[r] * rl, 0.f) & 0xffffu); stg[orow * 64 + 32 + r32] = (bf16)(cvt_pk_bf16(o1[r] * rl, 0.f) & 0xffffu); }
    LDS_WAIT();
#pragma unroll
    for (int i = 0; i < 4; ++i) { const int row = i * 8 + (lane >> 3), ch = lane & 7; const v4u v = *(const LAS v4u*)(stg + row * 64 + ch * 8);
#if NT_O
        __builtin_nontemporal_store(v, (v4u*)(O0 + (size_t)(wid * 32 + row) * opitch + ch * 8)); }
#else
        *(v4u*)(O0 + (size_t)(wid * 32 + row) * opitch + ch * 8) = v; }
#endif
    LDS_WAIT();
}

#undef AT_ENDWAIT
constexpr int DC_TSTR = 2080, DC_TB = 16 * DC_TSTR, DC_T0 = 0, DC_KR0 = 2 * DC_TB, DC_KRB = 4 * DC_TSTR, DC_P = DC_KR0 + 2 * DC_KRB, DC_AL = DC_P + 4096, DC_Q = DC_AL + 64, DC_QA = DC_Q + 8 * 192;
static_assert(DC_QA + 8 * 1024 <= RING_BYTES, "decode LDS");
constexpr int DC_STG = DC_QA + 8 * 1024, DC_STGK = XCH_OFF;
static_assert(DC_STG + 32768 <= RING_BYTES && DC_STGK + 8192 <= LDS_BYTES, "decode staging");
constexpr int DPART_STRIDE = 8 * 132;
template <bool B> struct BoolTag { static constexpr bool value = B; };
struct DecPre { f32x4 c[4]; f32x4 k; };
__device__ __forceinline__ void dec_load_half(DecPre& P, const float* ck, const float* kr, int hf, int tid) {
#pragma unroll
    for (int it = 0; it < 4; ++it) P.c[it] = *(const f32x4*)((const char*)(ck + 2048 * (4 * hf + it)) + (unsigned)tid * 16u);
    P.k = *(const f32x4*)((const char*)(kr + 2048 * hf) + (unsigned)tid * 16u);
}
#if DEC_NT
#define DEC_NT_SFX " nt"
#define DEC_NT_AUX 2
#else
#define DEC_NT_SFX ""
#define DEC_NT_AUX 0
#endif
__device__ __forceinline__ void dec_load_half_raw(DecPre& P, const float* ck, const float* kr, int hf, int tid) {
    const unsigned vo = (unsigned)tid * 16u;
#pragma unroll
    for (int it = 0; it < 4; ++it) { const float* bp = ck + 2048 * (4 * hf + it); asm volatile("global_load_dwordx4 %0, %1, %2" DEC_NT_SFX : "=v"(P.c[it]) : "v"(vo), "s"(bp) : "memory"); }
    { const float* bp = kr + 2048 * hf; asm volatile("global_load_dwordx4 %0, %1, %2" DEC_NT_SFX : "=v"(P.k) : "v"(vo), "s"(bp) : "memory"); }
}
template <int N> __device__ __forceinline__ void dec_wait_pre(DecPre& P) {
    asm volatile("s_waitcnt vmcnt(%5)" : "+v"(P.c[0]), "+v"(P.c[1]), "+v"(P.c[2]), "+v"(P.c[3]), "+v"(P.k) : "n"(N) : "memory");
}
__device__ __forceinline__ void dec_load_newtok_half(DecPre& P, const bf16* ckn, const bf16* krn, int hf, int tid) {
#pragma unroll
    for (int it = 0; it < 4; ++it) { const int i4 = tid + 512 * (4 * hf + it); f32x4 v = (f32x4){0.f, 0.f, 0.f, 0.f};
        if ((i4 >> 5) == 0) { const v2u w = *(const v2u*)(ckn + 4 * (i4 & 31)); v = (f32x4){bflo(w.x), bfhi(w.x), bflo(w.y), bfhi(w.y)}; } P.c[it] = v; }
    { const int j4 = tid + 512 * hf; f32x4 v = (f32x4){0.f, 0.f, 0.f, 0.f};
        if ((j4 >> 3) == 0) { const v2u w = *(const v2u*)(krn + 4 * (j4 & 7)); v = (f32x4){bflo(w.x), bfhi(w.x), bflo(w.y), bfhi(w.y)}; } P.k = v; }
}
__device__ __forceinline__ void dec_store_half(const DecPre& P, LAS unsigned char* T, LAS unsigned char* KR, int hf, int tid) {
#pragma unroll
    for (int it = 0; it < 4; ++it) { const int i4 = tid + 512 * (4 * hf + it), key = i4 >> 5, l4 = i4 & 31;
        v2u w; w.x = cvt_pk_bf16(P.c[it][0], P.c[it][1]); w.y = cvt_pk_bf16(P.c[it][2], P.c[it][3]);
        *(LAS v2u*)(T + (l4 >> 1) * DC_TSTR + key * 16 + (l4 & 1) * 8) = w; }
    { const int j4 = tid + 512 * hf, key = j4 >> 3, c4 = j4 & 7;
        v2u w; w.x = cvt_pk_bf16(P.k[0], P.k[1]); w.y = cvt_pk_bf16(P.k[2], P.k[3]);
        *(LAS v2u*)(KR + (c4 >> 1) * DC_TSTR + key * 16 + (c4 & 1) * 8) = w; }
}
__device__ __forceinline__ void dec_dma_half(const float* ck, const float* kr, int hf, int tid, int wid, LAS unsigned char* lds) {
#pragma unroll
    for (int it = 0; it < 4; ++it)
        __builtin_amdgcn_global_load_lds((const unsigned*)((const char*)(ck + 2048 * (4 * hf + it)) + (unsigned)tid * 16u), (LAS unsigned*)(lds + DC_STG + it * 8192 + wid * 1024), 16, 0, DEC_NT_AUX);
    __builtin_amdgcn_global_load_lds((const unsigned*)((const char*)(kr + 2048 * hf) + (unsigned)tid * 16u), (LAS unsigned*)(lds + DC_STGK + wid * 1024), 16, 0, DEC_NT_AUX);
}
__device__ __forceinline__ void dec_stage_to_pre(DecPre& P, int tid, LAS unsigned char* lds) {
#pragma unroll
    for (int it = 0; it < 4; ++it) P.c[it] = *(const LAS f32x4*)(lds + DC_STG + it * 8192 + tid * 16);
    P.k = *(const LAS f32x4*)(lds + DC_STGK + tid * 16);
}
__device__ __forceinline__ void decode_item(const Frame& F, int b, int half) {
    LAS unsigned char* lds = F.lds;
    int tid_ = F.tid; asm volatile("" : "+v"(tid_));
    const int tid = tid_, lane = tid & 63, wid = F.wave, r32 = lane & 31, hi = lane >> 5, fr = lane & 15, fq = lane >> 4;
    const bf16* wkv = (const bf16*)(F.ws + WS_WKV);
    const float* g_kn = F.in[22];
    __syncthreads();
#if DEC_PRIO
    if (wid >= 4) __builtin_amdgcn_s_setprio(1);
#endif
    LAS bf16* qrow = (LAS bf16*)(lds + DC_Q) + wid * 96;
    { const float* qs = (const float*)(F.ws + WS_QS) + (size_t)b * 768; const float epsq = EPS * (((const float*)(F.ws + WS_MSQ))[NTOK + b] + EPS); const int h = wid;
      const float rn = qs[256 * (h >> 2) + 128 * (lane >> 5) + 32 * (h & 3) + (lane & 31)];
      const float qn = rn * (__builtin_amdgcn_rsqf(wave_sum(rn * rn) * (1.0f / 64.0f) + epsq) * pg8::kC2Q) * F.in[17][lane];
      const float rr = lane < 32 ? qs[512 + 128 * (h >> 2) + 32 * (h & 3) + lane] : 0.f;
      const float w = rr * __builtin_amdgcn_rsqf(wave_sum(rr * rr) * (1.0f / 32.0f) + epsq) * F.in[18][lane & 31]; const float other = __shfl_xor(w, 16);
      const float* rp = (const float*)(F.ws + WS_ROPE) + (size_t)8192 * 32; const int i = lane & 15; const float cs = rp[i], sn = rp[16 + i];
      const float o = ((lane & 16) ? (other * sn + w * cs) : (w * cs - other * sn)) * pg8::kC2Q;
      const bf16 qnb = (bf16)(cvt_pk_bf16(qn, 0.f) & 0xffffu), qrb = (bf16)(cvt_pk_bf16(o, 0.f) & 0xffffu);
      qrow[lane] = qnb; if (lane < 32) qrow[64 + lane] = qrb;
      if (half == 0) { bf16* qg_ = (bf16*)(F.ws + WS_QB) + (size_t)(NTOK + b) * 768 + h * 96; qg_[lane] = qnb; if (lane < 32) qg_[64 + lane] = qrb; }
    }
    LDS_WAIT();
    bf16x8 wA[8][2];
    { const int pn = wid >> 2, wc = wid & 3; const unsigned loff = (unsigned)(r32 * 128 + 8 * hi) * 2u;
#pragma unroll
      for (int dt = 0; dt < 2; ++dt) { const char* rowp = (const char*)(wkv + (size_t)(256 * pn + 128 * dt + 32 * wc) * 128);
#pragma unroll
        for (int s = 0; s < 8; ++s) wA[s][dt] = *(const bf16x8*)(rowp + 32 * s + loff); } }
    float qg[2][16];
#pragma unroll
    for (int dt = 0; dt < 2; ++dt)
#pragma unroll
        for (int r = 0; r < 16; ++r) { const int d = 32 * dt + crow(r, hi); qg[dt][r] = g_kn[d] * bf2f(qrow[d]); }
    { v4u w = (v4u){0u, 0u, 0u, 0u}; if ((fr & 3) == 0) w = *(const LAS v4u*)(qrow + 64 + 8 * fq); *(LAS v4u*)(lds + DC_QA + wid * 1024 + lane * 16) = w; }
    for (int i = tid; i < 8 * 64; i += 512) ((LAS unsigned*)(lds + DC_P + 8 * 256))[i] = 0u;
    float mrun = -INFINITY, lrun = 0.f;
    f32x4 accL = (f32x4){0.f, 0.f, 0.f, 0.f};
    const int* ptab = (const int*)F.in[5] + b * NPAGES + half * 64;
    const int ptv = ptab[lane];
    const int npg = 64 + (half == 1 ? 1 : 0);
    const bf16* ckn = (const bf16*)(F.ws + WS_CKVB) + (size_t)(NTOK + b) * 128;
    const bf16* krn = (const bf16*)(F.ws + WS_KRB) + (size_t)(NTOK + b) * 32;
    DecPre pre;
    { const int page = __builtin_amdgcn_readlane(ptv, 0); const float* ck0 = F.in[3] + (size_t)page * (PAGE * 128); const float* kr0 = F.in[4] + (size_t)page * (PAGE * 32);
      dec_load_half(pre, ck0, kr0, 0, tid); dec_store_half(pre, lds + DC_T0, lds + DC_KR0, 0, tid);
      dec_load_half(pre, ck0, kr0, 1, tid); dec_store_half(pre, lds + DC_T0, lds + DC_KR0, 1, tid); }
    { const int page = __builtin_amdgcn_readlane(ptv, 1); const float* ck1 = F.in[3] + (size_t)page * (PAGE * 128); const float* kr1 = F.in[4] + (size_t)page * (PAGE * 32);
      dec_load_half_raw(pre, ck1, kr1, 0, tid); dec_dma_half(ck1, kr1, 1, tid, wid, lds); }
    asm volatile("s_waitcnt lgkmcnt(0)\n\ts_barrier" ::: "memory");
    auto page_body = [&](const int pg, auto steady_tag) __attribute__((always_inline)) {
        constexpr bool STEADY = decltype(steady_tag)::value;
        const bool newtok = !STEADY && pg == 64;
        LAS unsigned char* T = lds + DC_T0 + (pg & 1) * DC_TB; LAS unsigned char* KR = lds + DC_KR0 + (pg & 1) * DC_KRB;
        LAS unsigned char* Tn = lds + DC_T0 + ((pg + 1) & 1) * DC_TB; LAS unsigned char* KRn = lds + DC_KR0 + ((pg + 1) & 1) * DC_KRB;
        const bool more = STEADY || pg + 1 < npg, nextnew = !STEADY && pg + 1 >= 64, more2 = STEADY || pg + 2 < npg, next2new = !STEADY && pg + 2 >= 64, real2 = more2 && !next2new;
        const float* ck2 = nullptr; const float* kr2 = nullptr;
        if (real2) { const int page = __builtin_amdgcn_readlane(ptv, pg + 2); ck2 = F.in[3] + (size_t)page * (PAGE * 128); kr2 = F.in[4] + (size_t)page * (PAGE * 32); }
        float sc[4], sr4[4];
#define DS_R128(dst, addr, off) asm volatile("ds_read_b128 %0, %1 offset:%2" : "=v"(dst) : "v"(addr), "n"(off) : "memory")
#define LW3(bb) asm volatile("s_waitcnt lgkmcnt(3)" : "+v"(bb) :: "memory")
#define SB() __builtin_amdgcn_sched_barrier(0)
        typedef float f32x2 __attribute__((ext_vector_type(2)));
#if PROBE_VALU2
#define VP(acc_, dt_, r_, sv_, dv_) do { const f32x2 x_ = (f32x2){acc_[r_], acc_[(r_) + 1]}; sv_ = x_ * x_ + sv_; dv_ = x_ * (f32x2){qg[dt_][r_], qg[dt_][(r_) + 1]} + dv_; \
        asm volatile("v_pk_fma_f32 %0, %1, %1, %0\n\tv_pk_fma_f32 %0, %1, %1, %0" : "+v"(dumv) : "v"(x_)); } while (0)
        f32x2 dumv = (f32x2){0.f, 0.f};
#else
#define VP(acc_, dt_, r_, sv_, dv_) do { const f32x2 x_ = (f32x2){acc_[r_], acc_[(r_) + 1]}; sv_ = x_ * x_ + sv_; dv_ = x_ * (f32x2){qg[dt_][r_], qg[dt_][(r_) + 1]} + dv_; } while (0)
#endif
        const unsigned tb0 = (unsigned)(uintptr_t)T + hi * DC_TSTR + r32 * 16, kb0 = (unsigned)(uintptr_t)KR + fq * DC_TSTR + fr * 16, qa0 = (unsigned)(uintptr_t)(lds + DC_QA) + wid * 1024 + lane * 16;
        bf16x8 b0, b1, b2, b3;
        {
            bf16x8 qrA, kf[8];
            DS_R128(qrA, qa0, 0);
            DS_R128(kf[0], kb0, 0); DS_R128(kf[1], kb0, 256); DS_R128(kf[2], kb0, 512); DS_R128(kf[3], kb0, 768); DS_R128(kf[4], kb0, 1024); DS_R128(kf[5], kb0, 1280); DS_R128(kf[6], kb0, 1536); DS_R128(kf[7], kb0, 1792);
            DS_R128(b0, tb0, 0); DS_R128(b1, tb0, 2 * DC_TSTR); DS_R128(b2, tb0, 4 * DC_TSTR); DS_R128(b3, tb0, 6 * DC_TSTR);
            SB();
            asm volatile("s_waitcnt lgkmcnt(4)" : "+v"(qrA), "+v"(kf[0]), "+v"(kf[1]), "+v"(kf[2]), "+v"(kf[3]), "+v"(kf[4]), "+v"(kf[5]), "+v"(kf[6]), "+v"(kf[7]) :: "memory");
            SB();
            const f32x4 z4 = (f32x4){0.f, 0.f, 0.f, 0.f};
#pragma unroll
            for (int g = 0; g < 4; ++g) {
                const f32x4 rr0 = __builtin_amdgcn_mfma_f32_16x16x32_bf16(qrA, kf[2 * g], z4, 0, 0, 0), rr1 = __builtin_amdgcn_mfma_f32_16x16x32_bf16(qrA, kf[2 * g + 1], z4, 0, 0, 0);
                sr4[g] = (r32 < 16) ? rr0[0] : rr1[0];
            }
            SB();
        }
        f32x16 a0, a1;
        f32x2 s0v, d0v, s1v, d1v; const f32x2 z2 = (f32x2){0.f, 0.f};
#define DEC_FIN(gg) do { float ssq = (s0v[0] + s0v[1]) + (s1v[0] + s1v[1]), dot = (d0v[0] + d0v[1]) + (d1v[0] + d1v[1]); \
            { auto t = __builtin_amdgcn_permlane32_swap(__float_as_uint(ssq), __float_as_uint(ssq), false, false); ssq = __uint_as_float(t[0]) + __uint_as_float(t[1]); } \
            { auto t = __builtin_amdgcn_permlane32_swap(__float_as_uint(dot), __float_as_uint(dot), false, false); dot = __uint_as_float(t[0]) + __uint_as_float(t[1]); } \
            float sv = dot * __builtin_amdgcn_rsqf(ssq * (1.0f / 64.0f) + EPS) + sr4[gg]; \
            if (newtok && (32 * (gg) + r32) != 0) sv = -INFINITY; \
            sc[gg] = sv; } while (0)
#pragma unroll
        for (int g = 0; g < 4; ++g) {
#pragma unroll
            for (int r = 0; r < 16; ++r) a0[r] = 0.f;
            if (g > 0) { s1v = (f32x2){0.f, 0.f}; d1v = (f32x2){0.f, 0.f}; }
            SB();
#define XS(i_, bb, off_, VAL) LW3(bb); SB(); a0 = __builtin_amdgcn_mfma_f32_32x32x16_bf16(wA[i_][0], bb, a0, 0, 0, 0); SB(); DS_R128(bb, tb0, off_); SB(); if (g > 0) { VAL; } SB()
            XS(0, b0,  8 * DC_TSTR + 512 * g, (void)0);
            XS(1, b1, 10 * DC_TSTR + 512 * g, VP(a1, 1, 0, s1v, d1v));
            XS(2, b2, 12 * DC_TSTR + 512 * g, VP(a1, 1, 2, s1v, d1v));
            XS(3, b3, 14 * DC_TSTR + 512 * g, VP(a1, 1, 4, s1v, d1v));
            XS(4, b0,  0 * DC_TSTR + 512 * g, VP(a1, 1, 6, s1v, d1v));
            XS(5, b1,  2 * DC_TSTR + 512 * g, VP(a1, 1, 8, s1v, d1v));
            XS(6, b2,  4 * DC_TSTR + 512 * g, VP(a1, 1, 10, s1v, d1v));
            XS(7, b3,  6 * DC_TSTR + 512 * g, VP(a1, 1, 12, s1v, d1v); VP(a1, 1, 14, s1v, d1v));
#undef XS
#pragma unroll
            for (int r = 0; r < 16; ++r) a1[r] = 0.f;
            SB();
#define YS(i_, bb, WAITST, READST, VAL) WAITST; SB(); a1 = __builtin_amdgcn_mfma_f32_32x32x16_bf16(wA[i_][1], bb, a1, 0, 0, 0); SB(); READST; SB(); VAL; SB()
            YS(0, b0, LW3(b0), DS_R128(b0, tb0,  8 * DC_TSTR + 512 * g), if (g > 0) DEC_FIN(g - 1); s0v = z2; d0v = z2);
            YS(1, b1, LW3(b1), DS_R128(b1, tb0, 10 * DC_TSTR + 512 * g), VP(a0, 0, 0, s0v, d0v));
            YS(2, b2, LW3(b2), DS_R128(b2, tb0, 12 * DC_TSTR + 512 * g), VP(a0, 0, 2, s0v, d0v));
            YS(3, b3, LW3(b3), DS_R128(b3, tb0, 14 * DC_TSTR + 512 * g), VP(a0, 0, 4, s0v, d0v));
            if (g < 3) {
                YS(4, b0, LW3(b0), DS_R128(b0, tb0, 0 * DC_TSTR + 512 * (g + 1)), VP(a0, 0, 6, s0v, d0v));
                YS(5, b1, LW3(b1), DS_R128(b1, tb0, 2 * DC_TSTR + 512 * (g + 1)), VP(a0, 0, 8, s0v, d0v));
                YS(6, b2, LW3(b2), DS_R128(b2, tb0, 4 * DC_TSTR + 512 * (g + 1)), VP(a0, 0, 10, s0v, d0v));
                YS(7, b3, LW3(b3), DS_R128(b3, tb0, 6 * DC_TSTR + 512 * (g + 1)), VP(a0, 0, 12, s0v, d0v); VP(a0, 0, 14, s0v, d0v));
            } else {
                YS(4, b0, LW3(b0), (void)0, VP(a0, 0, 6, s0v, d0v));
                YS(5, b1, asm volatile("s_waitcnt lgkmcnt(2)" : "+v"(b1) :: "memory"), (void)0, VP(a0, 0, 8, s0v, d0v));
                YS(6, b2, asm volatile("s_waitcnt lgkmcnt(1)" : "+v"(b2) :: "memory"), (void)0, VP(a0, 0, 10, s0v, d0v));
                YS(7, b3, asm volatile("s_waitcnt lgkmcnt(0)" : "+v"(b3) :: "memory"), (void)0, VP(a0, 0, 12, s0v, d0v); VP(a0, 0, 14, s0v, d0v));
            }
#undef YS
            if (g == 1 && more) {
                if (STEADY) dec_wait_pre<5>(pre); else dec_wait_pre<0>(pre);
                dec_store_half(pre, Tn, KRn, 0, tid);
                __builtin_amdgcn_sched_barrier(0);
                if (more2) { if (!next2new) dec_load_half_raw(pre, ck2, kr2, 0, tid); else dec_load_newtok_half(pre, ckn, krn, 0, tid); }
                __builtin_amdgcn_sched_barrier(0);
            }
        }
        s1v = (f32x2){0.f, 0.f}; d1v = (f32x2){0.f, 0.f};
#pragma unroll
        for (int r = 0; r < 16; r += 2) VP(a1, 1, r, s1v, d1v);
        DEC_FIN(3);
#undef DS_R128
#undef LW3
#undef SB
#undef VP
#undef DEC_FIN
        const float pm = fmaxf(fmaxf(sc[0], sc[1]), fmaxf(sc[2], sc[3]));
        float alpha = 1.0f;
        if (__any(pm > mrun + 8.0f)) {
            const float mn = fmaxf(mrun, wave_max(pm));
            alpha = __builtin_amdgcn_exp2f(mrun - mn);
            mrun = mn; lrun *= alpha;
        }
#pragma unroll
        for (int g = 0; g < 4; ++g) { sc[g] = __builtin_amdgcn_exp2f(sc[g] - mrun); lrun += sc[g]; }
        if (hi == 0) {
#pragma unroll
            for (int g = 0; g < 4; ++g) ((LAS bf16*)(lds + DC_P))[wid * 128 + 32 * g + r32] = (bf16)(cvt_pk_bf16(sc[g], 0.f) & 0xffffu);
        }
        if (lane == 0) ((LAS float*)(lds + DC_AL))[wid] = alpha;
        asm volatile("s_waitcnt lgkmcnt(0)\n\ts_barrier" ::: "memory");
        DecPre st;
        if (more && !nextnew) {
            if (real2) asm volatile("s_waitcnt vmcnt(5)" ::: "memory"); else asm volatile("s_waitcnt vmcnt(0)" ::: "memory");
            dec_stage_to_pre(st, tid, lds);
        }
        {
            const int q = fr >> 2, p = fr & 3;
            const f32x4 al4 = *(const LAS f32x4*)(lds + DC_AL + (fq & 1) * 16);
            bf16x8 pa[4];
#pragma unroll
            for (int ks = 0; ks < 4; ++ks) pa[ks] = *(const LAS bf16x8*)(lds + DC_P + fr * 256 + (32 * ks + 8 * fq) * 2);
            const unsigned a0 = (unsigned)(uintptr_t)T + (2 * wid + (p >> 1)) * DC_TSTR + (8 * fq + q) * 16 + (p & 1) * 8;
            s16x4 lo0, hh0, lo1, hh1, lo2, hh2, lo3, hh3;
            asm volatile("ds_read_b64_tr_b16 %0, %8\n\tds_read_b64_tr_b16 %1, %8 offset:64\n\tds_read_b64_tr_b16 %2, %8 offset:512\n\tds_read_b64_tr_b16 %3, %8 offset:576\n\t"
                         "ds_read_b64_tr_b16 %4, %8 offset:1024\n\tds_read_b64_tr_b16 %5, %8 offset:1088\n\tds_read_b64_tr_b16 %6, %8 offset:1536\n\tds_read_b64_tr_b16 %7, %8 offset:1600\n\ts_waitcnt lgkmcnt(0)"
                         : "=&v"(lo0), "=&v"(hh0), "=&v"(lo1), "=&v"(hh1), "=&v"(lo2), "=&v"(hh2), "=&v"(lo3), "=&v"(hh3) : "v"(a0) : "memory");
            accL = accL * al4;
            accL = __builtin_amdgcn_mfma_f32_16x16x32_bf16(pa[0], (bf16x8){lo0[0], lo0[1], lo0[2], lo0[3], hh0[0], hh0[1], hh0[2], hh0[3]}, accL, 0, 0, 0);
            accL = __builtin_amdgcn_mfma_f32_16x16x32_bf16(pa[1], (bf16x8){lo1[0], lo1[1], lo1[2], lo1[3], hh1[0], hh1[1], hh1[2], hh1[3]}, accL, 0, 0, 0);
            accL = __builtin_amdgcn_mfma_f32_16x16x32_bf16(pa[2], (bf16x8){lo2[0], lo2[1], lo2[2], lo2[3], hh2[0], hh2[1], hh2[2], hh2[3]}, accL, 0, 0, 0);
            accL = __builtin_amdgcn_mfma_f32_16x16x32_bf16(pa[3], (bf16x8){lo3[0], lo3[1], lo3[2], lo3[3], hh3[0], hh3[1], hh3[2], hh3[3]}, accL, 0, 0, 0);
        }
        if (more && !nextnew) {
            dec_store_half(st, Tn, KRn, 1, tid);
            if (real2) dec_dma_half(ck2, kr2, 1, tid, wid, lds);
        }
        asm volatile("s_waitcnt lgkmcnt(0)\n\ts_barrier" ::: "memory");
    };
    for (int pg = 0; pg < 62; ++pg) page_body(pg, BoolTag<true>{});
    for (int pg = 62; pg < npg; ++pg) page_body(pg, BoolTag<false>{});
#if DEC_PRIO
    __builtin_amdgcn_s_setprio(0);
#endif
    { int l2 = threadIdx.x; asm volatile("" : "+v"(l2)); l2 &= 63; const int fr2 = l2 & 15, fq2 = l2 >> 4;
      float* part = (float*)(F.ws + WS_DPART) + (size_t)(b * 2 + half) * DPART_STRIDE;
      const float ltot = wave_sum(lrun) * 0.5f;
      if (l2 == 0) { part[wid * 132 + 0] = mrun; part[wid * 132 + 1] = ltot; }
      if (fq2 < 2) {
#pragma unroll
          for (int i = 0; i < 4; ++i) part[(4 * fq2 + i) * 132 + 4 + 16 * wid + fr2] = accL[i];
      } }
}
__device__ __forceinline__ v4u norm8_pack(const float (&v)[8], float inv) {
    v4u w; w.x = cvt_pk_bf16(v[0] * inv, v[1] * inv); w.y = cvt_pk_bf16(v[2] * inv, v[3] * inv); w.z = cvt_pk_bf16(v[4] * inv, v[5] * inv); w.w = cvt_pk_bf16(v[6] * inv, v[7] * inv); return w;
}
__device__ __forceinline__ v2u norm4_pack(const float (&v)[4], float inv) { v2u w; w.x = cvt_pk_bf16(v[0] * inv, v[1] * inv); w.y = cvt_pk_bf16(v[2] * inv, v[3] * inv); return w; }
__device__ __forceinline__ void tp_finish_row(bf16* omix_row, const float (&a)[8], const float (&y)[4], const float (&mo)[4], int lane, int parts = 3) {
    if (parts & 1) {
        float sa = 0.f;
#pragma unroll
        for (int i = 0; i < 8; ++i) sa += a[i] * a[i];
        sa = wave_sum(sa);
        const float ia = __builtin_amdgcn_rsqf(sa * (1.0f / 512.0f) + EPS);
        *(v4u*)(omix_row + 8 * lane) = norm8_pack(a, ia);
    }
    if (parts & 2) {
        float sy = 0.f, sm = 0.f;
#pragma unroll
        for (int i = 0; i < 4; ++i) { sy += y[i] * y[i]; sm += mo[i] * mo[i]; }
        sy = wave_sum(sy); sm = wave_sum(sm);
        const float iy = __builtin_amdgcn_rsqf(sy * (1.0f / 256.0f) + EPS), im = __builtin_amdgcn_rsqf(sm * (1.0f / 256.0f) + EPS);
        *(v2u*)(omix_row + 512 + 4 * lane) = norm4_pack(y, iy);
        *(v2u*)(omix_row + 768 + 4 * lane) = norm4_pack(mo, im);
    }
}
__device__ __forceinline__ void tp_prompt_row(const Frame& F, int r) {
    const int lane = F.lane, t = r & (SEQ - 1);
    const bf16* oab = (const bf16*)(F.ws + WS_OAB); const bf16* omb = (const bf16*)(F.ws + WS_OMB); const bf16* ub = (const bf16*)(F.ws + WS_UB); const bf16* gbb = (const bf16*)(F.ws + WS_GBB);
    const float* cw = F.in[24];
    float a[8], y[4], mo[4];
    { const v4u w = *(const v4u*)(oab + (size_t)r * 512 + 8 * lane); a[0] = bflo(w.x); a[1] = bfhi(w.x); a[2] = bflo(w.y); a[3] = bfhi(w.y); a[4] = bflo(w.z); a[5] = bfhi(w.z); a[6] = bflo(w.w); a[7] = bfhi(w.w); }
    { const v2u w = *(const v2u*)(omb + (size_t)r * 256 + 4 * lane); mo[0] = bflo(w.x); mo[1] = bfhi(w.x); mo[2] = bflo(w.y); mo[3] = bfhi(w.y); }
    { const v2u u0 = *(const v2u*)(ub + (size_t)r * 256 + 4 * lane);
      v2u u1 = (v2u){0u, 0u}, u2 = (v2u){0u, 0u};
      if (t >= 1) u1 = *(const v2u*)(ub + (size_t)(r - 1) * 256 + 4 * lane);
      if (t >= 2) u2 = *(const v2u*)(ub + (size_t)(r - 2) * 256 + 4 * lane);
      const v2u g = *(const v2u*)(gbb + (size_t)r * 256 + 4 * lane);
      const f32x4 w0 = *(const f32x4*)(cw + 4 * lane), w1 = *(const f32x4*)(cw + 256 + 4 * lane), w2 = *(const f32x4*)(cw + 512 + 4 * lane);
      y[0] = bflo(g.x) * (w0[0] * bflo(u2.x) + w1[0] * bflo(u1.x) + w2[0] * bflo(u0.x));
      y[1] = bfhi(g.x) * (w0[1] * bfhi(u2.x) + w1[1] * bfhi(u1.x) + w2[1] * bfhi(u0.x));
      y[2] = bflo(g.y) * (w0[2] * bflo(u2.y) + w1[2] * bflo(u1.y) + w2[2] * bflo(u0.y));
      y[3] = bfhi(g.y) * (w0[3] * bfhi(u2.y) + w1[3] * bfhi(u1.y) + w2[3] * bfhi(u0.y)); }
    tp_finish_row((bf16*)(F.ws + WS_OMIX) + (size_t)r * D, a, y, mo, lane);
}
__device__ __forceinline__ void tp_sample_wg(const Frame& F, int b, int parts = 3) {
    const int lane = F.lane, wid = F.wave, r = NTOK + b;
    LAS float* base = (LAS float*)F.lds;
    LAS float* lat = base; LAS float* oA = base + 1024; LAS float* oM = base + 1536; LAS float* yc = base + 1792; LAS float* qf = base + 2048 + (wid & 3) * 64; LAS float* pb = base + 2304 + (wid & 3) * 256;
    __syncthreads();
    if (parts & 1) { const int h = wid; const float* part = (const float*)(F.ws + WS_DPART) + (size_t)(b * 2) * DPART_STRIDE;
      const float m0 = part[h * 132], l0 = part[h * 132 + 1], m1 = part[DPART_STRIDE + h * 132], l1 = part[DPART_STRIDE + h * 132 + 1];
      const float M = fmaxf(m0, m1), e0 = __builtin_amdgcn_exp2f(m0 - M), e1 = __builtin_amdgcn_exp2f(m1 - M);
      const float rl = 1.0f / (l0 * e0 + l1 * e1);
#pragma unroll
      for (int j = 0; j < 2; ++j) { const int c = lane + 64 * j; lat[h * 128 + c] = (part[h * 132 + 4 + c] * e0 + part[DPART_STRIDE + h * 132 + 4 + c] * e1) * rl; }
      LDS_WAIT();
      const float* wuv = F.in[21] + h * 64 + lane; float a = 0.f;
#pragma unroll 32
      for (int l = 0; l < 128; ++l) a += lat[h * 128 + l] * wuv[(size_t)l * 512];
      oA[h * 64 + lane] = a; }
    if (!(parts & 2)) {}
    else if (wid < 4) {
        const int h = wid; const bf16* mqb = (const bf16*)(F.ws + WS_MQB) + (size_t)r * 256; const float* ck = F.in[7] + (size_t)b * (256 * 256); const float* cv = F.in[8] + (size_t)b * (256 * 256);
        qf[lane] = bf2f(mqb[h * 64 + lane]);
        LDS_WAIT();
        float sv[4];
#pragma unroll
        for (int j = 0; j < 4; ++j) { const int n = lane + 64 * j; const float* kp = ck + (size_t)n * 256 + h * 64; float acc = 0.f;
#pragma unroll
            for (int d4 = 0; d4 < 16; ++d4) { const f32x4 kv = *(const f32x4*)(kp + 4 * d4); const f32x4 qv = *(const LAS f32x4*)(qf + 4 * d4); acc += kv[0] * qv[0] + kv[1] * qv[1] + kv[2] * qv[2] + kv[3] * qv[3]; }
            sv[j] = acc; }
        const float mx = wave_max(fmaxf(fmaxf(sv[0], sv[1]), fmaxf(sv[2], sv[3])));
        float ls = 0.f;
#pragma unroll
        for (int j = 0; j < 4; ++j) { sv[j] = __builtin_amdgcn_exp2f(sv[j] - mx); ls += sv[j]; pb[lane + 64 * j] = sv[j]; }
        ls = wave_sum(ls);
        LDS_WAIT();
        float o = 0.f;
#pragma unroll 32
        for (int n = 0; n < 256; ++n) o += pb[n] * cv[(size_t)n * 256 + h * 64 + lane];
        oM[h * 64 + lane] = o / ls;
    } else {
        const int c = (wid - 4) * 64 + lane; const bf16* ub = (const bf16*)(F.ws + WS_UB); const bf16* gbb = (const bf16*)(F.ws + WS_GBB); const float* cw = F.in[24]; const float* st = F.in[6] + (size_t)b * 512;
        yc[c] = bf2f(gbb[(size_t)r * 256 + c]) * (cw[c] * st[c] + cw[256 + c] * st[256 + c] + cw[512 + c] * bf2f(ub[(size_t)r * 256 + c]));
    }
    __syncthreads();
    if (wid == 0) {
        float a[8], y[4], mo[4];
#pragma unroll
        for (int i = 0; i < 8; ++i) a[i] = (parts & 1) ? oA[8 * lane + i] : 0.f;
#pragma unroll
        for (int i = 0; i < 4; ++i) { y[i] = (parts & 2) ? yc[4 * lane + i] : 0.f; mo[i] = (parts & 2) ? oM[4 * lane + i] : 0.f; }
        if (parts & 1) *(v4u*)((bf16*)(F.ws + WS_OAB) + (size_t)r * 512 + 8 * lane) = norm8_pack(a, 1.0f);
        if (parts & 2) *(v2u*)((bf16*)(F.ws + WS_OMB) + (size_t)r * 256 + 4 * lane) = norm4_pack(mo, 1.0f);
        tp_finish_row((bf16*)(F.ws + WS_OMIX) + (size_t)r * D, a, y, mo, lane, parts);
    }
}
__device__ __forceinline__ void tp_phase(const Frame& F) {
    const int gw = F.vcu * NWAVES + F.wave, NGW = F.G * NWAVES;
    for (int r = gw; r < NTOK; r += NGW) tp_prompt_row(F, r);
}
struct ABf16 {
    const bf16* p; int ld;
    static constexpr bool NEEDS_INV = false;
    __device__ __forceinline__ float row_inv(int) const { return 1.f; }
    __device__ __forceinline__ v4u piece(int row, int k, float) const { return *(const v4u*)(p + (size_t)row * ld + k); }
};
struct ASum {
    const float* a; const float* b; float cb;
    static constexpr bool NEEDS_INV = false;
    __device__ __forceinline__ float row_inv(int) const { return 1.f; }
    __device__ __forceinline__ v4u piece(int row, int k, float) const {
        const f32x4 a0 = *(const f32x4*)(a + (size_t)row * 1024 + k), a1 = *(const f32x4*)(a + (size_t)row * 1024 + k + 4);
        const f32x4 b0 = *(const f32x4*)(b + (size_t)row * 1024 + k), b1 = *(const f32x4*)(b + (size_t)row * 1024 + k + 4);
        const f32x4 v0 = a0 + b0 * cb, v1 = a1 + b1 * cb;
        v4u w; w.x = cvt_pk_bf16(v0[0], v0[1]); w.y = cvt_pk_bf16(v0[2], v0[3]); w.z = cvt_pk_bf16(v1[0], v1[1]); w.w = cvt_pk_bf16(v1[2], v1[3]); return w;
    }
};
struct ASilu {
    const float* gu; const float* ssq;
    static constexpr bool NEEDS_INV = true;
    __device__ __forceinline__ float row_inv(int row) const { return pg8::row_inv_from_parts(ssq, NTOK + row); }
    __device__ __forceinline__ v4u piece(int row, int k, float iv) const {
        const float* gp = gu + (size_t)row * FF2 + 256 * (k >> 7) + (k & 127);
        const f32x4 g0 = *(const f32x4*)gp, g1 = *(const f32x4*)(gp + 4), u0 = *(const f32x4*)(gp + 128), u1 = *(const f32x4*)(gp + 132);
        v4u w;
        w.x = cvt_pk_bf16(pg8::silu_mul(g0[0] * iv, u0[0] * iv), pg8::silu_mul(g0[1] * iv, u0[1] * iv)); w.y = cvt_pk_bf16(pg8::silu_mul(g0[2] * iv, u0[2] * iv), pg8::silu_mul(g0[3] * iv, u0[3] * iv));
        w.z = cvt_pk_bf16(pg8::silu_mul(g1[0] * iv, u1[0] * iv), pg8::silu_mul(g1[1] * iv, u1[1] * iv)); w.w = cvt_pk_bf16(pg8::silu_mul(g1[2] * iv, u1[2] * iv), pg8::silu_mul(g1[3] * iv, u1[3] * iv));
        return w;
    }
};
template <int KB, class AProv, int CH = 1>
__device__ __forceinline__ void mini_gemm(const Frame& F, const AProv& A, const bf16* Bt, int K, int N, int item0, float* out, int ldo, float scale) {
    constexpr int PPR = KB / 8, PITCH = (KB + 8) * 2;
    constexpr int A_OFF = 0, B_OFF = 128 * PITCH, INV_OFF = B_OFF + 64 * PITCH;
    static_assert(INV_OFF + 512 <= RING_BYTES && KB % 16 == 0 && (CH == 1 || !AProv::NEEDS_INV), "mini_gemm LDS");
    int tid_ = F.tid; asm volatile("" : "+v"(tid_));
    const int tid = tid_, lane = tid & 63, r32 = lane & 31, hi = lane >> 5, wid = F.wave, rt = wid >> 1, ct = wid & 1;
    LAS unsigned char* lds = F.lds;
    const int nnb = N / 64, nitems = nnb * (K / (KB * CH));
    constexpr int NPA = (128 * PPR + 511) / 512, NPB = (64 * PPR + 511) / 512;
#ifndef MINI_REP
#define MINI_REP 1
#endif
    for (int rep_ = 0; rep_ < MINI_REP; ++rep_)
    for (int it = item0; it < nitems; it += F.G) {
        const int nb = it % nnb, kbase = (it / nnb) * (KB * CH), n0 = nb * 64;
        asm volatile("s_waitcnt lgkmcnt(0)\n\ts_barrier" ::: "memory");
        if (AProv::NEEDS_INV) { if (tid < 128) ((LAS float*)(lds + INV_OFF))[tid] = A.row_inv(tid); __syncthreads(); }
        v4u va[NPA], vb[NPB];
        auto load_chunk = [&](int k0) __attribute__((always_inline)) {
#pragma unroll
            for (int j = 0; j < NPA; ++j) { const int p = tid + 512 * j; const int row = p / PPR, c = p - row * PPR;
                va[j] = (v4u){0u, 0u, 0u, 0u};
                if (p < 128 * PPR) { const float iv = AProv::NEEDS_INV ? ((LAS float*)(lds + INV_OFF))[row] : 1.f; va[j] = A.piece(row, k0 + 8 * c, iv); } }
#pragma unroll
            for (int j = 0; j < NPB; ++j) { const int p = tid + 512 * j; const int n = p / PPR, c = p - n * PPR;
                vb[j] = (v4u){0u, 0u, 0u, 0u};
                if (p < 64 * PPR) vb[j] = *(const v4u*)(Bt + (size_t)(n0 + n) * K + k0 + 8 * c); } };
        load_chunk(kbase);
        f32x16 acc;
#pragma unroll
        for (int r = 0; r < 16; ++r) acc[r] = 0.f;
#pragma unroll
        for (int ch = 0; ch < CH; ++ch) {
            if (ch > 0) asm volatile("s_waitcnt lgkmcnt(0)\n\ts_barrier" ::: "memory");
#pragma unroll
            for (int j = 0; j < NPA; ++j) { const int p = tid + 512 * j; const int row = p / PPR, c = p - row * PPR; if (p < 128 * PPR) *(LAS v4u*)(lds + A_OFF + row * PITCH + c * 16) = va[j]; }
#pragma unroll
            for (int j = 0; j < NPB; ++j) { const int p = tid + 512 * j; const int n = p / PPR, c = p - n * PPR; if (p < 64 * PPR) *(LAS v4u*)(lds + B_OFF + n * PITCH + c * 16) = vb[j]; }
            if (ch + 1 < CH) load_chunk(kbase + (ch + 1) * KB);
            asm volatile("s_waitcnt lgkmcnt(0)\n\ts_barrier" ::: "memory");
            const LAS unsigned char* ap = lds + A_OFF + (32 * rt + r32) * PITCH + 16 * hi; const LAS unsigned char* bp = lds + B_OFF + (32 * ct + r32) * PITCH + 16 * hi;
#pragma unroll
            for (int s = 0; s < KB / 16; ++s) acc = __builtin_amdgcn_mfma_f32_32x32x16_bf16(*(const LAS bf16x8*)(ap + 32 * s), *(const LAS bf16x8*)(bp + 32 * s), acc, 0, 0, 0);
        }
        float* op = out + (size_t)(32 * rt) * ldo + n0 + 32 * ct + r32;
#pragma unroll
        for (int r = 0; r < 16; ++r) unsafeAtomicAdd(op + (size_t)crow(r, hi) * ldo, acc[r] * scale);
    }
    asm volatile("s_waitcnt lgkmcnt(0)\n\ts_barrier" ::: "memory");
}
__device__ __forceinline__ void postz_sample_row(const Frame& F, int b) {
    const int lane = F.lane, r = NTOK + b;
    const float* xr = F.in[2] + (size_t)b * D; const float* d1 = (const float*)(F.ws + WS_D1S) + (size_t)b * D; const float* zr = (const float*)(F.ws + WS_ZS) + (size_t)b * INWP;
    float* x1r = (float*)(F.ws + WS_X1F) + (size_t)r * D;
    float s = 0.f;
#pragma unroll
    for (int j = 0; j < 4; ++j) { const f32x4 v = ((const f32x4*)xr)[lane + 64 * j] + ((const f32x4*)d1)[lane + 64 * j] * 0.5f; ((f32x4*)x1r)[lane + 64 * j] = v; s += (v[0] * v[0] + v[1] * v[1]) + (v[2] * v[2] + v[3] * v[3]); }
    const float inv1 = __builtin_amdgcn_rsqf(wave_sum(s) * (1.0f / 1024.0f) + EPS);
    { const f32x4 v = ((const f32x4*)zr)[lane] * inv1; const float q = wave_sum((v[0] * v[0] + v[1] * v[1]) + (v[2] * v[2] + v[3] * v[3]));
      if (lane == 0) ((float*)(F.ws + WS_MSQ))[r] = q * (1.0f / 256.0f);
      v2u w; w.x = cvt_pk_bf16(v[0], v[1]); w.y = cvt_pk_bf16(v[2], v[3]); ((v2u*)((bf16*)(F.ws + WS_CQB) + (size_t)r * 256))[lane] = w; }
    { const float a0 = zr[256 + 2 * lane] * inv1, a1 = zr[256 + 2 * lane + 1] * inv1; const float ic = __builtin_amdgcn_rsqf(wave_sum(a0 * a0 + a1 * a1) * (1.0f / 128.0f) + EPS);
      const float o0 = a0 * ic * F.in[19][2 * lane], o1 = a1 * ic * F.in[19][2 * lane + 1];
      float* op = F.out + O_CKVS + (size_t)b * 128 + 2 * lane; op[0] = o0; op[1] = o1;
      ((unsigned*)((bf16*)(F.ws + WS_CKVB) + (size_t)r * 128))[lane] = cvt_pk_bf16(o0, o1); }
    { const float a = lane < 32 ? zr[384 + lane] * inv1 : 0.f; const float ik = __builtin_amdgcn_rsqf(wave_sum(a * a) * (1.0f / 32.0f) + EPS);
      const float w = a * ik * F.in[23][lane & 31]; const float other = __shfl_xor(w, 16);
      const float* rp = (const float*)(F.ws + WS_ROPE) + (size_t)8192 * 32; const int i = lane & 15; const float cs = rp[i], sn = rp[16 + i];
      const float o = (lane & 16) ? (other * sn + w * cs) : (w * cs - other * sn);
      if (lane < 32) { F.out[O_KRS + (size_t)b * 32 + lane] = o; ((bf16*)(F.ws + WS_KRB))[(size_t)r * 32 + lane] = (bf16)(cvt_pk_bf16(o, 0.f) & 0xffffu); } }
    { const int j = 4 * lane; const int zo = j < 128 ? 512 + j : 768 + (j - 128);
      const f32x4 ui = *(const f32x4*)(zr + zo) * inv1, gc = *(const f32x4*)(zr + zo + 128) * inv1; const f32x4 u = gc * ui;
      v2u w; w.x = cvt_pk_bf16(u[0], u[1]); w.y = cvt_pk_bf16(u[2], u[3]); ((v2u*)((bf16*)(F.ws + WS_UB) + (size_t)r * 256))[lane] = w;
      *(f32x4*)(F.out + O_CONVS + (size_t)b * 512 + 256 + j) = u;
      const f32x4 gb = *(const f32x4*)(zr + 1024 + j) * inv1; w.x = cvt_pk_bf16(gb[0], gb[1]); w.y = cvt_pk_bf16(gb[2], gb[3]); ((v2u*)((bf16*)(F.ws + WS_GBB) + (size_t)r * 256))[lane] = w;
      const int h = j >> 6, d = j & 63; const f32x4 mq = *(const f32x4*)(zr + 1280 + 128 * (d >> 5) + 32 * h + (d & 31)) * inv1;
      float q = (mq[0] * mq[0] + mq[1] * mq[1]) + (mq[2] * mq[2] + mq[3] * mq[3]);
      q += __shfl_xor(q, 1); q += __shfl_xor(q, 2); q += __shfl_xor(q, 4); q += __shfl_xor(q, 8);
      const float im = __builtin_amdgcn_rsqf(q * (1.0f / 64.0f) + EPS) * pg8::kC2M; const f32x4 g = *(const f32x4*)(F.in[28] + d); const f32x4 o = mq * im * g;
      w.x = cvt_pk_bf16(o[0], o[1]); w.y = cvt_pk_bf16(o[2], o[3]); ((v2u*)((bf16*)(F.ws + WS_MQB) + (size_t)r * 256))[lane] = w; }
}
__device__ __forceinline__ void q_sample_gemv(const Frame& F, int b) {
    const int lane = F.lane, wid = F.wave, r = NTOK + b;
    LAS float* cq = (LAS float*)F.lds;
    __syncthreads();
    { const bf16* cqr = (const bf16*)(F.ws + WS_CQB) + (size_t)r * 256; if (F.tid < 256) cq[F.tid] = bf2f(cqr[F.tid]); }
    __syncthreads();
    const bf16* W = (const bf16*)(F.ws + WS_WUQ);
    float* qs = (float*)(F.ws + WS_QS) + (size_t)b * 768;
    for (int jj = 0; jj < 2; ++jj) {
        const int j = lane + 64 * jj; if (j >= 96) break;
        const int n = 96 * wid + j;
        const bf16* wrow = W + (size_t)n * 256;
        float acc = 0.f;
#pragma unroll 8
        for (int c = 0; c < 32; ++c) { const v4u w = *(const v4u*)(wrow + 8 * c); const f32x4 c0 = *(const LAS f32x4*)(cq + 8 * c), c1 = *(const LAS f32x4*)(cq + 8 * c + 4);
            acc += (bflo(w.x) * c0[0] + bfhi(w.x) * c0[1]) + (bflo(w.y) * c0[2] + bfhi(w.y) * c0[3]) + (bflo(w.z) * c1[0] + bfhi(w.z) * c1[1]) + (bflo(w.w) * c1[2] + bfhi(w.w) * c1[3]); }
        qs[n] = acc;
    }
    __syncthreads();
}
__device__ __forceinline__ void x2_sample_row(const Frame& F, int b) {
    const int lane = F.lane, r = NTOK + b;
    const float* x1r = (const float*)(F.ws + WS_X1F) + (size_t)r * D; const float* d7 = (const float*)(F.ws + WS_D7S) + (size_t)b * D; float* x2r = (float*)(F.ws + WS_X2F) + (size_t)r * D; float* yr = F.out + O_YS + (size_t)b * D;
    float s = 0.f;
#pragma unroll
    for (int j = 0; j < 4; ++j) { const f32x4 v = ((const f32x4*)x1r)[lane + 64 * j] + ((const f32x4*)d7)[lane + 64 * j]; ((f32x4*)x2r)[lane + 64 * j] = v; ((f32x4*)yr)[lane + 64 * j] = v; s += (v[0] * v[0] + v[1] * v[1]) + (v[2] * v[2] + v[3] * v[3]); }
    s = wave_sum(s);
    if (lane == 0) ((float*)(F.ws + WS_SSQ2))[r] = s;
}
__device__ __forceinline__ void memkv_post_row(const Frame& F, int row) {
    const int lane = F.lane; const float* raw = (const float*)(F.ws + WS_MEMRAW) + (size_t)row * 512;
    const float iv = pg8::row_inv_from_parts((const float*)(F.ws + WS_SSQM), row);
    const int b_ = row >> 8, n_ = row & 255;
    { const int j = 4 * lane, h = j >> 6, d = j & 63;
      const f32x4 v = *(const f32x4*)(raw + 128 * (d >> 5) + 32 * h + (d & 31)) * iv;
      float q = (v[0] * v[0] + v[1] * v[1]) + (v[2] * v[2] + v[3] * v[3]);
      q += __shfl_xor(q, 1); q += __shfl_xor(q, 2); q += __shfl_xor(q, 4); q += __shfl_xor(q, 8);
      const f32x4 o = v * __builtin_amdgcn_rsqf(q * (1.0f / 64.0f) + EPS) * *(const f32x4*)(F.in[29] + d);
      *(f32x4*)(F.out + O_MKP + (size_t)row * 256 + j) = o;
      v2u w; w.x = cvt_pk_bf16(o[0], o[1]); w.y = cvt_pk_bf16(o[2], o[3]); *(v2u*)((bf16*)(F.ws + WS_MEMK) + ((size_t)(b_ * 4 + h) * 256 + n_) * 64 + d) = w; }
    { const int j = 4 * lane, h = j >> 6, d = j & 63;
      const f32x4 o = *(const f32x4*)(raw + 256 + j) * iv;
      *(f32x4*)(F.out + O_MVP + (size_t)row * 256 + j) = o;
      v2u w; w.x = cvt_pk_bf16(o[0], o[1]); w.y = cvt_pk_bf16(o[2], o[3]); *(v2u*)((bf16*)(F.ws + WS_MEMV) + ((size_t)(b_ * 4 + h) * 256 + n_) * 64 + d) = w; }
}
#if DBG_ORACLE
__device__ __forceinline__ void dbg_phase(const Frame& F);
__device__ __forceinline__ void dbg_report(const Frame& F, unsigned* barw);
#endif
#ifndef KD_G1
#define KD_G1 1
#endif
#ifndef KD_G2
#define KD_G2 1
#endif
#ifndef REP_X
#define REP_X 1
#endif
#ifndef ALIGN_SWIGLU
#define ALIGN_SWIGLU true
#endif
#ifndef STREAM_PROBE
#define STREAM_PROBE 0
#endif
#ifndef REP_DEC
#define REP_DEC 1
#endif
#ifndef REP_MLA
#define REP_MLA 1
#endif
#ifndef REP_GA
#define REP_GA 1
#endif
#ifndef REP_GB
#define REP_GB 1
#endif
#ifndef REP_GC
#define REP_GC 1
#endif
#define P_BF(off) ((bf16*)(F.ws + (off)))
#define P_F32(off) ((float*)(F.ws + (off)))
#define W1GU P_BF(WS_W1GU)
#define W1D P_BF(WS_W1D)
#define WIN P_BF(WS_WIN)
#define WUQ P_BF(WS_WUQ)
#define WKV P_BF(WS_WKV)
#define WO P_BF(WS_WO)
#define W2GU P_BF(WS_W2GU)
#define W2D P_BF(WS_W2D)
#define WMEM P_BF(WS_WMEM)
#define rope P_F32(WS_ROPE)
#define ssq0 P_F32(WS_SSQ0)
#define ssq1 P_F32(WS_SSQ1)
#define ssq2 P_F32(WS_SSQ2)
#define msq P_F32(WS_MSQ)
#define ssqm P_F32(WS_SSQM)
#define xb P_BF(WS_XB)
#define act1 P_BF(WS_ACT1)
#define act2 P_BF(WS_ACT2)
#define x1f P_F32(WS_X1F)
#define x1b P_BF(WS_X1B)
#define x2f P_F32(WS_X2F)
#define x2b P_BF(WS_X2B)
#define cqb P_BF(WS_CQB)
#define ckvb P_BF(WS_CKVB)
#define krb P_BF(WS_KRB)
#define ub P_BF(WS_UB)
#define gbb P_BF(WS_GBB)
#define mqb P_BF(WS_MQB)
#define qb P_BF(WS_QB)
#define Kb P_BF(WS_KB)
#define Vb P_BF(WS_VB)
#define memb P_BF(WS_MEMB)
#define memK P_BF(WS_MEMK)
#define memV P_BF(WS_MEMV)
#define oab P_BF(WS_OAB)
#define omb P_BF(WS_OMB)
#define omix P_BF(WS_OMIX)
__global__ void __launch_bounds__(NWAVES * 64, 2) mk_fwd(Args args) {
    extern __shared__ __attribute__((aligned(16))) unsigned char lds_raw[];
    Frame F;
    F.lds = (LAS unsigned char*)lds_raw;
    F.wave = __builtin_amdgcn_readfirstlane((int)threadIdx.x >> 6);
    F.G = gridDim.x; { const int bx = blockIdx.x; F.vcu = (F.G % 8 == 0) ? (bx % 8) * (F.G / 8) + bx / 8 : bx; }
#define PHASE_BEGIN() do { const CAS Args* ka_ = (const CAS Args*)__builtin_amdgcn_kernarg_segment_ptr(); asm volatile("" : "+s"(ka_)); F.in = (InTab)ka_->in; F.out = ka_->out; F.ws = ka_->ws; \
        int t_ = threadIdx.x; asm volatile("" : "+v"(t_)); F.tid = t_; F.lane = t_ & 63; } while (0)
    PHASE_BEGIN();
    for (int u = F.tid; u < (LDS_BYTES - LDSCTL_OFF) / 4; u += NWAVES * 64) ((LAS unsigned*)(F.lds + LDSCTL_OFF))[u] = 0u;
    __syncthreads();
    XcdBarrier bar = xcd_barrier_post((unsigned*)(F.ws + WS_CTL) + CW_BAR, (volatile LAS unsigned*)(F.lds + MISC_OFF) + 8);
    const int lo = args.ph_lo, hi = args.ph_hi;
#ifndef PH_MASK
#define PH_MASK 0xFFFF
#endif
#define IN(k) (((PH_MASK >> (k)) & 1) && lo <= (k) && (k) < hi)
#if TS_BUILD
#define TS_MARK(k) do { if (blockIdx.x == 0 && threadIdx.x == 0) ((unsigned long long*)(F.ws + WS_DBG))[(k)] = __builtin_amdgcn_s_memrealtime(); } while (0)
#else
#define TS_MARK(k) do {} while (0)
#endif
#define SEAM(k) do { if (IN(k) && IN((k) + 1)) xcd_barrier(bar); TS_MARK((k) + 1); } while (0)
    const int bx = (int)blockIdx.x;

#define GU1S P_F32(WS_GU1S)
#define GU2S P_F32(WS_GU2S)
#define D1S P_F32(WS_D1S)
#define D7S P_F32(WS_D7S)
#define ZS P_F32(WS_ZS)
#define QS P_F32(WS_QS)
    TS_MARK(0);
#ifndef REP_P0
#define REP_P0 1
#endif
    if (IN(0)) { PHASE_BEGIN(); for (int rep_ = 0; rep_ < REP_P0; ++rep_) p0_prologue(F); }
    SEAM(0);
    if (IN(1)) { PHASE_BEGIN();
        mini_gemm<256, ABf16, 2>(F, ABf16{xb + (size_t)NTOK * D, D}, W1GU, D, FF2, F.vcu, GU1S, FF2, 1.0f);
        { pg8::Gemm g{xb, W1GU, NTOK, FF2, D}; pg8::StaticOrder S; S.init(NTOK, FF2, F.G, bx);
          pg8::EpiSwiGLU E{ssq0, act1, FF};
#ifndef REP_G1
#define REP_G1 1
#endif
          for (int rep_ = 0; rep_ < REP_G1; ++rep_)
          pg8::gemm_phase<pg8::EpiSwiGLU, pg8::StaticOrder, ALIGN_SWIGLU, true, false, KD_G1>(F.lds, g, S, E); }
    }
    SEAM(1);
    if (IN(2)) { PHASE_BEGIN();
        mini_gemm<176>(F, ASilu{GU1S, ssq0}, W1D, FF, D, F.vcu, D1S, D, 1.0f);
        for (int rb = 0; rb < 8; ++rb)
            mini_gemm<256>(F, ABf16{memb + (size_t)rb * 128 * D, D}, WMEM, D, 512, (F.vcu + F.G - 32 * rb) % F.G, P_F32(WS_MEMRAW) + (size_t)rb * 128 * 512, 512, 1.0f);
        { pg8::Gemm g{act1, W1D, NTOK, D, FF}; pg8::StaticOrder S; S.init(NTOK, D, F.G, bx);
          pg8::EpiResid<false> E{F.in[0], nullptr, x1b, ssq1, 0.5f};
          for (int rep_ = 0; rep_ < REP_GA; ++rep_)
          pg8::gemm_phase<pg8::EpiResid<false>, pg8::StaticOrder, true, true, true, KD_G2>(F.lds, g, S, E); }
    }
    SEAM(2);
    if (IN(3)) { PHASE_BEGIN();
        if (F.G == 256) { if (F.vcu >= 192) for (int r = (F.vcu - 192) * NWAVES + F.wave; r < 1024; r += 64 * NWAVES) memkv_post_row(F, r); }
        else { const int gw = F.vcu * NWAVES + F.wave, NGW = F.G * NWAVES; for (int r = gw; r < 1024; r += NGW) memkv_post_row(F, r); }
        mini_gemm<128>(F, ASum{F.in[2], D1S, 0.5f}, WIN, D, INWP, F.vcu, ZS, INWP, 1.0f);
        { pg8::Gemm g{x1b, WIN, NTOK, INWP, D}; pg8::StaticOrder S; S.init(NTOK, INWP, F.G, bx);
          pg8::EpiZ E{ssq1, (LAS float*)(F.lds + XCH_OFF), msq, cqb, F.in[19], F.in[23], F.in[28], rope,
                      F.out + O_CKVP, F.out + O_CKVS, F.out + O_KRP, F.out + O_KRS, F.out + O_CONVP, F.out + O_CONVS, ckvb, krb, Kb, ub, gbb, mqb};
          for (int rep_ = 0; rep_ < REP_GB; ++rep_)
          pg8::gemm_phase<pg8::EpiZ, pg8::StaticOrder, true, true>(F.lds, g, S, E); }
    }
    SEAM(3);
    if (IN(4)) { PHASE_BEGIN();
        for (int rep_ = 0; rep_ < REP_X; ++rep_)
        {
            if (F.G == 256) { if (bx >= 128 && F.wave == 0) postz_sample_row(F, bx - 128); }
            else if (F.wave == 0) for (int b = F.vcu; b < NS; b += F.G) postz_sample_row(F, b); }
        { pg8::Gemm g{cqb, WUQ, NTOK, 768, 256}; pg8::StaticOrder S; S.init(NTOK, 768, F.G, bx);
          pg8::EpiQ E{msq, F.in[17], F.in[18], rope, qb};
          pg8::gemm_phase<pg8::EpiQ, pg8::StaticOrder, true, true>(F.lds, g, S, E); }
        { pg8::Gemm g{ckvb, WKV, NTOK, 1024, 128}; pg8::StaticOrder S; S.init(NTOK, 1024, F.G, bx);
          pg8::EpiKV E{F.in[22], Kb, Vb};
          pg8::gemm_phase<pg8::EpiKV, pg8::StaticOrder, true, true>(F.lds, g, S, E); }
    }
    SEAM(4);
    if (IN(5)) { PHASE_BEGIN();
        mini_gemm<128>(F, ABf16{cqb + (size_t)NTOK * 256, 256}, WUQ, 256, 768, F.vcu, QS, 768, 1.0f);
        for (int rep_ = 0; rep_ < REP_MLA; ++rep_) {
            auto mla_unit = [&](int i, int& bh, int& qblk) -> bool {
                if (F.G == 256) { if (i >= 4) return false; const int s = F.vcu & 7; bh = F.vcu >> 3; qblk = (i == 0) ? s : (i == 1) ? 15 - s : (i == 2) ? 16 + s : 31 - s; return true; }
                const int u = F.vcu + i * F.G; if (u >= 1024) return false; bh = u >> 5; qblk = u & 31; return true; };
            bf16x8 qr[6]; bool primed = false;
            for (int i = 0;; ++i) {
                int bh, qblk, nbh = 0, nqblk = 0;
                if (!mla_unit(i, bh, qblk)) break;
                const bool hn = AT_XPRE && mla_unit(i + 1, nbh, nqblk);
                const int b = bh >> 3, h = bh & 7; const size_t row0 = (size_t)b * SEQ + (size_t)qblk * 256;
                const int nb = nbh >> 3, nh = nbh & 7; const size_t nrow0 = (size_t)nb * SEQ + (size_t)nqblk * 256;
                attn_unit_simple<96, true>(qb + row0 * 768 + h * 96, 768, Kb + (size_t)bh * SEQ * 64, krb + (size_t)b * SEQ * 32, Vb + (size_t)bh * SEQ * 64, oab + row0 * 512 + h * 64, 512, 4 * (qblk + 1), F.lds,
                                           qr, primed, hn ? qb + nrow0 * 768 + nh * 96 : nullptr, Kb + (size_t)nbh * SEQ * 64, krb + (size_t)nb * SEQ * 32, Vb + (size_t)nbh * SEQ * 64, 4 * (nqblk + 1));
                primed = hn;
            }
        }
        for (int rep_ = 0; rep_ < REP_X; ++rep_) {
            bf16x8 qr[4]; bool primed = false;
            for (int u = F.vcu; u < 512; u += F.G) {
                const int b = u >> 7, h = (u >> 5) & 3, qblk = u & 31; const size_t row0 = (size_t)b * SEQ + (size_t)qblk * 256;
                const int nu = u + F.G; const bool hn = AT_XPRE && nu < 512;
                const int nb = nu >> 7, nh = (nu >> 5) & 3, nqblk = nu & 31; const size_t nrow0 = (size_t)nb * SEQ + (size_t)nqblk * 256;
                attn_unit_simple<64, false>(mqb + row0 * 256 + h * 64, 256, memK + (size_t)(b * 4 + h) * 256 * 64, nullptr, memV + (size_t)(b * 4 + h) * 256 * 64, omb + row0 * 256 + h * 64, 256, 4, F.lds,
                                            qr, primed, hn ? mqb + nrow0 * 256 + nh * 64 : nullptr, memK + (size_t)(nb * 4 + nh) * 256 * 64, nullptr, memV + (size_t)(nb * 4 + nh) * 256 * 64, 4);
                primed = hn;
            }
        }
        __syncthreads();
    }
    SEAM(5);
    if (IN(6)) { PHASE_BEGIN();
        for (int rep_ = 0; rep_ < REP_DEC; ++rep_)
        for (int it = F.vcu; it < 2 * NS; it += F.G) decode_item(F, it >> 1, it & 1);
#if STREAM_PROBE
        {
          f32x4 accp = (f32x4){0.f, 0.f, 0.f, 0.f};
          for (int it = F.vcu; it < 2 * NS; it += F.G) { const int b = it >> 1, half = it & 1; const int* ptab = (const int*)F.in[5] + b * NPAGES + half * 64;
              for (int pg = 0; pg < 64; ++pg) { const int page = __builtin_amdgcn_readfirstlane(ptab[pg]); const float* ck = F.in[3] + (size_t)page * (PAGE * 128); const float* kr = F.in[4] + (size_t)page * (PAGE * 32);
#pragma unroll
                  for (int j = 0; j < 8; ++j) accp = accp + *(const f32x4*)((const char*)(ck + 2048 * j) + (unsigned)F.tid * 16u);
#pragma unroll
                  for (int j = 0; j < 2; ++j) accp = accp + *(const f32x4*)((const char*)(kr + 2048 * j) + (unsigned)F.tid * 16u); } }
          ((f32x4*)(F.ws + WS_DBG))[F.vcu * 512 + F.tid] = accp; }
#endif
        __syncthreads();
        for (int rep_ = 0; rep_ < REP_X; ++rep_) tp_phase(F);
    }
    SEAM(6);
    if (IN(7)) { PHASE_BEGIN();
        for (int rep_ = 0; rep_ < REP_X; ++rep_)
        if (F.G == 256) tp_sample_wg(F, F.vcu & 127, F.vcu < 128 ? 1 : 2);
        else for (int b = F.vcu; b < NS; b += F.G) tp_sample_wg(F, b);
        __syncthreads();
        { pg8::Gemm g{omix, WO, NTOK, D, D}; pg8::StaticOrder S; S.init(NTOK, D, F.G, (bx + 128) % F.G);
          pg8::EpiResid<true> E{x1b, nullptr, x2b, ssq2, 1.0f};
          for (int rep_ = 0; rep_ < REP_GC; ++rep_)
          pg8::gemm_phase<pg8::EpiResid<true>, pg8::StaticOrder, true, true>(F.lds, g, S, E); }
    }
    SEAM(7);
    if (IN(8)) { PHASE_BEGIN();
        mini_gemm<128>(F, ABf16{omix + (size_t)NTOK * D, D}, WO, D, D, F.vcu, D7S, D, 1.0f);
        { pg8::Gemm g{x2b, W2GU, NTOK, FF2, D}; pg8::StaticOrder S; S.init(NTOK, FF2, F.G, bx);
          pg8::EpiSwiGLU E{ssq2, act2, FF};
          pg8::gemm_phase<pg8::EpiSwiGLU, pg8::StaticOrder, ALIGN_SWIGLU, true>(F.lds, g, S, E); }
    }
    SEAM(8);
    if (IN(9)) { PHASE_BEGIN();
        if (F.G == 256) { if (F.vcu >= 176 && F.wave < 2) { const int b = (F.vcu - 176) * 2 + F.wave; if (b < NS) x2_sample_row(F, b); } }
        else if (F.wave == 0) for (int b = F.vcu; b < NS; b += F.G) x2_sample_row(F, b);
        mini_gemm<256, ASum, 2>(F, ASum{x1f + (size_t)NTOK * D, D7S, 1.0f}, W2GU, D, FF2, F.vcu, GU2S, FF2, 1.0f);
        { pg8::Gemm g{act2, W2D, NTOK, D, FF}; pg8::StaticOrder S; S.init(NTOK, D, F.G, bx);
          pg8::EpiResid<true, true> E{x2b, F.out + O_Y, nullptr, nullptr, 0.5f};
          pg8::gemm_phase<pg8::EpiResid<true, true>, pg8::StaticOrder, true, true, true>(F.lds, g, S, E); }
    }
    SEAM(9);
    if (IN(10)) { PHASE_BEGIN();
        mini_gemm<176>(F, ASilu{GU2S, ssq2}, W2D, FF, D, F.vcu, F.out + O_YS, D, 0.5f);
    }
#if TS_BUILD
    { xcd_barrier(bar); PHASE_BEGIN();
      if (blockIdx.x == 0 && F.tid == 0) { const unsigned long long* ts = (const unsigned long long*)(F.ws + WS_DBG); const unsigned long long tend = __builtin_amdgcn_s_memrealtime();
        const float dA = (float)((TS_A == 10 ? tend : ts[TS_A + 1]) - ts[TS_A]) * 0.01f, dB = (float)((TS_B == 10 ? tend : ts[TS_B + 1]) - ts[TS_B]) * 0.01f;
        { const float x = dA * 0.01f; const int e = (int)x; float p10 = 1000.f; for (int i = 0; i < e; ++i) p10 *= 10.f; F.out[0] = (1.0f + 9.0f * (x - (float)e)) * p10; }
        (void)dB;
      } }
#endif
#if DBG_ORACLE
    if (IN(10)) { xcd_barrier(bar); PHASE_BEGIN(); dbg_phase(F); xcd_barrier(bar); PHASE_BEGIN(); dbg_report(F, (unsigned*)(F.ws + WS_CTL) + CW_BAR); }
#endif
#undef IN
#undef SEAM
#undef PHASE_BEGIN
}
#undef W1GU
#undef W1D
#undef WIN
#undef WUQ
#undef WKV
#undef WO
#undef W2GU
#undef W2D
#undef WMEM
#undef rope
#undef ssq0
#undef ssq1
#undef ssq2
#undef msq
#undef ssqm
#undef xb
#undef act1
#undef act2
#undef x1f
#undef x1b
#undef x2f
#undef x2b
#undef cqb
#undef ckvb
#undef krb
#undef ub
#undef gbb
#undef mqb
#undef qb
#undef Kb
#undef Vb
#undef memb
#undef memK
#undef memV
#undef oab
#undef omb
#undef omix
#undef P_BF
#undef P_F32

extern "C" void kernel_launch(void* const* d_in, const int* in_sizes, int n_in, void* d_out, int out_size, void* d_ws, size_t ws_size, hipStream_t stream) {
    static int grid = 0;
    if (grid == 0) {
        if (n_in != 38 || (size_t)out_size != O_TOTAL || ws_size < WS_END) { fprintf(stderr, "kernel_launch: unexpected shapes (n_in %d, out %d, ws %zu)\n", n_in, out_size, ws_size); grid = -1; return; }
        int dev = 0, cus = 0, per_cu = 0;
        if (hipGetDevice(&dev) != hipSuccess || hipDeviceGetAttribute(&cus, hipDeviceAttributeMultiprocessorCount, dev) != hipSuccess) { grid = -1; return; }
        if (hipFuncSetAttribute((const void*)mk_fwd, hipFuncAttributeMaxDynamicSharedMemorySize, LDS_BYTES) != hipSuccess) { fprintf(stderr, "kernel_launch: hipFuncSetAttribute failed\n"); grid = -1; return; }
        if (hipOccupancyMaxActiveBlocksPerMultiprocessor(&per_cu, (const void*)mk_fwd, NWAVES * 64, LDS_BYTES) != hipSuccess || per_cu < 1) { fprintf(stderr, "kernel_launch: occupancy query says %d\n", per_cu); }
        (void)hipGetLastError();
        grid = cus;
    }
    if (grid < 0) return;
    (void)hipMemsetAsync((char*)d_ws + WS_CTL, 0, CTL_ZERO_BYTES, stream);
#if DBG_ORACLE
    (void)hipMemsetAsync((char*)d_ws + WS_DBG, 0, 1 * MiB, stream);
#endif
    Args a{};
    for (int i = 0; i < 38; ++i) a.in[i] = (const float*)d_in[i];
    a.out = (float*)d_out; a.ws = (unsigned char*)d_ws;
    a.ph_lo = 0; a.ph_hi = 11;
    hipLaunchKernelGGL(mk_fwd, dim3(grid), dim3(NWAVES * 64), LDS_BYTES, stream, a);
}
```

```cpp
#include <hip/hip_runtime.h>
#include <cstdint>
#include <cstdio>
#include <cmath>
#define DBG_ORACLE 0
#define DBG_TOL 0.03f
#define AT_ROLL 1
#define NT_ACT 1
#define NT_Y 1
#define AT_XPRE 1
#ifndef PROBE_MFMA2
#define PROBE_MFMA2 0
#endif
#ifndef PROBE_VALU2
#define PROBE_VALU2 0
#endif
#ifndef PROBE_DUP
#define PROBE_DUP 1
#endif
#ifndef DEC_FLIP
#define DEC_FLIP 0
#endif
#ifndef DEC_SKEW
#define DEC_SKEW 0
#endif
#ifndef AT_ROLL
#define AT_ROLL 0
#endif
#ifndef AT_VPRE
#define AT_VPRE 0
#endif
#ifndef AT_VPIPE
#define AT_VPIPE 0
#endif
#ifndef PG8_AMID
#define PG8_AMID 0
#endif
#ifndef NT_ACT
#define NT_ACT 0
#endif
#ifndef NT_OUT
#define NT_OUT 0
#endif
#ifndef NT_Y
#define NT_Y 0
#endif
#ifndef NT_OB
#define NT_OB 0
#endif
#ifndef DEC_NT
#define DEC_NT 0
#endif
#ifndef NT_O
#define NT_O 0
#endif
#ifndef AT_DMAMID
#define AT_DMAMID 0
#endif
#ifndef AT_XPRE
#define AT_XPRE 0
#endif
#ifndef WT_OUT
#define WT_OUT 0
#endif
#ifndef WT_OB
#define WT_OB 0
#endif
#ifndef WT_O
#define WT_O 0
#endif
#ifndef WT_TP
#define WT_TP 0
#endif
#ifndef P0_PIPE
#define P0_PIPE 0
#endif
#ifndef AT_FLIP
#define AT_FLIP 0
#endif
#ifndef DEC_PRIO
#define DEC_PRIO 0
#endif
#ifndef MLA_PRIO
#define MLA_PRIO 0
#endif
#ifndef TS_BUILD
#define TS_BUILD 0
#endif
namespace pg8 {
#define PG8_LAS __attribute__((address_space(3)))
typedef unsigned short bf16_t;
typedef short bf16x8 __attribute__((ext_vector_type(8)));
typedef float f32x4 __attribute__((ext_vector_type(4)));
typedef unsigned u32x4 __attribute__((ext_vector_type(4)));
constexpr int BM = 256, BK = 64, HALF = 128, HTB = HALF * BK * 2  , STAGE_BYTES = 8 * HTB, NXCD = 8, WGM = 8;

__host__ __device__ __forceinline__ int lds_byte(int r, int c) { const int st = (r >> 4) * 2 + (c >> 5), rr = r & 15, cc = c & 31, ob = rr * 64 + cc * 2; return st * 1024 + (ob ^ (((ob >> 9) & 1) << 5)); }
__host__ __device__ __forceinline__ void stage_rc(int b, int& R, int& C) { const int st = b / 1024, sb = b % 1024, swz = sb ^ (((sb >> 9) & 1) << 5); R = (st >> 1) * 16 + swz / 64; C = (st & 1) * 32 + (swz % 64) / 2; }
__host__ __device__ __forceinline__ int perm32(int rho) { const int n = rho >> 4, i = rho & 15; return 8 * (i >> 2) + 4 * n + (i & 3); }

struct Unit { int pm, pn; };
struct Gemm { const bf16_t* A; const bf16_t* Bt; int M, N, K; };

struct StaticOrder {
    int nM, nN, nwg, G, c;
    __host__ __device__ void init(int M, int N, int G_, int c_) { nM = M / BM; nN = N / BM; nwg = nM * nN; G = G_; c = c_; }
    __host__ __device__ bool next(int i, Unit& u) const {
        const long L = (long)i * G + c; if (L >= nwg) return false;
        int wgid = (int)L; { const int q = nwg / NXCD, r = nwg % NXCD, xcd = wgid % NXCD, off = wgid / NXCD; wgid = (xcd < r ? xcd * (q + 1) : r * (q + 1) + (xcd - r) * q) + off; }
        const int nig = WGM * nN, gid = wgid / nig, fm = gid * WGM, gsz = (nM - fm) < WGM ? (nM - fm) : WGM;
        u.pm = fm + ((wgid % nig) % gsz); u.pn = (wgid % nig) / gsz; return true;
    }
    __device__ __forceinline__ void a_ready(const Unit&) const {}
    __device__ __forceinline__ void done(const Unit&) const {}
};

__device__ __forceinline__ unsigned cvt_pk_bf16(float lo, float hi) { typedef float f2_ __attribute__((ext_vector_type(2))); typedef __bf16 b2_ __attribute__((ext_vector_type(2))); const f2_ v = {lo, hi}; const b2_ b = __builtin_convertvector(v, b2_); return __builtin_bit_cast(unsigned, b); }
typedef float f32x2 __attribute__((ext_vector_type(2)));
constexpr int kNTOK = 32768, kMR = 32896, kSEQ = 8192;
constexpr float kEPS = 1e-6f;
constexpr float kLOG2E = 1.4426950408889634f;
constexpr float kC2Q = 0.10206207261596577f * 1.4426950408889634f;
constexpr float kC2M = 0.125f * 1.4426950408889634f;
typedef unsigned u32x2 __attribute__((ext_vector_type(2)));
__device__ __forceinline__ void st_wt(u32x4* p, u32x4 v) { asm volatile("global_store_dwordx4 %0, %1, off sc0 sc1\n\ts_nop 0" :: "v"(p), "v"(v) : "memory"); }
__device__ __forceinline__ void st_wt(f32x4* p, f32x4 v) { asm volatile("global_store_dwordx4 %0, %1, off sc0 sc1\n\ts_nop 0" :: "v"(p), "v"(v) : "memory"); }
__device__ __forceinline__ void st_wt(u32x2* p, u32x2 v) { asm volatile("global_store_dwordx2 %0, %1, off sc0 sc1\n\ts_nop 0" :: "v"(p), "v"(v) : "memory"); }
#if WT_OUT
#define EPI_ST(T_, ptr_, val_) st_wt((T_*)(ptr_), (val_))
#elif NT_OUT
#define EPI_ST(T_, ptr_, val_) __builtin_nontemporal_store((val_), (T_*)(ptr_))
#else
#define EPI_ST(T_, ptr_, val_) (*(T_*)(ptr_) = (val_))
#endif
#if WT_OB
#define EPI_STOB(T_, ptr_, val_) st_wt((T_*)(ptr_), (val_))
#elif NT_OB
#define EPI_STOB(T_, ptr_, val_) __builtin_nontemporal_store((val_), (T_*)(ptr_))
#else
#define EPI_STOB(T_, ptr_, val_) (*(T_*)(ptr_) = (val_))
#endif
#if NT_Y
#define EPI_STY(T_, ptr_, val_) __builtin_nontemporal_store((val_), (T_*)(ptr_))
#else
#define EPI_STY(T_, ptr_, val_) (*(T_*)(ptr_) = (val_))
#endif
__device__ __forceinline__ int fresh_lane() { int l; asm volatile("v_mbcnt_lo_u32_b32 %0, -1, 0\n\tv_mbcnt_hi_u32_b32 %0, -1, %0" : "=v"(l)); return l; }

__device__ __forceinline__ float sum_fq(float s) {
    { auto t = __builtin_amdgcn_permlane16_swap(__float_as_uint(s), __float_as_uint(s), false, false); s = __uint_as_float(t[0]) + __uint_as_float(t[1]); }
    { auto t = __builtin_amdgcn_permlane32_swap(__float_as_uint(s), __float_as_uint(s), false, false); s = __uint_as_float(t[0]) + __uint_as_float(t[1]); }
    return s;
}
__device__ __forceinline__ float row_inv_from_parts(const float* ssq, int row) {
    return __builtin_amdgcn_rsqf(ssq[row] * (1.0f / 1024.0f) + kEPS);
}
__device__ __forceinline__ float silu_mul(float g, float u) {
    const float e = __builtin_amdgcn_exp2f(-g * kLOG2E);
    return g * __builtin_amdgcn_rcpf(1.0f + e) * u;
}

struct EpiSwiGLU {
    static constexpr bool PERM = true, AFTER_DRAIN = false;
    const float* ssq; bf16_t* act; int ldact;
    __device__ __forceinline__ void operator()(const f32x4 (&acc)[2][2][4][2], const Unit& u, int wr, int wc, int fr_, int fq_) const {
        const int ln_ = fresh_lane(), fr = ln_ & 15, fq = ln_ >> 4; (void)fr_; (void)fq_;
        const int rr0 = wr * 64 + fr;
        const float* sp = ssq + (size_t)(u.pm * BM + rr0);
        bf16_t* ap = act + ((size_t)(u.pm * (ldact >> 6) + u.pn * 2 + (wc >> 1)) * BM + rr0) * BK + (wc & 1) * 32 + 8 * fq;
        f32x4 ones = (f32x4){1.0f, 1.0f, 1.0f, 1.0f}; asm volatile("" : "+v"(ones));
        float ss[2][4];
#pragma unroll
        for (int ai = 0; ai < 2; ++ai)
#pragma unroll
            for (int m = 0; m < 4; ++m) ss[ai][m] = sp[ai * HALF + m * 16];
        asm volatile("" : "+v"(ss[0][0]), "+v"(ss[0][1]), "+v"(ss[0][2]), "+v"(ss[0][3]), "+v"(ss[1][0]), "+v"(ss[1][1]), "+v"(ss[1][2]), "+v"(ss[1][3]));
#pragma unroll
        for (int ai = 0; ai < 2; ++ai)
#pragma unroll
            for (int m = 0; m < 4; ++m) {
                const float inv = __builtin_amdgcn_rsqf(ss[ai][m] * (1.0f / 1024.0f) + kEPS);
                const float a = inv * -kLOG2E, b = inv * inv;
                const f32x4 g0 = acc[ai][0][m][0], g1 = acc[ai][0][m][1];
                const f32x4 t0 = g0 * a, t1 = g1 * a;
                f32x4 e0, e1;
#pragma unroll
                for (int i = 0; i < 4; ++i) { e0[i] = __builtin_amdgcn_exp2f(t0[i]); e1[i] = __builtin_amdgcn_exp2f(t1[i]); }
                const f32x4 d0 = e0 + ones, d1 = e1 + ones;
                f32x4 r0, r1;
#pragma unroll
                for (int i = 0; i < 4; ++i) { r0[i] = __builtin_amdgcn_rcpf(d0[i]); r1[i] = __builtin_amdgcn_rcpf(d1[i]); }
                const f32x4 o0 = (g0 * acc[ai][1][m][0]) * r0 * b, o1 = (g1 * acc[ai][1][m][1]) * r1 * b;
                u32x4 w;
                w.x = cvt_pk_bf16(o0[0], o0[1]); w.y = cvt_pk_bf16(o0[2], o0[3]); w.z = cvt_pk_bf16(o1[0], o1[1]); w.w = cvt_pk_bf16(o1[2], o1[3]);
#if NT_ACT
                __builtin_nontemporal_store(w, (u32x4*)(ap + (ai * HALF + m * 16) * BK));
#else
                *(u32x4*)(ap + (ai * HALF + m * 16) * BK) = w;
#endif
                if (m & 1) asm volatile("" ::: "memory");
            }
    }
};

template <bool BASE_BF16, bool FINAL = false>
struct EpiResid {
    static constexpr bool PERM = true, AFTER_DRAIN = false;
    const void* base0; float* out0; bf16_t* ob; float* ssq_out; float scale;
    __device__ __forceinline__ void operator()(const f32x4 (&acc)[2][2][4][2], const Unit& u, int wr, int wc, int fr_, int fq_) const {
        const int ln_ = fresh_lane(), fr = ln_ & 15, fq = ln_ >> 4; (void)fr_; (void)fq_;
        u32x4 raw[2][4][2];
        if (BASE_BF16) {
#pragma unroll
            for (int ai = 0; ai < 2; ++ai)
#pragma unroll
                for (int m = 0; m < 4; ++m)
#pragma unroll
                    for (int bj = 0; bj < 2; ++bj)
                        raw[ai][m][bj] = *(const u32x4*)((const bf16_t*)base0 + (size_t)(u.pm * BM + ai * HALF + wr * 64 + m * 16 + fr) * 1024 + u.pn * BM + bj * HALF + wc * 32 + 8 * fq);
        }
#pragma unroll
        for (int ai = 0; ai < 2; ++ai) {
            f32x4 bv[BASE_BF16 ? 1 : 4][2][2];
            if (!BASE_BF16) {
#pragma unroll
                for (int m = 0; m < 4; ++m) {
                    const int row = u.pm * BM + ai * HALF + wr * 64 + m * 16 + fr;
#pragma unroll
                    for (int bj = 0; bj < 2; ++bj) { const int col = u.pn * BM + bj * HALF + wc * 32 + 8 * fq;
                        const float* bp = (const float*)base0 + (size_t)row * 1024 + col; bv[m][bj][0] = *(const f32x4*)bp; bv[m][bj][1] = *(const f32x4*)(bp + 4); }
                }
            }
#pragma unroll
            for (int m = 0; m < 4; ++m) {
                const int row = u.pm * BM + ai * HALF + wr * 64 + m * 16 + fr;
                float s = 0.f;
#pragma unroll
                for (int bj = 0; bj < 2; ++bj) {
                    const int col = u.pn * BM + bj * HALF + wc * 32 + 8 * fq;
                    f32x4 b0, b1;
                    if (BASE_BF16) { const u32x4 w = raw[ai][m][bj];
                        b0 = (f32x4){__uint_as_float(w.x << 16), __uint_as_float(w.x & 0xffff0000u), __uint_as_float(w.y << 16), __uint_as_float(w.y & 0xffff0000u)};
                        b1 = (f32x4){__uint_as_float(w.z << 16), __uint_as_float(w.z & 0xffff0000u), __uint_as_float(w.w << 16), __uint_as_float(w.w & 0xffff0000u)}; }
                    else { b0 = bv[BASE_BF16 ? 0 : m][bj][0]; b1 = bv[BASE_BF16 ? 0 : m][bj][1]; }
                    const f32x4 v0 = b0 + acc[ai][bj][m][0] * scale, v1 = b1 + acc[ai][bj][m][1] * scale;
                    if (!FINAL) s += (v0[0] * v0[0] + v0[1] * v0[1]) + (v0[2] * v0[2] + v0[3] * v0[3]) + (v1[0] * v1[0] + v1[1] * v1[1]) + (v1[2] * v1[2] + v1[3] * v1[3]);
                    if (FINAL) { float* op = out0 + (size_t)row * 1024 + col; EPI_STY(f32x4, op, v0); EPI_STY(f32x4, op + 4, v1); }
                    if (!FINAL) { u32x4 w; w.x = cvt_pk_bf16(v0[0], v0[1]); w.y = cvt_pk_bf16(v0[2], v0[3]); w.z = cvt_pk_bf16(v1[0], v1[1]); w.w = cvt_pk_bf16(v1[2], v1[3]);
                        EPI_STOB(u32x4, ob + (size_t)row * 1024 + col, w); }
                }
                if (!FINAL) { s = sum_fq(s);
                if (fq == 0) unsafeAtomicAdd(ssq_out + row, s); }
            }
            asm volatile("" ::: "memory");
        }
    }
};

struct EpiZ {
    static constexpr bool PERM = false, AFTER_DRAIN = false;
    const float* ssq1;
    PG8_LAS float* xch;
    float* msq;
    bf16_t* cqb;
    const float* g_kv; const float* g_kr; const float* g_mq;
    const float* rope;
    float* ckv_p; float* ckv_s; float* kr_p; float* kr_s; float* conv_p; float* conv_s;
    bf16_t* ckvb; bf16_t* krb; bf16_t* Kb; bf16_t* ub; bf16_t* gbb; bf16_t* mqb;
    __device__ __forceinline__ void operator()(const f32x4 (&acc)[2][2][4][2], const Unit& u, int wr, int wc, int fr_, int fq_) const {
        const int ln_ = fresh_lane(), fr = ln_ & 15, fq = ln_ >> 4; (void)fr_; (void)fq_;
        const int pn = u.pn;
        float inv1[2][4]; int rows[2][4];
#pragma unroll
        for (int ai = 0; ai < 2; ++ai)
#pragma unroll
            for (int m = 0; m < 4; ++m) { rows[ai][m] = u.pm * BM + ai * HALF + wr * 64 + m * 16 + fr; inv1[ai][m] = row_inv_from_parts(ssq1, rows[ai][m]); }
        if (pn == 0 || pn == 1) {
#pragma unroll
            for (int ai = 0; ai < 2; ++ai)
#pragma unroll
                for (int m = 0; m < 4; ++m) {
                    float s = 0.f; const float iv = inv1[ai][m];
#pragma unroll
                    for (int bj = 0; bj < 2; ++bj) { if (pn == 1 && bj == 1) continue;
#pragma unroll
                        for (int n = 0; n < 2; ++n) { const f32x4 v = acc[ai][bj][m][n] * iv; s += (v[0] * v[0] + v[1] * v[1]) + (v[2] * v[2] + v[3] * v[3]); } }
                    s += __shfl_xor(s, 16); s += __shfl_xor(s, 32);
                    if (fq == 0) xch[(ai * HALF + wr * 64 + m * 16 + fr) * 4 + wc] = s;
                }
            asm volatile("s_waitcnt lgkmcnt(0)" ::: "memory"); __builtin_amdgcn_s_barrier(); asm volatile("" ::: "memory");
        }
        if (pn == 0) {
#pragma unroll
            for (int ai = 0; ai < 2; ++ai)
#pragma unroll
                for (int m = 0; m < 4; ++m) {
                    const int row = rows[ai][m]; const float iv = inv1[ai][m];
                    const f32x4 t = *(const PG8_LAS f32x4*)(xch + (ai * HALF + wr * 64 + m * 16 + fr) * 4);
                    if (wc == 0 && fq == 0 && row < kMR) msq[row] = ((t[0] + t[1]) + (t[2] + t[3])) * (1.0f / 256.0f);
                    if (row < kMR) {
#pragma unroll
                        for (int bj = 0; bj < 2; ++bj)
#pragma unroll
                            for (int n = 0; n < 2; ++n) { const f32x4 v = acc[ai][bj][m][n] * iv; u32x2 w; w.x = cvt_pk_bf16(v[0], v[1]); w.y = cvt_pk_bf16(v[2], v[3]);
                                EPI_ST(u32x2, cqb + (size_t)row * 256 + bj * HALF + wc * 32 + n * 16 + 4 * fq, w); }
                    }
                }
        } else if (pn == 1) {
            f32x4 gkv[2];
#pragma unroll
            for (int n = 0; n < 2; ++n) gkv[n] = *(const f32x4*)(g_kv + wc * 32 + n * 16 + 4 * fq);
            const f32x4 ga = *(const f32x4*)(g_kr + 4 * fq), gb = *(const f32x4*)(g_kr + 16 + 4 * fq);
#pragma unroll
            for (int ai = 0; ai < 2; ++ai) {
#pragma unroll
              for (int mh = 0; mh < 2; ++mh) {
                f32x4 cs[2], sn[2];
                if (wc == 0) {
#pragma unroll
                    for (int mm = 0; mm < 2; ++mm) { const int pos = rows[ai][2 * mh + mm] & (kSEQ - 1); cs[mm] = *(const f32x4*)(rope + (size_t)pos * 32 + 4 * fq); sn[mm] = *(const f32x4*)(rope + (size_t)pos * 32 + 16 + 4 * fq); }
                }
#pragma unroll
                for (int mm = 0; mm < 2; ++mm) { const int m = 2 * mh + mm;
                    const int row = rows[ai][m]; const float iv = inv1[ai][m];
                    const f32x4 t = *(const PG8_LAS f32x4*)(xch + (ai * HALF + wr * 64 + m * 16 + fr) * 4);
                    const float ic = __builtin_amdgcn_rsqf(((t[0] + t[1]) + (t[2] + t[3])) * (1.0f / 128.0f) + kEPS);
#pragma unroll
                    for (int n = 0; n < 2; ++n) {
                        const int c = wc * 32 + n * 16 + 4 * fq;
                        const f32x4 v = acc[ai][0][m][n] * (iv * ic) * gkv[n];
                        EPI_ST(f32x4, ckv_p + (size_t)row * 128 + c, v);
                        u32x2 w; w.x = cvt_pk_bf16(v[0], v[1]); w.y = cvt_pk_bf16(v[2], v[3]);
                        EPI_ST(u32x2, ckvb + (size_t)row * 128 + c, w);
                    }
                    if (wc == 0) {
                        const f32x4 a = acc[ai][1][m][0] * iv, b = acc[ai][1][m][1] * iv;
                        float s = (a[0] * a[0] + a[1] * a[1]) + (a[2] * a[2] + a[3] * a[3]) + (b[0] * b[0] + b[1] * b[1]) + (b[2] * b[2] + b[3] * b[3]);
                        s += __shfl_xor(s, 16); s += __shfl_xor(s, 32);
                        const float ik = __builtin_amdgcn_rsqf(s * (1.0f / 32.0f) + kEPS);
                        const f32x4 x1 = a * ik * ga, x2 = b * ik * gb;
                        const f32x4 o1 = x1 * cs[mm] - x2 * sn[mm], o2 = x1 * sn[mm] + x2 * cs[mm];
                        float* kro = kr_p + (size_t)row * 32;
                        *(f32x4*)(kro + 4 * fq) = o1; *(f32x4*)(kro + 16 + 4 * fq) = o2;
                        u32x2 w1, w2; w1.x = cvt_pk_bf16(o1[0], o1[1]); w1.y = cvt_pk_bf16(o1[2], o1[3]); w2.x = cvt_pk_bf16(o2[0], o2[1]); w2.y = cvt_pk_bf16(o2[2], o2[3]);
                        *(u32x2*)(krb + (size_t)row * 32 + 4 * fq) = w1; *(u32x2*)(krb + (size_t)row * 32 + 16 + 4 * fq) = w2;
                    }
                }
                asm volatile("" ::: "memory");
              }
            }
        } else if (pn == 2 || pn == 3) {
#pragma unroll
            for (int ai = 0; ai < 2; ++ai)
#pragma unroll
                for (int m = 0; m < 4; ++m) {
                    const int row = rows[ai][m]; const float iv = inv1[ai][m];
                    if (row >= kMR) continue;
                    const bool smp = row >= kNTOK; const int t_ = row & (kSEQ - 1), b_ = row >> 13;
#pragma unroll
                    for (int n = 0; n < 2; ++n) {
                        const int c = (pn - 2) * 128 + wc * 32 + n * 16 + 4 * fq;
                        const f32x4 v = (acc[ai][0][m][n] * iv) * (acc[ai][1][m][n] * iv);
                        u32x2 w; w.x = cvt_pk_bf16(v[0], v[1]); w.y = cvt_pk_bf16(v[2], v[3]);
                        EPI_ST(u32x2, ub + (size_t)row * 256 + c, w);
                        if (smp) *(f32x4*)(conv_s + (size_t)(row - kNTOK) * 512 + 256 + c) = v;
                        else if (t_ >= kSEQ - 2) *(f32x4*)(conv_p + (size_t)(b_ * 2 + (t_ - (kSEQ - 2))) * 256 + c) = v;
                    }
                }
        } else if (pn == 4) {
#pragma unroll
            for (int ai = 0; ai < 2; ++ai)
#pragma unroll
                for (int m = 0; m < 4; ++m) {
                    const int row = rows[ai][m]; const float iv = inv1[ai][m];
                    if (row >= kMR) continue;
#pragma unroll
                    for (int bj = 0; bj < 2; ++bj)
#pragma unroll
                        for (int n = 0; n < 2; ++n) { const f32x4 v = acc[ai][bj][m][n] * iv; u32x2 w; w.x = cvt_pk_bf16(v[0], v[1]); w.y = cvt_pk_bf16(v[2], v[3]);
                            EPI_ST(u32x2, gbb + (size_t)row * 256 + bj * HALF + wc * 32 + n * 16 + 4 * fq, w); }
                }
        } else {
            f32x4 gmq[2][2];
#pragma unroll
            for (int bj = 0; bj < 2; ++bj)
#pragma unroll
                for (int n = 0; n < 2; ++n) gmq[bj][n] = *(const f32x4*)(g_mq + bj * 32 + n * 16 + 4 * fq);
#pragma unroll
            for (int ai = 0; ai < 2; ++ai)
#pragma unroll
                for (int m = 0; m < 4; ++m) {
                    const int row = rows[ai][m]; const float iv = inv1[ai][m];
                    float s = 0.f;
#pragma unroll
                    for (int bj = 0; bj < 2; ++bj)
#pragma unroll
                        for (int n = 0; n < 2; ++n) { const f32x4 v = acc[ai][bj][m][n] * iv; s += (v[0] * v[0] + v[1] * v[1]) + (v[2] * v[2] + v[3] * v[3]); }
                    s += __shfl_xor(s, 16); s += __shfl_xor(s, 32);
                    const float im = __builtin_amdgcn_rsqf(s * (1.0f / 64.0f) + kEPS) * kC2M;
                    if (row >= kMR) continue;
#pragma unroll
                    for (int bj = 0; bj < 2; ++bj)
#pragma unroll
                        for (int n = 0; n < 2; ++n) { const int d = bj * 32 + n * 16 + 4 * fq;
                            const f32x4 v = acc[ai][bj][m][n] * (iv * im) * gmq[bj][n]; u32x2 w; w.x = cvt_pk_bf16(v[0], v[1]); w.y = cvt_pk_bf16(v[2], v[3]);
                            EPI_ST(u32x2, mqb + (size_t)row * 256 + wc * 64 + d, w); }
                }
        }
    }
};

struct EpiQ {
    static constexpr bool PERM = false, AFTER_DRAIN = false;
    const float* msq; const float* g_qn; const float* g_qr; const float* rope; bf16_t* qb;
    __device__ __forceinline__ void operator()(const f32x4 (&acc)[2][2][4][2], const Unit& u, int wr, int wc, int fr_, int fq_) const {
        const int ln_ = fresh_lane(), fr = ln_ & 15, fq = ln_ >> 4; (void)fr_; (void)fq_;
        const int pn = u.pn;
        float epsq[2][4];
#pragma unroll
        for (int ai = 0; ai < 2; ++ai)
#pragma unroll
            for (int m = 0; m < 4; ++m) epsq[ai][m] = kEPS * (msq[u.pm * BM + ai * HALF + wr * 64 + m * 16 + fr] + kEPS);
        if (pn < 2) {
            const int head = 4 * pn + wc;
            f32x4 g[2][2];
#pragma unroll
            for (int bj = 0; bj < 2; ++bj)
#pragma unroll
                for (int n = 0; n < 2; ++n) g[bj][n] = *(const f32x4*)(g_qn + bj * 32 + n * 16 + 4 * fq);
#pragma unroll
            for (int ai = 0; ai < 2; ++ai) {
#pragma unroll
                for (int m = 0; m < 4; ++m) {
                    const int row = u.pm * BM + ai * HALF + wr * 64 + m * 16 + fr; float s = 0.f;
#pragma unroll
                    for (int bj = 0; bj < 2; ++bj)
#pragma unroll
                        for (int n = 0; n < 2; ++n) { const f32x4 v = acc[ai][bj][m][n]; s += (v[0] * v[0] + v[1] * v[1]) + (v[2] * v[2] + v[3] * v[3]); }
                    s += __shfl_xor(s, 16); s += __shfl_xor(s, 32);
                    const float rs = __builtin_amdgcn_rsqf(s * (1.0f / 64.0f) + epsq[ai][m]) * kC2Q;
#pragma unroll
                    for (int bj = 0; bj < 2; ++bj)
#pragma unroll
                        for (int n = 0; n < 2; ++n) { const int d = bj * 32 + n * 16 + 4 * fq;
                            const f32x4 v = acc[ai][bj][m][n] * rs * g[bj][n]; u32x2 w; w.x = cvt_pk_bf16(v[0], v[1]); w.y = cvt_pk_bf16(v[2], v[3]);
                            EPI_ST(u32x2, qb + (size_t)row * 768 + head * 96 + d, w); }
                }
                asm volatile("" ::: "memory");
            }
        } else {
            const f32x4 ga = *(const f32x4*)(g_qr + 4 * fq), gb = *(const f32x4*)(g_qr + 16 + 4 * fq);
#pragma unroll
            for (int ai = 0; ai < 2; ++ai) {
                f32x4 cs[4], sn[4];
#pragma unroll
                for (int m = 0; m < 4; ++m) { const int row = u.pm * BM + ai * HALF + wr * 64 + m * 16 + fr; const int pos = row & (kSEQ - 1);
                    cs[m] = *(const f32x4*)(rope + (size_t)pos * 32 + 4 * fq); sn[m] = *(const f32x4*)(rope + (size_t)pos * 32 + 16 + 4 * fq); }
#pragma unroll
                for (int m = 0; m < 4; ++m) {
                    const int row = u.pm * BM + ai * HALF + wr * 64 + m * 16 + fr;
#pragma unroll
                    for (int bj = 0; bj < 2; ++bj) {
                        const int head = 4 * bj + wc;
                        const f32x4 a = acc[ai][bj][m][0], b = acc[ai][bj][m][1];
                        float s = (a[0] * a[0] + a[1] * a[1]) + (a[2] * a[2] + a[3] * a[3]) + (b[0] * b[0] + b[1] * b[1]) + (b[2] * b[2] + b[3] * b[3]);
                        s += __shfl_xor(s, 16); s += __shfl_xor(s, 32);
                        const float rs = __builtin_amdgcn_rsqf(s * (1.0f / 32.0f) + epsq[ai][m]);
                        const f32x4 x1 = a * rs * ga, x2 = b * rs * gb;
                        const f32x4 o1 = (x1 * cs[m] - x2 * sn[m]) * kC2Q, o2 = (x1 * sn[m] + x2 * cs[m]) * kC2Q;
                        u32x2 w1, w2; w1.x = cvt_pk_bf16(o1[0], o1[1]); w1.y = cvt_pk_bf16(o1[2], o1[3]); w2.x = cvt_pk_bf16(o2[0], o2[1]); w2.y = cvt_pk_bf16(o2[2], o2[3]);
                        EPI_ST(u32x2, qb + (size_t)row * 768 + head * 96 + 64 + 4 * fq, w1); EPI_ST(u32x2, qb + (size_t)row * 768 + head * 96 + 80 + 4 * fq, w2);
                    }
                }
                asm volatile("" ::: "memory");
            }
        }
    }
};

struct EpiKV {
    static constexpr bool PERM = false, AFTER_DRAIN = false;
    const float* g_kn; bf16_t* Kb; bf16_t* Vb;
    __device__ __forceinline__ void operator()(const f32x4 (&acc)[2][2][4][2], const Unit& u, int wr, int wc, int fr_, int fq_) const {
        const int ln_ = fresh_lane(), fr = ln_ & 15, fq = ln_ >> 4; (void)fr_; (void)fq_;
        const int pn = u.pn;
        f32x4 gk[2][2];
#pragma unroll
        for (int bj = 0; bj < 2; ++bj)
#pragma unroll
            for (int n = 0; n < 2; ++n) gk[bj][n] = *(const f32x4*)(g_kn + bj * 32 + n * 16 + 4 * fq);
#pragma unroll
        for (int ai = 0; ai < 2; ++ai)
#pragma unroll
            for (int m = 0; m < 4; ++m) {
                const int row = u.pm * BM + ai * HALF + wr * 64 + m * 16 + fr;
                const int b_ = row >> 13, t_ = row & (kSEQ - 1);
                if (pn < 2) {
                    const int head = 4 * pn + wc; float s = 0.f;
#pragma unroll
                    for (int bj = 0; bj < 2; ++bj)
#pragma unroll
                        for (int n = 0; n < 2; ++n) { const f32x4 v = acc[ai][bj][m][n]; s += (v[0] * v[0] + v[1] * v[1]) + (v[2] * v[2] + v[3] * v[3]); }
                    s += __shfl_xor(s, 16); s += __shfl_xor(s, 32);
                    const float rs = __builtin_amdgcn_rsqf(s * (1.0f / 64.0f) + kEPS);
                    bf16_t* kp = Kb + ((size_t)(b_ * 8 + head) * kSEQ + t_) * 64;
#pragma unroll
                    for (int bj = 0; bj < 2; ++bj)
#pragma unroll
                        for (int n = 0; n < 2; ++n) { const int d = bj * 32 + n * 16 + 4 * fq;
                            const f32x4 v = acc[ai][bj][m][n] * rs * gk[bj][n]; u32x2 w; w.x = cvt_pk_bf16(v[0], v[1]); w.y = cvt_pk_bf16(v[2], v[3]);
                            EPI_ST(u32x2, kp + d, w); }
                } else {
#pragma unroll
                    for (int bj = 0; bj < 2; ++bj)
#pragma unroll
                        for (int n = 0; n < 2; ++n) { const int c = (pn - 2) * 256 + bj * HALF + wc * 32 + n * 16 + 4 * fq; const int head = c >> 6, d = c & 63;
                            const f32x4 v = acc[ai][bj][m][n]; u32x2 w; w.x = cvt_pk_bf16(v[0], v[1]); w.y = cvt_pk_bf16(v[2], v[3]);
                            EPI_ST(u32x2, Vb + ((size_t)(b_ * 8 + head) * kSEQ + t_) * 64 + d, w); }
                }
                if (m == 3) asm volatile("" ::: "memory");
            }
    }
};

struct EpiMem {
    static constexpr bool PERM = false, AFTER_DRAIN = false;
    const float* ssqm; const float* g_mk; float* mk_out; float* mv_out; bf16_t* mKb; bf16_t* mVb;
    __device__ __forceinline__ void operator()(const f32x4 (&acc)[2][2][4][2], const Unit& u, int wr, int wc, int fr_, int fq_) const {
        const int ln_ = fresh_lane(), fr = ln_ & 15, fq = ln_ >> 4; (void)fr_; (void)fq_;
        const int pn = u.pn;
#pragma unroll
        for (int ai = 0; ai < 2; ++ai)
#pragma unroll
            for (int m = 0; m < 4; ++m) {
                const int row = u.pm * BM + ai * HALF + wr * 64 + m * 16 + fr;
                const float iv = row_inv_from_parts(ssqm, row);
                const int b_ = row >> 8, n_ = row & 255;
                if (pn == 0) {
                    const int head = wc; float s = 0.f;
#pragma unroll
                    for (int bj = 0; bj < 2; ++bj)
#pragma unroll
                        for (int n = 0; n < 2; ++n) { const f32x4 v = acc[ai][bj][m][n] * iv; s += (v[0] * v[0] + v[1] * v[1]) + (v[2] * v[2] + v[3] * v[3]); }
                    s += __shfl_xor(s, 16); s += __shfl_xor(s, 32);
                    const float rs = __builtin_amdgcn_rsqf(s * (1.0f / 64.0f) + kEPS);
#pragma unroll
                    for (int bj = 0; bj < 2; ++bj)
#pragma unroll
                        for (int n = 0; n < 2; ++n) { const int d = bj * 32 + n * 16 + 4 * fq; const f32x4 g = *(const f32x4*)(g_mk + d);
                            const f32x4 v = acc[ai][bj][m][n] * (iv * rs) * g;
                            *(f32x4*)(mk_out + (size_t)row * 256 + head * 64 + d) = v;
                            u32x2 w; w.x = cvt_pk_bf16(v[0], v[1]); w.y = cvt_pk_bf16(v[2], v[3]);
                            *(u32x2*)(mKb + ((size_t)(b_ * 4 + head) * 256 + n_) * 64 + d) = w; }
                } else {
#pragma unroll
                    for (int bj = 0; bj < 2; ++bj)
#pragma unroll
                        for (int n = 0; n < 2; ++n) { const int c = bj * HALF + wc * 32 + n * 16 + 4 * fq; const int head = c >> 6, d = c & 63;
                            const f32x4 v = acc[ai][bj][m][n] * iv;
                            *(f32x4*)(mv_out + (size_t)row * 256 + c) = v;
                            u32x2 w; w.x = cvt_pk_bf16(v[0], v[1]); w.y = cvt_pk_bf16(v[2], v[3]);
                            *(u32x2*)(mVb + ((size_t)(b_ * 4 + head) * 256 + n_) * 64 + d) = w; }
                }
                asm volatile("" ::: "memory");
            }
    }
};
template <class Epi, class Sched, bool ALIGN_EPI = false, bool SP2 = false, bool ABLK = false, int KD = 1>
__device__ __forceinline__ void gemm_phase(PG8_LAS unsigned char* lds, const Gemm g, const Sched& S, const Epi& E) {
    int tid_ = threadIdx.x; asm volatile("" : "+v"(tid_));
    const int tid = tid_, wid = __builtin_amdgcn_readfirstlane(tid >> 6), lane = tid & 63, wr = wid >> 2, wc = wid & 3, fr = lane & 15, fq = lane >> 4;
    const int K = g.K, nt = K / BK;
    unsigned voffA[2], voffB[2];
#pragma unroll
    for (int i = 0; i < 2; ++i) { int R, C; stage_rc(tid * 16 + i * 8192, R, C); const int Rb = Epi::PERM ? ((R & ~31) + perm32(R & 31)) : R;
        voffA[i] = ABLK ? (unsigned)(R * BK + C) * 2u : (unsigned)(R * K + C) * 2u; voffB[i] = (unsigned)(Rb * K + C) * 2u; }
    const size_t kstep = (size_t)(BK * 2);
    const size_t hstep = (size_t)HALF * K * 2;
    const size_t tstep = 2 * hstep;
    const size_t kstepA = ABLK ? (size_t)(BM * BK * 2) : kstep, hstepA = ABLK ? (size_t)(HALF * BK * 2) : hstep, tstepA = ABLK ? (size_t)nt * (BM * BK * 2) : tstep;
    const unsigned ldsw = (unsigned)wid * 1024u;
    const int aoff = lds_byte(wr * 64 + fr, fq * 8), boff = lds_byte(wc * 32 + fr, fq * 8);
#define PG8_SA(b, h) (((b) * 2 + (h)) * HTB)
#define PG8_SB(b, h) ((4 + (b) * 2 + (h)) * HTB)
#define PG8_STAGE(bufoff, gbase, voff) do { _Pragma("unroll") for (int _i = 0; _i < 2; ++_i) \
        __builtin_amdgcn_global_load_lds((const unsigned*)((const char*)(gbase) + (voff)[_i]), (PG8_LAS unsigned*)(lds + (bufoff) + ldsw + _i * 8192), 16, 0, 0); } while (0)
#define PG8_LDA(dst, b, h) do { _Pragma("unroll") for (int m = 0; m < 4; ++m) _Pragma("unroll") for (int k = 0; k < 2; ++k) dst[m][k] = *(const PG8_LAS bf16x8*)(lds + PG8_SA(b, h) + aoff + m * 2048 + k * 1024); } while (0)
#define PG8_LDB(dst, b, h) do { _Pragma("unroll") for (int n = 0; n < 2; ++n) _Pragma("unroll") for (int k = 0; k < 2; ++k) dst[n][k] = *(const PG8_LAS bf16x8*)(lds + PG8_SB(b, h) + boff + n * 2048 + k * 1024); } while (0)
#define PG8_MMA(ai, bj, At, Bt) do { __builtin_amdgcn_s_setprio(1); _Pragma("unroll") for (int m = 0; m < 4; ++m) _Pragma("unroll") for (int n = 0; n < 2; ++n) _Pragma("unroll") for (int k = 0; k < 2; ++k) \
        acc[ai][bj][m][n] = __builtin_amdgcn_mfma_f32_16x16x32_bf16(Bt[n][k], At[m][k], acc[ai][bj][m][n], 0, 0, 0); __builtin_amdgcn_s_setprio(0); } while (0)
#define PG8_WAIT_V(n) asm volatile("s_waitcnt vmcnt(" #n ")" ::: "memory")
#define PG8_WAIT_L(n) asm volatile("s_waitcnt lgkmcnt(" #n ")" ::: "memory")
#define PG8_BAR __builtin_amdgcn_s_barrier()
#define PG8_SCHED __builtin_amdgcn_sched_barrier(0)
    Unit cur, nxt; int ui = 0;
    if (!S.next(0, cur)) return;
    f32x4 acc[2][2][4][2];
#pragma unroll
    for (int a = 0; a < 2; ++a)
#pragma unroll
        for (int b = 0; b < 2; ++b)
#pragma unroll
            for (int m = 0; m < 4; ++m)
#pragma unroll
                for (int n = 0; n < 2; ++n) acc[a][b][m][n] = (f32x4){0.f, 0.f, 0.f, 0.f};
    bf16x8 At[4][2], B0[2][2], B1[2][2];
    const char* cA = (const char*)g.A + (size_t)cur.pm * tstepA; const char* cB = (const char*)g.Bt + (size_t)cur.pn * tstep;
    S.a_ready(cur);
    if constexpr (SP2) {
        PG8_STAGE(PG8_SB(0, 0), cB, voffB); PG8_STAGE(PG8_SB(0, 1), cB + hstep, voffB); PG8_STAGE(PG8_SA(0, 0), cA, voffA); PG8_STAGE(PG8_SA(0, 1), cA + hstepA, voffA);
        if (wr == 1) PG8_BAR;
        PG8_WAIT_V(2); PG8_BAR;
        PG8_STAGE(PG8_SB(1, 0), cB + kstep, voffB); PG8_STAGE(PG8_SA(1, 0), cA + kstepA, voffA); PG8_STAGE(PG8_SB(1, 1), cB + hstep + kstep, voffB);
        PG8_WAIT_V(6); PG8_BAR;
    } else {
        PG8_STAGE(PG8_SB(0, 0), cB, voffB); PG8_STAGE(PG8_SA(0, 0), cA, voffA); PG8_STAGE(PG8_SB(0, 1), cB + hstep, voffB); PG8_STAGE(PG8_SA(0, 1), cA + hstepA, voffA);
        if (wr == 1) PG8_BAR;
        PG8_WAIT_V(4); PG8_BAR;
        PG8_STAGE(PG8_SB(1, 0), cB + kstep, voffB); PG8_STAGE(PG8_SA(1, 0), cA + kstepA, voffA); PG8_STAGE(PG8_SB(1, 1), cB + hstep + kstep, voffB);
        PG8_WAIT_V(6); PG8_BAR;
    }
    for (;;) {
        const bool has_next = S.next(ui + 1, nxt);
        const char* nA = has_next ? (const char*)g.A + (size_t)nxt.pm * tstepA : cA; const char* nB = has_next ? (const char*)g.Bt + (size_t)nxt.pn * tstep : cB;
        for (int kd = 0; kd < KD; ++kd) {
        const bool fin = (kd == KD - 1);
        const char* nA_ = fin ? nA : cA; const char* nB_ = fin ? nB : cB;
        for (int t = 0; t < nt; t += 2) {
            const bool last = (t == nt - 2);
            const char* a1 = cA + (size_t)(t + 1) * kstepA;
            const char* a2 = last ? nA_ : cA + (size_t)(t + 2) * kstepA; const char* b2 = last ? nB_ : cB + (size_t)(t + 2) * kstep;
            const char* a3 = a2 + kstepA; const char* b3 = b2 + kstep;
            if (last && has_next && fin) S.a_ready(nxt);
            if constexpr (SP2) {
            PG8_LDB(B0, 0, 0); PG8_LDB(B1, 0, 1); PG8_SCHED; PG8_LDA(At, 0, 0); PG8_STAGE(PG8_SA(1, 1), a1 + hstepA, voffA);
            PG8_WAIT_V(8); PG8_WAIT_L(0); PG8_BAR; PG8_MMA(0, 0, At, B0); PG8_MMA(0, 1, At, B1); PG8_BAR; PG8_SCHED;
#if PG8_AMID
            PG8_LDA(At, 0, 1); PG8_STAGE(PG8_SB(0, 0), b2, voffB); PG8_STAGE(PG8_SB(0, 1), b2 + hstep, voffB);
            PG8_WAIT_V(6); PG8_WAIT_L(0); PG8_BAR; PG8_MMA(1, 0, At, B0); PG8_SCHED; PG8_STAGE(PG8_SA(0, 0), a2, voffA); PG8_SCHED; PG8_MMA(1, 1, At, B1); PG8_BAR; PG8_SCHED;
#else
            PG8_LDA(At, 0, 1); PG8_STAGE(PG8_SB(0, 0), b2, voffB); PG8_STAGE(PG8_SB(0, 1), b2 + hstep, voffB); PG8_STAGE(PG8_SA(0, 0), a2, voffA);
            PG8_WAIT_V(8); PG8_WAIT_L(0); PG8_BAR; PG8_MMA(1, 0, At, B0); PG8_MMA(1, 1, At, B1); PG8_BAR; PG8_SCHED;
#endif
            PG8_LDB(B0, 1, 0); PG8_LDB(B1, 1, 1); PG8_SCHED; PG8_LDA(At, 1, 0); PG8_STAGE(PG8_SA(0, 1), a2 + hstepA, voffA);
            PG8_WAIT_V(8); PG8_WAIT_L(0); PG8_BAR; PG8_MMA(0, 0, At, B0); PG8_MMA(0, 1, At, B1); PG8_BAR; PG8_SCHED;
#if PG8_AMID
            PG8_LDA(At, 1, 1); PG8_STAGE(PG8_SB(1, 0), b3, voffB); PG8_STAGE(PG8_SB(1, 1), b3 + hstep, voffB);
            PG8_WAIT_V(6); PG8_WAIT_L(0); PG8_BAR; PG8_MMA(1, 0, At, B0); PG8_SCHED; PG8_STAGE(PG8_SA(1, 0), a3, voffA); PG8_SCHED; PG8_MMA(1, 1, At, B1); PG8_BAR; PG8_SCHED;
#else
            PG8_LDA(At, 1, 1); PG8_STAGE(PG8_SB(1, 0), b3, voffB); PG8_STAGE(PG8_SB(1, 1), b3 + hstep, voffB); PG8_STAGE(PG8_SA(1, 0), a3, voffA);
            PG8_WAIT_V(8); PG8_WAIT_L(0); PG8_BAR; PG8_MMA(1, 0, At, B0); PG8_MMA(1, 1, At, B1); PG8_BAR; PG8_SCHED;
#endif
            } else {
            PG8_LDB(B0, 0, 0); PG8_SCHED; PG8_LDA(At, 0, 0); PG8_STAGE(PG8_SA(1, 1), a1 + hstepA, voffA);
            PG8_WAIT_L(8); PG8_BAR; PG8_WAIT_L(0); PG8_MMA(0, 0, At, B0); PG8_BAR; PG8_SCHED;
            PG8_LDB(B1, 0, 1); PG8_STAGE(PG8_SB(0, 0), b2, voffB);
            PG8_BAR; PG8_WAIT_L(0); PG8_MMA(0, 1, At, B1); PG8_BAR;
            PG8_LDA(At, 0, 1); PG8_STAGE(PG8_SA(0, 0), a2, voffA);
            PG8_BAR; PG8_WAIT_L(0); PG8_MMA(1, 0, At, B0); PG8_BAR; PG8_SCHED;
            PG8_STAGE(PG8_SB(0, 1), b2 + hstep, voffB);
            PG8_WAIT_V(6); PG8_BAR; PG8_MMA(1, 1, At, B1); PG8_BAR;
            PG8_LDB(B0, 1, 0); PG8_SCHED; PG8_LDA(At, 1, 0); PG8_STAGE(PG8_SA(0, 1), a2 + hstepA, voffA);
            PG8_WAIT_L(8); PG8_BAR; PG8_WAIT_L(0); PG8_MMA(0, 0, At, B0); PG8_BAR; PG8_SCHED;
            PG8_LDB(B1, 1, 1); PG8_STAGE(PG8_SB(1, 0), b3, voffB);
            PG8_BAR; PG8_WAIT_L(0); PG8_MMA(0, 1, At, B1); PG8_BAR;
            PG8_LDA(At, 1, 1); PG8_STAGE(PG8_SA(1, 0), a3, voffA);
            PG8_BAR; PG8_WAIT_L(0); PG8_MMA(1, 0, At, B0); PG8_BAR; PG8_SCHED;
            PG8_STAGE(PG8_SB(1, 1), b3 + hstep, voffB);
            PG8_WAIT_V(6); PG8_BAR; PG8_MMA(1, 1, At, B1); PG8_BAR;
            }
        }
        if (KD > 1 && !fin) {
#pragma unroll
            for (int a = 0; a < 2; ++a)
#pragma unroll
                for (int b = 0; b < 2; ++b)
#pragma unroll
                    for (int m = 0; m < 4; ++m)
#pragma unroll
                        for (int n = 0; n < 2; ++n) { asm volatile("" :: "v"(acc[a][b][m][n])); acc[a][b][m][n] = (f32x4){0.f, 0.f, 0.f, 0.f}; }
        }
        }
        if constexpr (ALIGN_EPI) { if (wr == 0) PG8_BAR; }
        if constexpr (!Epi::AFTER_DRAIN) { E(acc, cur, wr, wc, fr, fq); S.done(cur); }
        if (!has_next) break;
#pragma unroll
        for (int a = 0; a < 2; ++a)
#pragma unroll
            for (int b = 0; b < 2; ++b)
#pragma unroll
                for (int m = 0; m < 4; ++m)
#pragma unroll
                    for (int n = 0; n < 2; ++n) acc[a][b][m][n] = (f32x4){0.f, 0.f, 0.f, 0.f};
        cur = nxt; cA = nA; cB = nB; ++ui;
        if constexpr (ALIGN_EPI) { if (wr == 1) PG8_BAR; }
    }
    PG8_WAIT_V(0);
    if constexpr (!ALIGN_EPI) { if (wr == 0) PG8_BAR; }
    PG8_BAR;
    if constexpr (Epi::AFTER_DRAIN) { E.fused(acc, cur, wr, wc, fr, fq, lds, wid, lane); S.done(cur); }
#undef PG8_SA
#undef PG8_SB
#undef PG8_STAGE
#undef PG8_LDA
#undef PG8_LDB
#undef PG8_MMA
#undef PG8_WAIT_V
#undef PG8_WAIT_L
#undef PG8_BAR
#undef PG8_SCHED
}
}
#define LAS __attribute__((address_space(3)))
#define XB_TMO      128
#define XB_XCNT(j)  (256  + 64 * (j))
#define XB_XSUB(j)  (1280 + 64 * (j))
#define XB_XGEN(j)  (2304 + 64 * (j))
#define XB_TOP      3328
#define XB_TOPGEN   3392
#define XCD_BAR_WORDS 3456
#define XB_SPIN_CAP (1u << 25)

__device__ __forceinline__ unsigned xb_ld(unsigned* p)              { return __hip_atomic_load(p, __ATOMIC_RELAXED, __HIP_MEMORY_SCOPE_AGENT); }
__device__ __forceinline__ unsigned xb_add(unsigned* p, unsigned v) { return __hip_atomic_fetch_add(p, v, __ATOMIC_RELAXED, __HIP_MEMORY_SCOPE_AGENT); }
__device__ __forceinline__ unsigned xb_xcc_id() { return (unsigned)__builtin_amdgcn_s_getreg((3 << 11) | 20) & 0xFu; }
#define XB_SPIN(cond, bar) do { unsigned _sp = 0; while (cond) { __builtin_amdgcn_s_sleep(1); \
    if ((++_sp & 255u) == 0u) { if (xb_ld(&(bar)[XB_TMO])) break; if (_sp > XB_SPIN_CAP) { atomicAdd(&(bar)[XB_TMO], 1u); break; } } } } while (0)

struct XcdBarrier {
    unsigned* bar; unsigned x;
    volatile LAS unsigned* st;
};

__device__ __forceinline__ XcdBarrier xcd_barrier_post(unsigned* bar, volatile LAS unsigned* st) {
    XcdBarrier b; b.bar = bar; b.x = xb_xcc_id(); b.st = st;
    if (threadIdx.x == 0) (void)xb_add(&bar[XB_XCNT(b.x)], 1u);
    return b;
}
__device__ __forceinline__ void xcd_barrier_complete(unsigned* bar, unsigned x, unsigned& nloc, unsigned& nx) {
    const unsigned G = gridDim.x * gridDim.y * gridDim.z;
    unsigned sum, cnt, mine, sp = 0u;
    for (;;) {
        sum = 0u; cnt = 0u; mine = 0u;
#pragma unroll
        for (unsigned j = 0; j < 16; ++j) { const unsigned c = xb_ld(&bar[XB_XCNT(j)]); sum += c; cnt += (c > 0u) ? 1u : 0u; mine = (j == x) ? c : mine; }
        if (sum == G) break;
        __builtin_amdgcn_s_sleep(1);
        if ((++sp & 255u) == 0u) { if (xb_ld(&bar[XB_TMO])) break; if (sp > XB_SPIN_CAP) { atomicAdd(&bar[XB_TMO], 1u); break; } }
    }
    nloc = mine > 0u ? mine : 1u; nx = cnt > 0u ? cnt : 1u;
}

__device__ __forceinline__ void xcd_barrier(const XcdBarrier& b) {
    asm volatile("s_waitcnt vmcnt(0)" ::: "memory");
    __syncthreads();
    if (threadIdx.x == 0) {
        unsigned* bar = b.bar;
        __builtin_amdgcn_s_waitcnt(0);
        unsigned nloc = b.st[0], nx = b.st[1];
        if (nloc == 0u) { xcd_barrier_complete(bar, b.x, nloc, nx); b.st[0] = nloc; b.st[1] = nx; }
        const unsigned old = xb_add(&bar[XB_XSUB(b.x)], 1u);
        const unsigned gen = old / nloc;
        if (old + 1u == (gen + 1u) * nloc) {
            __builtin_amdgcn_fence(__ATOMIC_RELEASE, "agent");
            asm volatile("s_waitcnt vmcnt(0)" ::: "memory");
            const unsigned og = xb_add(&bar[XB_TOP], 1u);
            const unsigned tg = og / nx;
            if (og + 1u == (tg + 1u) * nx) xb_add(&bar[XB_TOPGEN], 1u);
            else XB_SPIN(xb_ld(&bar[XB_TOPGEN]) == tg, bar);
            __builtin_amdgcn_fence(__ATOMIC_ACQUIRE, "agent");
            xb_add(&bar[XB_XGEN(b.x)], 1u);
            asm volatile("s_waitcnt vmcnt(0)" ::: "memory");
        } else {
            XB_SPIN(xb_ld(&bar[XB_XGEN(b.x)]) == gen, bar);
            __builtin_amdgcn_fence(__ATOMIC_ACQUIRE, "agent");
            asm volatile("s_waitcnt vmcnt(0)" ::: "memory");
        }
    }
    __syncthreads();
}
#define GAS __attribute__((address_space(1)))
typedef unsigned short bf16;
typedef unsigned v4u __attribute__((ext_vector_type(4)));
typedef unsigned v2u __attribute__((ext_vector_type(2)));
typedef float f32x4 __attribute__((ext_vector_type(4)));
typedef float f32x16 __attribute__((ext_vector_type(16)));
typedef short bf16x8 __attribute__((ext_vector_type(8)));
typedef short s16x4 __attribute__((ext_vector_type(4)));
#define LDS_WAIT() asm volatile("s_waitcnt lgkmcnt(0)" ::: "memory")
#define VM_WAIT() asm volatile("s_waitcnt vmcnt(0)" ::: "memory")
using pg8::cvt_pk_bf16;
__device__ __forceinline__ float bf2f(unsigned short h) { return __uint_as_float((unsigned)h << 16); }
__device__ __forceinline__ float bflo(unsigned w) { return __uint_as_float(w << 16); }
__device__ __forceinline__ float bfhi(unsigned w) { return __uint_as_float(w & 0xffff0000u); }

constexpr int D = 1024, SEQ = 8192, NB = 4, NTOK = 32768, NS = 128, MR = 32896, MP = 33024;
constexpr int FF = 2816, FF2 = 5632, INW = 1440, INWP = 1536;
constexpr int NPAGES = 128, PAGE = 128, NPHYS = 20480;
constexpr float EPS = 1e-6f;
static_assert(pg8::kNTOK == NTOK && pg8::kMR == MR && pg8::kSEQ == SEQ, "constants");

constexpr size_t O_Y = 0, O_YS = 33554432, O_CKVP = 33685504, O_KRP = 37879808, O_CONVP = 38928384, O_MKP = 38930432, O_MVP = 39192576,
                 O_CKVS = 39454720, O_KRS = 39471104, O_CONVS = 39475200, O_TOTAL = 39540736;

constexpr size_t MiB = 1u << 20;
constexpr size_t WS_CTL = 0, CTL_ZERO_BYTES = 1 * MiB;
constexpr size_t WS_W1GU = 1 * MiB, WS_W1D = WS_W1GU + 12 * MiB, WS_WIN = WS_W1D + 6 * MiB, WS_WUQ = WS_WIN + 3 * MiB, WS_WKV = WS_WUQ + 1 * MiB, WS_WO = WS_WKV + 1 * MiB,
                 WS_W2GU = WS_WO + 2 * MiB, WS_W2D = WS_W2GU + 12 * MiB, WS_WMEM = WS_W2D + 6 * MiB, WS_ROPE = WS_WMEM + 1 * MiB,
                 WS_SSQ0 = WS_ROPE + 2 * MiB, WS_SSQ1 = WS_SSQ0 + 3 * MiB, WS_SSQ2 = WS_SSQ1 + 3 * MiB, WS_MSQ = WS_SSQ2 + 3 * MiB, WS_SSQM = WS_MSQ + 1 * MiB,
                 WS_XB = WS_SSQM + 1 * MiB, WS_ACT1 = WS_XB + 65 * MiB, WS_ACT2 = WS_ACT1 + 178 * MiB, WS_X1F = WS_ACT2 + 178 * MiB, WS_X1B = WS_X1F + 129 * MiB,
                 WS_X2F = WS_X1B + 65 * MiB, WS_X2B = WS_X2F + 129 * MiB, WS_CQB = WS_X2B + 65 * MiB, WS_CKVB = WS_CQB + 17 * MiB, WS_KRB = WS_CKVB + 9 * MiB,
                 WS_UB = WS_KRB + 3 * MiB, WS_GBB = WS_UB + 17 * MiB, WS_MQB = WS_GBB + 17 * MiB, WS_QB = WS_MQB + 17 * MiB, WS_KB = WS_QB + 49 * MiB, WS_VB = WS_KB + 48 * MiB,
                 WS_MEMB = WS_VB + 32 * MiB, WS_MEMK = WS_MEMB + 2 * MiB, WS_MEMV = WS_MEMK + 1 * MiB, WS_OAB = WS_MEMV + 1 * MiB, WS_OMB = WS_OAB + 33 * MiB,
                 WS_OMIX = WS_OMB + 17 * MiB, WS_DPART = WS_OMIX + 65 * MiB, WS_DBG = WS_DPART + 2 * MiB, WS_GU1S = WS_DBG + 1 * MiB, WS_GU2S = WS_GU1S + 3 * MiB, WS_D1S = WS_GU2S + 3 * MiB, WS_D7S = WS_D1S + 1 * MiB, WS_ZS = WS_D7S + 1 * MiB, WS_QS = WS_ZS + 1 * MiB, WS_MEMRAW = WS_QS + 1 * MiB,
                 WS_END = WS_MEMRAW + 2 * MiB;
constexpr int CW_BAR = 4096;

constexpr int RING_BYTES = 131072, LDSCTL_OFF = RING_BYTES, MISC_OFF = LDSCTL_OFF + 320, XCH_OFF = RING_BYTES + 512, LDS_BYTES = 147456;
constexpr int NWAVES = 8;

struct Args {
    const float* in[38];
    float* out; unsigned char* ws;
    int ph_lo, ph_hi;
};

#define CAS __attribute__((address_space(4)))
typedef const float* const CAS* InTab;
struct Frame {
    LAS unsigned char* lds;
    int tid, lane, wave, vcu, G;
    InTab in;
    float* out; unsigned char* ws;
};
__device__ __forceinline__ float wave_sum(float v) {
#pragma unroll
    for (int o = 1; o < 64; o <<= 1) v += __shfl_xor(v, o);
    return v;
}
__device__ __forceinline__ float wave_max(float v) {
#pragma unroll
    for (int o = 1; o < 64; o <<= 1) v = fmaxf(v, __shfl_xor(v, o));
    return v;
}

struct TSrc { const float* p; int ld; int col0; };
__device__ __forceinline__ void tr_item(TSrc s, const float* kscale, int K, bf16* WT, int n0, int k0, LAS float* scr, int lane) {
    f32x4 v[8];
#pragma unroll
    for (int i = 0; i < 8; ++i) { const int idx = lane + 64 * i, kk = idx >> 3, n4 = idx & 7;
        v[i] = (f32x4){0.f, 0.f, 0.f, 0.f};
        if (s.p) { v[i] = *(const f32x4*)(s.p + (size_t)(k0 + kk) * s.ld + s.col0 + 4 * n4); if (kscale) v[i] = v[i] * kscale[k0 + kk]; } }
#pragma unroll
    for (int i = 0; i < 8; ++i) { const int idx = lane + 64 * i, kk = idx >> 3, n4 = idx & 7; LAS float* d = scr + kk * 33 + 4 * n4; d[0] = v[i][0]; d[1] = v[i][1]; d[2] = v[i][2]; d[3] = v[i][3]; }
    LDS_WAIT(); asm volatile("" ::: "memory");
    const int c = lane & 7;
#pragma unroll
    for (int j = 0; j < 4; ++j) { const int n = (lane >> 3) + 8 * j; const LAS float* q = scr + (8 * c) * 33 + n;
        v4u o; o.x = cvt_pk_bf16(q[0 * 33], q[1 * 33]); o.y = cvt_pk_bf16(q[2 * 33], q[3 * 33]); o.z = cvt_pk_bf16(q[4 * 33], q[5 * 33]); o.w = cvt_pk_bf16(q[6 * 33], q[7 * 33]);
        *(v4u*)(WT + (size_t)(n0 + n) * K + k0 + 8 * c) = o; }
    LDS_WAIT(); asm volatile("" ::: "memory");
}
enum { MAT_W1GU = 0, MAT_W1D, MAT_WIN, MAT_WUQ, MAT_WKV, MAT_WO, MAT_W2GU, MAT_W2D, MAT_WMEM, MAT_N };
__device__ __forceinline__ void mat_dims(int mat, int& N, int& K) {
    switch (mat) {
        case MAT_W1GU: case MAT_W2GU: N = FF2; K = D; break;
        case MAT_W1D: case MAT_W2D: N = D; K = FF; break;
        case MAT_WIN: N = INWP; K = D; break;
        case MAT_WUQ: N = 768; K = 256; break;
        case MAT_WKV: N = 1024; K = 128; break;
        case MAT_WO: N = D; K = D; break;
        default: N = 512; K = D; break;
    }
}
__device__ __forceinline__ void p0_weight_item(const Frame& F, int mat, int item, LAS float* scr) {
    int N, K; mat_dims(mat, N, K);
    const int nkb = K / 64, kb = item % nkb, slot = item / nkb, k0 = kb * 64;
    const int pn = slot >> 3, w = slot & 7, bj = w >> 2, wc = w & 3;
    InTab in = F.in;
    TSrc s{nullptr, 0, 0}; const float* ks = nullptr; bf16* dst = nullptr;
    switch (mat) {
        case MAT_W1GU: s = TSrc{bj == 0 ? in[10] : in[11], FF, 128 * pn + 32 * wc}; ks = in[9]; dst = (bf16*)(F.ws + WS_W1GU); break;
        case MAT_W2GU: s = TSrc{bj == 0 ? in[35] : in[36], FF, 128 * pn + 32 * wc}; ks = in[34]; dst = (bf16*)(F.ws + WS_W2GU); break;
        case MAT_W1D: s = TSrc{in[12], D, 32 * slot}; dst = (bf16*)(F.ws + WS_W1D); break;
        case MAT_W2D: s = TSrc{in[37], D, 32 * slot}; dst = (bf16*)(F.ws + WS_W2D); break;
        case MAT_WIN: {
            int c0 = -1;
            if (pn == 0) c0 = 32 * w;
            else if (pn == 1) c0 = (bj == 0) ? 256 + 32 * wc : (wc == 0 ? 384 : -1);
            else if (pn == 2) c0 = (bj == 0) ? 416 + 32 * wc : 928 + 32 * wc;
            else if (pn == 3) c0 = (bj == 0) ? 416 + 128 + 32 * wc : 928 + 128 + 32 * wc;
            else if (pn == 4) c0 = 672 + 32 * w;
            else c0 = 1184 + 64 * wc + 32 * bj;
            if (c0 >= 0) s = TSrc{in[14], INW, c0};
            ks = in[13]; dst = (bf16*)(F.ws + WS_WIN); break; }
        case MAT_WUQ: s = TSrc{in[16], 768, pn < 2 ? (4 * pn + wc) * 96 + 32 * bj : (4 * bj + wc) * 96 + 64}; ks = in[15]; dst = (bf16*)(F.ws + WS_WUQ); break;
        case MAT_WKV: if (pn < 2) s = TSrc{in[20], 512, (4 * pn + wc) * 64 + 32 * bj}; else s = TSrc{in[21], 512, 256 * (pn - 2) + 32 * w}; dst = (bf16*)(F.ws + WS_WKV); break;
        case MAT_WO: s = TSrc{in[33], D, 32 * slot}; ks = (k0 < 512) ? in[30] : (k0 < 768) ? in[31] - 512 : in[32] - 768; dst = (bf16*)(F.ws + WS_WO); break;
        default: if (pn == 0) s = TSrc{in[26], 256, 64 * wc + 32 * bj}; else s = TSrc{in[27], 256, 32 * w}; ks = in[25]; dst = (bf16*)(F.ws + WS_WMEM); break;
    }
    tr_item(s, ks, K, dst, 32 * slot, k0, scr, F.lane);
}
__device__ __forceinline__ void row_to_bf16_ssq(const float* src, bf16* dst, float* parts, int lane) {
    f32x4 v[4]; float s = 0.f;
#pragma unroll
    for (int j = 0; j < 4; ++j) { v[j] = src ? ((const f32x4*)src)[lane + 64 * j] : (f32x4){0.f, 0.f, 0.f, 0.f}; s += (v[j][0] * v[j][0] + v[j][1] * v[j][1]) + (v[j][2] * v[j][2] + v[j][3] * v[j][3]); }
    s = wave_sum(s);
#pragma unroll
    for (int j = 0; j < 4; ++j) { v2u w; w.x = cvt_pk_bf16(v[j][0], v[j][1]); w.y = cvt_pk_bf16(v[j][2], v[j][3]); ((v2u*)dst)[lane + 64 * j] = w; }
    if (lane == 0) parts[0] = s;
}
__device__ __forceinline__ float rope_inv_freq(int i) {
    switch (i) { case 0: return 1.000000000e+00f; case 1: return 5.623413324e-01f; case 2: return 3.162277639e-01f; case 3: return 1.778279394e-01f;
        case 4: return 1.000000015e-01f; case 5: return 5.623413250e-02f; case 6: return 3.162277490e-02f; case 7: return 1.778279431e-02f;
        case 8: return 9.999999776e-03f; case 9: return 5.623413250e-03f; case 10: return 3.162277630e-03f; case 11: return 1.778279431e-03f;
        case 12: return 1.000000047e-03f; case 13: return 5.623413017e-04f; case 14: return 3.162277571e-04f; default: return 1.778279402e-04f; }
}
__device__ __forceinline__ void p0_prologue(const Frame& F) {
    LAS float* scr = (LAS float*)(F.lds + F.wave * 16384);
    const int gw = F.vcu * NWAVES + F.wave, NGW = F.G * NWAVES;
    int base = 0;
#pragma unroll 1
    for (int mat = 0; mat < MAT_N; ++mat) {
        int N, K; mat_dims(mat, N, K);
        const int nit = (N / 32) * (K / 64);
        int first = (gw - base % NGW + NGW) % NGW;
        for (int it = first; it < nit; it += NGW) p0_weight_item(F, mat, it, scr);
        base += nit;
    }
    bf16* xb = (bf16*)(F.ws + WS_XB); float* ssq0 = (float*)(F.ws + WS_SSQ0);
#if P0_PIPE
    {
        auto srcp = [&](int r) -> const float* { return r < NTOK ? F.in[0] + (size_t)r * D : (r < MR ? F.in[2] + (size_t)(r - NTOK) * D : nullptr); };
        f32x4 va[4], vb[4];
        { const int r = gw, r2 = gw + NGW; const float* src = r < MP ? srcp(r) : nullptr; const float* src2 = r2 < MP ? srcp(r2) : nullptr;
#pragma unroll
          for (int j = 0; j < 4; ++j) { va[j] = src ? ((const f32x4*)src)[F.lane + 64 * j] : (f32x4){0.f, 0.f, 0.f, 0.f}; vb[j] = src2 ? ((const f32x4*)src2)[F.lane + 64 * j] : (f32x4){0.f, 0.f, 0.f, 0.f}; } }
        for (int r = gw; r < MP; r += 2 * NGW) {
            const int r2 = r + NGW, rn = r + 2 * NGW, rn2 = r + 3 * NGW;
            f32x4 na[4], nb[4];
            { const float* src = rn < MP ? srcp(rn) : nullptr; const float* src2 = rn2 < MP ? srcp(rn2) : nullptr;
#pragma unroll
              for (int j = 0; j < 4; ++j) { na[j] = src ? ((const f32x4*)src)[F.lane + 64 * j] : (f32x4){0.f, 0.f, 0.f, 0.f}; nb[j] = src2 ? ((const f32x4*)src2)[F.lane + 64 * j] : (f32x4){0.f, 0.f, 0.f, 0.f}; } }
            float sa = 0.f, sb = 0.f;
#pragma unroll
            for (int j = 0; j < 4; ++j) { sa += (va[j][0] * va[j][0] + va[j][1] * va[j][1]) + (va[j][2] * va[j][2] + va[j][3] * va[j][3]); sb += (vb[j][0] * vb[j][0] + vb[j][1] * vb[j][1]) + (vb[j][2] * vb[j][2] + vb[j][3] * vb[j][3]); }
            sa = wave_sum(sa); sb = wave_sum(sb);
#pragma unroll
            for (int j = 0; j < 4; ++j) { v2u w; w.x = cvt_pk_bf16(va[j][0], va[j][1]); w.y = cvt_pk_bf16(va[j][2], va[j][3]); ((v2u*)(xb + (size_t)r * D))[F.lane + 64 * j] = w; }
            if (F.lane == 0) ssq0[r] = sa;
            if (r2 < MP) {
#pragma unroll
                for (int j = 0; j < 4; ++j) { v2u w; w.x = cvt_pk_bf16(vb[j][0], vb[j][1]); w.y = cvt_pk_bf16(vb[j][2], vb[j][3]); ((v2u*)(xb + (size_t)r2 * D))[F.lane + 64 * j] = w; }
                if (F.lane == 0) ssq0[r2] = sb;
            }
#pragma unroll
            for (int j = 0; j < 4; ++j) { va[j] = na[j]; vb[j] = nb[j]; }
        }
    }
#else
    for (int r = gw; r < MP; r += 2 * NGW) {
        const int r2 = r + NGW;
        const float* src = r < NTOK ? F.in[0] + (size_t)r * D : (r < MR ? F.in[2] + (size_t)(r - NTOK) * D : nullptr);
        const float* src2 = r2 < NTOK ? F.in[0] + (size_t)r2 * D : (r2 < MR ? F.in[2] + (size_t)(r2 - NTOK) * D : nullptr);
        f32x4 va[4], vb[4];
#pragma unroll
        for (int j = 0; j < 4; ++j) { va[j] = src ? ((const f32x4*)src)[F.lane + 64 * j] : (f32x4){0.f, 0.f, 0.f, 0.f}; vb[j] = (r2 < MP && src2) ? ((const f32x4*)src2)[F.lane + 64 * j] : (f32x4){0.f, 0.f, 0.f, 0.f}; }
        float sa = 0.f, sb = 0.f;
#pragma unroll
        for (int j = 0; j < 4; ++j) { sa += (va[j][0] * va[j][0] + va[j][1] * va[j][1]) + (va[j][2] * va[j][2] + va[j][3] * va[j][3]); sb += (vb[j][0] * vb[j][0] + vb[j][1] * vb[j][1]) + (vb[j][2] * vb[j][2] + vb[j][3] * vb[j][3]); }
        sa = wave_sum(sa); sb = wave_sum(sb);
#pragma unroll
        for (int j = 0; j < 4; ++j) { v2u w; w.x = cvt_pk_bf16(va[j][0], va[j][1]); w.y = cvt_pk_bf16(va[j][2], va[j][3]); ((v2u*)(xb + (size_t)r * D))[F.lane + 64 * j] = w; }
        if (F.lane == 0) ssq0[r] = sa;
        if (r2 < MP) {
#pragma unroll
            for (int j = 0; j < 4; ++j) { v2u w; w.x = cvt_pk_bf16(vb[j][0], vb[j][1]); w.y = cvt_pk_bf16(vb[j][2], vb[j][3]); ((v2u*)(xb + (size_t)r2 * D))[F.lane + 64 * j] = w; }
            if (F.lane == 0) ssq0[r2] = sb;
        }
    }
#endif
    bf16* memb = (bf16*)(F.ws + WS_MEMB); float* ssqm = (float*)(F.ws + WS_SSQM);
    for (int r = gw; r < 1024; r += NGW) row_to_bf16_ssq(F.in[1] + (size_t)r * D, memb + (size_t)r * D, ssqm + r, F.lane);
    float* rope = (float*)(F.ws + WS_ROPE);
    const int gt = F.vcu * (NWAVES * 64) + F.tid, NGT = F.G * NWAVES * 64;
    for (int e = gt; e < 8193 * 16; e += NGT) { const int pi = e >> 4, i = e & 15; const float pos = pi == 8192 ? 16384.0f : (float)pi;
        const float ang = pos * rope_inv_freq(i);
        const double rev = (double)ang * 0.15915494309189535;
        const float fr = (float)(rev - floor(rev));
        rope[(size_t)pi * 32 + i] = __builtin_amdgcn_cosf(fr); rope[(size_t)pi * 32 + 16 + i] = __builtin_amdgcn_sinf(fr); }
    for (int e = gt; e < MP; e += NGT) { ((float*)(F.ws + WS_SSQ1))[e] = 0.f; ((float*)(F.ws + WS_SSQ2))[e] = 0.f; }
    { f32x4* z = (f32x4*)(F.ws + WS_GU1S); const int nz = (int)((WS_END - WS_GU1S) / 16); for (int e = gt; e < nz; e += NGT) z[e] = (f32x4){0.f, 0.f, 0.f, 0.f}; }
    for (int e = gt; e < NS * 256; e += NGT) { const int b = e >> 8, c = e & 255; F.out[O_CONVS + (size_t)b * 512 + c] = F.in[6][(size_t)b * 512 + 256 + c]; }
}
__device__ __forceinline__ int crow(int r, int hi) { return (r & 3) + 8 * (r >> 2) + 4 * hi; }
constexpr int AT_BUF = 20480, AT_V = 12288, AT_WS = 3 * AT_BUF, AT_OST = AT_WS + 2048;
template <int DQK>
__device__ __forceinline__ void attn_dma_tile(const bf16* Kt, const bf16* Krt, const bf16* Vt, LAS unsigned char* buf, int wid, int lane) {
    constexpr int NC = DQK / 8;
    __builtin_amdgcn_global_load_lds((const unsigned*)(Kt + (size_t)lane * 64 + wid * 8), (LAS unsigned*)(buf + wid * 1024), 16, 0, 0);
    if (NC > 8 && wid < NC - 8) __builtin_amdgcn_global_load_lds((const unsigned*)(Krt + (size_t)lane * (DQK - 64) + wid * 8), (LAS unsigned*)(buf + (8 + wid) * 1024), 16, 0, 0);
    __builtin_amdgcn_global_load_lds((const unsigned*)(Vt + (size_t)(16 * (wid & 3) + (lane >> 2)) * 64 + (wid >> 2) * 32 + (lane & 3) * 8), (LAS unsigned*)(buf + AT_V + wid * 1024), 16, 0, 0);
}
template <int DQK, bool CAUSAL, class Mid>
__device__ __forceinline__ void at_qk(f32x16& p0, f32x16& p1, const bf16x8 (&qr)[DQK / 16], const f32x16& negm, LAS unsigned char* kb, int jb, int qrel, int r32, int hi, Mid mid) {
#if AT_ROLL
#define ATK_R(dst, off) asm volatile("ds_read_b128 %0, %1 offset:%2" : "=v"(dst) : "v"(ka0), "n"(off) : "memory")
    const unsigned ka0 = (unsigned)(uintptr_t)kb + hi * 1024 + r32 * 16;
    bf16x8 ke0, ke1, ko0, ko1;
    ATK_R(ke0, 0); ATK_R(ke1, 512); ATK_R(ko0, 2048); ATK_R(ko1, 2048 + 512);
    __builtin_amdgcn_sched_barrier(0);
    mid();
    __builtin_amdgcn_sched_barrier(0);
#if AT_FLIP
    __builtin_amdgcn_s_setprio(1);
#endif
#pragma unroll
    for (int d0 = 0; d0 < DQK / 16; ++d0) {
        bf16x8& k0 = (d0 & 1) ? ko0 : ke0; bf16x8& k1 = (d0 & 1) ? ko1 : ke1;
        if (d0 + 1 < DQK / 16) asm volatile("s_waitcnt lgkmcnt(2)" : "+v"(k0), "+v"(k1) :: "memory"); else asm volatile("s_waitcnt lgkmcnt(0)" : "+v"(k0), "+v"(k1) :: "memory");
        __builtin_amdgcn_sched_barrier(0);
        if (d0 == 0) { p0 = __builtin_amdgcn_mfma_f32_32x32x16_bf16(k0, qr[0], negm, 0, 0, 0); p1 = __builtin_amdgcn_mfma_f32_32x32x16_bf16(k1, qr[0], negm, 0, 0, 0); }
        else { p0 = __builtin_amdgcn_mfma_f32_32x32x16_bf16(k0, qr[d0], p0, 0, 0, 0); p1 = __builtin_amdgcn_mfma_f32_32x32x16_bf16(k1, qr[d0], p1, 0, 0, 0); }
        __builtin_amdgcn_sched_barrier(0);
        if (d0 + 2 < DQK / 16) { if (d0 & 1) { ATK_R(ko0, 2048 * (d0 + 2)); ATK_R(ko1, 2048 * (d0 + 2) + 512); } else { ATK_R(ke0, 2048 * (d0 + 2)); ATK_R(ke1, 2048 * (d0 + 2) + 512); } }
        __builtin_amdgcn_sched_barrier(0);
    }
#if AT_FLIP
    __builtin_amdgcn_s_setprio(0);
#endif
#undef ATK_R
#else
    mid();
#pragma unroll
    for (int d0 = 0; d0 < DQK / 16; ++d0) {
        const bf16x8 k0 = *(const LAS bf16x8*)(kb + (2 * d0 + hi) * 1024 + r32 * 16);
        const bf16x8 k1 = *(const LAS bf16x8*)(kb + (2 * d0 + hi) * 1024 + 512 + r32 * 16);
        if (d0 == 0) { p0 = __builtin_amdgcn_mfma_f32_32x32x16_bf16(k0, qr[0], negm, 0, 0, 0); p1 = __builtin_amdgcn_mfma_f32_32x32x16_bf16(k1, qr[0], negm, 0, 0, 0); }
        else { p0 = __builtin_amdgcn_mfma_f32_32x32x16_bf16(k0, qr[d0], p0, 0, 0, 0); p1 = __builtin_amdgcn_mfma_f32_32x32x16_bf16(k1, qr[d0], p1, 0, 0, 0); }
    }
#endif
    if (CAUSAL && jb >= 0) {
        const int kb_ = 64 * jb + 4 * hi;
#pragma unroll
        for (int r = 0; r < 16; ++r) { const int kv = kb_ + (r & 3) + 8 * (r >> 2); if (kv > qrel) p0[r] = -INFINITY; if (kv + 32 > qrel) p1[r] = -INFINITY; }
    }
}
__device__ __forceinline__ void at_sp(f32x16& p0, f32x16& p1, f32x16& negm, f32x16& o0, f32x16& o1, float& mhat, float& lrun, bool first, LAS float* wsf, LAS unsigned char* vbuf, int lane, int r32, int hi) {
#if AT_VPRE
    const unsigned vb = (unsigned)(uintptr_t)vbuf + ((lane >> 4) & 1) * 32 + (lane & 3) * 8 + (4 * hi + ((lane & 15) >> 2)) * 64;
    s16x4 vlo[2][4], vhh[2][4];
#pragma unroll
    for (int d0 = 0; d0 < 2; ++d0)
#pragma unroll
        for (int ks = 0; ks < 4; ++ks) {
            asm volatile("ds_read_b64_tr_b16 %0, %1 offset:%2" : "=v"(vlo[d0][ks]) : "v"(vb), "i"(d0 * 4096 + ks * 1024) : "memory");
            asm volatile("ds_read_b64_tr_b16 %0, %1 offset:%2" : "=v"(vhh[d0][ks]) : "v"(vb), "i"(d0 * 4096 + ks * 1024 + 512) : "memory");
        }
#endif
    float rm;
    { float a = fmaxf(fmaxf(p0[0], p0[1]), p1[0]), b2 = fmaxf(fmaxf(p0[2], p0[3]), p1[1]); a = fmaxf(fmaxf(a, p1[2]), p1[3]);
#pragma unroll
      for (int r = 4; r < 16; r += 4) { a = fmaxf(fmaxf(a, p0[r]), p0[r + 1]); b2 = fmaxf(fmaxf(b2, p0[r + 2]), p0[r + 3]); a = fmaxf(fmaxf(a, p1[r]), p1[r + 1]); b2 = fmaxf(fmaxf(b2, p1[r + 2]), p1[r + 3]); }
      rm = fmaxf(a, b2); }
    { auto tt = __builtin_amdgcn_permlane32_swap(__float_as_uint(rm), __float_as_uint(rm), false, false); rm = fmaxf(__uint_as_float(tt[0]), __uint_as_float(tt[1])); }
    if (first || __any(rm > 8.0f)) {
        const float dl = first ? rm : fmaxf(rm, 0.f);
        const float alpha = __builtin_amdgcn_exp2f(-dl);
        mhat += dl; lrun *= alpha;
#pragma unroll
        for (int r = 0; r < 16; ++r) { p0[r] -= dl; p1[r] -= dl; negm[r] = -mhat; }
        asm volatile("" : "+v"(negm));
        if (hi == 0) wsf[r32] = alpha;
        LDS_WAIT();
#pragma unroll
        for (int r = 0; r < 16; ++r) { const float a = wsf[crow(r, hi)]; o0[r] *= a; o1[r] *= a; }
    }
    typedef float f32x2 __attribute__((ext_vector_type(2)));
    f32x2 ls2 = (f32x2){0.f, 0.f};
#pragma unroll
    for (int r = 0; r < 16; ++r) { p0[r] = __builtin_amdgcn_exp2f(p0[r]); p1[r] = __builtin_amdgcn_exp2f(p1[r]); }
#pragma unroll
    for (int r = 0; r < 16; r += 2) { ls2 = ls2 + (f32x2){p0[r], p0[r + 1]}; ls2 = ls2 + (f32x2){p1[r], p1[r + 1]}; }
    lrun += ls2[0] + ls2[1];
    bf16x8 pa[4];
    { v4u w;
      w.x = cvt_pk_bf16(p0[0], p0[1]); w.y = cvt_pk_bf16(p0[2], p0[3]); w.z = cvt_pk_bf16(p0[4], p0[5]); w.w = cvt_pk_bf16(p0[6], p0[7]); pa[0] = __builtin_bit_cast(bf16x8, w);
      w.x = cvt_pk_bf16(p0[8], p0[9]); w.y = cvt_pk_bf16(p0[10], p0[11]); w.z = cvt_pk_bf16(p0[12], p0[13]); w.w = cvt_pk_bf16(p0[14], p0[15]); pa[1] = __builtin_bit_cast(bf16x8, w);
      w.x = cvt_pk_bf16(p1[0], p1[1]); w.y = cvt_pk_bf16(p1[2], p1[3]); w.z = cvt_pk_bf16(p1[4], p1[5]); w.w = cvt_pk_bf16(p1[6], p1[7]); pa[2] = __builtin_bit_cast(bf16x8, w);
      w.x = cvt_pk_bf16(p1[8], p1[9]); w.y = cvt_pk_bf16(p1[10], p1[11]); w.z = cvt_pk_bf16(p1[12], p1[13]); w.w = cvt_pk_bf16(p1[14], p1[15]); pa[3] = __builtin_bit_cast(bf16x8, w); }
#if AT_VPRE
    asm volatile("s_waitcnt lgkmcnt(0)" : "+v"(vlo[0][0]), "+v"(vlo[0][1]), "+v"(vlo[0][2]), "+v"(vlo[0][3]), "+v"(vhh[0][0]), "+v"(vhh[0][1]), "+v"(vhh[0][2]), "+v"(vhh[0][3]),
                 "+v"(vlo[1][0]), "+v"(vlo[1][1]), "+v"(vlo[1][2]), "+v"(vlo[1][3]), "+v"(vhh[1][0]), "+v"(vhh[1][1]), "+v"(vhh[1][2]), "+v"(vhh[1][3]) :: "memory");
#pragma unroll
    for (int d0 = 0; d0 < 2; ++d0)
#pragma unroll
        for (int ks = 0; ks < 4; ++ks) {
            const bf16x8 vf = (bf16x8){vlo[d0][ks][0], vlo[d0][ks][1], vlo[d0][ks][2], vlo[d0][ks][3], vhh[d0][ks][0], vhh[d0][ks][1], vhh[d0][ks][2], vhh[d0][ks][3]};
            if (d0 == 0) o0 = __builtin_amdgcn_mfma_f32_32x32x16_bf16(pa[ks], vf, o0, 0, 0, 0);
            else o1 = __builtin_amdgcn_mfma_f32_32x32x16_bf16(pa[ks], vf, o1, 0, 0, 0);
        }
#elif AT_VPIPE
    const unsigned vb = (unsigned)(uintptr_t)vbuf + ((lane >> 4) & 1) * 32 + (lane & 3) * 8 + (4 * hi + ((lane & 15) >> 2)) * 64;
    s16x4 lo[2][4], hh[2][4];
#pragma unroll
    for (int ks = 0; ks < 4; ++ks) {
        asm volatile("ds_read_b64_tr_b16 %0, %1 offset:%2" : "=&v"(lo[0][ks]) : "v"(vb), "i"(ks * 1024) : "memory");
        asm volatile("ds_read_b64_tr_b16 %0, %1 offset:%2" : "=&v"(hh[0][ks]) : "v"(vb), "i"(ks * 1024 + 512) : "memory");
    }
    asm volatile("s_waitcnt lgkmcnt(0)" : "+v"(lo[0][0]), "+v"(lo[0][1]), "+v"(lo[0][2]), "+v"(lo[0][3]), "+v"(hh[0][0]), "+v"(hh[0][1]), "+v"(hh[0][2]), "+v"(hh[0][3]) :: "memory");
#pragma unroll
    for (int ks = 0; ks < 4; ++ks) {
        asm volatile("ds_read_b64_tr_b16 %0, %1 offset:%2" : "=&v"(lo[1][ks]) : "v"(vb), "i"(4096 + ks * 1024) : "memory");
        asm volatile("ds_read_b64_tr_b16 %0, %1 offset:%2" : "=&v"(hh[1][ks]) : "v"(vb), "i"(4096 + ks * 1024 + 512) : "memory");
    }
    __builtin_amdgcn_sched_barrier(0);
#pragma unroll
    for (int ks = 0; ks < 4; ++ks) {
        const bf16x8 vf = (bf16x8){lo[0][ks][0], lo[0][ks][1], lo[0][ks][2], lo[0][ks][3], hh[0][ks][0], hh[0][ks][1], hh[0][ks][2], hh[0][ks][3]};
        o0 = __builtin_amdgcn_mfma_f32_32x32x16_bf16(pa[ks], vf, o0, 0, 0, 0);
    }
    __builtin_amdgcn_sched_barrier(0);
    asm volatile("s_waitcnt lgkmcnt(0)" : "+v"(lo[1][0]), "+v"(lo[1][1]), "+v"(lo[1][2]), "+v"(lo[1][3]), "+v"(hh[1][0]), "+v"(hh[1][1]), "+v"(hh[1][2]), "+v"(hh[1][3]) :: "memory");
#pragma unroll
    for (int ks = 0; ks < 4; ++ks) {
        const bf16x8 vf = (bf16x8){lo[1][ks][0], lo[1][ks][1], lo[1][ks][2], lo[1][ks][3], hh[1][ks][0], hh[1][ks][1], hh[1][ks][2], hh[1][ks][3]};
        o1 = __builtin_amdgcn_mfma_f32_32x32x16_bf16(pa[ks], vf, o1, 0, 0, 0);
    }
#else
    const unsigned vb = (unsigned)(uintptr_t)vbuf + ((lane >> 4) & 1) * 32 + (lane & 3) * 8 + (4 * hi + ((lane & 15) >> 2)) * 64;
#pragma unroll
    for (int d0 = 0; d0 < 2; ++d0) {
        s16x4 lo[4], hh[4];
#pragma unroll
        for (int ks = 0; ks < 4; ++ks) {
            asm volatile("ds_read_b64_tr_b16 %0, %1 offset:%2" : "=&v"(lo[ks]) : "v"(vb), "i"(d0 * 4096 + ks * 1024) : "memory");
            asm volatile("ds_read_b64_tr_b16 %0, %1 offset:%2" : "=&v"(hh[ks]) : "v"(vb), "i"(d0 * 4096 + ks * 1024 + 512) : "memory");
        }
        asm volatile("s_waitcnt lgkmcnt(0)" : "+v"(lo[0]), "+v"(lo[1]), "+v"(lo[2]), "+v"(lo[3]), "+v"(hh[0]), "+v"(hh[1]), "+v"(hh[2]), "+v"(hh[3]) :: "memory");
#if AT_FLIP
        __builtin_amdgcn_s_setprio(1);
#endif
#pragma unroll
        for (int ks = 0; ks < 4; ++ks) {
            const bf16x8 vf = (bf16x8){lo[ks][0], lo[ks][1], lo[ks][2], lo[ks][3], hh[ks][0], hh[ks][1], hh[ks][2], hh[ks][3]};
            if (d0 == 0) o0 = __builtin_amdgcn_mfma_f32_32x32x16_bf16(pa[ks], vf, o0, 0, 0, 0);
            else o1 = __builtin_amdgcn_mfma_f32_32x32x16_bf16(pa[ks], vf, o1, 0, 0, 0);
        }
#if AT_FLIP
        __builtin_amdgcn_s_setprio(0);
#endif
    }
#endif
}
#define AT_ENDWAIT(more) do { if (more) { if (DQK > 64 && wid < DQK / 8 - 8) asm volatile("s_waitcnt vmcnt(3) lgkmcnt(0)\n\ts_barrier" ::: "memory"); else asm volatile("s_waitcnt vmcnt(2) lgkmcnt(0)\n\ts_barrier" ::: "memory"); } \
        else asm volatile("s_waitcnt vmcnt(0) lgkmcnt(0)\n\ts_barrier" ::: "memory"); } while (0)
template <int DQK, bool CAUSAL>
__device__ __forceinline__ void attn_unit_simple(const bf16* Q0, int qpitch, const bf16* Kh, const bf16* Kr, const bf16* Vh, bf16* O0, int opitch, int NT, LAS unsigned char* lds,
                                                 bf16x8 (&qr)[DQK / 16], bool primed, const bf16* nQ0, const bf16* nKh, const bf16* nKr, const bf16* nVh, int nNT) {
    constexpr int ND = DQK / 16;
    int tid_ = threadIdx.x; asm volatile("" : "+v"(tid_));
    const int tid = tid_, lane = tid & 63, r32 = lane & 31, hi = lane >> 5; const int wid = __builtin_amdgcn_readfirstlane(tid >> 6);
    if (!primed) {
        __syncthreads();
        attn_dma_tile<DQK>(Kh, Kr, Vh, lds, wid, lane);
        if (NT > 1) attn_dma_tile<DQK>(Kh + (size_t)64 * 64, Kr + (size_t)64 * (DQK - 64), Vh + (size_t)64 * 64, lds + AT_BUF, wid, lane);
#pragma unroll
        for (int d0 = 0; d0 < ND; ++d0) qr[d0] = *(const bf16x8*)(Q0 + (size_t)(wid * 32 + r32) * qpitch + d0 * 16 + hi * 8);
    }
    float mhat = 0.f, lrun = 0.f;
    f32x16 o0, o1, negm, p0, p1;
#pragma unroll
    for (int r = 0; r < 16; ++r) { o0[r] = 0.f; o1[r] = 0.f; negm[r] = 0.f; }
    asm volatile("" : "+v"(negm));
    LAS float* wsf = (LAS float*)(lds + AT_WS) + wid * 64;
    const int qrel = wid * 32 + r32;
    __syncthreads();
    const int NB = CAUSAL ? NT - 4 : NT;
    for (int t = 0; t < NB; ++t) {
        const bool more = t + 2 < NT;
        LAS unsigned char* kb = lds + (t % 3) * AT_BUF;
#if AT_DMAMID
        at_qk<DQK, false>(p0, p1, qr, negm, kb, -1, qrel, r32, hi, [&]() __attribute__((always_inline)) { if (more) attn_dma_tile<DQK>(Kh + (size_t)(t + 2) * 64 * 64, Kr + (size_t)(t + 2) * 64 * (DQK - 64), Vh + (size_t)(t + 2) * 64 * 64, lds + ((t + 2) % 3) * AT_BUF, wid, lane); });
#else
        if (more) attn_dma_tile<DQK>(Kh + (size_t)(t + 2) * 64 * 64, Kr + (size_t)(t + 2) * 64 * (DQK - 64), Vh + (size_t)(t + 2) * 64 * 64, lds + ((t + 2) % 3) * AT_BUF, wid, lane);
        at_qk<DQK, false>(p0, p1, qr, negm, kb, -1, qrel, r32, hi, []() {});
#endif
        at_sp(p0, p1, negm, o0, o1, mhat, lrun, t == 0, wsf, kb + AT_V, lane, r32, hi);
        AT_ENDWAIT(more);
    }
    if (CAUSAL) {
        for (int t = NB; t < NT; ++t) {
            const bool more = t + 2 < NT;
            if (more) attn_dma_tile<DQK>(Kh + (size_t)(t + 2) * 64 * 64, Kr + (size_t)(t + 2) * 64 * (DQK - 64), Vh + (size_t)(t + 2) * 64 * 64, lds + ((t + 2) % 3) * AT_BUF, wid, lane);
            const int jb = t - NB;
            if (!(64 * jb > 32 * wid + 31)) { LAS unsigned char* kb = lds + (t % 3) * AT_BUF;
                at_qk<DQK, true>(p0, p1, qr, negm, kb, jb, qrel, r32, hi, []() {});
                at_sp(p0, p1, negm, o0, o1, mhat, lrun, t == 0, wsf, kb + AT_V, lane, r32, hi); }
            AT_ENDWAIT(more);
        }
    }
    if (nQ0) {
        attn_dma_tile<DQK>(nKh, nKr, nVh, lds, wid, lane);
        if (nNT > 1) attn_dma_tile<DQK>(nKh + (size_t)64 * 64, nKr + (size_t)64 * (DQK - 64), nVh + (size_t)64 * 64, lds + AT_BUF, wid, lane);
#pragma unroll
        for (int d0 = 0; d0 < ND; ++d0) qr[d0] = *(const bf16x8*)(nQ0 + (size_t)(wid * 32 + r32) * qpitch + d0 * 16 + hi * 8);
    }
    lrun += __shfl_xor(lrun, 32);
    if (hi == 0) wsf[32 + r32] = lrun;
    LDS_WAIT();
    LAS bf16* stg = (LAS bf16*)(lds + AT_OST) + wid * 2048;
#pragma unroll
    for (int r = 0; r < 16; ++r) { const int orow = crow(r, hi); const float rl = __builtin_amdgcn_rcpf(wsf[32 + orow]);
        stg[orow * 64 + r32] = (bf16)(cvt_pk_bf16(o0[r] * rl, 0.f) & 0xffffu); stg[orow * 64 + 32 + r32] = (bf16)(cvt_pk_bf16(o1[r] * rl, 0.f) & 0xffffu); }
    LDS_WAIT();
#pragma unroll
    for (int i = 0; i < 4; ++i) { const int row = i * 8 + (lane >> 3), ch = lane & 7; const v4u v = *(const LAS v4u*)(stg + row * 64 + ch * 8);
#if NT_O
        __builtin_nontemporal_store(v, (v4u*)(O0 + (size_t)(wid * 32 + row) * opitch + ch * 8)); }
#else
        *(v4u*)(O0 + (size_t)(wid * 32 + row) * opitch + ch * 8) = v; }
#endif
    LDS_WAIT();
}

#undef AT_ENDWAIT
constexpr int DC_TSTR = 2080, DC_TB = 16 * DC_TSTR, DC_T0 = 0, DC_KR0 = 2 * DC_TB, DC_KRB = 4 * DC_TSTR, DC_P = DC_KR0 + 2 * DC_KRB, DC_AL = DC_P + 4096, DC_Q = DC_AL + 64, DC_QA = DC_Q + 8 * 192;
static_assert(DC_QA + 8 * 1024 <= RING_BYTES, "decode LDS");
constexpr int DC_STG = DC_QA + 8 * 1024, DC_STGK = XCH_OFF;
static_assert(DC_STG + 32768 <= RING_BYTES && DC_STGK + 8192 <= LDS_BYTES, "decode staging");
constexpr int DPART_STRIDE = 8 * 132;
template <bool B> struct BoolTag { static constexpr bool value = B; };
struct DecPre { f32x4 c[4]; f32x4 k; };
__device__ __forceinline__ void dec_load_half(DecPre& P, const float* ck, const float* kr, int hf, int tid) {
#pragma unroll
    for (int it = 0; it < 4; ++it) P.c[it] = *(const f32x4*)((const char*)(ck + 2048 * (4 * hf + it)) + (unsigned)tid * 16u);
    P.k = *(const f32x4*)((const char*)(kr + 2048 * hf) + (unsigned)tid * 16u);
}
#if DEC_NT
#define DEC_NT_SFX " nt"
#define DEC_NT_AUX 2
#else
#define DEC_NT_SFX ""
#define DEC_NT_AUX 0
#endif
__device__ __forceinline__ void dec_load_half_raw(DecPre& P, const float* ck, const float* kr, int hf, int tid) {
    const unsigned vo = (unsigned)tid * 16u;
#pragma unroll
    for (int it = 0; it < 4; ++it) { const float* bp = ck + 2048 * (4 * hf + it); asm volatile("global_load_dwordx4 %0, %1, %2" DEC_NT_SFX : "=v"(P.c[it]) : "v"(vo), "s"(bp) : "memory"); }
    { const float* bp = kr + 2048 * hf; asm volatile("global_load_dwordx4 %0, %1, %2" DEC_NT_SFX : "=v"(P.k) : "v"(vo), "s"(bp) : "memory"); }
}
template <int N> __device__ __forceinline__ void dec_wait_pre(DecPre& P) {
    asm volatile("s_waitcnt vmcnt(%5)" : "+v"(P.c[0]), "+v"(P.c[1]), "+v"(P.c[2]), "+v"(P.c[3]), "+v"(P.k) : "n"(N) : "memory");
}
__device__ __forceinline__ void dec_load_newtok_half(DecPre& P, const bf16* ckn, const bf16* krn, int hf, int tid) {
#pragma unroll
    for (int it = 0; it < 4; ++it) { const int i4 = tid + 512 * (4 * hf + it); f32x4 v = (f32x4){0.f, 0.f, 0.f, 0.f};
        if ((i4 >> 5) == 0) { const v2u w = *(const v2u*)(ckn + 4 * (i4 & 31)); v = (f32x4){bflo(w.x), bfhi(w.x), bflo(w.y), bfhi(w.y)}; } P.c[it] = v; }
    { const int j4 = tid + 512 * hf; f32x4 v = (f32x4){0.f, 0.f, 0.f, 0.f};
        if ((j4 >> 3) == 0) { const v2u w = *(const v2u*)(krn + 4 * (j4 & 7)); v = (f32x4){bflo(w.x), bfhi(w.x), bflo(w.y), bfhi(w.y)}; } P.k = v; }
}
__device__ __forceinline__ void dec_store_half(const DecPre& P, LAS unsigned char* T, LAS unsigned char* KR, int hf, int tid) {
#pragma unroll
    for (int it = 0; it < 4; ++it) { const int i4 = tid + 512 * (4 * hf + it), key = i4 >> 5, l4 = i4 & 31;
        v2u w; w.x = cvt_pk_bf16(P.c[it][0], P.c[it][1]); w.y = cvt_pk_bf16(P.c[it][2], P.c[it][3]);
        *(LAS v2u*)(T + (l4 >> 1) * DC_TSTR + key * 16 + (l4 & 1) * 8) = w; }
    { const int j4 = tid + 512 * hf, key = j4 >> 3, c4 = j4 & 7;
        v2u w; w.x = cvt_pk_bf16(P.k[0], P.k[1]); w.y = cvt_pk_bf16(P.k[2], P.k[3]);
        *(LAS v2u*)(KR + (c4 >> 1) * DC_TSTR + key * 16 + (c4 & 1) * 8) = w; }
}
__device__ __forceinline__ void dec_dma_half(const float* ck, const float* kr, int hf, int tid, int wid, LAS unsigned char* lds) {
#pragma unroll
    for (int it = 0; it < 4; ++it)
        __builtin_amdgcn_global_load_lds((const unsigned*)((const char*)(ck + 2048 * (4 * hf + it)) + (unsigned)tid * 16u), (LAS unsigned*)(lds + DC_STG + it * 8192 + wid * 1024), 16, 0, DEC_NT_AUX);
    __builtin_amdgcn_global_load_lds((const unsigned*)((const char*)(kr + 2048 * hf) + (unsigned)tid * 16u), (LAS unsigned*)(lds + DC_STGK + wid * 1024), 16, 0, DEC_NT_AUX);
}
__device__ __forceinline__ void dec_stage_to_pre(DecPre& P, int tid, LAS unsigned char* lds) {
#pragma unroll
    for (int it = 0; it < 4; ++it) P.c[it] = *(const LAS f32x4*)(lds + DC_STG + it * 8192 + tid * 16);
    P.k = *(const LAS f32x4*)(lds + DC_STGK + tid * 16);
}
__device__ __forceinline__ void decode_item(const Frame& F, int b, int half) {
    LAS unsigned char* lds = F.lds;
    int tid_ = F.tid; asm volatile("" : "+v"(tid_));
    const int tid = tid_, lane = tid & 63, wid = F.wave, r32 = lane & 31, hi = lane >> 5, fr = lane & 15, fq = lane >> 4;
    const bf16* wkv = (const bf16*)(F.ws + WS_WKV);
    const float* g_kn = F.in[22];
    __syncthreads();
#if DEC_PRIO
    if (wid >= 4) __builtin_amdgcn_s_setprio(1);
#endif
    LAS bf16* qrow = (LAS bf16*)(lds + DC_Q) + wid * 96;
    { const float* qs = (const float*)(F.ws + WS_QS) + (size_t)b * 768; const float epsq = EPS * (((const float*)(F.ws + WS_MSQ))[NTOK + b] + EPS); const int h = wid;
      const float rn = qs[256 * (h >> 2) + 128 * (lane >> 5) + 32 * (h & 3) + (lane & 31)];
      const float qn = rn * (__builtin_amdgcn_rsqf(wave_sum(rn * rn) * (1.0f / 64.0f) + epsq) * pg8::kC2Q) * F.in[17][lane];
      const float rr = lane < 32 ? qs[512 + 128 * (h >> 2) + 32 * (h & 3) + lane] : 0.f;
      const float w = rr * __builtin_amdgcn_rsqf(wave_sum(rr * rr) * (1.0f / 32.0f) + epsq) * F.in[18][lane & 31]; const float other = __shfl_xor(w, 16);
      const float* rp = (const float*)(F.ws + WS_ROPE) + (size_t)8192 * 32; const int i = lane & 15; const float cs = rp[i], sn = rp[16 + i];
      const float o = ((lane & 16) ? (other * sn + w * cs) : (w * cs - other * sn)) * pg8::kC2Q;
      const bf16 qnb = (bf16)(cvt_pk_bf16(qn, 0.f) & 0xffffu), qrb = (bf16)(cvt_pk_bf16(o, 0.f) & 0xffffu);
      qrow[lane] = qnb; if (lane < 32) qrow[64 + lane] = qrb;
      if (half == 0) { bf16* qg_ = (bf16*)(F.ws + WS_QB) + (size_t)(NTOK + b) * 768 + h * 96; qg_[lane] = qnb; if (lane < 32) qg_[64 + lane] = qrb; }
    }
    LDS_WAIT();
    bf16x8 wA[8][2];
    { const int pn = wid >> 2, wc = wid & 3; const unsigned loff = (unsigned)(r32 * 128 + 8 * hi) * 2u;
#pragma unroll
      for (int dt = 0; dt < 2; ++dt) { const char* rowp = (const char*)(wkv + (size_t)(256 * pn + 128 * dt + 32 * wc) * 128);
#pragma unroll
        for (int s = 0; s < 8; ++s) wA[s][dt] = *(const bf16x8*)(rowp + 32 * s + loff); } }
    float qg[2][16];
#pragma unroll
    for (int dt = 0; dt < 2; ++dt)
#pragma unroll
        for (int r = 0; r < 16; ++r) { const int d = 32 * dt + crow(r, hi); qg[dt][r] = g_kn[d] * bf2f(qrow[d]); }
    { v4u w = (v4u){0u, 0u, 0u, 0u}; if ((fr & 3) == 0) w = *(const LAS v4u*)(qrow + 64 + 8 * fq); *(LAS v4u*)(lds + DC_QA + wid * 1024 + lane * 16) = w; }
    for (int i = tid; i < 8 * 64; i += 512) ((LAS unsigned*)(lds + DC_P + 8 * 256))[i] = 0u;
    float mrun = -INFINITY, lrun = 0.f;
    f32x4 accL = (f32x4){0.f, 0.f, 0.f, 0.f};
    const int* ptab = (const int*)F.in[5] + b * NPAGES + half * 64;
    const int ptv = ptab[lane];
    const int npg = 64 + (half == 1 ? 1 : 0);
    const bf16* ckn = (const bf16*)(F.ws + WS_CKVB) + (size_t)(NTOK + b) * 128;
    const bf16* krn = (const bf16*)(F.ws + WS_KRB) + (size_t)(NTOK + b) * 32;
    DecPre pre;
    { const int page = __builtin_amdgcn_readlane(ptv, 0); const float* ck0 = F.in[3] + (size_t)page * (PAGE * 128); const float* kr0 = F.in[4] + (size_t)page * (PAGE * 32);
      dec_load_half(pre, ck0, kr0, 0, tid); dec_store_half(pre, lds + DC_T0, lds + DC_KR0, 0, tid);
      dec_load_half(pre, ck0, kr0, 1, tid); dec_store_half(pre, lds + DC_T0, lds + DC_KR0, 1, tid); }
    { const int page = __builtin_amdgcn_readlane(ptv, 1); const float* ck1 = F.in[3] + (size_t)page * (PAGE * 128); const float* kr1 = F.in[4] + (size_t)page * (PAGE * 32);
      dec_load_half_raw(pre, ck1, kr1, 0, tid); dec_dma_half(ck1, kr1, 1, tid, wid, lds); }
    asm volatile("s_waitcnt lgkmcnt(0)\n\ts_barrier" ::: "memory");
    auto page_body = [&](const int pg, auto steady_tag) __attribute__((always_inline)) {
        constexpr bool STEADY = decltype(steady_tag)::value;
        const bool newtok = !STEADY && pg == 64;
        LAS unsigned char* T = lds + DC_T0 + (pg & 1) * DC_TB; LAS unsigned char* KR = lds + DC_KR0 + (pg & 1) * DC_KRB;
        LAS unsigned char* Tn = lds + DC_T0 + ((pg + 1) & 1) * DC_TB; LAS unsigned char* KRn = lds + DC_KR0 + ((pg + 1) & 1) * DC_KRB;
        const bool more = STEADY || pg + 1 < npg, nextnew = !STEADY && pg + 1 >= 64, more2 = STEADY || pg + 2 < npg, next2new = !STEADY && pg + 2 >= 64, real2 = more2 && !next2new;
        const float* ck2 = nullptr; const float* kr2 = nullptr;
        if (real2) { const int page = __builtin_amdgcn_readlane(ptv, pg + 2); ck2 = F.in[3] + (size_t)page * (PAGE * 128); kr2 = F.in[4] + (size_t)page * (PAGE * 32); }
        float sc[4], sr4[4];
#define DS_R128(dst, addr, off) asm volatile("ds_read_b128 %0, %1 offset:%2" : "=v"(dst) : "v"(addr), "n"(off) : "memory")
#define LW3(bb) asm volatile("s_waitcnt lgkmcnt(3)" : "+v"(bb) :: "memory")
#define SB() __builtin_amdgcn_sched_barrier(0)
        typedef float f32x2 __attribute__((ext_vector_type(2)));
#if PROBE_VALU2
#define VP(acc_, dt_, r_, sv_, dv_) do { const f32x2 x_ = (f32x2){acc_[r_], acc_[(r_) + 1]}; sv_ = x_ * x_ + sv_; dv_ = x_ * (f32x2){qg[dt_][r_], qg[dt_][(r_) + 1]} + dv_; \
        asm volatile("v_pk_fma_f32 %0, %1, %1, %0\n\tv_pk_fma_f32 %0, %1, %1, %0" : "+v"(dumv) : "v"(x_)); } while (0)
        f32x2 dumv = (f32x2){0.f, 0.f};
#else
#define VP(acc_, dt_, r_, sv_, dv_) do { const f32x2 x_ = (f32x2){acc_[r_], acc_[(r_) + 1]}; sv_ = x_ * x_ + sv_; dv_ = x_ * (f32x2){qg[dt_][r_], qg[dt_][(r_) + 1]} + dv_; } while (0)
#endif
        const unsigned tb0 = (unsigned)(uintptr_t)T + hi * DC_TSTR + r32 * 16, kb0 = (unsigned)(uintptr_t)KR + fq * DC_TSTR + fr * 16, qa0 = (unsigned)(uintptr_t)(lds + DC_QA) + wid * 1024 + lane * 16;
        bf16x8 b0, b1, b2, b3;
        {
            bf16x8 qrA, kf[8];
            DS_R128(qrA, qa0, 0);
            DS_R128(kf[0], kb0, 0); DS_R128(kf[1], kb0, 256); DS_R128(kf[2], kb0, 512); DS_R128(kf[3], kb0, 768); DS_R128(kf[4], kb0, 1024); DS_R128(kf[5], kb0, 1280); DS_R128(kf[6], kb0, 1536); DS_R128(kf[7], kb0, 1792);
            DS_R128(b0, tb0, 0); DS_R128(b1, tb0, 2 * DC_TSTR); DS_R128(b2, tb0, 4 * DC_TSTR); DS_R128(b3, tb0, 6 * DC_TSTR);
            SB();
            asm volatile("s_waitcnt lgkmcnt(4)" : "+v"(qrA), "+v"(kf[0]), "+v"(kf[1]), "+v"(kf[2]), "+v"(kf[3]), "+v"(kf[4]), "+v"(kf[5]), "+v"(kf[6]), "+v"(kf[7]) :: "memory");
            SB();
            const f32x4 z4 = (f32x4){0.f, 0.f, 0.f, 0.f};
#pragma unroll
            for (int g = 0; g < 4; ++g) {
                const f32x4 rr0 = __builtin_amdgcn_mfma_f32_16x16x32_bf16(qrA, kf[2 * g], z4, 0, 0, 0), rr1 = __builtin_amdgcn_mfma_f32_16x16x32_bf16(qrA, kf[2 * g + 1], z4, 0, 0, 0);
                sr4[g] = (r32 < 16) ? rr0[0] : rr1[0];
            }
            SB();
        }
        f32x16 a0, a1;
        f32x2 s0v, d0v, s1v, d1v; const f32x2 z2 = (f32x2){0.f, 0.f};
#define DEC_FIN(gg) do { float ssq = (s0v[0] + s0v[1]) + (s1v[0] + s1v[1]), dot = (d0v[0] + d0v[1]) + (d1v[0] + d1v[1]); \
            { auto t = __builtin_amdgcn_permlane32_swap(__float_as_uint(ssq), __float_as_uint(ssq), false, false); ssq = __uint_as_float(t[0]) + __uint_as_float(t[1]); } \
            { auto t = __builtin_amdgcn_permlane32_swap(__float_as_uint(dot), __float_as_uint(dot), false, false); dot = __uint_as_float(t[0]) + __uint_as_float(t[1]); } \
            float sv = dot * __builtin_amdgcn_rsqf(ssq * (1.0f / 64.0f) + EPS) + sr4[gg]; \
            if (newtok && (32 * (gg) + r32) != 0) sv = -INFINITY; \
            sc[gg] = sv; } while (0)
#pragma unroll
        for (int g = 0; g < 4; ++g) {
#pragma unroll
            for (int r = 0; r < 16; ++r) a0[r] = 0.f;
            if (g > 0) { s1v = (f32x2){0.f, 0.f}; d1v = (f32x2){0.f, 0.f}; }
            SB();
#define XS(i_, bb, off_, VAL) LW3(bb); SB(); a0 = __builtin_amdgcn_mfma_f32_32x32x16_bf16(wA[i_][0], bb, a0, 0, 0, 0); SB(); DS_R128(bb, tb0, off_); SB(); if (g > 0) { VAL; } SB()
            XS(0, b0,  8 * DC_TSTR + 512 * g, (void)0);
            XS(1, b1, 10 * DC_TSTR + 512 * g, VP(a1, 1, 0, s1v, d1v));
            XS(2, b2, 12 * DC_TSTR + 512 * g, VP(a1, 1, 2, s1v, d1v));
            XS(3, b3, 14 * DC_TSTR + 512 * g, VP(a1, 1, 4, s1v, d1v));
            XS(4, b0,  0 * DC_TSTR + 512 * g, VP(a1, 1, 6, s1v, d1v));
            XS(5, b1,  2 * DC_TSTR + 512 * g, VP(a1, 1, 8, s1v, d1v));
            XS(6, b2,  4 * DC_TSTR + 512 * g, VP(a1, 1, 10, s1v, d1v));
            XS(7, b3,  6 * DC_TSTR + 512 * g, VP(a1, 1, 12, s1v, d1v); VP(a1, 1, 14, s1v, d1v));
#undef XS
#pragma unroll
            for (int r = 0; r < 16; ++r) a1[r] = 0.f;
            SB();
#define YS(i_, bb, WAITST, READST, VAL) WAITST; SB(); a1 = __builtin_amdgcn_mfma_f32_32x32x16_bf16(wA[i_][1], bb, a1, 0, 0, 0); SB(); READST; SB(); VAL; SB()
            YS(0, b0, LW3(b0), DS_R128(b0, tb0,  8 * DC_TSTR + 512 * g), if (g > 0) DEC_FIN(g - 1); s0v = z2; d0v = z2);
            YS(1, b1, LW3(b1), DS_R128(b1, tb0, 10 * DC_TSTR + 512 * g), VP(a0, 0, 0, s0v, d0v));
            YS(2, b2, LW3(b2), DS_R128(b2, tb0, 12 * DC_TSTR + 512 * g), VP(a0, 0, 2, s0v, d0v));
            YS(3, b3, LW3(b3), DS_R128(b3, tb0, 14 * DC_TSTR + 512 * g), VP(a0, 0, 4, s0v, d0v));
            if (g < 3) {
                YS(4, b0, LW3(b0), DS_R128(b0, tb0, 0 * DC_TSTR + 512 * (g + 1)), VP(a0, 0, 6, s0v, d0v));
                YS(5, b1, LW3(b1), DS_R128(b1, tb0, 2 * DC_TSTR + 512 * (g + 1)), VP(a0, 0, 8, s0v, d0v));
                YS(6, b2, LW3(b2), DS_R128(b2, tb0, 4 * DC_TSTR + 512 * (g + 1)), VP(a0, 0, 10, s0v, d0v));
                YS(7, b3, LW3(b3), DS_R128(b3, tb0, 6 * DC_TSTR + 512 * (g + 1)), VP(a0, 0, 12, s0v, d0v); VP(a0, 0, 14, s0v, d0v));
            } else {
                YS(4, b0, LW3(b0), (void)0, VP(a0, 0, 6, s0v, d0v));
                YS(5, b1, asm volatile("s_waitcnt lgkmcnt(2)" : "+v"(b1) :: "memory"), (void)0, VP(a0, 0, 8, s0v, d0v));
                YS(6, b2, asm volatile("s_waitcnt lgkmcnt(1)" : "+v"(b2) :: "memory"), (void)0, VP(a0, 0, 10, s0v, d0v));
                YS(7, b3, asm volatile("s_waitcnt lgkmcnt(0)" : "+v"(b3) :: "memory"), (void)0, VP(a0, 0, 12, s0v, d0v); VP(a0, 0, 14, s0v, d0v));
            }
#undef YS
            if (g == 1 && more) {
                if (STEADY) dec_wait_pre<5>(pre); else dec_wait_pre<0>(pre);
                dec_store_half(pre, Tn, KRn, 0, tid);
                __builtin_amdgcn_sched_barrier(0);
                if (more2) { if (!next2new) dec_load_half_raw(pre, ck2, kr2, 0, tid); else dec_load_newtok_half(pre, ckn, krn, 0, tid); }
                __builtin_amdgcn_sched_barrier(0);
            }
        }
        s1v = (f32x2){0.f, 0.f}; d1v = (f32x2){0.f, 0.f};
#pragma unroll
        for (int r = 0; r < 16; r += 2) VP(a1, 1, r, s1v, d1v);
        DEC_FIN(3);
#undef DS_R128
#undef LW3
#undef SB
#undef VP
#undef DEC_FIN
        const float pm = fmaxf(fmaxf(sc[0], sc[1]), fmaxf(sc[2], sc[3]));
        float alpha = 1.0f;
        if (__any(pm > mrun + 8.0f)) {
            const float mn = fmaxf(mrun, wave_max(pm));
            alpha = __builtin_amdgcn_exp2f(mrun - mn);
            mrun = mn; lrun *= alpha;
        }
#pragma unroll
        for (int g = 0; g < 4; ++g) { sc[g] = __builtin_amdgcn_exp2f(sc[g] - mrun); lrun += sc[g]; }
        if (hi == 0) {
#pragma unroll
            for (int g = 0; g < 4; ++g) ((LAS bf16*)(lds + DC_P))[wid * 128 + 32 * g + r32] = (bf16)(cvt_pk_bf16(sc[g], 0.f) & 0xffffu);
        }
        if (lane == 0) ((LAS float*)(lds + DC_AL))[wid] = alpha;
        asm volatile("s_waitcnt lgkmcnt(0)\n\ts_barrier" ::: "memory");
        DecPre st;
        if (more && !nextnew) {
            if (real2) asm volatile("s_waitcnt vmcnt(5)" ::: "memory"); else asm volatile("s_waitcnt vmcnt(0)" ::: "memory");
            dec_stage_to_pre(st, tid, lds);
        }
        {
            const int q = fr >> 2, p = fr & 3;
            const f32x4 al4 = *(const LAS f32x4*)(lds + DC_AL + (fq & 1) * 16);
            bf16x8 pa[4];
#pragma unroll
            for (int ks = 0; ks < 4; ++ks) pa[ks] = *(const LAS bf16x8*)(lds + DC_P + fr * 256 + (32 * ks + 8 * fq) * 2);
            const unsigned a0 = (unsigned)(uintptr_t)T + (2 * wid + (p >> 1)) * DC_TSTR + (8 * fq + q) * 16 + (p & 1) * 8;
            s16x4 lo0, hh0, lo1, hh1, lo2, hh2, lo3, hh3;
            asm volatile("ds_read_b64_tr_b16 %0, %8\n\tds_read_b64_tr_b16 %1, %8 offset:64\n\tds_read_b64_tr_b16 %2, %8 offset:512\n\tds_read_b64_tr_b16 %3, %8 offset:576\n\t"
                         "ds_read_b64_tr_b16 %4, %8 offset:1024\n\tds_read_b64_tr_b16 %5, %8 offset:1088\n\tds_read_b64_tr_b16 %6, %8 offset:1536\n\tds_read_b64_tr_b16 %7, %8 offset:1600\n\ts_waitcnt lgkmcnt(0)"
                         : "=&v"(lo0), "=&v"(hh0), "=&v"(lo1), "=&v"(hh1), "=&v"(lo2), "=&v"(hh2), "=&v"(lo3), "=&v"(hh3) : "v"(a0) : "memory");
            accL = accL * al4;
            accL = __builtin_amdgcn_mfma_f32_16x16x32_bf16(pa[0], (bf16x8){lo0[0], lo0[1], lo0[2], lo0[3], hh0[0], hh0[1], hh0[2], hh0[3]}, accL, 0, 0, 0);
            accL = __builtin_amdgcn_mfma_f32_16x16x32_bf16(pa[1], (bf16x8){lo1[0], lo1[1], lo1[2], lo1[3], hh1[0], hh1[1], hh1[2], hh1[3]}, accL, 0, 0, 0);
            accL = __builtin_amdgcn_mfma_f32_16x16x32_bf16(pa[2], (bf16x8){lo2[0], lo2[1], lo2[2], lo2[3], hh2[0], hh2[1], hh2[2], hh2[3]}, accL, 0, 0, 0);
            accL = __builtin_amdgcn_mfma_f32_16x16x32_bf16(pa[3], (bf16x8){lo3[0], lo3[1], lo3[2], lo3[3], hh3[0], hh3[1], hh3[2], hh3[3]}, accL, 0, 0, 0);
        }
        if (more && !nextnew) {
            dec_store_half(st, Tn, KRn, 1, tid);
            if (real2) dec_dma_half(ck2, kr2, 1, tid, wid, lds);
        }
        asm volatile("s_waitcnt lgkmcnt(0)\n\ts_barrier" ::: "memory");
    };
    for (int pg = 0; pg < 62; ++pg) page_body(pg, BoolTag<true>{});
    for (int pg = 62; pg < npg; ++pg) page_body(pg, BoolTag<false>{});
#if DEC_PRIO
    __builtin_amdgcn_s_setprio(0);
#endif
    { int l2 = threadIdx.x; asm volatile("" : "+v"(l2)); l2 &= 63; const int fr2 = l2 & 15, fq2 = l2 >> 4;
      float* part = (float*)(F.ws + WS_DPART) + (size_t)(b * 2 + half) * DPART_STRIDE;
      const float ltot = wave_sum(lrun) * 0.5f;
      if (l2 == 0) { part[wid * 132 + 0] = mrun; part[wid * 132 + 1] = ltot; }
      if (fq2 < 2) {
#pragma unroll
          for (int i = 0; i < 4; ++i) part[(4 * fq2 + i) * 132 + 4 + 16 * wid + fr2] = accL[i];
      } }
}
__device__ __forceinline__ v4u norm8_pack(const float (&v)[8], float inv) {
    v4u w; w.x = cvt_pk_bf16(v[0] * inv, v[1] * inv); w.y = cvt_pk_bf16(v[2] * inv, v[3] * inv); w.z = cvt_pk_bf16(v[4] * inv, v[5] * inv); w.w = cvt_pk_bf16(v[6] * inv, v[7] * inv); return w;
}
__device__ __forceinline__ v2u norm4_pack(const float (&v)[4], float inv) { v2u w; w.x = cvt_pk_bf16(v[0] * inv, v[1] * inv); w.y = cvt_pk_bf16(v[2] * inv, v[3] * inv); return w; }
__device__ __forceinline__ void tp_finish_row(bf16* omix_row, const float (&a)[8], const float (&y)[4], const float (&mo)[4], int lane, int parts = 3) {
    if (parts & 1) {
        float sa = 0.f;
#pragma unroll
        for (int i = 0; i < 8; ++i) sa += a[i] * a[i];
        sa = wave_sum(sa);
        const float ia = __builtin_amdgcn_rsqf(sa * (1.0f / 512.0f) + EPS);
        *(v4u*)(omix_row + 8 * lane) = norm8_pack(a, ia);
    }
    if (parts & 2) {
        float sy = 0.f, sm = 0.f;
#pragma unroll
        for (int i = 0; i < 4; ++i) { sy += y[i] * y[i]; sm += mo[i] * mo[i]; }
        sy = wave_sum(sy); sm = wave_sum(sm);
        const float iy = __builtin_amdgcn_rsqf(sy * (1.0f / 256.0f) + EPS), im = __builtin_amdgcn_rsqf(sm * (1.0f / 256.0f) + EPS);
        *(v2u*)(omix_row + 512 + 4 * lane) = norm4_pack(y, iy);
        *(v2u*)(omix_row + 768 + 4 * lane) = norm4_pack(mo, im);
    }
}
__device__ __forceinline__ void tp_prompt_row(const Frame& F, int r) {
    const int lane = F.lane, t = r & (SEQ - 1);
    const bf16* oab = (const bf16*)(F.ws + WS_OAB); const bf16* omb = (const bf16*)(F.ws + WS_OMB); const bf16* ub = (const bf16*)(F.ws + WS_UB); const bf16* gbb = (const bf16*)(F.ws + WS_GBB);
    const float* cw = F.in[24];
    float a[8], y[4], mo[4];
    { const v4u w = *(const v4u*)(oab + (size_t)r * 512 + 8 * lane); a[0] = bflo(w.x); a[1] = bfhi(w.x); a[2] = bflo(w.y); a[3] = bfhi(w.y); a[4] = bflo(w.z); a[5] = bfhi(w.z); a[6] = bflo(w.w); a[7] = bfhi(w.w); }
    { const v2u w = *(const v2u*)(omb + (size_t)r * 256 + 4 * lane); mo[0] = bflo(w.x); mo[1] = bfhi(w.x); mo[2] = bflo(w.y); mo[3] = bfhi(w.y); }
    { const v2u u0 = *(const v2u*)(ub + (size_t)r * 256 + 4 * lane);
      v2u u1 = (v2u){0u, 0u}, u2 = (v2u){0u, 0u};
      if (t >= 1) u1 = *(const v2u*)(ub + (size_t)(r - 1) * 256 + 4 * lane);
      if (t >= 2) u2 = *(const v2u*)(ub + (size_t)(r - 2) * 256 + 4 * lane);
      const v2u g = *(const v2u*)(gbb + (size_t)r * 256 + 4 * lane);
      const f32x4 w0 = *(const f32x4*)(cw + 4 * lane), w1 = *(const f32x4*)(cw + 256 + 4 * lane), w2 = *(const f32x4*)(cw + 512 + 4 * lane);
      y[0] = bflo(g.x) * (w0[0] * bflo(u2.x) + w1[0] * bflo(u1.x) + w2[0] * bflo(u0.x));
      y[1] = bfhi(g.x) * (w0[1] * bfhi(u2.x) + w1[1] * bfhi(u1.x) + w2[1] * bfhi(u0.x));
      y[2] = bflo(g.y) * (w0[2] * bflo(u2.y) + w1[2] * bflo(u1.y) + w2[2] * bflo(u0.y));
      y[3] = bfhi(g.y) * (w0[3] * bfhi(u2.y) + w1[3] * bfhi(u1.y) + w2[3] * bfhi(u0.y)); }
    tp_finish_row((bf16*)(F.ws + WS_OMIX) + (size_t)r * D, a, y, mo, lane);
}
__device__ __forceinline__ void tp_sample_wg(const Frame& F, int b, int parts = 3) {
    const int lane = F.lane, wid = F.wave, r = NTOK + b;
    LAS float* base = (LAS float*)F.lds;
    LAS float* lat = base; LAS float* oA = base + 1024; LAS float* oM = base + 1536; LAS float* yc = base + 1792; LAS float* qf = base + 2048 + (wid & 3) * 64; LAS float* pb = base + 2304 + (wid & 3) * 256;
    __syncthreads();
    if (parts & 1) { const int h = wid; const float* part = (const float*)(F.ws + WS_DPART) + (size_t)(b * 2) * DPART_STRIDE;
      const float m0 = part[h * 132], l0 = part[h * 132 + 1], m1 = part[DPART_STRIDE + h * 132], l1 = part[DPART_STRIDE + h * 132 + 1];
      const float M = fmaxf(m0, m1), e0 = __builtin_amdgcn_exp2f(m0 - M), e1 = __builtin_amdgcn_exp2f(m1 - M);
      const float rl = 1.0f / (l0 * e0 + l1 * e1);
#pragma unroll
      for (int j = 0; j < 2; ++j) { const int c = lane + 64 * j; lat[h * 128 + c] = (part[h * 132 + 4 + c] * e0 + part[DPART_STRIDE + h * 132 + 4 + c] * e1) * rl; }
      LDS_WAIT();
      const float* wuv = F.in[21] + h * 64 + lane; float a = 0.f;
#pragma unroll 32
      for (int l = 0; l < 128; ++l) a += lat[h * 128 + l] * wuv[(size_t)l * 512];
      oA[h * 64 + lane] = a; }
    if (!(parts & 2)) {}
    else if (wid < 4) {
        const int h = wid; const bf16* mqb = (const bf16*)(F.ws + WS_MQB) + (size_t)r * 256; const float* ck = F.in[7] + (size_t)b * (256 * 256); const float* cv = F.in[8] + (size_t)b * (256 * 256);
        qf[lane] = bf2f(mqb[h * 64 + lane]);
        LDS_WAIT();
        float sv[4];
#pragma unroll
        for (int j = 0; j < 4; ++j) { const int n = lane + 64 * j; const float* kp = ck + (size_t)n * 256 + h * 64; float acc = 0.f;
#pragma unroll
            for (int d4 = 0; d4 < 16; ++d4) { const f32x4 kv = *(const f32x4*)(kp + 4 * d4); const f32x4 qv = *(const LAS f32x4*)(qf + 4 * d4); acc += kv[0] * qv[0] + kv[1] * qv[1] + kv[2] * qv[2] + kv[3] * qv[3]; }
            sv[j] = acc; }
        const float mx = wave_max(fmaxf(fmaxf(sv[0], sv[1]), fmaxf(sv[2], sv[3])));
        float ls = 0.f;
#pragma unroll
        for (int j = 0; j < 4; ++j) { sv[j] = __builtin_amdgcn_exp2f(sv[j] - mx); ls += sv[j]; pb[lane + 64 * j] = sv[j]; }
        ls = wave_sum(ls);
        LDS_WAIT();
        float o = 0.f;
#pragma unroll 32
        for (int n = 0; n < 256; ++n) o += pb[n] * cv[(size_t)n * 256 + h * 64 + lane];
        oM[h * 64 + lane] = o / ls;
    } else {
        const int c = (wid - 4) * 64 + lane; const bf16* ub = (const bf16*)(F.ws + WS_UB); const bf16* gbb = (const bf16*)(F.ws + WS_GBB); const float* cw = F.in[24]; const float* st = F.in[6] + (size_t)b * 512;
        yc[c] = bf2f(gbb[(size_t)r * 256 + c]) * (cw[c] * st[c] + cw[256 + c] * st[256 + c] + cw[512 + c] * bf2f(ub[(size_t)r * 256 + c]));
    }
    __syncthreads();
    if (wid == 0) {
        float a[8], y[4], mo[4];
#pragma unroll
        for (int i = 0; i < 8; ++i) a[i] = (parts & 1) ? oA[8 * lane + i] : 0.f;
#pragma unroll
        for (int i = 0; i < 4; ++i) { y[i] = (parts & 2) ? yc[4 * lane + i] : 0.f; mo[i] = (parts & 2) ? oM[4 * lane + i] : 0.f; }
        if (parts & 1) *(v4u*)((bf16*)(F.ws + WS_OAB) + (size_t)r * 512 + 8 * lane) = norm8_pack(a, 1.0f);
        if (parts & 2) *(v2u*)((bf16*)(F.ws + WS_OMB) + (size_t)r * 256 + 4 * lane) = norm4_pack(mo, 1.0f);
        tp_finish_row((bf16*)(F.ws + WS_OMIX) + (size_t)r * D, a, y, mo, lane, parts);
    }
}
__device__ __forceinline__ void tp_phase(const Frame& F) {
    const int gw = F.vcu * NWAVES + F.wave, NGW = F.G * NWAVES;
    for (int r = gw; r < NTOK; r += NGW) tp_prompt_row(F, r);
}
struct ABf16 {
    const bf16* p; int ld;
    static constexpr bool NEEDS_INV = false;
    __device__ __forceinline__ float row_inv(int) const { return 1.f; }
    __device__ __forceinline__ v4u piece(int row, int k, float) const { return *(const v4u*)(p + (size_t)row * ld + k); }
};
struct ASum {
    const float* a; const float* b; float cb;
    static constexpr bool NEEDS_INV = false;
    __device__ __forceinline__ float row_inv(int) const { return 1.f; }
    __device__ __forceinline__ v4u piece(int row, int k, float) const {
        const f32x4 a0 = *(const f32x4*)(a + (size_t)row * 1024 + k), a1 = *(const f32x4*)(a + (size_t)row * 1024 + k + 4);
        const f32x4 b0 = *(const f32x4*)(b + (size_t)row * 1024 + k), b1 = *(const f32x4*)(b + (size_t)row * 1024 + k + 4);
        const f32x4 v0 = a0 + b0 * cb, v1 = a1 + b1 * cb;
        v4u w; w.x = cvt_pk_bf16(v0[0], v0[1]); w.y = cvt_pk_bf16(v0[2], v0[3]); w.z = cvt_pk_bf16(v1[0], v1[1]); w.w = cvt_pk_bf16(v1[2], v1[3]); return w;
    }
};
struct ASilu {
    const float* gu; const float* ssq;
    static constexpr bool NEEDS_INV = true;
    __device__ __forceinline__ float row_inv(int row) const { return pg8::row_inv_from_parts(ssq, NTOK + row); }
    __device__ __forceinline__ v4u piece(int row, int k, float iv) const {
        const float* gp = gu + (size_t)row * FF2 + 256 * (k >> 7) + (k & 127);
        const f32x4 g0 = *(const f32x4*)gp, g1 = *(const f32x4*)(gp + 4), u0 = *(const f32x4*)(gp + 128), u1 = *(const f32x4*)(gp + 132);
        v4u w;
        w.x = cvt_pk_bf16(pg8::silu_mul(g0[0] * iv, u0[0] * iv), pg8::silu_mul(g0[1] * iv, u0[1] * iv)); w.y = cvt_pk_bf16(pg8::silu_mul(g0[2] * iv, u0[2] * iv), pg8::silu_mul(g0[3] * iv, u0[3] * iv));
        w.z = cvt_pk_bf16(pg8::silu_mul(g1[0] * iv, u1[0] * iv), pg8::silu_mul(g1[1] * iv, u1[1] * iv)); w.w = cvt_pk_bf16(pg8::silu_mul(g1[2] * iv, u1[2] * iv), pg8::silu_mul(g1[3] * iv, u1[3] * iv));
        return w;
    }
};
template <int KB, class AProv, int CH = 1>
__device__ __forceinline__ void mini_gemm(const Frame& F, const AProv& A, const bf16* Bt, int K, int N, int item0, float* out, int ldo, float scale) {
    constexpr int PPR = KB / 8, PITCH = (KB + 8) * 2;
    constexpr int A_OFF = 0, B_OFF = 128 * PITCH, INV_OFF = B_OFF + 64 * PITCH;
    static_assert(INV_OFF + 512 <= RING_BYTES && KB % 16 == 0 && (CH == 1 || !AProv::NEEDS_INV), "mini_gemm LDS");
    int tid_ = F.tid; asm volatile("" : "+v"(tid_));
    const int tid = tid_, lane = tid & 63, r32 = lane & 31, hi = lane >> 5, wid = F.wave, rt = wid >> 1, ct = wid & 1;
    LAS unsigned char* lds = F.lds;
    const int nnb = N / 64, nitems = nnb * (K / (KB * CH));
    constexpr int NPA = (128 * PPR + 511) / 512, NPB = (64 * PPR + 511) / 512;
#ifndef MINI_REP
#define MINI_REP 1
#endif
    for (int rep_ = 0; rep_ < MINI_REP; ++rep_)
    for (int it = item0; it < nitems; it += F.G) {
        const int nb = it % nnb, kbase = (it / nnb) * (KB * CH), n0 = nb * 64;
        asm volatile("s_waitcnt lgkmcnt(0)\n\ts_barrier" ::: "memory");
        if (AProv::NEEDS_INV) { if (tid < 128) ((LAS float*)(lds + INV_OFF))[tid] = A.row_inv(tid); __syncthreads(); }
        v4u va[NPA], vb[NPB];
        auto load_chunk = [&](int k0) __attribute__((always_inline)) {
#pragma unroll
            for (int j = 0; j < NPA; ++j) { const int p = tid + 512 * j; const int row = p / PPR, c = p - row * PPR;
                va[j] = (v4u){0u, 0u, 0u, 0u};
                if (p < 128 * PPR) { const float iv = AProv::NEEDS_INV ? ((LAS float*)(lds + INV_OFF))[row] : 1.f; va[j] = A.piece(row, k0 + 8 * c, iv); } }
#pragma unroll
            for (int j = 0; j < NPB; ++j) { const int p = tid + 512 * j; const int n = p / PPR, c = p - n * PPR;
                vb[j] = (v4u){0u, 0u, 0u, 0u};
                if (p < 64 * PPR) vb[j] = *(const v4u*)(Bt + (size_t)(n0 + n) * K + k0 + 8 * c); } };
        load_chunk(kbase);
        f32x16 acc;
#pragma unroll
        for (int r = 0; r < 16; ++r) acc[r] = 0.f;
#pragma unroll
        for (int ch = 0; ch < CH; ++ch) {
            if (ch > 0) asm volatile("s_waitcnt lgkmcnt(0)\n\ts_barrier" ::: "memory");
#pragma unroll
            for (int j = 0; j < NPA; ++j) { const int p = tid + 512 * j; const int row = p / PPR, c = p - row * PPR; if (p < 128 * PPR) *(LAS v4u*)(lds + A_OFF + row * PITCH + c * 16) = va[j]; }
#pragma unroll
            for (int j = 0; j < NPB; ++j) { const int p = tid + 512 * j; const int n = p / PPR, c = p - n * PPR; if (p < 64 * PPR) *(LAS v4u*)(lds + B_OFF + n * PITCH + c * 16) = vb[j]; }
            if (ch + 1 < CH) load_chunk(kbase + (ch + 1) * KB);
            asm volatile("s_waitcnt lgkmcnt(0)\n\ts_barrier" ::: "memory");
            const LAS unsigned char* ap = lds + A_OFF + (32 * rt + r32) * PITCH + 16 * hi; const LAS unsigned char* bp = lds + B_OFF + (32 * ct + r32) * PITCH + 16 * hi;
#pragma unroll
            for (int s = 0; s < KB / 16; ++s) acc = __builtin_amdgcn_mfma_f32_32x32x16_bf16(*(const LAS bf16x8*)(ap + 32 * s), *(const LAS bf16x8*)(bp + 32 * s), acc, 0, 0, 0);
        }
        float* op = out + (size_t)(32 * rt) * ldo + n0 + 32 * ct + r32;
#pragma unroll
        for (int r = 0; r < 16; ++r) unsafeAtomicAdd(op + (size_t)crow(r, hi) * ldo, acc[r] * scale);
    }
    asm volatile("s_waitcnt lgkmcnt(0)\n\ts_barrier" ::: "memory");
}
__device__ __forceinline__ void postz_sample_row(const Frame& F, int b) {
    const int lane = F.lane, r = NTOK + b;
    const float* xr = F.in[2] + (size_t)b * D; const float* d1 = (const float*)(F.ws + WS_D1S) + (size_t)b * D; const float* zr = (const float*)(F.ws + WS_ZS) + (size_t)b * INWP;
    float* x1r = (float*)(F.ws + WS_X1F) + (size_t)r * D;
    float s = 0.f;
#pragma unroll
    for (int j = 0; j < 4; ++j) { const f32x4 v = ((const f32x4*)xr)[lane + 64 * j] + ((const f32x4*)d1)[lane + 64 * j] * 0.5f; ((f32x4*)x1r)[lane + 64 * j] = v; s += (v[0] * v[0] + v[1] * v[1]) + (v[2] * v[2] + v[3] * v[3]); }
    const float inv1 = __builtin_amdgcn_rsqf(wave_sum(s) * (1.0f / 1024.0f) + EPS);
    { const f32x4 v = ((const f32x4*)zr)[lane] * inv1; const float q = wave_sum((v[0] * v[0] + v[1] * v[1]) + (v[2] * v[2] + v[3] * v[3]));
      if (lane == 0) ((float*)(F.ws + WS_MSQ))[r] = q * (1.0f / 256.0f);
      v2u w; w.x = cvt_pk_bf16(v[0], v[1]); w.y = cvt_pk_bf16(v[2], v[3]); ((v2u*)((bf16*)(F.ws + WS_CQB) + (size_t)r * 256))[lane] = w; }
    { const float a0 = zr[256 + 2 * lane] * inv1, a1 = zr[256 + 2 * lane + 1] * inv1; const float ic = __builtin_amdgcn_rsqf(wave_sum(a0 * a0 + a1 * a1) * (1.0f / 128.0f) + EPS);
      const float o0 = a0 * ic * F.in[19][2 * lane], o1 = a1 * ic * F.in[19][2 * lane + 1];
      float* op = F.out + O_CKVS + (size_t)b * 128 + 2 * lane; op[0] = o0; op[1] = o1;
      ((unsigned*)((bf16*)(F.ws + WS_CKVB) + (size_t)r * 128))[lane] = cvt_pk_bf16(o0, o1); }
    { const float a = lane < 32 ? zr[384 + lane] * inv1 : 0.f; const float ik = __builtin_amdgcn_rsqf(wave_sum(a * a) * (1.0f / 32.0f) + EPS);
      const float w = a * ik * F.in[23][lane & 31]; const float other = __shfl_xor(w, 16);
      const float* rp = (const float*)(F.ws + WS_ROPE) + (size_t)8192 * 32; const int i = lane & 15; const float cs = rp[i], sn = rp[16 + i];
      const float o = (lane & 16) ? (other * sn + w * cs) : (w * cs - other * sn);
      if (lane < 32) { F.out[O_KRS + (size_t)b * 32 + lane] = o; ((bf16*)(F.ws + WS_KRB))[(size_t)r * 32 + lane] = (bf16)(cvt_pk_bf16(o, 0.f) & 0xffffu); } }
    { const int j = 4 * lane; const int zo = j < 128 ? 512 + j : 768 + (j - 128);
      const f32x4 ui = *(const f32x4*)(zr + zo) * inv1, gc = *(const f32x4*)(zr + zo + 128) * inv1; const f32x4 u = gc * ui;
      v2u w; w.x = cvt_pk_bf16(u[0], u[1]); w.y = cvt_pk_bf16(u[2], u[3]); ((v2u*)((bf16*)(F.ws + WS_UB) + (size_t)r * 256))[lane] = w;
      *(f32x4*)(F.out + O_CONVS + (size_t)b * 512 + 256 + j) = u;
      const f32x4 gb = *(const f32x4*)(zr + 1024 + j) * inv1; w.x = cvt_pk_bf16(gb[0], gb[1]); w.y = cvt_pk_bf16(gb[2], gb[3]); ((v2u*)((bf16*)(F.ws + WS_GBB) + (size_t)r * 256))[lane] = w;
      const int h = j >> 6, d = j & 63; const f32x4 mq = *(const f32x4*)(zr + 1280 + 128 * (d >> 5) + 32 * h + (d & 31)) * inv1;
      float q = (mq[0] * mq[0] + mq[1] * mq[1]) + (mq[2] * mq[2] + mq[3] * mq[3]);
      q += __shfl_xor(q, 1); q += __shfl_xor(q, 2); q += __shfl_xor(q, 4); q += __shfl_xor(q, 8);
      const float im = __builtin_amdgcn_rsqf(q * (1.0f / 64.0f) + EPS) * pg8::kC2M; const f32x4 g = *(const f32x4*)(F.in[28] + d); const f32x4 o = mq * im * g;
      w.x = cvt_pk_bf16(o[0], o[1]); w.y = cvt_pk_bf16(o[2], o[3]); ((v2u*)((bf16*)(F.ws + WS_MQB) + (size_t)r * 256))[lane] = w; }
}
__device__ __forceinline__ void q_sample_gemv(const Frame& F, int b) {
    const int lane = F.lane, wid = F.wave, r = NTOK + b;
    LAS float* cq = (LAS float*)F.lds;
    __syncthreads();
    { const bf16* cqr = (const bf16*)(F.ws + WS_CQB) + (size_t)r * 256; if (F.tid < 256) cq[F.tid] = bf2f(cqr[F.tid]); }
    __syncthreads();
    const bf16* W = (const bf16*)(F.ws + WS_WUQ);
    float* qs = (float*)(F.ws + WS_QS) + (size_t)b * 768;
    for (int jj = 0; jj < 2; ++jj) {
        const int j = lane + 64 * jj; if (j >= 96) break;
        const int n = 96 * wid + j;
        const bf16* wrow = W + (size_t)n * 256;
        float acc = 0.f;
#pragma unroll 8
        for (int c = 0; c < 32; ++c) { const v4u w = *(const v4u*)(wrow + 8 * c); const f32x4 c0 = *(const LAS f32x4*)(cq + 8 * c), c1 = *(const LAS f32x4*)(cq + 8 * c + 4);
            acc += (bflo(w.x) * c0[0] + bfhi(w.x) * c0[1]) + (bflo(w.y) * c0[2] + bfhi(w.y) * c0[3]) + (bflo(w.z) * c1[0] + bfhi(w.z) * c1[1]) + (bflo(w.w) * c1[2] + bfhi(w.w) * c1[3]); }
        qs[n] = acc;
    }
    __syncthreads();
}
__device__ __forceinline__ void x2_sample_row(const Frame& F, int b) {
    const int lane = F.lane, r = NTOK + b;
    const float* x1r = (const float*)(F.ws + WS_X1F) + (size_t)r * D; const float* d7 = (const float*)(F.ws + WS_D7S) + (size_t)b * D; float* x2r = (float*)(F.ws + WS_X2F) + (size_t)r * D; float* yr = F.out + O_YS + (size_t)b * D;
    float s = 0.f;
#pragma unroll
    for (int j = 0; j < 4; ++j) { const f32x4 v = ((const f32x4*)x1r)[lane + 64 * j] + ((const f32x4*)d7)[lane + 64 * j]; ((f32x4*)x2r)[lane + 64 * j] = v; ((f32x4*)yr)[lane + 64 * j] = v; s += (v[0] * v[0] + v[1] * v[1]) + (v[2] * v[2] + v[3] * v[3]); }
    s = wave_sum(s);
    if (lane == 0) ((float*)(F.ws + WS_SSQ2))[r] = s;
}
__device__ __forceinline__ void memkv_post_row(const Frame& F, int row) {
    const int lane = F.lane; const float* raw = (const float*)(F.ws + WS_MEMRAW) + (size_t)row * 512;
    const float iv = pg8::row_inv_from_parts((const float*)(F.ws + WS_SSQM), row);
    const int b_ = row >> 8, n_ = row & 255;
    { const int j = 4 * lane, h = j >> 6, d = j & 63;
      const f32x4 v = *(const f32x4*)(raw + 128 * (d >> 5) + 32 * h + (d & 31)) * iv;
      float q = (v[0] * v[0] + v[1] * v[1]) + (v[2] * v[2] + v[3] * v[3]);
      q += __shfl_xor(q, 1); q += __shfl_xor(q, 2); q += __shfl_xor(q, 4); q += __shfl_xor(q, 8);
      const f32x4 o = v * __builtin_amdgcn_rsqf(q * (1.0f / 64.0f) + EPS) * *(const f32x4*)(F.in[29] + d);
      *(f32x4*)(F.out + O_MKP + (size_t)row * 256 + j) = o;
      v2u w; w.x = cvt_pk_bf16(o[0], o[1]); w.y = cvt_pk_bf16(o[2], o[3]); *(v2u*)((bf16*)(F.ws + WS_MEMK) + ((size_t)(b_ * 4 + h) * 256 + n_) * 64 + d) = w; }
    { const int j = 4 * lane, h = j >> 6, d = j & 63;
      const f32x4 o = *(const f32x4*)(raw + 256 + j) * iv;
      *(f32x4*)(F.out + O_MVP + (size_t)row * 256 + j) = o;
      v2u w; w.x = cvt_pk_bf16(o[0], o[1]); w.y = cvt_pk_bf16(o[2], o[3]); *(v2u*)((bf16*)(F.ws + WS_MEMV) + ((size_t)(b_ * 4 + h) * 256 + n_) * 64 + d) = w; }
}
#if DBG_ORACLE
__device__ __forceinline__ void dbg_phase(const Frame& F);
__device__ __forceinline__ void dbg_report(const Frame& F, unsigned* barw);
#endif
#ifndef KD_G1
#define KD_G1 1
#endif
#ifndef KD_G2
#define KD_G2 1
#endif
#ifndef REP_X
#define REP_X 1
#endif
#ifndef ALIGN_SWIGLU
#define ALIGN_SWIGLU true
#endif
#ifndef STREAM_PROBE
#define STREAM_PROBE 0
#endif
#ifndef REP_DEC
#define REP_DEC 1
#endif
#ifndef REP_MLA
#define REP_MLA 1
#endif
#ifndef REP_GA
#define REP_GA 1
#endif
#ifndef REP_GB
#define REP_GB 1
#endif
#ifndef REP_GC
#define REP_GC 1
#endif
#define P_BF(off) ((bf16*)(F.ws + (off)))
#define P_F32(off) ((float*)(F.ws + (off)))
#define W1GU P_BF(WS_W1GU)
#define W1D P_BF(WS_W1D)
#define WIN P_BF(WS_WIN)
#define WUQ P_BF(WS_WUQ)
#define WKV P_BF(WS_WKV)
#define WO P_BF(WS_WO)
#define W2GU P_BF(WS_W2GU)
#define W2D P_BF(WS_W2D)
#define WMEM P_BF(WS_WMEM)
#define rope P_F32(WS_ROPE)
#define ssq0 P_F32(WS_SSQ0)
#define ssq1 P_F32(WS_SSQ1)
#define ssq2 P_F32(WS_SSQ2)
#define msq P_F32(WS_MSQ)
#define ssqm P_F32(WS_SSQM)
#define xb P_BF(WS_XB)
#define act1 P_BF(WS_ACT1)
#define act2 P_BF(WS_ACT2)
#define x1f P_F32(WS_X1F)
#define x1b P_BF(WS_X1B)
#define x2f P_F32(WS_X2F)
#define x2b P_BF(WS_X2B)
#define cqb P_BF(WS_CQB)
#define ckvb P_BF(WS_CKVB)
#define krb P_BF(WS_KRB)
#define ub P_BF(WS_UB)
#define gbb P_BF(WS_GBB)
#define mqb P_BF(WS_MQB)
#define qb P_BF(WS_QB)
#define Kb P_BF(WS_KB)
#define Vb P_BF(WS_VB)
#define memb P_BF(WS_MEMB)
#define memK P_BF(WS_MEMK)
#define memV P_BF(WS_MEMV)
#define oab P_BF(WS_OAB)
#define omb P_BF(WS_OMB)
#define omix P_BF(WS_OMIX)
__global__ void __launch_bounds__(NWAVES * 64, 2) mk_fwd(Args args) {
    extern __shared__ __attribute__((aligned(16))) unsigned char lds_raw[];
    Frame F;
    F.lds = (LAS unsigned char*)lds_raw;
    F.wave = __builtin_amdgcn_readfirstlane((int)threadIdx.x >> 6);
    F.G = gridDim.x; { const int bx = blockIdx.x; F.vcu = (F.G % 8 == 0) ? (bx % 8) * (F.G / 8) + bx / 8 : bx; }
#define PHASE_BEGIN() do { const CAS Args* ka_ = (const CAS Args*)__builtin_amdgcn_kernarg_segment_ptr(); asm volatile("" : "+s"(ka_)); F.in = (InTab)ka_->in; F.out = ka_->out; F.ws = ka_->ws; \
        int t_ = threadIdx.x; asm volatile("" : "+v"(t_)); F.tid = t_; F.lane = t_ & 63; } while (0)
    PHASE_BEGIN();
    for (int u = F.tid; u < (LDS_BYTES - LDSCTL_OFF) / 4; u += NWAVES * 64) ((LAS unsigned*)(F.lds + LDSCTL_OFF))[u] = 0u;
    __syncthreads();
    XcdBarrier bar = xcd_barrier_post((unsigned*)(F.ws + WS_CTL) + CW_BAR, (volatile LAS unsigned*)(F.lds + MISC_OFF) + 8);
    const int lo = args.ph_lo, hi = args.ph_hi;
#ifndef PH_MASK
#define PH_MASK 0xFFFF
#endif
#define IN(k) (((PH_MASK >> (k)) & 1) && lo <= (k) && (k) < hi)
#if TS_BUILD
#define TS_MARK(k) do { if (blockIdx.x == 0 && threadIdx.x == 0) ((unsigned long long*)(F.ws + WS_DBG))[(k)] = __builtin_amdgcn_s_memrealtime(); } while (0)
#else
#define TS_MARK(k) do {} while (0)
#endif
#define SEAM(k) do { if (IN(k) && IN((k) + 1)) xcd_barrier(bar); TS_MARK((k) + 1); } while (0)
    const int bx = (int)blockIdx.x;

#define GU1S P_F32(WS_GU1S)
#define GU2S P_F32(WS_GU2S)
#define D1S P_F32(WS_D1S)
#define D7S P_F32(WS_D7S)
#define ZS P_F32(WS_ZS)
#define QS P_F32(WS_QS)
    TS_MARK(0);
#ifndef REP_P0
#define REP_P0 1
#endif
    if (IN(0)) { PHASE_BEGIN(); for (int rep_ = 0; rep_ < REP_P0; ++rep_) p0_prologue(F); }
    SEAM(0);
    if (IN(1)) { PHASE_BEGIN();
        mini_gemm<256, ABf16, 2>(F, ABf16{xb + (size_t)NTOK * D, D}, W1GU, D, FF2, F.vcu, GU1S, FF2, 1.0f);
        { pg8::Gemm g{xb, W1GU, NTOK, FF2, D}; pg8::StaticOrder S; S.init(NTOK, FF2, F.G, bx);
          pg8::EpiSwiGLU E{ssq0, act1, FF};
#ifndef REP_G1
#define REP_G1 1
#endif
          for (int rep_ = 0; rep_ < REP_G1; ++rep_)
          pg8::gemm_phase<pg8::EpiSwiGLU, pg8::StaticOrder, ALIGN_SWIGLU, true, false, KD_G1>(F.lds, g, S, E); }
    }
    SEAM(1);
    if (IN(2)) { PHASE_BEGIN();
        mini_gemm<176>(F, ASilu{GU1S, ssq0}, W1D, FF, D, F.vcu, D1S, D, 1.0f);
        for (int rb = 0; rb < 8; ++rb)
            mini_gemm<256>(F, ABf16{memb + (size_t)rb * 128 * D, D}, WMEM, D, 512, (F.vcu + F.G - 32 * rb) % F.G, P_F32(WS_MEMRAW) + (size_t)rb * 128 * 512, 512, 1.0f);
        { pg8::Gemm g{act1, W1D, NTOK, D, FF}; pg8::StaticOrder S; S.init(NTOK, D, F.G, bx);
          pg8::EpiResid<false> E{F.in[0], nullptr, x1b, ssq1, 0.5f};
          for (int rep_ = 0; rep_ < REP_GA; ++rep_)
          pg8::gemm_phase<pg8::EpiResid<false>, pg8::StaticOrder, true, true, true, KD_G2>(F.lds, g, S, E); }
    }
    SEAM(2);
    if (IN(3)) { PHASE_BEGIN();
        if (F.G == 256) { if (F.vcu >= 192) for (int r = (F.vcu - 192) * NWAVES + F.wave; r < 1024; r += 64 * NWAVES) memkv_post_row(F, r); }
        else { const int gw = F.vcu * NWAVES + F.wave, NGW = F.G * NWAVES; for (int r = gw; r < 1024; r += NGW) memkv_post_row(F, r); }
        mini_gemm<128>(F, ASum{F.in[2], D1S, 0.5f}, WIN, D, INWP, F.vcu, ZS, INWP, 1.0f);
        { pg8::Gemm g{x1b, WIN, NTOK, INWP, D}; pg8::StaticOrder S; S.init(NTOK, INWP, F.G, bx);
          pg8::EpiZ E{ssq1, (LAS float*)(F.lds + XCH_OFF), msq, cqb, F.in[19], F.in[23], F.in[28], rope,
                      F.out + O_CKVP, F.out + O_CKVS, F.out + O_KRP, F.out + O_KRS, F.out + O_CONVP, F.out + O_CONVS, ckvb, krb, Kb, ub, gbb, mqb};
          for (int rep_ = 0; rep_ < REP_GB; ++rep_)
          pg8::gemm_phase<pg8::EpiZ, pg8::StaticOrder, true, true>(F.lds, g, S, E); }
    }
    SEAM(3);
    if (IN(4)) { PHASE_BEGIN();
        for (int rep_ = 0; rep_ < REP_X; ++rep_)
        {
            if (F.G == 256) { if (bx >= 128 && F.wave == 0) postz_sample_row(F, bx - 128); }
            else if (F.wave == 0) for (int b = F.vcu; b < NS; b += F.G) postz_sample_row(F, b); }
        { pg8::Gemm g{cqb, WUQ, NTOK, 768, 256}; pg8::StaticOrder S; S.init(NTOK, 768, F.G, bx);
          pg8::EpiQ E{msq, F.in[17], F.in[18], rope, qb};
          pg8::gemm_phase<pg8::EpiQ, pg8::StaticOrder, true, true>(F.lds, g, S, E); }
        { pg8::Gemm g{ckvb, WKV, NTOK, 1024, 128}; pg8::StaticOrder S; S.init(NTOK, 1024, F.G, bx);
          pg8::EpiKV E{F.in[22], Kb, Vb};
          pg8::gemm_phase<pg8::EpiKV, pg8::StaticOrder, true, true>(F.lds, g, S, E); }
    }
    SEAM(4);
    if (IN(5)) { PHASE_BEGIN();
        mini_gemm<128>(F, ABf16{cqb + (size_t)NTOK * 256, 256}, WUQ, 256, 768, F.vcu, QS, 768, 1.0f);
        for (int rep_ = 0; rep_ < REP_MLA; ++rep_) {
            auto mla_unit = [&](int i, int& bh, int& qblk) -> bool {
                if (F.G == 256) { if (i >= 4) return false; const int s = F.vcu & 7; bh = F.vcu >> 3; qblk = (i == 0) ? s : (i == 1) ? 15 - s : (i == 2) ? 16 + s : 31 - s; return true; }
                const int u = F.vcu + i * F.G; if (u >= 1024) return false; bh = u >> 5; qblk = u & 31; return true; };
            bf16x8 qr[6]; bool primed = false;
            for (int i = 0;; ++i) {
                int bh, qblk, nbh = 0, nqblk = 0;
                if (!mla_unit(i, bh, qblk)) break;
                const bool hn = AT_XPRE && mla_unit(i + 1, nbh, nqblk);
                const int b = bh >> 3, h = bh & 7; const size_t row0 = (size_t)b * SEQ + (size_t)qblk * 256;
                const int nb = nbh >> 3, nh = nbh & 7; const size_t nrow0 = (size_t)nb * SEQ + (size_t)nqblk * 256;
                attn_unit_simple<96, true>(qb + row0 * 768 + h * 96, 768, Kb + (size_t)bh * SEQ * 64, krb + (size_t)b * SEQ * 32, Vb + (size_t)bh * SEQ * 64, oab + row0 * 512 + h * 64, 512, 4 * (qblk + 1), F.lds,
                                           qr, primed, hn ? qb + nrow0 * 768 + nh * 96 : nullptr, Kb + (size_t)nbh * SEQ * 64, krb + (size_t)nb * SEQ * 32, Vb + (size_t)nbh * SEQ * 64, 4 * (nqblk + 1));
                primed = hn;
            }
        }
        for (int rep_ = 0; rep_ < REP_X; ++rep_) {
            bf16x8 qr[4]; bool primed = false;
            for (int u = F.vcu; u < 512; u += F.G) {
                const int b = u >> 7, h = (u >> 5) & 3, qblk = u & 31; const size_t row0 = (size_t)b * SEQ + (size_t)qblk * 256;
                const int nu = u + F.G; const bool hn = AT_XPRE && nu < 512;
                const int nb = nu >> 7, nh = (nu >> 5) & 3, nqblk = nu & 31; const size_t nrow0 = (size_t)nb * SEQ + (size_t)nqblk * 256;
                attn_unit_simple<64, false>(mqb + row0 * 256 + h * 64, 256, memK + (size_t)(b * 4 + h) * 256 * 64, nullptr, memV + (size_t)(b * 4 + h) * 256 * 64, omb + row0 * 256 + h * 64, 256, 4, F.lds,
                                            qr, primed, hn ? mqb + nrow0 * 256 + nh * 64 : nullptr, memK + (size_t)(nb * 4 + nh) * 256 * 64, nullptr, memV + (size_t)(nb * 4 + nh) * 256 * 64, 4);
                primed = hn;
            }
        }
        __syncthreads();
    }
    SEAM(5);
    if (IN(6)) { PHASE_BEGIN();
        for (int rep_ = 0; rep_ < REP_DEC; ++rep_)
        for (int it = F.vcu; it < 2 * NS; it += F.G) decode_item(F, it >> 1, it & 1);
#if STREAM_PROBE
        {
          f32x4 accp = (f32x4){0.f, 0.f, 0.f, 0.f};
          for (int it = F.vcu; it < 2 * NS; it += F.G) { const int b = it >> 1, half = it & 1; const int* ptab = (const int*)F.in[5] + b * NPAGES + half * 64;
              for (int pg = 0; pg < 64; ++pg) { const int page = __builtin_amdgcn_readfirstlane(ptab[pg]); const float* ck = F.in[3] + (size_t)page * (PAGE * 128); const float* kr = F.in[4] + (size_t)page * (PAGE * 32);
#pragma unroll
                  for (int j = 0; j < 8; ++j) accp = accp + *(const f32x4*)((const char*)(ck + 2048 * j) + (unsigned)F.tid * 16u);
#pragma unroll
                  for (int j = 0; j < 2; ++j) accp = accp + *(const f32x4*)((const char*)(kr + 2048 * j) + (unsigned)F.tid * 16u); } }
          ((f32x4*)(F.ws + WS_DBG))[F.vcu * 512 + F.tid] = accp; }
#endif
        __syncthreads();
        for (int rep_ = 0; rep_ < REP_X; ++rep_) tp_phase(F);
    }
    SEAM(6);
    if (IN(7)) { PHASE_BEGIN();
        for (int rep_ = 0; rep_ < REP_X; ++rep_)
        if (F.G == 256) tp_sample_wg(F, F.vcu & 127, F.vcu < 128 ? 1 : 2);
        else for (int b = F.vcu; b < NS; b += F.G) tp_sample_wg(F, b);
        __syncthreads();
        { pg8::Gemm g{omix, WO, NTOK, D, D}; pg8::StaticOrder S; S.init(NTOK, D, F.G, (bx + 128) % F.G);
          pg8::EpiResid<true> E{x1b, nullptr, x2b, ssq2, 1.0f};
          for (int rep_ = 0; rep_ < REP_GC; ++rep_)
          pg8::gemm_phase<pg8::EpiResid<true>, pg8::StaticOrder, true, true>(F.lds, g, S, E); }
    }
    SEAM(7);
    if (IN(8)) { PHASE_BEGIN();
        mini_gemm<128>(F, ABf16{omix + (size_t)NTOK * D, D}, WO, D, D, F.vcu, D7S, D, 1.0f);
        { pg8::Gemm g{x2b, W2GU, NTOK, FF2, D}; pg8::StaticOrder S; S.init(NTOK, FF2, F.G, bx);
          pg8::EpiSwiGLU E{ssq2, act2, FF};
          pg8::gemm_phase<pg8::EpiSwiGLU, pg8::StaticOrder, ALIGN_SWIGLU, true>(F.lds, g, S, E); }
    }
    SEAM(8);
    if (IN(9)) { PHASE_BEGIN();
        if (F.G == 256) { if (F.vcu >= 176 && F.wave < 2) { const int b = (F.vcu - 176) * 2 + F.wave; if (b < NS) x2_sample_row(F, b); } }
        else if (F.wave == 0) for (int b = F.vcu; b < NS; b += F.G) x2_sample_row(F, b);
        mini_gemm<256, ASum, 2>(F, ASum{x1f + (size_t)NTOK * D, D7S, 1.0f}, W2GU, D, FF2, F.vcu, GU2S, FF2, 1.0f);
        { pg8::Gemm g{act2, W2D, NTOK, D, FF}; pg8::StaticOrder S; S.init(NTOK, D, F.G, bx);
          pg8::EpiResid<true, true> E{x2b, F.out + O_Y, nullptr, nullptr, 0.5f};
          pg8::gemm_phase<pg8::EpiResid<true, true>, pg8::StaticOrder, true, true, true>(F.lds, g, S, E); }
    }
    SEAM(9);
    if (IN(10)) { PHASE_BEGIN();
        mini_gemm<176>(F, ASilu{GU2S, ssq2}, W2D, FF, D, F.vcu, F.out + O_YS, D, 0.5f);
    }
#if TS_BUILD
    { xcd_barrier(bar); PHASE_BEGIN();
      if (blockIdx.x == 0 && F.tid == 0) { const unsigned long long* ts = (const unsigned long long*)(F.ws + WS_DBG); const unsigned long long tend = __builtin_amdgcn_s_memrealtime();
        const float dA = (float)((TS_A == 10 ? tend : ts[TS_A + 1]) - ts[TS_A]) * 0.01f, dB = (float)((TS_B == 10 ? tend : ts[TS_B + 1]) - ts[TS_B]) * 0.01f;
        { const float x = dA * 0.01f; const int e = (int)x; float p10 = 1000.f; for (int i = 0; i < e; ++i) p10 *= 10.f; F.out[0] = (1.0f + 9.0f * (x - (float)e)) * p10; }
        (void)dB;
      } }
#endif
#if DBG_ORACLE
    if (IN(10)) { xcd_barrier(bar); PHASE_BEGIN(); dbg_phase(F); xcd_barrier(bar); PHASE_BEGIN(); dbg_report(F, (unsigned*)(F.ws + WS_CTL) + CW_BAR); }
#endif
#undef IN
#undef SEAM
#undef PHASE_BEGIN
}
#undef W1GU
#undef W1D
#undef WIN
#undef WUQ
#undef WKV
#undef WO
#undef W2GU
#undef W2D
#undef WMEM
#undef rope
#undef ssq0
#undef ssq1
#undef ssq2
#undef msq
#undef ssqm
#undef xb
#undef act1
#undef act2
#undef x1f
#undef x1b
#undef x2f
#undef x2b
#undef cqb
#undef ckvb
#undef krb
#undef ub
#undef gbb
#undef mqb
#undef qb
#undef Kb
#undef Vb
#undef memb
#undef memK
#undef memV
#undef oab
#undef omb
#undef omix
#undef P_BF
#undef P_F32

extern "C" void kernel_launch(void* const* d_in, const int* in_sizes, int n_in, void* d_out, int out_size, void* d_ws, size_t ws_size, hipStream_t stream) {
    static int grid = 0;
    if (grid == 0) {
        if (n_in != 38 || (size_t)out_size != O_TOTAL || ws_size < WS_END) { fprintf(stderr, "kernel_launch: unexpected shapes (n_in %d, out %d, ws %zu)\n", n_in, out_size, ws_size); grid = -1; return; }
        int dev = 0, cus = 0, per_cu = 0;
        if (hipGetDevice(&dev) != hipSuccess || hipDeviceGetAttribute(&cus, hipDeviceAttributeMultiprocessorCount, dev) != hipSuccess) { grid = -1; return; }
        if (hipFuncSetAttribute((const void*)mk_fwd, hipFuncAttributeMaxDynamicSharedMemorySize, LDS_BYTES) != hipSuccess) { fprintf(stderr, "kernel_launch: hipFuncSetAttribute failed\n"); grid = -1; return; }
        if (hipOccupancyMaxActiveBlocksPerMultiprocessor(&per_cu, (const void*)mk_fwd, NWAVES * 64, LDS_BYTES) != hipSuccess || per_cu < 1) { fprintf(stderr, "kernel_launch: occupancy query says %d\n", per_cu); }
        (void)hipGetLastError();
        grid = cus;
    }
    if (grid < 0) return;
    (void)hipMemsetAsync((char*)d_ws + WS_CTL, 0, CTL_ZERO_BYTES, stream);
#if DBG_ORACLE
    (void)hipMemsetAsync((char*)d_ws + WS_DBG, 0, 1 * MiB, stream);
#endif
    Args a{};
    for (int i = 0; i < 38; ++i) a.in[i] = (const float*)d_in[i];
    a.out = (float*)d_out; a.ws = (unsigned char*)d_ws;
    a.ph_lo = 0; a.ph_hi = 11;
    hipLaunchKernelGGL(mk_fwd, dim3(grid), dim3(NWAVES * 64), LDS_BYTES, stream, a);
}
```
